# Optimizing an MI355X kernel written in HIP

```python
import math
import jax, jax.numpy as jnp
from jax import lax
import numpy as np

D_MODEL = 1024
BATCH = 2
SEQ = 8192
DEPTH = 2

GRID_W = 64
CTX_LEN = 256
EPS = 1e-6

CONV_WIDTH = 512
CONV_K = 3
DA_HEADS = 4
DA_HEAD_DIM = 64
DA_V_DIM = 2 * DA_HEAD_DIM
DA_WIDTH = DA_HEADS * DA_V_DIM
EVEN_IN = 3 * CONV_WIDTH + 3 * DA_WIDTH
EVEN_MIX = CONV_WIDTH + DA_WIDTH
Q_BLOCK = 128
ROPE_BASE = 10000.0

LRU_WIDTH = 1024
LRU_BLOCKS = 8
LRU_BLOCK = LRU_WIDTH // LRU_BLOCKS
LRU_CONV_K = 4
LRU_C = 8.0

N_GROUPS = 4
EXPERTS_PER_GROUP = 4
N_EXPERTS = N_GROUPS * EXPERTS_PER_GROUP
D_EXPERT = 512
TOP_K = 2

N_EVEN = (DEPTH + 1) // 2
N_ODD = DEPTH // 2

kernel_name = "hybrid_conv_diffattn_rglru_hmoe_dit"


def rms_norm(x, g):
    xf = x.astype(jnp.float32)
    y = xf * lax.rsqrt(jnp.mean(xf * xf, axis=-1, keepdims=True) + EPS)
    return (y * g.astype(jnp.float32)).astype(x.dtype)


def modulate(h, shift, scale):
    return h * (1.0 + scale) + shift


def axial_rope(n_rows):
    rows = jnp.repeat(jnp.arange(n_rows), GRID_W).astype(jnp.float32)
    cols = jnp.tile(jnp.arange(GRID_W), n_rows).astype(jnp.float32)
    n_freq = DA_HEAD_DIM // 4
    inv = ROPE_BASE ** (-jnp.arange(n_freq, dtype=jnp.float32) / n_freq)
    ang = jnp.concatenate([rows[:, None] * inv, cols[:, None] * inv], axis=-1)
    return jnp.cos(ang), jnp.sin(ang)


def apply_rope(t, cos, sin):
    half = t.shape[-1] // 2
    tf = t.astype(jnp.float32)
    t1, t2 = tf[..., :half], tf[..., half:]
    cs = cos[None, :, None, None, :]
    sn = sin[None, :, None, None, :]
    return jnp.concatenate([t1 * cs - t2 * sn, t2 * cs + t1 * sn], axis=-1).astype(t.dtype)


def depthwise_conv(u, w, b, pad_left, pad_right):
    n = u.shape[1]
    up = jnp.pad(u, ((0, 0), (pad_left, pad_right), (0, 0)))
    y = b
    for k in range(w.shape[0]):
        y = y + up[:, k:k + n] * w[k]
    return y


def diff_attn(q, k, v, lam):
    s = jnp.einsum('bhmqd,bhmkd->bhmqk', q, k, preferred_element_type=jnp.float32) * (DA_HEAD_DIM ** -0.5)
    p = jax.nn.softmax(s, axis=-1)
    w = p[:, :, 0] - lam * p[:, :, 1]
    return jnp.einsum('bhqk,bhkv->bhqv', w, v.astype(jnp.float32)).astype(v.dtype)


def even_mixer(h_lat, h_ctx, w_in, conv_w, conv_b, q_norm, k_norm, lq1, lk1, lq2, lk2,
               sub_norm, w_out, lam_init, cos, sin, with_ctx):
    bsz, n = h_lat.shape[:2]
    c_len = h_ctx.shape[1]
    kv_col = 3 * CONV_WIDTH + DA_WIDTH

    def to_heads_qk(t, g, m):
        return rms_norm(t.reshape(bsz, m, DA_HEADS, 2, DA_HEAD_DIM), g)

    def to_heads_v(t, m):
        return t.reshape(bsz, m, DA_HEADS, DA_V_DIM).transpose(0, 2, 1, 3)

    lam = (jnp.exp(jnp.sum(lq1.astype(jnp.float32) * lk1.astype(jnp.float32)))
           - jnp.exp(jnp.sum(lq2.astype(jnp.float32) * lk2.astype(jnp.float32))) + lam_init)

    z = h_lat @ w_in
    cb, cc, cx, q, k, v = jnp.split(z, 6, axis=-1)
    q_l = apply_rope(to_heads_qk(q, q_norm, n), cos, sin).transpose(0, 2, 3, 1, 4)
    k_l = apply_rope(to_heads_qk(k, k_norm, n), cos, sin).transpose(0, 2, 3, 1, 4)
    v_l = to_heads_v(v, n)

    if with_ctx:
        zc = h_ctx @ w_in
        ccb, ccc, ccx, qc, kc, vc = jnp.split(zc, 6, axis=-1)
    else:
        kc, vc = jnp.split(h_ctx @ w_in[:, kv_col:], 2, axis=-1)
    k_c = to_heads_qk(kc, k_norm, c_len).transpose(0, 2, 3, 1, 4)
    v_c = to_heads_v(vc, c_len)

    out_a = cb * depthwise_conv(cc * cx, conv_w, conv_b, 1, 1)

    k_all = jnp.concatenate([k_l, k_c], axis=3)
    v_all = jnp.concatenate([v_l, v_c], axis=2)
    nb = n // Q_BLOCK
    qb = q_l.reshape(bsz, DA_HEADS, 2, nb, Q_BLOCK, DA_HEAD_DIM).transpose(3, 0, 1, 2, 4, 5)
    o = lax.map(lambda q_blk: diff_attn(q_blk, k_all, v_all, lam), qb)
    o = o.transpose(1, 0, 3, 2, 4).reshape(bsz, n, DA_HEADS, DA_V_DIM)
    out_b = (rms_norm(o, sub_norm) * (1.0 - lam_init)).reshape(bsz, n, DA_WIDTH)
    y_lat = jnp.concatenate([out_a, out_b], axis=-1) @ w_out

    if not with_ctx:
        return y_lat, None
    out_ac = ccb * depthwise_conv(ccc * ccx, conv_w, conv_b, 1, 1)
    q_c = to_heads_qk(qc, q_norm, c_len).transpose(0, 2, 3, 1, 4)
    oc = diff_attn(q_c, k_c, v_c, lam).transpose(0, 2, 1, 3)
    out_bc = (rms_norm(oc, sub_norm) * (1.0 - lam_init)).reshape(bsz, c_len, DA_WIDTH)
    y_ctx = jnp.concatenate([out_ac, out_bc], axis=-1) @ w_out
    return y_lat, y_ctx


def block_diag(u, w, b):
    ub = u.reshape(u.shape[:-1] + (LRU_BLOCKS, LRU_BLOCK))
    return jnp.einsum('bshi,hij->bshj', ub, w).reshape(u.shape) + b


def scan_from(a, b, h0, reverse):
    def combine(e1, e2):
        a1, b1 = e1
        a2, b2 = e2
        return a1 * a2, a2 * b1 + b2
    a_cum, b_cum = lax.associative_scan(combine, (a, b), reverse=reverse, axis=1)
    return a_cum * h0[:, None, :] + b_cum


def rglru_direction(u_lat, u_ctx, conv_w, conv_b, w_a, b_a, w_x, b_x, lam, reverse):
    pads = (0, LRU_CONV_K - 1) if reverse else (LRU_CONV_K - 1, 0)

    def coeffs(u):
        uc = depthwise_conv(u, conv_w, conv_b, pads[0], pads[1]).astype(jnp.float32)
        r = jax.nn.sigmoid(block_diag(uc, w_a.astype(jnp.float32), b_a.astype(jnp.float32)))
        i = jax.nn.sigmoid(block_diag(uc, w_x.astype(jnp.float32), b_x.astype(jnp.float32)))
        log_a = -LRU_C * r * jax.nn.softplus(-lam.astype(jnp.float32))
        return jnp.exp(log_a), jnp.sqrt(-jnp.expm1(2.0 * log_a)) * (i * uc)

    a_c, b_c = coeffs(u_ctx)
    h_ctx = scan_from(a_c, b_c, jnp.zeros((u_ctx.shape[0], LRU_WIDTH), jnp.float32), reverse)
    h0 = h_ctx[:, 0] if reverse else h_ctx[:, -1]
    a_l, b_l = coeffs(u_lat)
    h_lat = scan_from(a_l, b_l, h0, reverse)
    return h_lat, h_ctx


def odd_mixer(h_lat, h_ctx, w_in, conv_w, conv_b, w_a, b_a, w_x, b_x, lam, w_out, with_ctx):
    z = h_lat @ w_in
    y_l = jax.nn.gelu(z[..., :LRU_WIDTH], approximate=True)
    u_l = z[..., LRU_WIDTH:]
    if with_ctx:
        zc = h_ctx @ w_in
        y_c = jax.nn.gelu(zc[..., :LRU_WIDTH], approximate=True)
        u_c = zc[..., LRU_WIDTH:]
    else:
        u_c = h_ctx @ w_in[:, LRU_WIDTH:]
    hf_l, hf_c = rglru_direction(u_l, u_c, conv_w[0], conv_b[0], w_a[0], b_a[0], w_x[0], b_x[0], lam[0], False)
    hb_l, hb_c = rglru_direction(u_l, u_c, conv_w[1], conv_b[1], w_a[1], b_a[1], w_x[1], b_x[1], lam[1], True)
    y_lat = (y_l * (hf_l + hb_l).astype(y_l.dtype)) @ w_out
    if not with_ctx:
        return y_lat, None
    y_ctx = (y_c * (hf_c + hb_c).astype(y_c.dtype)) @ w_out
    return y_lat, y_ctx


def hier_moe(h, w_grp, b_grp, w_rt, b_rt, w_gate, w_up, w_down):
    f32 = jnp.float32
    g_logit = jnp.einsum('bsd,dg->bsg', h, w_grp, preferred_element_type=f32) + b_grp.astype(f32)
    p_grp = jax.nn.softmax(g_logit, axis=-1)
    g_idx = jnp.argmax(g_logit, axis=-1)
    p_sel = jnp.max(p_grp, axis=-1, keepdims=True)
    e_logit = jnp.einsum('bsd,dge->bsge', h, w_rt, preferred_element_type=f32) + b_rt.astype(f32)
    e_sel = jnp.einsum('bsge,bsg->bse', e_logit, jax.nn.one_hot(g_idx, N_GROUPS, dtype=f32))
    top_v, top_i = lax.top_k(e_sel, TOP_K)
    w_sel = jax.nn.softmax(top_v, axis=-1) * p_sel
    eid = g_idx[..., None] * EXPERTS_PER_GROUP + top_i
    gate = jnp.sum(jax.nn.one_hot(eid, N_EXPERTS, dtype=f32) * w_sel[..., None], axis=-2)
    hg = jnp.einsum('bsd,edf->bsef', h, w_gate)
    hu = jnp.einsum('bsd,edf->bsef', h, w_up)
    act = jax.nn.silu(hg) * hu * gate[..., None].astype(h.dtype)
    return jnp.einsum('bsef,efd->bsd', act, w_down)


def setup_inputs(seed: int = 0) -> dict:
    key = jax.random.key(seed)
    ks = iter(jax.random.split(key, 64))
    D = D_MODEL

    def nrm(shape, scale):
        return jax.random.normal(next(ks), shape, jnp.float32) * scale

    def gain(shape):
        return 1.0 + nrm(shape, 0.02)

    u = jax.random.uniform(next(ks), (N_ODD, 2, LRU_WIDTH), jnp.float32, minval=0.9, maxval=0.999)
    s = u ** (1.0 / LRU_C)
    od_lam = jnp.log(s) - jnp.log1p(-s)
    return {
        "x": nrm((BATCH, SEQ, D), 1.0),
        "c": nrm((BATCH, D), 1.0),
        "ctx": nrm((BATCH, CTX_LEN, D), 1.0),
        "c_ctx": nrm((D,), 1.0),
        "ada_w": nrm((DEPTH, D, 6 * D), 0.5 * D ** -0.5),
        "ada_b": nrm((DEPTH, 6 * D), 0.02),
        "norm_mix": gain((DEPTH, D)),
        "norm_ffn": gain((DEPTH, D)),
        "ev_w_in": nrm((N_EVEN, D, EVEN_IN), D ** -0.5),
        "ev_conv_w": nrm((N_EVEN, CONV_K, CONV_WIDTH), CONV_K ** -0.5),
        "ev_conv_b": nrm((N_EVEN, CONV_WIDTH), 0.02),
        "ev_q_norm": gain((N_EVEN, DA_HEAD_DIM)),
        "ev_k_norm": gain((N_EVEN, DA_HEAD_DIM)),
        "ev_lam_q1": nrm((N_EVEN, DA_HEAD_DIM), 0.1),
        "ev_lam_k1": nrm((N_EVEN, DA_HEAD_DIM), 0.1),
        "ev_lam_q2": nrm((N_EVEN, DA_HEAD_DIM), 0.1),
        "ev_lam_k2": nrm((N_EVEN, DA_HEAD_DIM), 0.1),
        "ev_sub_norm": gain((N_EVEN, DA_V_DIM)),
        "ev_w_out": nrm((N_EVEN, EVEN_MIX, D), EVEN_MIX ** -0.5),
        "od_w_in": nrm((N_ODD, D, 2 * LRU_WIDTH), D ** -0.5),
        "od_conv_w": nrm((N_ODD, 2, LRU_CONV_K, LRU_WIDTH), LRU_CONV_K ** -0.5),
        "od_conv_b": nrm((N_ODD, 2, LRU_WIDTH), 0.02),
        "od_w_a": nrm((N_ODD, 2, LRU_BLOCKS, LRU_BLOCK, LRU_BLOCK), LRU_BLOCK ** -0.5),
        "od_b_a": nrm((N_ODD, 2, LRU_WIDTH), 0.02),
        "od_w_x": nrm((N_ODD, 2, LRU_BLOCKS, LRU_BLOCK, LRU_BLOCK), LRU_BLOCK ** -0.5),
        "od_b_x": nrm((N_ODD, 2, LRU_WIDTH), 0.02),
        "od_lam": od_lam,
        "od_w_out": nrm((N_ODD, LRU_WIDTH, D), LRU_WIDTH ** -0.5),
        "moe_w_grp": nrm((DEPTH, D, N_GROUPS), D ** -0.5),
        "moe_b_grp": nrm((DEPTH, N_GROUPS), 0.01),
        "moe_w_rt": nrm((DEPTH, D, N_GROUPS, EXPERTS_PER_GROUP), D ** -0.5),
        "moe_b_rt": nrm((DEPTH, N_GROUPS, EXPERTS_PER_GROUP), 0.01),
        "moe_w_gate": nrm((DEPTH, N_EXPERTS, D, D_EXPERT), D ** -0.5),
        "moe_w_up": nrm((DEPTH, N_EXPERTS, D, D_EXPERT), D ** -0.5),
        "moe_w_down": nrm((DEPTH, N_EXPERTS, D_EXPERT, D), D_EXPERT ** -0.5),
    }


def reference(x, c, ctx, c_ctx, ada_w, ada_b, norm_mix, norm_ffn,
              ev_w_in, ev_conv_w, ev_conv_b, ev_q_norm, ev_k_norm,
              ev_lam_q1, ev_lam_k1, ev_lam_q2, ev_lam_k2, ev_sub_norm, ev_w_out,
              od_w_in, od_conv_w, od_conv_b, od_w_a, od_b_a, od_w_x, od_b_x, od_lam, od_w_out,
              moe_w_grp, moe_b_grp, moe_w_rt, moe_b_rt, moe_w_gate, moe_w_up, moe_w_down):
    n = x.shape[1]
    ROWS = n // GRID_W
    cos, sin = axial_rope(ROWS)
    for l in range(DEPTH):
        with_ctx = l < DEPTH - 1
        mod = jax.nn.silu(c) @ ada_w[l] + ada_b[l]
        mod_c = jax.nn.silu(c_ctx) @ ada_w[l] + ada_b[l]
        sh1, sc1, g1, sh2, sc2, g2 = jnp.split(mod[:, None, :], 6, axis=-1)
        csh1, csc1, cg1, csh2, csc2, cg2 = jnp.split(mod_c, 6, axis=-1)
        h = modulate(rms_norm(x, norm_mix[l]), sh1, sc1)
        hc = modulate(rms_norm(ctx, norm_mix[l]), csh1, csc1)
        j = l // 2
        if l % 2 == 0:
            lam_init = 0.8 - 0.6 * math.exp(-0.3 * l)
            y, yc = even_mixer(h, hc, ev_w_in[j], ev_conv_w[j], ev_conv_b[j], ev_q_norm[j], ev_k_norm[j],
                               ev_lam_q1[j], ev_lam_k1[j], ev_lam_q2[j], ev_lam_k2[j], ev_sub_norm[j],
                               ev_w_out[j], lam_init, cos, sin, with_ctx)
        else:
            y, yc = odd_mixer(h, hc, od_w_in[j], od_conv_w[j], od_conv_b[j], od_w_a[j], od_b_a[j],
                              od_w_x[j], od_b_x[j], od_lam[j], od_w_out[j], with_ctx)
        x = x + g1 * y
        hf = modulate(rms_norm(x, norm_ffn[l]), sh2, sc2)
        x = x + g2 * hier_moe(hf, moe_w_grp[l], moe_b_grp[l], moe_w_rt[l], moe_b_rt[l],
                              moe_w_gate[l], moe_w_up[l], moe_w_down[l])
        if with_ctx:
            ctx = ctx + cg1 * yc
            hfc = modulate(rms_norm(ctx, norm_ffn[l]), csh2, csc2)
            ctx = ctx + cg2 * hier_moe(hfc, moe_w_grp[l], moe_b_grp[l], moe_w_rt[l], moe_b_rt[l],
                                       moe_w_gate[l], moe_w_up[l], moe_w_down[l])
    return x
```

```cpp
#include <hip/hip_runtime.h>
#include <stdint.h>
#include <stdio.h>

#define DI __device__ __forceinline__
#define LAS __attribute__((address_space(3)))
typedef unsigned short u16;
typedef unsigned char uchar;
typedef short bf16x8 __attribute__((ext_vector_type(8)));
typedef float f32x16 __attribute__((ext_vector_type(16)));
typedef float f32x4 __attribute__((ext_vector_type(4)));
typedef float f32x2 __attribute__((ext_vector_type(2)));
typedef __bf16 bf2_t __attribute__((ext_vector_type(2)));
typedef unsigned u32x2 __attribute__((ext_vector_type(2)));
typedef unsigned u32x4 __attribute__((ext_vector_type(4)));

#ifndef N_LAUNCHES
#define N_LAUNCHES 1
#endif
#ifndef PROBE_GEMM2X
#define PROBE_GEMM2X 0
#endif
#ifndef PROBE_ROUTER2X
#define PROBE_ROUTER2X 0
#endif
#ifndef PROBE_REPS
#define PROBE_REPS 0x0000
#endif

DI unsigned pk2(float a, float b) { f32x2 v = {a, b}; bf2_t r = __builtin_convertvector(v, bf2_t); return __builtin_bit_cast(unsigned, r); }
DI u16 f2b(float a) { __bf16 r = (__bf16)a; return __builtin_bit_cast(u16, r); }
DI float b2f(u16 v) { return __uint_as_float(((unsigned)v) << 16); }
DI float blo(unsigned v) { return __uint_as_float(v << 16); }
DI float bhi(unsigned v) { return __uint_as_float(v & 0xffff0000u); }
#define MFMA32(a, b, c) __builtin_amdgcn_mfma_f32_32x32x16_bf16((a), (b), (c), 0, 0, 0)

constexpr int D = 1024, NL = 16384, NC = 512, R = 16896, SEQ = 8192, CTXL = 256, SK = 8448;
constexpr int NPH = 17;
constexpr float EPS = 1e-6f;
constexpr float LAM_INIT0 = 0.2f;
constexpr float QSCALE = 0.125f * 1.4426950408889634f;

enum { I_X = 0, I_C, I_CTX, I_CCTX, I_ADAW, I_ADAB, I_NMIX, I_NFFN, I_EVWIN, I_EVCW, I_EVCB, I_QN, I_KN, I_LQ1, I_LK1, I_LQ2, I_LK2, I_SUBN, I_EVWOUT,
       I_ODWIN, I_ODCW, I_ODCB, I_ODWA, I_ODBA, I_ODWX, I_ODBX, I_ODLAM, I_ODWOUT, I_MWGRP, I_MBGRP, I_MWRT, I_MBRT, I_MGATE, I_MUP, I_MDOWN, N_IN };

constexpr size_t al256(size_t x) { return (x + 255) & ~(size_t)255; }
constexpr size_t WS_CTL   = 0;
constexpr size_t CTL_BYTES = 65536;
constexpr size_t CTL_CNT  = 16384;
constexpr size_t WS_MOD   = WS_CTL + CTL_BYTES;
constexpr size_t WS_ROPE  = WS_MOD + al256(2 * 3 * 6144 * 4);
constexpr size_t WS_ROUTE = WS_ROPE + (size_t)SEQ * 32 * 8;
constexpr size_t WS_LIST  = WS_ROUTE + al256((size_t)R * 8);
constexpr size_t WS_SUMM  = WS_LIST + al256((size_t)24 * R * 4);
constexpr size_t WS_CARRY = WS_SUMM + (size_t)2 * 264 * 1024 * 8;
constexpr size_t WS_WIN0  = WS_CARRY + (size_t)2 * 256 * 1024 * 4;
constexpr size_t WS_WOUT0 = WS_WIN0 + (size_t)3072 * 1024 * 2;
constexpr size_t WS_WIN1  = WS_WOUT0 + (size_t)1024 * 1024 * 2;
constexpr size_t WS_WOUT1 = WS_WIN1 + (size_t)2048 * 1024 * 2;
constexpr size_t WS_WA    = WS_WOUT1 + (size_t)1024 * 1024 * 2;
constexpr size_t WS_WX    = WS_WA + (size_t)2 * 8 * 128 * 128 * 2;
constexpr size_t WS_WGU   = WS_WX + (size_t)2 * 8 * 128 * 128 * 2;
constexpr size_t WS_WD    = WS_WGU + (size_t)2 * 16 * 1024 * 1024 * 2;
constexpr size_t WS_XS    = WS_WD + (size_t)2 * 16 * 1024 * 512 * 2;
constexpr size_t WS_HB    = WS_XS + (size_t)R * 1024 * 4;
constexpr size_t WS_REGA  = WS_HB + (size_t)R * 1024 * 2;
constexpr size_t RA_ZC    = 0;
constexpr size_t RA_Q     = RA_ZC + (size_t)R * 1536 * 2;
constexpr size_t RA_K     = RA_Q + (size_t)16 * SK * 64 * 2;
constexpr size_t RA_VT    = RA_K + (size_t)16 * SK * 64 * 2;
constexpr size_t RA_END0  = RA_VT + (size_t)8 * 128 * SK * 2;
constexpr size_t RA_ACT   = 0;
constexpr size_t RA_Y     = 0;
constexpr size_t RA_U     = RA_Y + (size_t)NL * 1024 * 2;
constexpr size_t RA_BS0   = RA_U + (size_t)R * 1024 * 2;
constexpr size_t WS_OM1B  = WS_REGA + RA_END0;
constexpr size_t WS_END   = WS_OM1B + (size_t)128 * 4 * 32768;
static_assert(RA_BS0 + (size_t)256 * 4 * 8 * 1024 * 4 <= RA_END0 && (size_t)20480 * 1024 * 2 <= RA_END0, "region A overlays");
static_assert((size_t)256 * 4 * 8 * 1024 * 4 <= (size_t)16 * 1024 * 1024 * 2, "b of direction 1 fits layer 0's gate/up weights");
static_assert(WS_END <= 352000000ull, "workspace budget");

constexpr int LDS_BYTES = 147456 + 1024 + 1024;
constexpr int LDS_USER = 1024;

struct CvtJob { const float* src; u16* dst; int nmat, K, N, sstride, dstride, lddst, mode, half, tile0, pad; };
struct Params {
    const float* in[N_IN];
    float* out;
    uchar* ws;
    CvtJob jobs[9];
    int ncvt, ph_lo, ph_hi, pad;
};
struct Ctx { uchar* ws; float* out; const LAS unsigned long long* tab; };
typedef const __attribute__((address_space(1))) float* gcf_t;
DI const float* inp(const Ctx& c, int i) { return (const float*)(gcf_t)c.tab[i]; }

extern __shared__ __attribute__((aligned(16))) uchar smem[];
DI int hw_slot() { return (int)(__builtin_amdgcn_s_getreg(((6 - 1) << 11) | 4) & 63u); }
DI int tid_opaque() {
    const int lane = (int)__builtin_amdgcn_mbcnt_hi(~0u, __builtin_amdgcn_mbcnt_lo(~0u, 0u));
    int w = ((volatile LAS int*)smem)[96 + hw_slot()];
    w = __builtin_amdgcn_readfirstlane(w);
    int t = w * 64 + lane; asm volatile("" : "+v"(t)); return t;
}
#define XB_TMO      128
#define XB_XCNT(j)  (256  + 64 * (j))
#define XB_XSUB(j)  (1280 + 64 * (j))
#define XB_XGEN(j)  (2304 + 64 * (j))
#define XB_TOP      3328
#define XB_TOPGEN   3392
#define XCD_BAR_WORDS 3456
#define XB_SPIN_CAP (1u << 20)
DI unsigned xb_ld(unsigned* p)              { return __hip_atomic_load(p, __ATOMIC_RELAXED, __HIP_MEMORY_SCOPE_AGENT); }
DI unsigned xb_add(unsigned* p, unsigned v) { return __hip_atomic_fetch_add(p, v, __ATOMIC_RELAXED, __HIP_MEMORY_SCOPE_AGENT); }
DI unsigned xb_xcc_id() { return (unsigned)__builtin_amdgcn_s_getreg((3 << 11) | 20) & 0xFu; }
#define XB_SPIN(cond, bar) do { unsigned _sp = 0; while (cond) { __builtin_amdgcn_s_sleep(1); \
    if ((++_sp & 255u) == 0u) { if (xb_ld(&(bar)[XB_TMO])) break; if (_sp > XB_SPIN_CAP) { atomicAdd(&(bar)[XB_TMO], 1u); break; } } } } while (0)
struct XcdBarrier { unsigned* bar; unsigned x; volatile LAS unsigned* st; };
DI XcdBarrier xcd_barrier_post(unsigned* bar, volatile LAS unsigned* st) {
    XcdBarrier b; b.bar = bar; b.x = xb_xcc_id(); b.st = st;
    if (tid_opaque() == 0) (void)xb_add(&bar[XB_XCNT(b.x)], 1u);
    return b;
}
DI void xcd_barrier_complete(unsigned* bar, unsigned x, unsigned& nloc, unsigned& nx) {
    const unsigned G = gridDim.x * gridDim.y * gridDim.z;
    unsigned sum, cnt, mine, sp = 0u;
    for (;;) {
        sum = 0u; cnt = 0u; mine = 0u;
#pragma unroll
        for (unsigned j = 0; j < 16; ++j) { const unsigned c = xb_ld(&bar[XB_XCNT(j)]); sum += c; cnt += (c > 0u) ? 1u : 0u; mine = (j == x) ? c : mine; }
        if (sum == G) break;
        __builtin_amdgcn_s_sleep(1);
        if ((++sp & 255u) == 0u) { if (xb_ld(&bar[XB_TMO])) break; if (sp > XB_SPIN_CAP) { atomicAdd(&bar[XB_TMO], 1u); break; } }
    }
    nloc = mine > 0u ? mine : 1u; nx = cnt > 0u ? cnt : 1u;
}
DI void xcd_barrier(const XcdBarrier& b) {
    asm volatile("s_waitcnt vmcnt(0)" ::: "memory");
    __syncthreads();
    if (tid_opaque() == 0) {
        unsigned* bar = b.bar;
        __builtin_amdgcn_s_waitcnt(0);
        unsigned nloc = b.st[0], nx = b.st[1];
        if (nloc == 0u) { xcd_barrier_complete(bar, b.x, nloc, nx); b.st[0] = nloc; b.st[1] = nx; }
        const unsigned old = xb_add(&bar[XB_XSUB(b.x)], 1u);
        const unsigned gen = old / nloc;
        if (old + 1u == (gen + 1u) * nloc) {
            __builtin_amdgcn_fence(__ATOMIC_RELEASE, "agent");
            asm volatile("s_waitcnt vmcnt(0)" ::: "memory");
            const unsigned og = xb_add(&bar[XB_TOP], 1u);
            const unsigned tg = og / nx;
            if (og + 1u == (tg + 1u) * nx) xb_add(&bar[XB_TOPGEN], 1u);
            else XB_SPIN(xb_ld(&bar[XB_TOPGEN]) == tg, bar);
            __builtin_amdgcn_fence(__ATOMIC_ACQUIRE, "agent");
            xb_add(&bar[XB_XGEN(b.x)], 1u);
            asm volatile("s_waitcnt vmcnt(0)" ::: "memory");
        } else {
            XB_SPIN(xb_ld(&bar[XB_XGEN(b.x)]) == gen, bar);
            __builtin_amdgcn_fence(__ATOMIC_ACQUIRE, "agent");
            asm volatile("s_waitcnt vmcnt(0)" ::: "memory");
        }
    }
    __syncthreads();
}

DI float xor32_sum(float x) {
    const unsigned u = __float_as_uint(x);
    const auto r = __builtin_amdgcn_permlane32_swap(u, u, false, false);
    return __uint_as_float(r[0]) + __uint_as_float(r[1]);
}
#define DPP_ADD(v, ctrl) ((v) + __uint_as_float((unsigned)__builtin_amdgcn_update_dpp(0, (int)__float_as_uint(v), (ctrl), 0xf, 0xf, true)))
DI float wave_sum(float v) {
    v = DPP_ADD(v, 0xB1);
    v = DPP_ADD(v, 0x4E);
    v = DPP_ADD(v, 0x141);
    v = DPP_ADD(v, 0x140);
    const unsigned u = __float_as_uint(v);
    return (__uint_as_float(__builtin_amdgcn_readlane(u, 0)) + __uint_as_float(__builtin_amdgcn_readlane(u, 16))) +
           (__uint_as_float(__builtin_amdgcn_readlane(u, 32)) + __uint_as_float(__builtin_amdgcn_readlane(u, 48)));
}
DI int crow(int i, int hh) { return (i & 3) + 8 * (i >> 2) + 4 * hh; }
DI int mod_row(int r) { return r < NL ? (r >> 13) : 2; }
DI float frcp(float x) { return __builtin_amdgcn_rcpf(x); }
DI float fexp(float x) { return __builtin_amdgcn_exp2f(x * 1.4426950408889634f); }
DI float sigmoidf_(float x) { return frcp(1.0f + fexp(-x)); }
DI float one_minus_exp(float x) {
    const float s = -x * (1.0f + x * 0.5f * (1.0f + x * (1.0f / 3.0f) * (1.0f + x * 0.25f * (1.0f + x * 0.2f * (1.0f + x * (1.0f / 6.0f))))));
    const float d = 1.0f - fexp(x);
    return x > -0.125f ? s : d;
}

template <class F>
DI void cvt_list(const Params& P, uchar* lds, int i0, int step, int n, F&& job_of) {
    const int tid = tid_opaque();
    float* tl = (float*)lds;
    f32x4 rv[2];
    auto tile_src = [&](int idx, int& j, int& mat, int& kt, int& nt) -> const float* {
        int t; job_of(idx, j, t);
        const int N = P.jobs[j].N, tn = N >> 6, per = (P.jobs[j].K >> 6) * tn; mat = t / per; t -= mat * per; kt = t / tn; nt = t - kt * tn;
        return P.jobs[j].src + (size_t)mat * P.jobs[j].sstride + (size_t)(kt * 64) * N + nt * 64;
    };
    int u = i0, j = 0, mat = 0, kt = 0, nt = 0;
    __syncthreads();
    if (u < n) { const float* src = tile_src(u, j, mat, kt, nt); const int N = P.jobs[j].N;
#pragma unroll
        for (int i = 0; i < 2; ++i) rv[i] = *(const f32x4*)(src + (size_t)((tid >> 4) + 32 * i) * N + (tid & 15) * 4); }
    for (; u < n; u += step) {
#pragma unroll
        for (int i = 0; i < 2; ++i) { float* q = tl + ((tid >> 4) + 32 * i) * 65 + (tid & 15) * 4; q[0] = rv[i][0]; q[1] = rv[i][1]; q[2] = rv[i][2]; q[3] = rv[i][3]; }
        const CvtJob J = P.jobs[j];
        const int cmat = mat, ckt = kt, cnt_ = nt;
        const int un = u + step;
        if (un < n) { const float* src = tile_src(un, j, mat, kt, nt); const int N = P.jobs[j].N;
#pragma unroll
            for (int i = 0; i < 2; ++i) rv[i] = *(const f32x4*)(src + (size_t)((tid >> 4) + 32 * i) * N + (tid & 15) * 4); }
        __syncthreads();
        const int n_ = tid >> 3, kc = tid & 7;
        float v[8];
#pragma unroll
        for (int e = 0; e < 8; ++e) v[e] = tl[(kc * 8 + e) * 65 + n_];
        const int ng = cnt_ * 64 + n_;
        const int drow = J.mode ? ((ng >> 5) * 64 + J.half * 32 + (ng & 31)) : ng;
        u16* d = J.dst + (size_t)cmat * J.dstride + (size_t)drow * J.lddst + ckt * 64 + kc * 8;
        u32x4 w; w.x = pk2(v[0], v[1]); w.y = pk2(v[2], v[3]); w.z = pk2(v[4], v[5]); w.w = pk2(v[6], v[7]);
        *(u32x4*)d = w;
        __syncthreads();
    }
}
constexpr int MOE_CVT_TILES = 6144;
DI void tail_cvt_dense(const Params& P, uchar* lds, int nunits, int lo, int hi) {
    const int G = gridDim.x, rem = nunits % G;
    int rank = blockIdx.x, nidle = G;
    if (rem != 0) { if ((int)blockIdx.x < rem) return; rank = blockIdx.x - rem; nidle = G - rem; }
    cvt_list(P, lds, lo + rank, nidle, hi, [&](int idx, int& j, int& t) {
        j = 0;
#pragma unroll
        for (int q = 1; q < 6; ++q) if (idx >= P.jobs[q].tile0) j = q;
        t = idx - P.jobs[j].tile0; });
}
DI void tail_cvt_moe(const Params& P, uchar* lds, int nunits, int layer, int lo, int hi) {
    const int G = gridDim.x, rem = nunits % G;
    int rank = blockIdx.x, nidle = G;
    if (rem != 0) { if ((int)blockIdx.x < rem) return; rank = blockIdx.x - rem; nidle = G - rem; }
    cvt_list(P, lds, lo + rank, nidle, hi, [&](int idx, int& j, int& t) { j = 6 + (idx >> 11); t = layer * 2048 + (idx & 2047); });
}

DI void phase_prep(const Params& P, const Ctx& p, uchar* lds) {
    const int tid = tid_opaque();
    float* tl = (float*)lds;
    {
        float* sc = tl;
        float* red = tl + 3072;
        for (int u = blockIdx.x; u < 192; u += gridDim.x) {
            __syncthreads();
            for (int i = tid; i < 3072; i += 512) { const int mr = i >> 10, d = i & 1023; const float c = mr < 2 ? inp(p, I_C)[mr * 1024 + d] : inp(p, I_CCTX)[d]; sc[i] = c * sigmoidf_(c); }
            __syncthreads();
            const int l = u / 96, nc = u % 96, c4 = tid & 15, dg = tid >> 4;
            const float* w = inp(p, I_ADAW) + (size_t)l * 1024 * 6144 + nc * 64 + c4 * 4;
            f32x4 a0 = (f32x4){0.f, 0.f, 0.f, 0.f}, a1 = a0, a2 = a0;
#pragma unroll 16
            for (int dd = 0; dd < 32; ++dd) {
                const int d = dg * 32 + dd; const f32x4 wv = *(const f32x4*)(w + (size_t)d * 6144);
                const float s0 = sc[d], s1 = sc[1024 + d], s2 = sc[2048 + d];
#pragma unroll
                for (int e = 0; e < 4; ++e) { a0[e] += s0 * wv[e]; a1[e] += s1 * wv[e]; a2[e] += s2 * wv[e]; }
            }
            *(f32x4*)(red + (dg * 3 + 0) * 64 + c4 * 4) = a0; *(f32x4*)(red + (dg * 3 + 1) * 64 + c4 * 4) = a1; *(f32x4*)(red + (dg * 3 + 2) * 64 + c4 * 4) = a2;
            __syncthreads();
            if (tid < 192) {
                const int mr = tid >> 6, nn = tid & 63; float s = 0.f;
#pragma unroll
                for (int g = 0; g < 32; ++g) s += red[(g * 3 + mr) * 64 + nn];
                const int ncol = nc * 64 + nn;
                ((float*)(p.ws + WS_MOD))[(l * 3 + mr) * 6144 + ncol] = s + inp(p, I_ADAB)[l * 6144 + ncol];
            }
        }
        __syncthreads();
    }
    cvt_list(P, lds, blockIdx.x, gridDim.x, P.jobs[1].tile0, [&](int idx, int& j, int& t) {
        j = 0;
#pragma unroll
        for (int q = 1; q < 6; ++q) if (idx >= P.jobs[q].tile0) j = q;
        t = idx - P.jobs[j].tile0; });
    for (int i = blockIdx.x * 512 + tid; i < SEQ * 32; i += gridDim.x * 512) {
        const int t = i >> 5, j = i & 31;
        const double pos = (double)(j < 16 ? (t >> 6) : (t & 63));
        const double inv = pow(10000.0, -(double)(j & 15) / 16.0);
        const double a = pos * inv;
        ((f32x2*)(p.ws + WS_ROPE))[i] = (f32x2){(float)cos(a), (float)sin(a)};
    }
}

DI void load_row16(const float* src, int lane, float (&v)[16]) {
#pragma unroll
    for (int j = 0; j < 4; ++j) { const f32x4 x = *(const f32x4*)(src + j * 256 + lane * 4); v[j * 4 + 0] = x[0]; v[j * 4 + 1] = x[1]; v[j * 4 + 2] = x[2]; v[j * 4 + 3] = x[3]; }
}
DI void norm_mod16(float (&v)[16], const float* g, const float* sh, const float* sc, int lane) {
    float ss = 0.f;
#pragma unroll
    for (int i = 0; i < 16; ++i) ss += v[i] * v[i];
    ss = wave_sum(ss);
    const float rstd = rsqrtf(ss * (1.0f / 1024.0f) + EPS);
#pragma unroll
    for (int j = 0; j < 4; ++j) {
        const int c = j * 256 + lane * 4;
        const f32x4 gg = *(const f32x4*)(g + c), s1 = *(const f32x4*)(sc + c), s0 = *(const f32x4*)(sh + c);
#pragma unroll
        for (int e = 0; e < 4; ++e) v[j * 4 + e] = (v[j * 4 + e] * rstd * gg[e]) * (1.0f + s1[e]) + s0[e];
    }
}
DI void store_row16_bf16(u16* dst, int lane, const float (&v)[16]) {
#pragma unroll
    for (int j = 0; j < 4; ++j) { u32x2 w; w.x = pk2(v[j * 4 + 0], v[j * 4 + 1]); w.y = pk2(v[j * 4 + 2], v[j * 4 + 3]); *(u32x2*)(dst + j * 256 + lane * 4) = w; }
}
DI const float* row_src(const Ctx& p, int layer, int r) {
    if (layer == 0) return r < NL ? inp(p, I_X) + (size_t)r * 1024 : inp(p, I_CTX) + (size_t)(r - NL) * 1024;
    return (const float*)(p.ws + WS_XS) + (size_t)r * 1024;
}
DI void phase_norm(const Ctx& p, int layer) {
    const int tid = tid_opaque(), lane = tid & 63, wv = blockIdx.x * 8 + (tid >> 6), nwv = gridDim.x * 8;
    const float* mod = (const float*)(p.ws + WS_MOD);
    u16* hb = (u16*)(p.ws + WS_HB);
    for (int r = wv; r < R; r += nwv) {
        float v[16];
        load_row16(row_src(p, layer, r), lane, v);
        const float* m = mod + (layer * 3 + mod_row(r)) * 6144;
        norm_mod16(v, inp(p, I_NMIX) + layer * 1024, m, m + 1024, lane);
        store_row16_bf16(hb + (size_t)r * 1024, lane, v);
    }
}
DI void phase_router(const Ctx& p, uchar* lds, int layer, int cnt_slot = -1) {
    const int tid = tid_opaque(), lane = tid & 63, wid = tid >> 6, wv = blockIdx.x * 8 + wid, nwv = gridDim.x * 8;
    const float* mod = (const float*)(p.ws + WS_MOD);
    u16* hb = (u16*)(p.ws + WS_HB);
    const float* xs = (const float*)(p.ws + WS_XS);
    const int nrows = layer == 0 ? R : NL;
    const float* wg = inp(p, I_MWGRP) + layer * 1024 * 4;
    const float* wr = inp(p, I_MWRT) + layer * 1024 * 16;
    const float* gnorm = inp(p, I_NFFN) + layer * 1024;
    int* cnt = (int*)(p.ws + WS_CTL + CTL_CNT) + (cnt_slot >= 0 ? cnt_slot : layer) * 1024;
    int* list = (int*)(p.ws + WS_LIST);
    f32x2* route = (f32x2*)(p.ws + WS_ROUTE);
    float* wrl = (float*)lds;
    float* wgl = wrl + 16384;
    float* hs = (float*)(lds + 81920 + wid * 8192);
    __syncthreads();
#pragma unroll
    for (int i = 0; i < 8; ++i) *(f32x4*)(wrl + (i * 512 + tid) * 4) = *(const f32x4*)(wr + (i * 512 + tid) * 4);
#pragma unroll
    for (int i = 0; i < 2; ++i) *(f32x4*)(wgl + (i * 512 + tid) * 4) = *(const f32x4*)(wg + (i * 512 + tid) * 4);
    __syncthreads();
    float bg[4], br[4];
#pragma unroll
    for (int o = 0; o < 4; ++o) { bg[o] = inp(p, I_MBGRP)[layer * 4 + o]; br[o] = inp(p, I_MBRT)[layer * 16 + (lane & 3) * 4 + o]; }
    for (int r0 = wv * 2; r0 < nrows; r0 += nwv * 2) {
        const float* m = mod + (layer * 3 + mod_row(r0)) * 6144;
        float v0[16], v1[16];
        load_row16(xs + (size_t)r0 * 1024, lane, v0);
        load_row16(xs + (size_t)(r0 + 1) * 1024, lane, v1);
        norm_mod16(v0, gnorm, m + 3 * 1024, m + 4 * 1024, lane);
        norm_mod16(v1, gnorm, m + 3 * 1024, m + 4 * 1024, lane);
        store_row16_bf16(hb + (size_t)r0 * 1024, lane, v0);
        store_row16_bf16(hb + (size_t)(r0 + 1) * 1024, lane, v1);
#pragma unroll
        for (int j = 0; j < 4; ++j) {
            *(f32x4*)(hs + (j * 256 + lane * 4) * 2) = (f32x4){v0[j * 4], v1[j * 4], v0[j * 4 + 1], v1[j * 4 + 1]};
            *(f32x4*)(hs + (j * 256 + lane * 4) * 2 + 4) = (f32x4){v0[j * 4 + 2], v1[j * 4 + 2], v0[j * 4 + 3], v1[j * 4 + 3]};
        }
        float ar[2][4], ag[2][4];
#pragma unroll
        for (int q = 0; q < 2; ++q)
#pragma unroll
            for (int o = 0; o < 4; ++o) { ar[q][o] = 0.f; ag[q][o] = 0.f; }
#pragma unroll 8
        for (int it = 0; it < 64; ++it) {
            const f32x4 w4 = *(const f32x4*)(wrl + (it * 64 + lane) * 4);
            const f32x2 x2 = *(const f32x2*)(hs + (it * 16 + (lane >> 2)) * 2);
#pragma unroll
            for (int o = 0; o < 4; ++o) { ar[0][o] += x2.x * w4[o]; ar[1][o] += x2.y * w4[o]; }
        }
#pragma unroll 8
        for (int it = 0; it < 16; ++it) {
            const f32x4 w4 = *(const f32x4*)(wgl + (it * 64 + lane) * 4);
            const f32x2 x2 = *(const f32x2*)(hs + (it * 64 + lane) * 2);
#pragma unroll
            for (int o = 0; o < 4; ++o) { ag[0][o] += x2.x * w4[o]; ag[1][o] += x2.y * w4[o]; }
        }
#pragma unroll
        for (int q = 0; q < 2; ++q)
#pragma unroll
            for (int o = 0; o < 4; ++o) {
                ag[q][o] = wave_sum(ag[q][o]);
                float v = ar[q][o]; v += __shfl_xor(v, 4); v += __shfl_xor(v, 8); v += __shfl_xor(v, 16); v = xor32_sum(v); ar[q][o] = v;
            }
#pragma unroll
        for (int q = 0; q < 2; ++q) {
            float gl[4];
#pragma unroll
            for (int o = 0; o < 4; ++o) gl[o] = ag[q][o] + bg[o];
            int gi = 0; float gm = gl[0];
#pragma unroll
            for (int o = 1; o < 4; ++o) if (gl[o] > gm) { gm = gl[o]; gi = o; }
            float gs = 0.f;
#pragma unroll
            for (int o = 0; o < 4; ++o) gs += __expf(gl[o] - gm);
            const float psel = 1.0f / gs;
            float el[4];
#pragma unroll
            for (int o = 0; o < 4; ++o) el[o] = __shfl(ar[q][o] + br[o], gi);
            int i1 = 0; float m1 = el[0];
#pragma unroll
            for (int o = 1; o < 4; ++o) if (el[o] > m1) { m1 = el[o]; i1 = o; }
            int i2 = -1; float m2 = -3.0e38f;
#pragma unroll
            for (int o = 0; o < 4; ++o) if (o != i1 && el[o] > m2) { m2 = el[o]; i2 = o; }
            if (lane == 0) {
                const int r = r0 + q;
                const float e2 = __expf(m2 - m1);
                const float w1 = psel / (1.0f + e2), w2 = psel * e2 / (1.0f + e2);
                const int lo = i1 < i2 ? i1 : i2, hi = i1 < i2 ? i2 : i1;
                const float wlo = i1 < i2 ? w1 : w2, whi = i1 < i2 ? w2 : w1;
                const int pi = lo == 0 ? (hi - 1) : (lo == 1 ? (hi + 1) : 5);
                const int bucket = gi * 6 + pi;
                const int pos = atomicAdd(cnt + bucket * 32, 1);
                list[(size_t)bucket * R + pos] = r;
                route[r] = (f32x2){wlo, whi};
            }
        }
    }
}

constexpr int LROW = 144;
constexpr int GEMM_A = 128 * 128, GEMM_B = 256 * 128, GEMM_STAGE = GEMM_A + GEMM_B;
constexpr int EPI_PITCH = 272, EPI_WAVE = 64 * EPI_PITCH;
static_assert(8 * EPI_WAVE <= 3 * GEMM_STAGE, "epilogue strips overlay the GEMM stages");
#define WAIT_V(n) asm volatile("s_waitcnt vmcnt(%0)" ::"n"(n) : "memory")
#define WAIT_L(n) asm volatile("s_waitcnt lgkmcnt(%0)" ::"n"(n) : "memory")
#define RAW_BARRIER() do { WAIT_L(0); __builtin_amdgcn_s_barrier(); } while (0)

template <class Epi>
DI void gemm_tile(uchar* lds, const u16* a0, const u16* a1, const u16* b0, const u16* b1, const u16* b2, const u16* b3, int nk, int ksplit, long bjump, Epi&& epi) {
    const int tid = tid_opaque(), lane = tid & 63, wid = tid >> 6, wr = wid >> 2, wc = wid & 3, l31 = lane & 31, hh = lane >> 5;
    const int lch = (lane & 7) ^ ((((wid & 1) << 3) + (lane >> 3)) >> 1);
    a0 += lch * 8; a1 += lch * 8; b0 += lch * 8; b1 += lch * 8; b2 += lch * 8; b3 += lch * 8;
    const unsigned pw = (unsigned)__builtin_amdgcn_readfirstlane(wid) * 1024u;
    const int sw = (l31 >> 1) & 7;
    unsigned xo[4];
#pragma unroll
    for (int ks = 0; ks < 4; ++ks) xo[ks] = (unsigned)(((ks * 2 + hh) ^ sw) << 4);
    const unsigned aro = (unsigned)((wr * 64 + l31) * 128), bro = (unsigned)(GEMM_A + (wc * 64 + l31) * 128);
    f32x16 acc[2][2];
#pragma unroll
    for (int a = 0; a < 2; ++a)
#pragma unroll
        for (int b = 0; b < 2; ++b)
#pragma unroll
            for (int i = 0; i < 16; ++i) acc[a][b][i] = 0.f;
#define GEMM_DMA(st_, kt_) do { const int kq_ = (kt_); const long bo_ = (long)kq_ * 64 + (kq_ >= ksplit ? bjump : 0); uchar* s_ = lds + (st_) * GEMM_STAGE + pw; \
        __builtin_amdgcn_global_load_lds((const unsigned*)(a0 + kq_ * 64), (LAS unsigned*)(s_), 16, 0, 0); \
        __builtin_amdgcn_global_load_lds((const unsigned*)(a1 + kq_ * 64), (LAS unsigned*)(s_ + 8192), 16, 0, 0); \
        __builtin_amdgcn_global_load_lds((const unsigned*)(b0 + bo_), (LAS unsigned*)(s_ + GEMM_A), 16, 0, 0); \
        __builtin_amdgcn_global_load_lds((const unsigned*)(b1 + bo_), (LAS unsigned*)(s_ + GEMM_A + 8192), 16, 0, 0); \
        __builtin_amdgcn_global_load_lds((const unsigned*)(b2 + bo_), (LAS unsigned*)(s_ + GEMM_A + 16384), 16, 0, 0); \
        __builtin_amdgcn_global_load_lds((const unsigned*)(b3 + bo_), (LAS unsigned*)(s_ + GEMM_A + 24576), 16, 0, 0); } while (0)
    RAW_BARRIER();
    GEMM_DMA(0, 0); GEMM_DMA(1, 1);
    WAIT_V(6);
    RAW_BARRIER();
    int cur = 0;
#pragma unroll 1
    for (int kt = 0; kt < nk; ++kt) {
        const int nxt = cur == 0 ? 2 : cur - 1;
        if (kt + 2 < nk) GEMM_DMA(nxt, kt + 2);
        const uchar* s = lds + cur * GEMM_STAGE;
#pragma unroll
        for (int ks = 0; ks < 4; ++ks) {
            const bf16x8 fa0 = *(const bf16x8*)(s + aro + xo[ks]), fa1 = *(const bf16x8*)(s + aro + 4096 + xo[ks]);
            const bf16x8 fb0 = *(const bf16x8*)(s + bro + xo[ks]), fb1 = *(const bf16x8*)(s + bro + 4096 + xo[ks]);
            acc[0][0] = MFMA32(fb0, fa0, acc[0][0]); acc[0][1] = MFMA32(fb0, fa1, acc[0][1]);
            acc[1][0] = MFMA32(fb1, fa0, acc[1][0]); acc[1][1] = MFMA32(fb1, fa1, acc[1][1]);
        }
        if (kt + 2 < nk) WAIT_V(6); else WAIT_V(0);
        RAW_BARRIER();
        cur = cur == 2 ? 0 : cur + 1;
    }
#if PROBE_GEMM2X == 1
    {
        f32x16 d[2][2];
        for (int a = 0; a < 2; ++a) for (int b = 0; b < 2; ++b) for (int i = 0; i < 16; ++i) d[a][b][i] = 0.f;
        RAW_BARRIER(); GEMM_DMA(0, 0); GEMM_DMA(1, 1); WAIT_V(6); RAW_BARRIER();
        int cur2 = 0;
#pragma unroll 1
        for (int kt = 0; kt < nk; ++kt) {
            const int nxt = cur2 == 0 ? 2 : cur2 - 1;
            if (kt + 2 < nk) GEMM_DMA(nxt, kt + 2);
            const uchar* s = lds + cur2 * GEMM_STAGE;
#pragma unroll
            for (int ks = 0; ks < 4; ++ks) {
                const bf16x8 fa0 = *(const bf16x8*)(s + aro + xo[ks]), fa1 = *(const bf16x8*)(s + aro + 4096 + xo[ks]);
                const bf16x8 fb0 = *(const bf16x8*)(s + bro + xo[ks]), fb1 = *(const bf16x8*)(s + bro + 4096 + xo[ks]);
                d[0][0] = MFMA32(fb0, fa0, d[0][0]); d[0][1] = MFMA32(fb0, fa1, d[0][1]);
                d[1][0] = MFMA32(fb1, fa0, d[1][0]); d[1][1] = MFMA32(fb1, fa1, d[1][1]);
            }
            if (kt + 2 < nk) WAIT_V(6); else WAIT_V(0);
            RAW_BARRIER();
            cur2 = cur2 == 2 ? 0 : cur2 + 1;
        }
        asm volatile("" :: "v"(d[0][0]), "v"(d[0][1]), "v"(d[1][0]), "v"(d[1][1]));
    }
#elif PROBE_GEMM2X == 2
    {
        f32x4 d[4][4];
        for (int a = 0; a < 4; ++a) for (int b = 0; b < 4; ++b) d[a][b] = (f32x4){0.f, 0.f, 0.f, 0.f};
        RAW_BARRIER(); GEMM_DMA(0, 0); GEMM_DMA(1, 1); WAIT_V(6); RAW_BARRIER();
        int cur2 = 0;
#pragma unroll 1
        for (int kt = 0; kt < nk; ++kt) {
            const int nxt = cur2 == 0 ? 2 : cur2 - 1;
            if (kt + 2 < nk) GEMM_DMA(nxt, kt + 2);
            const uchar* s = lds + cur2 * GEMM_STAGE;
#pragma unroll
            for (int kp = 0; kp < 2; ++kp) {
                bf16x8 fa[4], fb[4];
                fa[0] = *(const bf16x8*)(s + aro + xo[2 * kp]); fa[1] = *(const bf16x8*)(s + aro + 4096 + xo[2 * kp]); fa[2] = *(const bf16x8*)(s + aro + xo[2 * kp + 1]); fa[3] = *(const bf16x8*)(s + aro + 4096 + xo[2 * kp + 1]);
                fb[0] = *(const bf16x8*)(s + bro + xo[2 * kp]); fb[1] = *(const bf16x8*)(s + bro + 4096 + xo[2 * kp]); fb[2] = *(const bf16x8*)(s + bro + xo[2 * kp + 1]); fb[3] = *(const bf16x8*)(s + bro + 4096 + xo[2 * kp + 1]);
#pragma unroll
                for (int a = 0; a < 4; ++a)
#pragma unroll
                    for (int b = 0; b < 4; ++b) d[a][b] = __builtin_amdgcn_mfma_f32_16x16x32_bf16(fb[b], fa[a], d[a][b], 0, 0, 0);
            }
            if (kt + 2 < nk) WAIT_V(6); else WAIT_V(0);
            RAW_BARRIER();
            cur2 = cur2 == 2 ? 0 : cur2 + 1;
        }
        asm volatile("" :: "v"(d[0][0]), "v"(d[0][1]), "v"(d[0][2]), "v"(d[0][3]), "v"(d[1][0]), "v"(d[1][1]), "v"(d[1][2]), "v"(d[1][3]));
        asm volatile("" :: "v"(d[2][0]), "v"(d[2][1]), "v"(d[2][2]), "v"(d[2][3]), "v"(d[3][0]), "v"(d[3][1]), "v"(d[3][2]), "v"(d[3][3]));
    }
#endif
    epi(acc, wr * 64, wc, lane, lds + wid * EPI_WAVE);
}

constexpr int G2_A = 256 * 64, G2_STAGE = 2 * G2_A;
template <class Epi>
DI void gemm_tile256(uchar* lds, const u16* a0, const u16* a1, const u16* b0, const u16* b1, int nk, int ksplit, long bjump, Epi&& epi) {
    const int tid = tid_opaque(), lane = tid & 63, wid = tid >> 6, wr = wid >> 2, wc = wid & 3, l31 = lane & 31, hh = lane >> 5;
    const int lch = (lane & 3) ^ ((lane >> 4) & 3);
    a0 += lch * 8; a1 += lch * 8; b0 += lch * 8; b1 += lch * 8;
    const unsigned pw = (unsigned)__builtin_amdgcn_readfirstlane(wid) * 1024u;
    const int sw = (l31 >> 2) & 3;
    const unsigned xo0 = (unsigned)(((0 + hh) ^ sw) << 4), xo1 = (unsigned)(((2 + hh) ^ sw) << 4);
    const unsigned aro = (unsigned)((wr * 128 + l31) * 64), bro = (unsigned)(G2_A + (wc * 64 + l31) * 64);
    f32x16 acc[2][4];
#pragma unroll
    for (int a = 0; a < 2; ++a)
#pragma unroll
        for (int b = 0; b < 4; ++b)
#pragma unroll
            for (int i = 0; i < 16; ++i) acc[a][b][i] = 0.f;
#define G2_DMA(st_, kt_) do { const int kq_ = (kt_); const long bo_ = (long)kq_ * 32 + (kq_ >= ksplit ? bjump : 0); uchar* s_ = lds + (st_) * G2_STAGE + pw; \
        __builtin_amdgcn_global_load_lds((const unsigned*)(a0 + kq_ * 32), (LAS unsigned*)(s_), 16, 0, 0); \
        __builtin_amdgcn_global_load_lds((const unsigned*)(a1 + kq_ * 32), (LAS unsigned*)(s_ + 8192), 16, 0, 0); \
        __builtin_amdgcn_global_load_lds((const unsigned*)(b0 + bo_), (LAS unsigned*)(s_ + G2_A), 16, 0, 0); \
        __builtin_amdgcn_global_load_lds((const unsigned*)(b1 + bo_), (LAS unsigned*)(s_ + G2_A + 8192), 16, 0, 0); } while (0)
    RAW_BARRIER();
    G2_DMA(0, 0); G2_DMA(1, 1); G2_DMA(2, 2);
    WAIT_V(8);
    RAW_BARRIER();
#pragma unroll 1
    for (int kt = 0; kt < nk; ++kt) {
        if (kt + 3 < nk) G2_DMA((kt + 3) & 3, kt + 3);
        const uchar* s = lds + (kt & 3) * G2_STAGE;
#pragma unroll
        for (int ks = 0; ks < 2; ++ks) {
            const unsigned xo = ks ? xo1 : xo0;
            bf16x8 fa[4], fb[2];
#pragma unroll
            for (int mb = 0; mb < 4; ++mb) fa[mb] = *(const bf16x8*)(s + aro + mb * 2048 + xo);
#pragma unroll
            for (int nb = 0; nb < 2; ++nb) fb[nb] = *(const bf16x8*)(s + bro + nb * 2048 + xo);
#pragma unroll
            for (int nb = 0; nb < 2; ++nb)
#pragma unroll
                for (int mb = 0; mb < 4; ++mb) acc[nb][mb] = MFMA32(fb[nb], fa[mb], acc[nb][mb]);
        }
        if (kt + 3 < nk) WAIT_V(8); else if (kt + 2 < nk) WAIT_V(4); else WAIT_V(0);
        RAW_BARRIER();
    }
#pragma unroll
    for (int half = 0; half < 2; ++half) {
        f32x16 t[2][2];
#pragma unroll
        for (int nb = 0; nb < 2; ++nb)
#pragma unroll
            for (int mb = 0; mb < 2; ++mb) t[nb][mb] = acc[nb][2 * half + mb];
        epi(t, wr * 128 + half * 64, wc, lane, lds + wid * EPI_WAVE);
    }
}

DI void epi_put4(uchar* w, int row, int col, float a, float b, float c, float d) { *(f32x4*)(w + row * EPI_PITCH + col * 4) = (f32x4){a, b, c, d}; }
DI void epi_stage(uchar* w, const f32x16 (&acc)[2][2], int l31, int hh) {
#pragma unroll
    for (int mb = 0; mb < 2; ++mb)
#pragma unroll
        for (int nb = 0; nb < 2; ++nb)
#pragma unroll
            for (int g = 0; g < 4; ++g) epi_put4(w, mb * 32 + l31, nb * 32 + 8 * g + 4 * hh, acc[nb][mb][4 * g], acc[nb][mb][4 * g + 1], acc[nb][mb][4 * g + 2], acc[nb][mb][4 * g + 3]);
}
template <class F> DI void epi_rows4(const uchar* w, int lane, F&& f) {
#pragma unroll
    for (int it = 0; it < 16; ++it) { const int row = it * 4 + (lane >> 4), col = (lane & 15) * 4; f(row, col, *(const f32x4*)(w + row * EPI_PITCH + col * 4)); }
}
template <int NC, class F> DI void epi_rows8(const uchar* w, int lane, F&& f) {
    constexpr int LPR = NC / 8, RPI = 64 / LPR;
#pragma unroll
    for (int it = 0; it < 64 / RPI; ++it) { const int row = it * RPI + lane / LPR, col = (lane % LPR) * 8; f(row, col, *(const f32x4*)(w + row * EPI_PITCH + col * 4), *(const f32x4*)(w + row * EPI_PITCH + col * 4 + 16)); }
}
DI u32x4 pack8(const f32x4& a, const f32x4& b) { u32x4 r; r.x = pk2(a[0], a[1]); r.y = pk2(a[2], a[3]); r.z = pk2(b[0], b[1]); r.w = pk2(b[2], b[3]); return r; }

#define MFMA16(a, b, c) __builtin_amdgcn_mfma_f32_16x16x32_bf16((a), (b), (c), 0, 0, 0)
constexpr int P8_HT = 16384;
DI void p8_rc(int tid, int& r0, int& c) { const int wid = tid >> 6, lane = tid & 63; r0 = (wid >> 1) * 16 + (lane >> 2); c = (wid & 1) * 32 + (((lane & 3) ^ ((lane >> 5) << 1)) << 3); }
DI void glds16(const uchar* g, uchar* s) { __builtin_amdgcn_global_load_lds((const unsigned*)g, (LAS unsigned*)s, 16, 0, 0); }
template <class Epi>
DI void gemm_tile8p(uchar* lds, const uchar* abase, unsigned a0_0, unsigned a1_0, unsigned a0_1, unsigned a1_1, int ac1_0, int ac0_1, int ac1_1,
                    const uchar* bbase, unsigned bo, int bc1_0, int bc0_1, int bc1_1, int nk, int ksplit, long bjump, Epi&& epi) {
    constexpr int ac0_0 = 0, bc0_0 = 0;
    const int tid = tid_opaque(), lane = tid & 63, wid = tid >> 6, wr = wid >> 2, wc = wid & 3, fr = lane & 15, fq = lane >> 4;
    const unsigned pw = (unsigned)__builtin_amdgcn_readfirstlane(wid) * 1024u;
    const unsigned lp = (unsigned)((fr * 64 + fq * 16) ^ ((fr >> 3) << 5));
    const unsigned la = (unsigned)wr * 8192u + lp, lb = (unsigned)wc * 4096u + lp;
    f32x4 acc[2][2][4][2];
#pragma unroll
    for (int a = 0; a < 2; ++a)
#pragma unroll
        for (int b = 0; b < 2; ++b)
#pragma unroll
            for (int m = 0; m < 4; ++m)
#pragma unroll
                for (int n = 0; n < 2; ++n) acc[a][b][m][n] = (f32x4){0.f, 0.f, 0.f, 0.f};
    bf16x8 At[4][2], B0[2][2], B1[2][2];
#define P8_SA(b, h) (((b) * 2 + (h)) * P8_HT)
#define P8_SB(b, h) ((4 + (b) * 2 + (h)) * P8_HT)
#define P8_STAGE_A(b, h, kt) do { const uchar* g_ = abase + (size_t)(kt) * 128; uchar* s_ = lds + P8_SA(b, h) + pw; glds16(g_ + ac0_##h + a0_##h, s_); glds16(g_ + ac1_##h + a1_##h, s_ + 8192); } while (0)
#define P8_STAGE_B(b, h, kt) do { const int kq_ = (kt); const uchar* g_ = bbase + (size_t)kq_ * 128 + (kq_ >= ksplit ? bjump : 0); uchar* s_ = lds + P8_SB(b, h) + pw; glds16(g_ + bc0_##h + bo, s_); glds16(g_ + bc1_##h + bo, s_ + 8192); } while (0)
#define P8_LDA(dst, b, h) do { _Pragma("unroll") for (int m = 0; m < 4; ++m) { _Pragma("unroll") for (int k = 0; k < 2; ++k) dst[m][k] = *(const bf16x8*)(lds + P8_SA(b, h) + la + (m * 2 + k) * 1024); } } while (0)
#define P8_LDB(dst, b, h) do { _Pragma("unroll") for (int n = 0; n < 2; ++n) { _Pragma("unroll") for (int k = 0; k < 2; ++k) dst[n][k] = *(const bf16x8*)(lds + P8_SB(b, h) + lb + (n * 2 + k) * 1024); } } while (0)
#define P8_MMA(ai, bj, Bx) do { __builtin_amdgcn_s_setprio(1); \
        _Pragma("unroll") for (int m = 0; m < 4; ++m) { _Pragma("unroll") for (int n = 0; n < 2; ++n) { _Pragma("unroll") for (int k = 0; k < 2; ++k) acc[ai][bj][m][n] = MFMA16(Bx[n][k], At[m][k], acc[ai][bj][m][n]); } } \
        __builtin_amdgcn_s_setprio(0); } while (0)
#define P8_BAR() __builtin_amdgcn_s_barrier()
#define P8_SCHED() __builtin_amdgcn_sched_barrier(0)
    RAW_BARRIER();
    P8_STAGE_B(0, 0, 0); P8_STAGE_A(0, 0, 0); P8_STAGE_B(0, 1, 0); P8_STAGE_A(0, 1, 0);
    if (wr == 1) P8_BAR();
    WAIT_V(4); P8_BAR();
    P8_STAGE_B(1, 0, 1); P8_STAGE_A(1, 0, 1); P8_STAGE_B(1, 1, 1);
    WAIT_V(6); P8_BAR();
#pragma unroll 1
    for (int t = 0; t < nk - 2; t += 2) {
        P8_LDB(B0, 0, 0); P8_SCHED(); P8_LDA(At, 0, 0); P8_STAGE_A(1, 1, t + 1);
        WAIT_L(8); P8_BAR(); WAIT_L(0); P8_MMA(0, 0, B0); P8_BAR(); P8_SCHED();
        P8_LDB(B1, 0, 1); P8_STAGE_B(0, 0, t + 2);
        P8_BAR(); WAIT_L(0); P8_MMA(0, 1, B1); P8_BAR();
        P8_LDA(At, 0, 1); P8_STAGE_A(0, 0, t + 2);
        P8_BAR(); WAIT_L(0); P8_MMA(1, 0, B0); P8_BAR(); P8_SCHED();
        P8_STAGE_B(0, 1, t + 2);
        WAIT_V(6); P8_BAR(); P8_MMA(1, 1, B1); P8_BAR();
        P8_LDB(B0, 1, 0); P8_SCHED(); P8_LDA(At, 1, 0); P8_STAGE_A(0, 1, t + 2);
        WAIT_L(8); P8_BAR(); WAIT_L(0); P8_MMA(0, 0, B0); P8_BAR(); P8_SCHED();
        P8_LDB(B1, 1, 1); P8_STAGE_B(1, 0, t + 3);
        P8_BAR(); WAIT_L(0); P8_MMA(0, 1, B1); P8_BAR();
        P8_LDA(At, 1, 1); P8_STAGE_A(1, 0, t + 3);
        P8_BAR(); WAIT_L(0); P8_MMA(1, 0, B0); P8_BAR(); P8_SCHED();
        P8_STAGE_B(1, 1, t + 3);
        WAIT_V(6); P8_BAR(); P8_MMA(1, 1, B1); P8_BAR();
    }
    {
        P8_LDB(B0, 0, 0); P8_LDA(At, 0, 0); P8_STAGE_A(1, 1, nk - 1);
        P8_BAR(); WAIT_L(0); P8_MMA(0, 0, B0); P8_BAR();
        P8_LDB(B1, 0, 1); P8_BAR(); WAIT_L(0); P8_MMA(0, 1, B1); P8_BAR();
        P8_LDA(At, 0, 1); WAIT_V(4); P8_BAR(); WAIT_L(0); P8_MMA(1, 0, B0); P8_MMA(1, 1, B1); P8_BAR();
    }
    {
        P8_LDB(B0, 1, 0); P8_LDA(At, 1, 0); WAIT_V(2); P8_BAR(); WAIT_L(0); P8_MMA(0, 0, B0); P8_BAR();
        P8_LDB(B1, 1, 1); WAIT_V(0); P8_BAR(); WAIT_L(0); P8_MMA(0, 1, B1); P8_BAR();
        P8_LDA(At, 1, 1); P8_BAR(); WAIT_L(0); P8_MMA(1, 0, B0); P8_MMA(1, 1, B1); P8_BAR();
    }
    if (wr == 0) P8_BAR();
    RAW_BARRIER();
    uchar* w = lds + wid * EPI_WAVE;
#pragma unroll
    for (int ai = 0; ai < 2; ++ai) {
#pragma unroll
        for (int bj = 0; bj < 2; ++bj)
#pragma unroll
            for (int m = 0; m < 4; ++m)
#pragma unroll
                for (int n = 0; n < 2; ++n) *(f32x4*)(w + (m * 16 + fr) * EPI_PITCH + (bj * 32 + n * 16 + fq * 4) * 4) = acc[ai][bj][m][n];
        epi(wr * 128 + ai * 64, wc, lane, w);
    }
}
DI void epi_unstage(const uchar* w, f32x16 (&t)[2][2], int l31, int hh) {
#pragma unroll
    for (int mb = 0; mb < 2; ++mb)
#pragma unroll
        for (int nb = 0; nb < 2; ++nb)
#pragma unroll
            for (int g = 0; g < 4; ++g) { const f32x4 v = *(const f32x4*)(w + (mb * 32 + l31) * EPI_PITCH + (nb * 32 + 8 * g + 4 * hh) * 4); t[nb][mb][4 * g] = v[0]; t[nb][mb][4 * g + 1] = v[1]; t[nb][mb][4 * g + 2] = v[2]; t[nb][mb][4 * g + 3] = v[3]; }
}

DI void rect_unit(int v, int MT, int NT, int& mt, int& nt) {
    if (gridDim.x != 256) { mt = v / NT; nt = v % NT; return; }
    const int r = v >> 8, b = v & 255, x = b & 7, y = b >> 3;
    const int q = r * 8 + x, nqn = NT >> 2, qm = q / nqn, qn = q - qm * nqn;
    mt = qm * 8 + (y & 7); nt = qn * 4 + (y >> 3);
}
DI void phase_inproj0(const Params& P, const Ctx& p, uchar* lds) {
    const int tid = tid_opaque();
    const u16* hb = (const u16*)(p.ws + WS_HB);
    const u16* w = (const u16*)(p.ws + WS_WIN0);
    u16* zc = (u16*)(p.ws + WS_REGA + RA_ZC);
    u16* qa = (u16*)(p.ws + WS_REGA + RA_Q);
    u16* ka = (u16*)(p.ws + WS_REGA + RA_K);
    u16* vt = (u16*)(p.ws + WS_REGA + RA_VT);
    const f32x2* rope = (const f32x2*)(p.ws + WS_ROPE);
    const int rs = tid >> 3;
    for (int u = blockIdx.x; u < 768 + 48; u += gridDim.x) {
        const bool big = u < 768;
        int mt, nt; if (big) rect_unit(u, 64, 12, mt, nt); else { mt = (u - 768) / 12; nt = (u - 768) % 12; }
        const int m0 = big ? mt * 256 : NL + mt * 128, n0 = nt * 256;
        auto epi =
            [&](f32x16 (&acc)[2][2], int roff, int wc, int lane, uchar* w) {
                const int l31 = lane & 31, hh = lane >> 5, nw = n0 + wc * 64;
                const int row0 = m0 + roff;
                int b, spos0; if (row0 < NL) { b = row0 >> 13; spos0 = row0 & 8191; } else { b = (row0 - NL) >> 8; spos0 = SEQ + ((row0 - NL) & 255); }
                if (nw < 1536) {
                    epi_stage(w, acc, l31, hh);
                    epi_rows8<64>(w, lane, [&](int row, int col, const f32x4& v0, const f32x4& v1) { *(u32x4*)(zc + (size_t)(row0 + row) * 1536 + nw + col) = pack8(v0, v1); });
                } else if (nw < 2560) {
                    const bool isq = nw < 2048;
                    const int cg = (nw - (isq ? 1536 : 2048)) >> 6, head = cg >> 1, map = cg & 1;
                    const float* gain = isq ? inp(p, I_QN) : inp(p, I_KN);
                    const float osc = isq ? QSCALE : 1.0f;
#pragma unroll
                    for (int mb = 0; mb < 2; ++mb) {
                        float ss = 0.f;
#pragma unroll
                        for (int nb = 0; nb < 2; ++nb)
#pragma unroll
                            for (int i = 0; i < 16; ++i) ss += acc[nb][mb][i] * acc[nb][mb][i];
                        ss = xor32_sum(ss);
                        const float rstd = rsqrtf(ss * (1.0f / 64.0f) + EPS);
                        const int spos = spos0 + mb * 32 + l31;
#pragma unroll
                        for (int g = 0; g < 4; ++g) {
                            const int d0 = 8 * g + 4 * hh;
                            const f32x4 g1v = *(const f32x4*)(gain + d0), g2v = *(const f32x4*)(gain + 32 + d0);
                            f32x4 csa = (f32x4){1.f, 0.f, 1.f, 0.f}, csb = csa;
                            if (row0 < NL) { csa = *(const f32x4*)((const float*)(rope + spos * 32 + d0)); csb = *(const f32x4*)((const float*)(rope + spos * 32 + d0 + 2)); }
                            float o1[4], o2[4];
#pragma unroll
                            for (int e = 0; e < 4; ++e) {
                                const float v1 = acc[0][mb][4 * g + e] * rstd * g1v[e], v2 = acc[1][mb][4 * g + e] * rstd * g2v[e];
                                const float cs = e < 2 ? csa[2 * e] : csb[2 * (e - 2)], sn = e < 2 ? csa[2 * e + 1] : csb[2 * (e - 2) + 1];
                                o1[e] = (v1 * cs - v2 * sn) * osc; o2[e] = (v2 * cs + v1 * sn) * osc;
                            }
                            epi_put4(w, mb * 32 + l31, d0, o1[0], o1[1], o1[2], o1[3]);
                            epi_put4(w, mb * 32 + l31, 32 + d0, o2[0], o2[1], o2[2], o2[3]);
                        }
                    }
                    u16* dst = (isq ? qa : ka) + ((size_t)(((b * 4 + head) * 2 + map)) * SK + spos0) * 64;
                    epi_rows8<64>(w, lane, [&](int row, int col, const f32x4& v0, const f32x4& v1) { *(u32x4*)(dst + (size_t)row * 64 + col) = pack8(v0, v1); });
                } else {
                    const int head = (nw - 2560) >> 7, vb0 = (nw - 2560) & 127;
#pragma unroll
                    for (int mb = 0; mb < 2; ++mb) {
                        const int tok = mb * 32 + l31, tp = (tok & ~12) | (((tok >> 3) & 1) << 2) | (((tok >> 2) & 1) << 3);
#pragma unroll
                        for (int nb = 0; nb < 2; ++nb)
#pragma unroll
                            for (int i = 0; i < 16; ++i) *(u16*)(w + (nb * 32 + crow(i, hh)) * 144 + tp * 2) = f2b(acc[nb][mb][i]);
                    }
                    u16* dst = vt + ((size_t)(b * 4 + head) * 128 + vb0) * SK + spos0;
#pragma unroll
                    for (int it = 0; it < 8; ++it) { const int v = it * 8 + (lane >> 3), c8 = lane & 7; *(u32x4*)(dst + (size_t)v * SK + c8 * 8) = *(const u32x4*)(w + v * 144 + c8 * 16); }
                }
            };
        if (big) {
            int r0, c; p8_rc(tid, r0, c);
            const unsigned ao = (unsigned)(r0 * 2048 + c * 2), bo = (unsigned)((((r0 >> 5) * 64 + (r0 & 31)) * 2048) + c * 2);
            gemm_tile8p(lds, (const uchar*)(hb + (size_t)m0 * 1024), ao, ao, ao, ao, 128 * 2048, 64 * 2048, 192 * 2048,
                        (const uchar*)(w + (size_t)n0 * 1024), bo, 128 * 2048, 32 * 2048, 160 * 2048, 16, 1 << 30, 0,
                        [&](int roff, int wc, int lane, uchar* w) {
                            const int nw = n0 + wc * 64;
                            if (nw < 1536) { const int row0 = m0 + roff; epi_rows8<64>(w, lane, [&](int row, int col, const f32x4& v0, const f32x4& v1) { *(u32x4*)(zc + (size_t)(row0 + row) * 1536 + nw + col) = pack8(v0, v1); }); }
                            else { f32x16 t[2][2]; epi_unstage(w, t, lane & 31, lane >> 5); epi(t, roff, wc, lane, w); } });
        } else {
            const u16* ab = hb + (size_t)(m0 + rs) * 1024;
            const u16* bb = w + (size_t)(n0 + rs) * 1024;
            gemm_tile(lds, ab, ab + 64 * 1024, bb, bb + 64 * 1024, bb + 128 * 1024, bb + 192 * 1024, 16, 1 << 30, 0, epi);
        }
    }
    tail_cvt_moe(P, lds, 768 + 48, 0, 0, MOE_CVT_TILES / 2);
    tail_cvt_dense(P, lds, 768 + 48, P.jobs[1].tile0, P.jobs[2].tile0);
}

constexpr int ATT_K = 64 * 128, ATT_V = 128 * 128;
constexpr int ATT_STAGE = 2 * ATT_K + ATT_V;
DI void attn_unit(const Ctx& p, uchar* lds, int bh, int q0, int key0, int ntile, int out_row0) {
    const int tid = tid_opaque();
    const int lane = tid & 63, wid = tid >> 6, l31 = lane & 31, hh = lane >> 5, m = wid >> 2, g = wid & 3;
    const u16* qa = (const u16*)(p.ws + WS_REGA + RA_Q);
    const u16* ka = (const u16*)(p.ws + WS_REGA + RA_K);
    const u16* vt = (const u16*)(p.ws + WS_REGA + RA_VT);
    uchar* qs = lds + 2 * ATT_STAGE + wid * 8192 + lane * 16;
    RAW_BARRIER();
    {
        const u16* qp = qa + ((size_t)(bh * 2 + m) * SK + q0 + g * 64 + l31) * 64 + hh * 8;
#pragma unroll
        for (int rg = 0; rg < 2; ++rg)
#pragma unroll
            for (int ks = 0; ks < 4; ++ks) *(bf16x8*)(qs + (rg * 4 + ks) * 1024) = *(const bf16x8*)(qp + rg * 32 * 64 + ks * 16);
    }
    const int lch = (lane & 7) ^ ((((wid & 1) << 3) + (lane >> 3)) >> 1);
    const u16* kp = ka + ((size_t)(bh * 2) * SK + key0 + wid * 8 + (lane >> 3)) * 64 + lch * 8;
    const u16* vp = vt + ((size_t)bh * 128 + wid * 8 + (lane >> 3)) * SK + key0 + lch * 8;
    const unsigned pw = (unsigned)__builtin_amdgcn_readfirstlane(wid) * 1024u;
    const int sw = (l31 >> 1) & 7;
    unsigned xo[4];
#pragma unroll
    for (int ks = 0; ks < 4; ++ks) xo[ks] = (unsigned)(((ks * 2 + hh) ^ sw) << 4);
    const unsigned kro = (unsigned)(m * ATT_K + l31 * 128), vro = (unsigned)(2 * ATT_K + l31 * 128);
    f32x16 O[2][4];
#pragma unroll
    for (int rg = 0; rg < 2; ++rg)
#pragma unroll
        for (int vb = 0; vb < 4; ++vb)
#pragma unroll
            for (int i = 0; i < 16; ++i) O[rg][vb][i] = 0.f;
    float lsum0 = 0.f, lsum1 = 0.f;
#define ATT_DMA(st_, t_) do { const int tq_ = (t_); uchar* s_ = lds + (st_) * ATT_STAGE + pw; \
        __builtin_amdgcn_global_load_lds((const unsigned*)(kp + (size_t)tq_ * 4096), (LAS unsigned*)(s_), 16, 0, 0); \
        __builtin_amdgcn_global_load_lds((const unsigned*)(kp + (size_t)SK * 64 + (size_t)tq_ * 4096), (LAS unsigned*)(s_ + ATT_K), 16, 0, 0); \
        __builtin_amdgcn_global_load_lds((const unsigned*)(vp + tq_ * 64), (LAS unsigned*)(s_ + 2 * ATT_K), 16, 0, 0); \
        __builtin_amdgcn_global_load_lds((const unsigned*)(vp + (size_t)64 * SK + tq_ * 64), (LAS unsigned*)(s_ + 2 * ATT_K + 8192), 16, 0, 0); } while (0)
    ATT_DMA(0, 0);
    WAIT_V(0);
    RAW_BARRIER();
#pragma unroll 1
    for (int t = 0; t < ntile; ++t) {
        if (t + 1 < ntile) ATT_DMA((t + 1) & 1, t + 1);
        const uchar* s = lds + (t & 1) * ATT_STAGE;
#pragma unroll 1
        for (int kb = 0; kb < 2; ++kb) {
            bf16x8 P[2][2];
#pragma unroll
            for (int rg = 0; rg < 2; ++rg) {
                f32x16 S;
#pragma unroll
                for (int i = 0; i < 16; ++i) S[i] = 0.f;
#pragma unroll
                for (int ks = 0; ks < 4; ++ks) { const bf16x8 kf = *(const bf16x8*)(s + kro + kb * 4096 + xo[ks]); const bf16x8 q = *(const bf16x8*)(qs + (rg * 4 + ks) * 1024); S = MFMA32(kf, q, S); }
                float ls = 0.f;
#pragma unroll
                for (int i = 0; i < 16; ++i) { S[i] = __builtin_amdgcn_exp2f(S[i]); ls += S[i]; }
                if (rg == 0) lsum0 += ls; else lsum1 += ls;
#pragma unroll
                for (int s2 = 0; s2 < 2; ++s2) {
                    u32x4 pw4; pw4.x = pk2(S[8 * s2], S[8 * s2 + 1]); pw4.y = pk2(S[8 * s2 + 2], S[8 * s2 + 3]); pw4.z = pk2(S[8 * s2 + 4], S[8 * s2 + 5]); pw4.w = pk2(S[8 * s2 + 6], S[8 * s2 + 7]);
                    P[rg][s2] = __builtin_bit_cast(bf16x8, pw4);
                }
            }
#pragma unroll
            for (int s2 = 0; s2 < 2; ++s2)
#pragma unroll
                for (int vb = 0; vb < 4; ++vb) {
                    const bf16x8 vf = *(const bf16x8*)(s + vro + vb * 4096 + (unsigned)(((4 * kb + 2 * s2 + hh) ^ sw) << 4));
                    O[0][vb] = MFMA32(vf, P[0][s2], O[0][vb]); O[1][vb] = MFMA32(vf, P[1][s2], O[1][vb]);
                }
        }
        WAIT_V(0);
        RAW_BARRIER();
    }
    lsum0 = xor32_sum(lsum0); lsum1 = xor32_sum(lsum1);
    const int tid2 = tid_opaque(), lane2 = tid2 & 63, wid2 = tid2 >> 6, e_l31 = lane2 & 31, e_hh = lane2 >> 5, e_m = wid2 >> 2, e_g = wid2 & 3;
    float lam;
    { float d1 = inp(p, I_LQ1)[lane2] * inp(p, I_LK1)[lane2], d2 = inp(p, I_LQ2)[lane2] * inp(p, I_LK2)[lane2]; d1 = wave_sum(d1); d2 = wave_sum(d2); lam = fexp(d1) - fexp(d2) + LAM_INIT0; }
    float* comb = (float*)lds + (size_t)e_g * 8192 + lane2;
    if (e_m == 1) {
#pragma unroll
        for (int rg = 0; rg < 2; ++rg) {
            const float sc = lam / (rg ? lsum1 : lsum0);
#pragma unroll
            for (int vb = 0; vb < 4; ++vb) {
#pragma unroll
                for (int i = 0; i < 16; ++i) comb[((rg * 4 + vb) * 16 + i) * 64] = O[rg][vb][i] * sc;
                __builtin_amdgcn_sched_barrier(0);
            }
        }
    }
    RAW_BARRIER();
    if (e_m == 0) {
        const float* snl = (const float*)(lds + 131072);
        const int h = bh & 3;
#pragma unroll
        for (int rg = 0; rg < 2; ++rg) {
            const float i0 = 1.0f / (rg ? lsum1 : lsum0);
            float ss = 0.f;
#pragma unroll
            for (int vb = 0; vb < 4; ++vb) {
#pragma unroll
                for (int i = 0; i < 16; ++i) { const float o = O[rg][vb][i] * i0 - comb[((rg * 4 + vb) * 16 + i) * 64]; O[rg][vb][i] = o; ss += o * o; }
                __builtin_amdgcn_sched_barrier(0);
            }
            ss = xor32_sum(ss);
            const float rstd = rsqrtf(ss * (1.0f / 128.0f) + EPS) * (1.0f - LAM_INIT0);
            u16* dst = (u16*)(p.ws + WS_HB) + (size_t)(out_row0 + e_g * 64 + rg * 32 + e_l31) * 1024 + 512 + h * 128;
#pragma unroll
            for (int vb = 0; vb < 4; ++vb)
#pragma unroll
                for (int gq = 0; gq < 4; ++gq) {
                    const int v0 = vb * 32 + 8 * gq + 4 * e_hh;
                    const f32x4 gn = *(const f32x4*)(snl + v0);
                    u32x2 w; w.x = pk2(O[rg][vb][4 * gq] * rstd * gn[0], O[rg][vb][4 * gq + 1] * rstd * gn[1]); w.y = pk2(O[rg][vb][4 * gq + 2] * rstd * gn[2], O[rg][vb][4 * gq + 3] * rstd * gn[3]);
                    *(u32x2*)(dst + v0) = w;
                }
        }
    }
}
DI void phase_attn(const Ctx& p, uchar* lds) {
    const int tid = tid_opaque();
    if (tid < 128) ((float*)(lds + 131072))[tid] = inp(p, I_SUBN)[tid];
    for (int u = blockIdx.x; u < 264; u += gridDim.x) {
        const bool lat = u < 256;
        const int bh = u & 7, qb = u >> 3;
        attn_unit(p, lds, bh, lat ? qb * 256 : SEQ, lat ? 0 : SEQ, lat ? 132 : 4, lat ? (bh >> 2) * SEQ + qb * 256 : NL + (bh >> 2) * CTXL);
    }
    {
        const u16* zc = (const u16*)(p.ws + WS_REGA + RA_ZC);
        u16* hb = (u16*)(p.ws + WS_HB);
        const int c = tid_opaque();
        const float w0 = inp(p, I_EVCW)[c], w1 = inp(p, I_EVCW)[512 + c], w2 = inp(p, I_EVCW)[1024 + c], bias = inp(p, I_EVCB)[c];
        for (int u = blockIdx.x; u < 256; u += gridDim.x) {
            const int r0 = u * 66;
            auto prod = [&](int r) -> float { return b2f(zc[(size_t)r * 1536 + 512 + c]) * b2f(zc[(size_t)r * 1536 + 1024 + c]); };
            auto first = [&](int r) -> bool { return r < NL ? (r & 8191) == 0 : ((r - NL) & 255) == 0; };
            auto last = [&](int r) -> bool { return r < NL ? (r & 8191) == 8191 : ((r - NL) & 255) == 255; };
            float pp = first(r0) ? 0.f : prod(r0 - 1), pc = prod(r0);
#pragma unroll 2
            for (int r = r0; r < r0 + 66; ++r) {
                const float pn = last(r) ? 0.f : prod(r + 1);
                const float cv = bias + w0 * (first(r) ? 0.f : pp) + w1 * pc + w2 * pn;
                hb[(size_t)r * 1024 + c] = f2b(b2f(zc[(size_t)r * 1536 + c]) * cv);
                pp = pc; pc = pn;
            }
        }
    }
}

DI void phase_outproj(const Params& P, const Ctx& p, uchar* lds, int layer) {
    const int tid = tid_opaque();
    const u16* hb = (const u16*)(p.ws + WS_HB);
    const u16* w = (const u16*)(p.ws + (layer == 0 ? WS_WOUT0 : WS_WOUT1));
    float* xs = (float*)(p.ws + WS_XS);
    const float* mod = (const float*)(p.ws + WS_MOD);
    const int nbig = 256, nunits = nbig + (layer == 0 ? 16 : 0);
    for (int u = blockIdx.x; u < nunits; u += gridDim.x) {
        const bool big = u < nbig;
        int mt, nt; if (big) rect_unit(u, 64, 4, mt, nt); else { mt = (u - nbig) >> 2; nt = u & 3; }
        const int m0 = big ? mt * 256 : NL + mt * 128, n0 = nt * 256;
        auto epi_body =
            [&](int roff, int wc, int lane, uchar* w) {
                const int row0 = m0 + roff, nw = n0 + wc * 64;
                const float* g1 = mod + (layer * 3 + mod_row(row0)) * 6144 + 2048 + nw;
                const float* src = row_src(p, layer, row0) + nw;
                f32x4 xi[16], gg = *(const f32x4*)(g1 + (lane & 15) * 4);
#pragma unroll
                for (int it = 0; it < 16; ++it) xi[it] = *(const f32x4*)(src + (size_t)(it * 4 + (lane >> 4)) * 1024 + (lane & 15) * 4);
#pragma unroll
                for (int it = 0; it < 16; ++it) {
                    const int row = it * 4 + (lane >> 4), col = (lane & 15) * 4;
                    const f32x4 v = *(const f32x4*)(w + row * EPI_PITCH + col * 4);
                    f32x4 o;
#pragma unroll
                    for (int e = 0; e < 4; ++e) o[e] = xi[it][e] + gg[e] * v[e];
                    *(f32x4*)(xs + (size_t)(row0 + row) * 1024 + nw + col) = o;
                }
            };
        auto epi = [&](f32x16 (&acc)[2][2], int roff, int wc, int lane, uchar* w) { epi_stage(w, acc, lane & 31, lane >> 5); epi_body(roff, wc, lane, w); };
        if (big) {
            int r0, c; p8_rc(tid, r0, c);
            const unsigned ao = (unsigned)(r0 * 2048 + c * 2), bo = (unsigned)((((r0 >> 5) * 64 + (r0 & 31)) * 2048) + c * 2);
            gemm_tile8p(lds, (const uchar*)(hb + (size_t)m0 * 1024), ao, ao, ao, ao, 128 * 2048, 64 * 2048, 192 * 2048,
                        (const uchar*)(w + (size_t)n0 * 1024), bo, 128 * 2048, 32 * 2048, 160 * 2048, 16, 1 << 30, 0, epi_body);
        } else {
            const int rs = tid >> 3;
            const u16* ab = hb + (size_t)(m0 + rs) * 1024;
            const u16* bb = w + (size_t)(n0 + rs) * 1024;
            gemm_tile(lds, ab, ab + 64 * 1024, bb, bb + 64 * 1024, bb + 128 * 1024, bb + 192 * 1024, 16, 1 << 30, 0, epi);
        }
    }
    if (layer == 0) tail_cvt_moe(P, lds, nunits, 0, MOE_CVT_TILES / 2, MOE_CVT_TILES);
}

struct TileInfo { int bucket, mt, cnt, ntiles; };
DI int moe_ntiles(const int* cnt) { int s = 0; for (int b = 0; b < 24; ++b) s += (cnt[b * 32] + 127) >> 7; return s; }
DI TileInfo moe_tile(const int* cnt, int t) {
    TileInfo ti; ti.bucket = 0; ti.mt = 0; ti.cnt = 0; ti.ntiles = 0;
    int base = 0;
    for (int b = 0; b < 24; ++b) { const int c = cnt[b * 32], n = (c + 127) >> 7; if (t >= base && t < base + n) { ti.bucket = b; ti.mt = t - base; ti.cnt = c; } base += n; }
    ti.ntiles = base; return ti;
}
DI void bucket_experts(int bucket, int& ea, int& eb) {
    const int g = bucket / 6, pi = bucket - g * 6;
    const int lo = pi < 3 ? 0 : (pi < 5 ? 1 : 2), hi = pi < 3 ? pi + 1 : (pi < 5 ? pi - 1 : 3);
    ea = g * 4 + lo; eb = g * 4 + hi;
}
struct MoeUnit { int bucket, t, mt, cnt, big, nt; };
DI int moe_units(const int* cnt, int NT, int G, int& B, int& NBIG) {
    int b2 = 0, s1 = 0;
    for (int b = 0; b < 24; ++b) { const int n = (cnt[b * 32] + 127) >> 7; b2 += n >> 1; s1 += n & 1; }
    B = b2;
    const int cand = b2 * NT;
    int best = 1 << 30; NBIG = 0;
    for (int k = 0; k <= (cand + G - 1) / G; ++k) {
        const int nb = k * G < cand ? k * G : cand, U = 2 * cand + s1 * NT - nb;
        const int rb = (nb + G - 1) / G, ru = (U + G - 1) / G, cost = rb * 7 + (ru - rb) * 5;
        if (cost < best) { best = cost; NBIG = nb; }
    }
    return 2 * cand + s1 * NT - NBIG;
}
DI MoeUnit moe_unit(const int* cnt, int u, int NT, int B, int NBIG) {
    const int sh = NT == 8 ? 3 : 2;
    int kind, idx, half = 0, nt;
    if (u < NBIG) { kind = 0; idx = u >> sh; nt = u & (NT - 1); }
    else {
        int v = u - NBIG; const int npl = B - (NBIG >> sh);
        if (v < npl * 2 * NT) { kind = 1; idx = (NBIG >> sh) + (v >> (sh + 1)); half = (v >> sh) & 1; nt = v & (NT - 1); }
        else { v -= npl * 2 * NT; kind = 2; idx = v >> sh; nt = v & (NT - 1); }
    }
    MoeUnit r; r.bucket = 0; r.t = 0; r.mt = 0; r.cnt = 0; r.big = kind == 0; r.nt = nt;
    int pb = 0, ps = 0, pt = 0;
    for (int b = 0; b < 24; ++b) {
        const int c = cnt[b * 32], n = (c + 127) >> 7, np = n >> 1, sg = n & 1;
        if (kind != 2) { if (idx >= pb && idx < pb + np) { r.bucket = b; r.mt = 2 * (idx - pb) + half; r.t = pt + r.mt; r.cnt = c; } }
        else if (sg && idx == ps) { r.bucket = b; r.mt = n - 1; r.t = pt + n - 1; r.cnt = c; }
        pb += np; ps += sg; pt += n;
    }
    return r;
}
constexpr int MOE_TOK = 3 * GEMM_STAGE;
DI void phase_moe_up(const Params& P, const Ctx& p, uchar* lds, int layer) {
    const int tid = tid_opaque();
    const int* cnt = (const int*)(p.ws + WS_CTL + CTL_CNT) + layer * 1024;
    const int* list = (const int*)(p.ws + WS_LIST);
    const f32x2* route = (const f32x2*)(p.ws + WS_ROUTE);
    const u16* hb = (const u16*)(p.ws + WS_HB);
    const u16* wgu = (const u16*)(p.ws + WS_WGU) + (size_t)layer * 16 * 1024 * 1024;
    u16* act = (u16*)(p.ws + WS_REGA + RA_ACT);
    int* tok = (int*)(lds + MOE_TOK);
    const int rs = tid >> 3;
    int B, NBIG;
    const int U = moe_units(cnt, 8, gridDim.x, B, NBIG);
    for (int u = blockIdx.x; u < U; u += gridDim.x) {
        const MoeUnit mu = moe_unit(cnt, u, 8, B, NBIG);
        const int nt = mu.nt;
        int ea, eb; bucket_experts(mu.bucket, ea, eb);
        __syncthreads();
        if (tid < (mu.big ? 256 : 128)) { const int pos = mu.mt * 128 + tid; tok[tid] = list[(size_t)mu.bucket * R + (pos < mu.cnt ? pos : 0)]; }
        __syncthreads();
        const int e = nt < 4 ? ea : eb;
        auto epi_body =
            [&](int roff, int wc, int lane, uchar* w) {
                u16* dst = act + ((size_t)mu.t * 128 + roff) * 1024 + (nt >= 4 ? 512 : 0) + (nt & 3) * 128 + wc * 32;
                const int col = (lane & 3) * 8;
                f32x2 rw[4];
#pragma unroll
                for (int it = 0; it < 4; ++it) rw[it] = route[tok[roff + it * 16 + (lane >> 2)]];
#pragma unroll
                for (int it = 0; it < 4; ++it) {
                    const int row = it * 16 + (lane >> 2);
                    const float wgt = nt < 4 ? rw[it].x : rw[it].y;
                    const uchar* wp = w + row * EPI_PITCH + col * 4;
                    const f32x4 g0 = *(const f32x4*)wp, g1 = *(const f32x4*)(wp + 16), u0 = *(const f32x4*)(wp + 128), u1 = *(const f32x4*)(wp + 144);
                    f32x4 o0, o1;
#pragma unroll
                    for (int e2 = 0; e2 < 4; ++e2) { o0[e2] = g0[e2] * sigmoidf_(g0[e2]) * u0[e2] * wgt; o1[e2] = g1[e2] * sigmoidf_(g1[e2]) * u1[e2] * wgt; }
                    *(u32x4*)(dst + (size_t)row * 1024 + col) = pack8(o0, o1);
                }
            };
        if (mu.big) {
            int r0, c; p8_rc(tid, r0, c);
            const unsigned bo = (unsigned)((((r0 >> 5) * 64 + (r0 & 31)) * 2048) + c * 2);
            const unsigned a00 = (unsigned)tok[r0] * 2048u + c * 2, a10 = (unsigned)tok[128 + r0] * 2048u + c * 2, a01 = (unsigned)tok[64 + r0] * 2048u + c * 2, a11 = (unsigned)tok[192 + r0] * 2048u + c * 2;
            gemm_tile8p(lds, (const uchar*)hb, a00, a10, a01, a11, 0, 0, 0,
                        (const uchar*)(wgu + ((size_t)e * 1024 + (nt & 3) * 256) * 1024), bo, 128 * 2048, 32 * 2048, 160 * 2048, 16, 1 << 30, 0, epi_body);
        } else {
            const u16* a0 = hb + (size_t)tok[rs] * 1024;
            const u16* a1 = hb + (size_t)tok[rs + 64] * 1024;
            const u16* bb = wgu + ((size_t)e * 1024 + (nt & 3) * 256 + rs) * 1024;
            gemm_tile(lds, a0, a1, bb, bb + 64 * 1024, bb + 128 * 1024, bb + 192 * 1024, 16, 1 << 30, 0,
                [&](f32x16 (&acc)[2][2], int roff, int wc, int lane, uchar* w) { epi_stage(w, acc, lane & 31, lane >> 5); epi_body(roff, wc, lane, w); });
        }
    }
    if (layer == 0) tail_cvt_dense(P, lds, U, P.jobs[2].tile0, P.jobs[6].tile0);
}
DI void phase_moe_down(const Params& P, const Ctx& p, uchar* lds, int layer) {
    const int tid = tid_opaque();
    const int* cnt = (const int*)(p.ws + WS_CTL + CTL_CNT) + layer * 1024;
    const int* list = (const int*)(p.ws + WS_LIST);
    const u16* wd = (const u16*)(p.ws + WS_WD) + (size_t)layer * 16 * 1024 * 512;
    const u16* act = (const u16*)(p.ws + WS_REGA + RA_ACT);
    float* xs = (float*)(p.ws + WS_XS);
    float* dsto = layer == 0 ? xs : p.out;
    const float* mod = (const float*)(p.ws + WS_MOD);
    int* tok = (int*)(lds + MOE_TOK);
    const int rs = tid >> 3;
    int B, NBIG;
    const int U = moe_units(cnt, 4, gridDim.x, B, NBIG);
    for (int u = blockIdx.x; u < U; u += gridDim.x) {
        const MoeUnit mu = moe_unit(cnt, u, 4, B, NBIG);
        const int nt = mu.nt, n0 = nt * 256;
        int ea, eb; bucket_experts(mu.bucket, ea, eb);
        __syncthreads();
        if (tid < (mu.big ? 256 : 128)) { const int pos = mu.mt * 128 + tid; tok[tid] = pos < mu.cnt ? list[(size_t)mu.bucket * R + pos] : -1; }
        __syncthreads();
        const long bjump = (long)(eb - ea) * 1024 * 512 - 512;
        auto epi_body =
            [&](int roff, int wc, int lane, uchar* w) {
                const int nw = n0 + wc * 64 + (lane & 15) * 4;
                int tk[16]; f32x4 xi[16];
#pragma unroll
                for (int it = 0; it < 16; ++it) {
                    tk[it] = tok[roff + it * 4 + (lane >> 4)];
                    xi[it] = (f32x4){0.f, 0.f, 0.f, 0.f};
                    if (tk[it] >= 0) xi[it] = *(const f32x4*)(xs + (size_t)tk[it] * 1024 + nw);
                }
#pragma unroll
                for (int it = 0; it < 16; ++it) {
                    const int row = it * 4 + (lane >> 4);
                    if (tk[it] >= 0) {
                        const f32x4 gg = *(const f32x4*)(mod + (layer * 3 + mod_row(tk[it])) * 6144 + 5 * 1024 + nw);
                        const f32x4 v = *(const f32x4*)(w + row * EPI_PITCH + (lane & 15) * 16);
                        f32x4 o;
#pragma unroll
                        for (int e = 0; e < 4; ++e) o[e] = xi[it][e] + gg[e] * v[e];
                        *(f32x4*)(dsto + (size_t)tk[it] * 1024 + nw) = o;
                    }
                }
            };
        if (mu.big) {
            int r0, c; p8_rc(tid, r0, c);
            const unsigned ao = (unsigned)(r0 * 2048 + c * 2), bo = (unsigned)((((r0 >> 5) * 64 + (r0 & 31)) * 1024) + c * 2);
            gemm_tile8p(lds, (const uchar*)(act + (size_t)mu.t * 128 * 1024), ao, ao, ao, ao, 128 * 2048, 64 * 2048, 192 * 2048,
                        (const uchar*)(wd + ((size_t)ea * 1024 + n0) * 512), bo, 128 * 1024, 32 * 1024, 160 * 1024, 16, 8, bjump * 2, epi_body);
        } else {
            const u16* ab = act + ((size_t)mu.t * 128 + rs) * 1024;
            const u16* bb = wd + ((size_t)ea * 1024 + n0 + rs) * 512;
            gemm_tile(lds, ab, ab + 64 * 1024, bb, bb + 64 * 512, bb + 128 * 512, bb + 192 * 512, 16, 8, bjump,
                [&](f32x16 (&acc)[2][2], int roff, int wc, int lane, uchar* w) { epi_stage(w, acc, lane & 31, lane >> 5); epi_body(roff, wc, lane, w); });
        }
    }
    if (layer == 0) tail_cvt_moe(P, lds, U, 1, 0, MOE_CVT_TILES / 2);
}

DI void phase_inproj1(const Params& P, const Ctx& p, uchar* lds) {
    const int tid = tid_opaque();
    const u16* hb = (const u16*)(p.ws + WS_HB);
    const u16* w = (const u16*)(p.ws + WS_WIN1);
    u16* yb = (u16*)(p.ws + WS_REGA + RA_Y);
    u16* ub = (u16*)(p.ws + WS_REGA + RA_U);
    const int rs = tid >> 3;
    for (int u = blockIdx.x; u < 512 + 16; u += gridDim.x) {
        const bool big = u < 512;
        int mt, nt; if (big) rect_unit(u, 64, 8, mt, nt); else { mt = (u - 512) >> 2; nt = 4 + ((u - 512) & 3); }
        const int m0 = big ? mt * 256 : NL + mt * 128, n0 = nt * 256;
        auto epi_body =
            [&](int roff, int wc, int lane, uchar* w) {
                const int row0 = m0 + roff, nw = n0 + wc * 64;
                if (nt < 4) {
                    epi_rows8<64>(w, lane, [&](int row, int col, const f32x4& v0, const f32x4& v1) {
                        f32x4 a, b2;
#pragma unroll
                        for (int e = 0; e < 4; ++e) { const float x = v0[e], y = v1[e]; a[e] = x * sigmoidf_(1.5957691216057308f * (x + 0.044715f * x * x * x)); b2[e] = y * sigmoidf_(1.5957691216057308f * (y + 0.044715f * y * y * y)); }
                        *(u32x4*)(yb + (size_t)(row0 + row) * 1024 + nw + col) = pack8(a, b2); });
                } else {
                    epi_rows8<64>(w, lane, [&](int row, int col, const f32x4& v0, const f32x4& v1) { *(u32x4*)(ub + (size_t)(row0 + row) * 1024 + nw - 1024 + col) = pack8(v0, v1); });
                }
            };
        if (big) {
            int r0, c; p8_rc(tid, r0, c);
            const unsigned ao = (unsigned)(r0 * 2048 + c * 2), bo = (unsigned)((((r0 >> 5) * 64 + (r0 & 31)) * 2048) + c * 2);
            gemm_tile8p(lds, (const uchar*)(hb + (size_t)m0 * 1024), ao, ao, ao, ao, 128 * 2048, 64 * 2048, 192 * 2048,
                        (const uchar*)(w + (size_t)n0 * 1024), bo, 128 * 2048, 32 * 2048, 160 * 2048, 16, 1 << 30, 0, epi_body);
        } else {
            const u16* ab = hb + (size_t)(m0 + rs) * 1024;
            const u16* bb = w + (size_t)(n0 + rs) * 1024;
            gemm_tile(lds, ab, ab + 64 * 1024, bb, bb + 64 * 1024, bb + 128 * 1024, bb + 192 * 1024, 16, 1 << 30, 0,
                [&](f32x16 (&acc)[2][2], int roff, int wc, int lane, uchar* w) { epi_stage(w, acc, lane & 31, lane >> 5); epi_body(roff, wc, lane, w); });
        }
    }
    tail_cvt_moe(P, lds, 512 + 16, 1, MOE_CVT_TILES / 2, MOE_CVT_TILES);
}

constexpr int LRU_U = 0, LRU_UC = 36864, UROW = 272, UC_BLK = 64 * UROW  , UC_DIR = 2 * UC_BLK;
DI int lru_perm(int r) { return ((r >> 2) & 1) * 16 + (r >> 3) * 4 + (r & 3); }
DI unsigned* lru_bsave(const Ctx& p, int dir, int c, int cblk, int wid) {
    unsigned* base = (unsigned*)(p.ws + (dir == 0 ? WS_REGA + RA_BS0 : WS_WGU));
    return base + ((size_t)(c * 4 + cblk) * 8 + wid) * 1024;
}
DI u32x4* lru_osave(const Ctx& p, int dir, int c, int cblk, int wid, int q, int lane) {
    if (dir == 0) return (u32x4*)(p.ws + WS_HB + ((size_t)(c * 64 + (wid * 4 + q) * 2 + (lane >> 5)) * 2048 + cblk * 512 + (lane & 31) * 16));
    uchar* base = p.ws + (c < 128 ? WS_WD : WS_OM1B);
    return (u32x4*)(base + ((size_t)((c & 127) * 4 + cblk) * 32768 + ((wid * 4 + q) * 64 + lane) * 16));
}
struct LruW { bf16x8 fa[8], fx[8]; };
DI void lru_wload(const Ctx& p, int dir, int cblk, int wid, int lane, LruW& w, int which = 3) {
    const int l31 = lane & 31, hh = lane >> 5, bl = wid >> 2, jq = wid & 3, blkg = cblk * 2 + bl;
    const u16* wa = (const u16*)(p.ws + WS_WA) + ((size_t)(dir * 8 + blkg) * 128 + jq * 32 + l31) * 128 + hh * 8;
    const u16* wx = (const u16*)(p.ws + WS_WX) + ((size_t)(dir * 8 + blkg) * 128 + jq * 32 + l31) * 128 + hh * 8;
    if (which & 1) {
#pragma unroll
        for (int ks = 0; ks < 8; ++ks) w.fa[ks] = *(const bf16x8*)(wa + ks * 16);
    }
    if (which & 2) {
#pragma unroll
        for (int ks = 0; ks < 8; ++ks) w.fx[ks] = *(const bf16x8*)(wx + ks * 16);
    }
    __builtin_amdgcn_sched_barrier(0);
}
template <class Hook, class Hook2>
DI void lru_gates(const Ctx& p, const uchar* lds, int dir, int cblk, int wid, int lane, const LruW& w, float (&a)[2][16], float (&b)[2][16], unsigned* bsave, Hook&& hook, Hook2&& hook2) {
    const int l31 = lane & 31, hh = lane >> 5, bl = wid >> 2, jq = wid & 3;
    const int chl = bl * 128 + jq * 32 + l31;
    const int ch = cblk * 256 + chl;
    const uchar* uc = lds + LRU_UC + dir * UC_DIR + bl * UC_BLK;
    f32x16 dr[2], di[2];
#pragma unroll
    for (int rb = 0; rb < 2; ++rb)
#pragma unroll
        for (int i = 0; i < 16; ++i) { dr[rb][i] = 0.f; di[rb][i] = 0.f; }
    const int tk = lru_perm(l31);
#pragma unroll
    for (int ks = 0; ks < 8; ++ks) {
#pragma unroll
        for (int rb = 0; rb < 2; ++rb) dr[rb] = MFMA32(*(const bf16x8*)(uc + (rb * 32 + tk) * UROW + ks * 32 + hh * 16), w.fa[ks], dr[rb]);
    }
#pragma unroll
    for (int ks = 0; ks < 8; ++ks) {
#pragma unroll
        for (int rb = 0; rb < 2; ++rb) di[rb] = MFMA32(*(const bf16x8*)(uc + (rb * 32 + tk) * UROW + ks * 32 + hh * 16), w.fx[ks], di[rb]);
    }
    __builtin_amdgcn_sched_barrier(0);
    hook();
    const float nl2 = -1.4426950408889634f;
    const float kba = inp(p, I_ODBA)[dir * 1024 + ch] * nl2, kbx = inp(p, I_ODBX)[dir * 1024 + ch] * nl2;
    const float sp8 = 8.0f * log1pf(__expf(-inp(p, I_ODLAM)[dir * 1024 + ch]));
    const float c1 = sp8 * nl2;
    const int cofs = (jq * 32 + l31) * 2;
#pragma unroll
    for (int rb = 0; rb < 2; ++rb)
#pragma unroll
        for (int i = 0; i < 16; ++i) {
            const int token = rb * 32 + hh * 16 + i;
            const float r = frcp(1.0f + __builtin_amdgcn_exp2f(__builtin_fmaf(dr[rb][i], nl2, kba)));
            const float av = __builtin_amdgcn_exp2f(c1 * r);
            a[rb][i] = av;
            const float om = __builtin_fmaf(-av, av, 1.0f);
            const float ucv = b2f(*(const u16*)(uc + token * UROW + cofs));
            const float ig = frcp(1.0f + __builtin_amdgcn_exp2f(__builtin_fmaf(di[rb][i], nl2, kbx)));
            b[rb][i] = __builtin_amdgcn_sqrtf(om) * (ig * ucv);
        }
    __builtin_amdgcn_sched_barrier(0);
    hook2();
    if (bsave) {
#pragma unroll
        for (int q = 0; q < 4; ++q) {
            u32x4 v;
#pragma unroll
            for (int e = 0; e < 4; ++e) { const int j = q * 4 + e, rb = j >> 3, i = (j & 7) * 2; v[e] = pk2(b[rb][i], b[rb][i + 1]); }
            ((u32x4*)bsave)[q * 64 + lane] = v;
        }
    }
}
constexpr int LRU_U2 = 106496;
DI void lru_seq(int c, int& s0, int& s1) { if (c < 256) { s0 = (c >> 7) * SEQ; s1 = s0 + SEQ; } else { s0 = NL + ((c - 256) >> 2) * CTXL; s1 = s0 + CTXL; } }
DI void lru_dma(const Ctx& p, uchar* lds, int c, int cblk, int buf) {
    const int tid = tid_opaque(), lane = tid & 63, wid = tid >> 6;
    const u16* ub = (const u16*)(p.ws + WS_REGA + RA_U);
    int s0, s1; lru_seq(c, s0, s1);
    const int w0 = __builtin_amdgcn_readfirstlane(wid);
    uchar* dst = lds + (buf ? LRU_U2 : LRU_U);
#pragma unroll
    for (int k = 0; k < 5; ++k) {
        const int i = w0 + 8 * k;
        if (i < 35) {
            int row = c * 64 - 3 + 2 * i + (lane >> 5);
            row = row < s0 ? s0 : (row >= s1 ? s1 - 1 : row);
            __builtin_amdgcn_global_load_lds((const unsigned*)(ub + (size_t)row * 1024 + cblk * 256 + (lane & 31) * 8), (LAS unsigned*)(dst + i * 1024), 16, 0, 0);
        }
    }
}
DI void lru_conv(const Ctx& p, uchar* lds, int c, int cblk, int buf, bool counted = false) {
    const int tid = tid_opaque();
    const int row0 = c * 64;
    int s0, s1; lru_seq(c, s0, s1);
    const uchar* ut = lds + (buf ? LRU_U2 : LRU_U);
    if (counted) WAIT_V(8); else WAIT_V(0);
    __syncthreads();
    const int c8 = tid & 31, tq = tid >> 5, t0 = tq * 4;
    float uv[10][8];
#pragma unroll
    for (int rr = 0; rr < 10; ++rr) {
        u32x4 v = *(const u32x4*)(ut + (t0 + rr) * 512 + c8 * 16);
        const int row = row0 - 3 + t0 + rr;
        if (row < s0 || row >= s1) v = (u32x4){0u, 0u, 0u, 0u};
        uv[rr][0] = blo(v.x); uv[rr][1] = bhi(v.x); uv[rr][2] = blo(v.y); uv[rr][3] = bhi(v.y); uv[rr][4] = blo(v.z); uv[rr][5] = bhi(v.z); uv[rr][6] = blo(v.w); uv[rr][7] = bhi(v.w);
    }
#pragma unroll
    for (int dir = 0; dir < 2; ++dir) {
        const float* cw = inp(p, I_ODCW) + dir * 4096 + cblk * 256 + c8 * 8;
        const float* cb = inp(p, I_ODCB) + dir * 1024 + cblk * 256 + c8 * 8;
        float w[4][8], bs[8];
#pragma unroll
        for (int k = 0; k < 4; ++k) { const f32x4 x0 = *(const f32x4*)(cw + k * 1024), x1 = *(const f32x4*)(cw + k * 1024 + 4); w[k][0] = x0[0]; w[k][1] = x0[1]; w[k][2] = x0[2]; w[k][3] = x0[3]; w[k][4] = x1[0]; w[k][5] = x1[1]; w[k][6] = x1[2]; w[k][7] = x1[3]; }
        { const f32x4 x0 = *(const f32x4*)cb, x1 = *(const f32x4*)(cb + 4); bs[0] = x0[0]; bs[1] = x0[1]; bs[2] = x0[2]; bs[3] = x0[3]; bs[4] = x1[0]; bs[5] = x1[1]; bs[6] = x1[2]; bs[7] = x1[3]; }
#pragma unroll
        for (int tt = 0; tt < 4; ++tt) {
            float o[8];
#pragma unroll
            for (int e = 0; e < 8; ++e) {
                float s = bs[e];
#pragma unroll
                for (int k = 0; k < 4; ++k) s += w[k][e] * uv[tt + k + (dir ? 3 : 0)][e];
                o[e] = s;
            }
            const int t = t0 + tt;
            u32x4 wv; wv.x = pk2(o[0], o[1]); wv.y = pk2(o[2], o[3]); wv.z = pk2(o[4], o[5]); wv.w = pk2(o[6], o[7]);
            *(u32x4*)(lds + LRU_UC + dir * UC_DIR + (c8 >> 4) * UC_BLK + t * UROW + (c8 & 15) * 16) = wv;
        }
    }
    __syncthreads();
}
DI void lru_seg(const float (&a)[2][16], const float (&b)[2][16], int dir, int hh, float (&SA)[4], float (&SB)[4]) {
    float oa[2], ob[2];
#pragma unroll
    for (int rb = 0; rb < 2; ++rb) {
        float A = 1.f, B = 0.f;
#pragma unroll
        for (int ii = 0; ii < 16; ++ii) { const int i = dir ? 15 - ii : ii; B = a[rb][i] * B + b[rb][i]; A *= a[rb][i]; }
        oa[rb] = A; ob[rb] = B;
    }
    float pa[2], pb[2];
#pragma unroll
    for (int rb = 0; rb < 2; ++rb) { pa[rb] = __shfl_xor(oa[rb], 32); pb[rb] = __shfl_xor(ob[rb], 32); }
#pragma unroll
    for (int rb = 0; rb < 2; ++rb)
#pragma unroll
        for (int h = 0; h < 2; ++h) {
            const float A = (h == hh) ? oa[rb] : pa[rb], B = (h == hh) ? ob[rb] : pb[rb];
            const int s = dir ? 3 - (rb * 2 + h) : rb * 2 + h;
            SA[s] = A; SB[s] = B;
        }
}
DI void lru_summ_item(int j, int& c, int& cblk, int& role) {
    if (j < 1024) { c = j >> 2; cblk = j & 3; role = -1; } else { const int mini = j - 1024, cu = mini >> 3; c = 256 + (cu >> 2); cblk = cu & 3; role = mini & 7; }
}
template <class F>
DI void lru_summ_wave(const Ctx& p, uchar* lds, int c, int cblk, int role, LruW& w, F&& next_dma) {
    const int tid = tid_opaque(), lane = tid & 63, wid = role < 0 ? (tid >> 6) : role, hh = lane >> 5;
    f32x2* summ = (f32x2*)(p.ws + WS_SUMM);
    const int ch = cblk * 256 + (wid >> 2) * 128 + (wid & 3) * 32 + (lane & 31);
#pragma unroll
    for (int dir = 0; dir < 2; ++dir) {
        float a[2][16], b[2][16];
        unsigned* bs = c < 256 ? lru_bsave(p, dir, c, cblk, wid) : (unsigned*)nullptr;
        if (dir == 0) lru_gates(p, lds, 0, cblk, wid, lane, w, a, b, bs, [&]() { lru_wload(p, 1, cblk, wid, lane, w, 1); }, [&]() { lru_wload(p, 1, cblk, wid, lane, w, 2); });
        else          lru_gates(p, lds, 1, cblk, wid, lane, w, a, b, bs, [&]() { next_dma(); lru_wload(p, 0, cblk, wid, lane, w, 1); }, [&]() { lru_wload(p, 0, cblk, wid, lane, w, 2); });
        if (c < 256) {
#pragma unroll
            for (int q = 0; q < 4; ++q) {
                u32x4 v;
#pragma unroll
                for (int e = 0; e < 4; ++e) { const int j = q * 4 + e, rb = j >> 3, i = (j & 7) * 2; v[e] = pk2(1.0f - a[rb][i], 1.0f - a[rb][i + 1]); }
                *lru_osave(p, dir, c, cblk, wid, q, lane) = v;
            }
        }
        float SA[4], SB[4];
        lru_seg(a, b, dir, hh, SA, SB);
        float A = 1.f, B = 0.f;
#pragma unroll
        for (int s = 0; s < 4; ++s) { B = SA[s] * B + SB[s]; A *= SA[s]; }
        if (hh == 0) summ[((size_t)dir * 264 + c) * 1024 + ch] = (f32x2){A, B};
    }
}
DI void phase_lru_summ(const Ctx& p, uchar* lds) {
    const int tid = tid_opaque(), lane = tid & 63, wid = tid >> 6;
    constexpr int NITEM = 1024 + 32 * 8;
    int c, cblk, role;
    if ((int)blockIdx.x >= NITEM) return;
    lru_summ_item(blockIdx.x, c, cblk, role); lru_dma(p, lds, c, cblk, 0);
    LruW w;
    lru_wload(p, 0, cblk, role < 0 ? wid : role, lane, w);
    int buf = 0;
    bool counted = false;
    for (int j = blockIdx.x; j < NITEM; j += gridDim.x, buf ^= 1) {
        lru_summ_item(j, c, cblk, role);
        lru_conv(p, lds, c, cblk, buf, counted);
        counted = role < 0;
        int c2 = 0, cblk2 = 0, role2 = -1;
        const bool more = j + (int)gridDim.x < NITEM;
        if (more) lru_summ_item(j + gridDim.x, c2, cblk2, role2);
        auto next_dma = [&]() { if (more) lru_dma(p, lds, c2, cblk2, buf ^ 1); };
        if (role < 0) {
            lru_summ_wave(p, lds, c, cblk, -1, w, next_dma);
            if (more && role2 >= 0) lru_wload(p, 0, cblk2, role2, lane, w);
        } else {
            if (wid == 0) lru_summ_wave(p, lds, c, cblk, role, w, next_dma); else next_dma();
            if (more && (cblk2 != cblk || role2 != role)) lru_wload(p, 0, cblk2, role2, lane, w);
        }
    }
    WAIT_V(0);
}
DI void phase_lru_carry(const Ctx& p) {
    const int tid = tid_opaque();
    const f32x2* summ = (const f32x2*)(p.ws + WS_SUMM);
    float* carry = (float*)(p.ws + WS_CARRY);
    for (int g = blockIdx.x * 512 + tid; g < 4096; g += gridDim.x * 512) {
        const int ch = g & 1023, bt = (g >> 10) & 1, dir = g >> 11;
        const f32x2* sd = summ + (size_t)dir * 264 * 1024 + ch;
        float h = 0.f;
        f32x2 s[4];
#pragma unroll
        for (int q = 0; q < 4; ++q) s[q] = sd[(size_t)(256 + bt * 4 + (dir ? 3 - q : q)) * 1024];
#pragma unroll
        for (int q = 0; q < 4; ++q) h = s[q].x * h + s[q].y;
        for (int q0 = 0; q0 < 128; q0 += 16) {
            f32x2 t[16];
#pragma unroll
            for (int q = 0; q < 16; ++q) { const int ci = dir ? 127 - (q0 + q) : q0 + q; t[q] = sd[(size_t)(bt * 128 + ci) * 1024]; }
#pragma unroll
            for (int q = 0; q < 16; ++q) { const int ci = dir ? 127 - (q0 + q) : q0 + q; carry[((size_t)dir * 256 + bt * 128 + ci) * 1024 + ch] = h; h = t[q].x * h + t[q].y; }
        }
    }
}
DI void phase_lru_scan(const Ctx& p, uchar* lds) {
    const int tid = tid_opaque(), lane = tid & 63, wid = tid >> 6, hh = lane >> 5;
    const u16* yb = (const u16*)(p.ws + WS_REGA + RA_Y);
    u16* hb = (u16*)(p.ws + WS_HB);
    for (int u = blockIdx.x; u < 256 * 4; u += gridDim.x) {
        const int c = u >> 2, cblk = u & 3;
        const int ch = cblk * 256 + (wid >> 2) * 128 + (wid & 3) * 32 + (lane & 31);
        float hsum[2][16];
        __syncthreads();
#pragma unroll
        for (int dir = 0; dir < 2; ++dir) {
            const float h0 = ((const float*)(p.ws + WS_CARRY))[((size_t)dir * 256 + c) * 1024 + ch];
            float a[2][16], b[2][16];
            {
                const unsigned* bs = lru_bsave(p, dir, c, cblk, wid);
                unsigned bw[16], ow[16];
#pragma unroll
                for (int q = 0; q < 4; ++q) {
                    const u32x4 vb = ((const u32x4*)bs)[q * 64 + lane], vo = *lru_osave(p, dir, c, cblk, wid, q, lane);
#pragma unroll
                    for (int e = 0; e < 4; ++e) { bw[q * 4 + e] = vb[e]; ow[q * 4 + e] = vo[e]; }
                }
#pragma unroll
                for (int rb = 0; rb < 2; ++rb)
#pragma unroll
                    for (int i = 0; i < 16; ++i) {
                        const unsigned wb = bw[rb * 8 + (i >> 1)], wo = ow[rb * 8 + (i >> 1)];
                        b[rb][i] = (i & 1) ? bhi(wb) : blo(wb);
                        a[rb][i] = 1.0f - ((i & 1) ? bhi(wo) : blo(wo));
                    }
            }
            float SA[4], SB[4];
            lru_seg(a, b, dir, hh, SA, SB);
            float st[4]; st[0] = h0;
#pragma unroll
            for (int s = 1; s < 4; ++s) st[s] = SA[s - 1] * st[s - 1] + SB[s - 1];
#pragma unroll
            for (int rb = 0; rb < 2; ++rb) {
                const int sidx = dir ? 3 - (rb * 2 + hh) : rb * 2 + hh;
                float h = sidx == 0 ? st[0] : (sidx == 1 ? st[1] : (sidx == 2 ? st[2] : st[3]));
#pragma unroll
                for (int ii = 0; ii < 16; ++ii) { const int i = dir ? 15 - ii : ii; h = a[rb][i] * h + b[rb][i]; if (dir == 0) hsum[rb][i] = h; else hsum[rb][i] += h; }
            }
        }
        __syncthreads();
        {
            const int chl = (wid >> 2) * 128 + (wid & 3) * 32 + (lane & 31);
#pragma unroll
            for (int rb = 0; rb < 2; ++rb)
#pragma unroll
                for (int i = 0; i < 16; ++i) *(float*)(lds + (rb * 32 + hh * 16 + i) * 1040 + chl * 4) = hsum[rb][i];
        }
        __syncthreads();
#pragma unroll
        for (int j = 0; j < 4; ++j) {
            const int pi = j * 512 + tid, tk = pi >> 5, c8 = pi & 31;
            const f32x4 h0 = *(const f32x4*)(lds + tk * 1040 + c8 * 32), h1 = *(const f32x4*)(lds + tk * 1040 + c8 * 32 + 16);
            const size_t o = (size_t)(c * 64 + tk) * 1024 + cblk * 256 + c8 * 8;
            const u32x4 yv = *(const u32x4*)(yb + o);
            u32x4 w;
            w.x = pk2(blo(yv.x) * h0[0], bhi(yv.x) * h0[1]); w.y = pk2(blo(yv.y) * h0[2], bhi(yv.y) * h0[3]);
            w.z = pk2(blo(yv.z) * h1[0], bhi(yv.z) * h1[1]); w.w = pk2(blo(yv.w) * h1[2], bhi(yv.w) * h1[3]);
            *(u32x4*)(hb + o) = w;
        }
    }
}

__global__ void __launch_bounds__(512) fwd_mega(const Params P) {
    uchar* lds = smem + LDS_USER;
    LAS unsigned long long* tab = (LAS unsigned long long*)(smem + 64);
    if (threadIdx.x < N_IN) tab[threadIdx.x] = (unsigned long long)P.in[threadIdx.x];
    if ((threadIdx.x & 63) == 0) ((volatile LAS int*)smem)[96 + hw_slot()] = threadIdx.x >> 6;
    const bool multi = (P.ph_hi - P.ph_lo) > 1;
    if (threadIdx.x == 0) { ((volatile LAS unsigned*)smem)[0] = 0u; ((volatile LAS unsigned*)smem)[1] = 0u; ((volatile LAS unsigned*)smem)[2] = 0u; ((volatile LAS unsigned*)smem)[3] = 0u; }
    __syncthreads();
    if (multi) (void)xcd_barrier_post((unsigned*)(P.ws + WS_CTL), (volatile LAS unsigned*)smem);
#define RUN_PHASE(k, call) if (P.ph_lo <= (k) && (k) < P.ph_hi) { { Ctx p; { unsigned long long wsi = (unsigned long long)P.ws; asm volatile("" : "+s"(wsi)); p.ws = (uchar*)(__attribute__((address_space(1))) uchar*)wsi; } p.out = P.out; p.tab = tab; call; } if ((PROBE_REPS >> (k)) & 1) { { XcdBarrier xb_; xb_.bar = (unsigned*)(P.ws + WS_CTL); xb_.x = xb_xcc_id(); xb_.st = (volatile LAS unsigned*)smem; xcd_barrier(xb_); } Ctx p; { unsigned long long wsi = (unsigned long long)P.ws; asm volatile("" : "+s"(wsi)); p.ws = (uchar*)(__attribute__((address_space(1))) uchar*)wsi; } p.out = P.out; p.tab = tab; call; } if (multi && (k) + 1 < P.ph_hi) { XcdBarrier xb_; xb_.bar = (unsigned*)(P.ws + WS_CTL); xb_.x = xb_xcc_id(); xb_.st = (volatile LAS unsigned*)smem; xcd_barrier(xb_); } }
    RUN_PHASE(0, phase_prep(P, p, lds))
    RUN_PHASE(1, phase_norm(p, 0))
    RUN_PHASE(2, phase_inproj0(P, p, lds))
    RUN_PHASE(3, phase_attn(p, lds))
    RUN_PHASE(4, phase_outproj(P, p, lds, 0))
    RUN_PHASE(5, phase_router(p, lds, 0))
#if PROBE_ROUTER2X
    if (P.ph_lo <= 5 && 5 < P.ph_hi) { Ctx p; { unsigned long long wsi = (unsigned long long)P.ws; asm volatile("" : "+s"(wsi)); p.ws = (uchar*)(__attribute__((address_space(1))) uchar*)wsi; } p.out = P.out; p.tab = tab; phase_router(p, lds, 0, 2); { XcdBarrier xb_; xb_.bar = (unsigned*)(P.ws + WS_CTL); xb_.x = xb_xcc_id(); xb_.st = (volatile LAS unsigned*)smem; xcd_barrier(xb_); } }
#endif
    RUN_PHASE(6, phase_moe_up(P, p, lds, 0))
    RUN_PHASE(7, phase_moe_down(P, p, lds, 0))
    RUN_PHASE(8, phase_norm(p, 1))
    RUN_PHASE(9, phase_inproj1(P, p, lds))
    RUN_PHASE(10, phase_lru_summ(p, lds))
    RUN_PHASE(11, phase_lru_carry(p))
    RUN_PHASE(12, phase_lru_scan(p, lds))
    RUN_PHASE(13, phase_outproj(P, p, lds, 1))
    RUN_PHASE(14, phase_router(p, lds, 1))
    RUN_PHASE(15, phase_moe_up(P, p, lds, 1))
    RUN_PHASE(16, phase_moe_down(P, p, lds, 1))
}

extern "C" void kernel_launch(void* const* d_in, const int* in_sizes, int n_in, void* d_out, int out_size, void* d_ws, size_t ws_size, hipStream_t stream) {
    static int grid = 0;
    if (grid == 0) {
        if (n_in != N_IN || out_size != NL * D || ws_size < WS_END) { fprintf(stderr, "kernel_launch: unexpected shapes (n_in %d, out %d, ws %zu, need %zu)\n", n_in, out_size, ws_size, (size_t)WS_END); grid = -1; return; }
        int dev = 0, cus = 0, per_cu = 0;
        if (hipGetDevice(&dev) != hipSuccess || hipDeviceGetAttribute(&cus, hipDeviceAttributeMultiprocessorCount, dev) != hipSuccess) { grid = -1; return; }
        if (hipFuncSetAttribute((const void*)fwd_mega, hipFuncAttributeMaxDynamicSharedMemorySize, LDS_BYTES) != hipSuccess) { fprintf(stderr, "kernel_launch: hipFuncSetAttribute failed\n"); grid = -1; return; }
        if (hipOccupancyMaxActiveBlocksPerMultiprocessor(&per_cu, (const void*)fwd_mega, 512, LDS_BYTES) != hipSuccess || per_cu < 1) { fprintf(stderr, "kernel_launch: occupancy query says %d\n", per_cu); (void)hipGetLastError(); grid = -1; return; }
        grid = cus;
    }
    if (grid < 0) return;
    if (hipMemsetAsync((char*)d_ws + WS_CTL, 0, CTL_BYTES, stream) != hipSuccess) return;
    Params p{};
    for (int i = 0; i < N_IN; ++i) p.in[i] = (const float*)d_in[i];
    p.out = (float*)d_out; p.ws = (uchar*)d_ws;
    uchar* ws = (uchar*)d_ws;
    int t0 = 0;
    auto job = [&](int j, const float* src, size_t dst_off, int nmat, int K, int N, int sstride, int dstride, int lddst, int mode, int half) {
        CvtJob& J = p.jobs[j]; J.src = src; J.dst = (u16*)(ws + dst_off); J.nmat = nmat; J.K = K; J.N = N; J.sstride = sstride; J.dstride = dstride; J.lddst = lddst; J.mode = mode; J.half = half; J.tile0 = t0; J.pad = 0;
        t0 += nmat * (K / 64) * (N / 64);
    };
    job(0, p.in[I_EVWIN], WS_WIN0, 1, 1024, 3072, 0, 0, 1024, 0, 0);
    job(1, p.in[I_EVWOUT], WS_WOUT0, 1, 1024, 1024, 0, 0, 1024, 0, 0);
    job(2, p.in[I_ODWIN], WS_WIN1, 1, 1024, 2048, 0, 0, 1024, 0, 0);
    job(3, p.in[I_ODWOUT], WS_WOUT1, 1, 1024, 1024, 0, 0, 1024, 0, 0);
    job(4, p.in[I_ODWA], WS_WA, 16, 128, 128, 16384, 16384, 128, 0, 0);
    job(5, p.in[I_ODWX], WS_WX, 16, 128, 128, 16384, 16384, 128, 0, 0);
    job(6, p.in[I_MGATE], WS_WGU, 32, 1024, 512, 524288, 1048576, 1024, 1, 0);
    job(7, p.in[I_MUP], WS_WGU, 32, 1024, 512, 524288, 1048576, 1024, 1, 1);
    job(8, p.in[I_MDOWN], WS_WD, 32, 512, 1024, 524288, 524288, 512, 0, 0);
    p.ncvt = t0;
    const int nl = N_LAUNCHES;
    for (int li = 0; li < nl; ++li) {
        p.ph_lo = li * NPH / nl; p.ph_hi = (li + 1) * NPH / nl;
        hipLaunchKernelGGL(fwd_mega, dim3(grid), dim3(512), LDS_BYTES, stream, p);
    }
}
```

```cpp
#include <hip/hip_runtime.h>
#include <stdint.h>
#include <stdio.h>

#define DI __device__ __forceinline__
#define LAS __attribute__((address_space(3)))
typedef unsigned short u16;
typedef unsigned char uchar;
typedef short bf16x8 __attribute__((ext_vector_type(8)));
typedef float f32x16 __attribute__((ext_vector_type(16)));
typedef float f32x4 __attribute__((ext_vector_type(4)));
typedef float f32x2 __attribute__((ext_vector_type(2)));
typedef __bf16 bf2_t __attribute__((ext_vector_type(2)));
typedef unsigned u32x2 __attribute__((ext_vector_type(2)));
typedef unsigned u32x4 __attribute__((ext_vector_type(4)));

#ifndef N_LAUNCHES
#define N_LAUNCHES 1
#endif
#ifndef PROBE_GEMM2X
#define PROBE_GEMM2X 0
#endif
#ifndef PROBE_ROUTER2X
#define PROBE_ROUTER2X 0
#endif
#ifndef PROBE_REPS
#define PROBE_REPS 0x0000
#endif

DI unsigned pk2(float a, float b) { f32x2 v = {a, b}; bf2_t r = __builtin_convertvector(v, bf2_t); return __builtin_bit_cast(unsigned, r); }
DI u16 f2b(float a) { __bf16 r = (__bf16)a; return __builtin_bit_cast(u16, r); }
DI float b2f(u16 v) { return __uint_as_float(((unsigned)v) << 16); }
DI float blo(unsigned v) { return __uint_as_float(v << 16); }
DI float bhi(unsigned v) { return __uint_as_float(v & 0xffff0000u); }
#define MFMA32(a, b, c) __builtin_amdgcn_mfma_f32_32x32x16_bf16((a), (b), (c), 0, 0, 0)

constexpr int D = 1024, NL = 16384, NC = 512, R = 16896, SEQ = 8192, CTXL = 256, SK = 8448;
constexpr int NPH = 17;
constexpr float EPS = 1e-6f;
constexpr float LAM_INIT0 = 0.2f;
constexpr float QSCALE = 0.125f * 1.4426950408889634f;

enum { I_X = 0, I_C, I_CTX, I_CCTX, I_ADAW, I_ADAB, I_NMIX, I_NFFN, I_EVWIN, I_EVCW, I_EVCB, I_QN, I_KN, I_LQ1, I_LK1, I_LQ2, I_LK2, I_SUBN, I_EVWOUT,
       I_ODWIN, I_ODCW, I_ODCB, I_ODWA, I_ODBA, I_ODWX, I_ODBX, I_ODLAM, I_ODWOUT, I_MWGRP, I_MBGRP, I_MWRT, I_MBRT, I_MGATE, I_MUP, I_MDOWN, N_IN };

constexpr size_t al256(size_t x) { return (x + 255) & ~(size_t)255; }
constexpr size_t WS_CTL   = 0;
constexpr size_t CTL_BYTES = 65536;
constexpr size_t CTL_CNT  = 16384;
constexpr size_t WS_MOD   = WS_CTL + CTL_BYTES;
constexpr size_t WS_ROPE  = WS_MOD + al256(2 * 3 * 6144 * 4);
constexpr size_t WS_ROUTE = WS_ROPE + (size_t)SEQ * 32 * 8;
constexpr size_t WS_LIST  = WS_ROUTE + al256((size_t)R * 8);
constexpr size_t WS_SUMM  = WS_LIST + al256((size_t)24 * R * 4);
constexpr size_t WS_CARRY = WS_SUMM + (size_t)2 * 264 * 1024 * 8;
constexpr size_t WS_WIN0  = WS_CARRY + (size_t)2 * 256 * 1024 * 4;
constexpr size_t WS_WOUT0 = WS_WIN0 + (size_t)3072 * 1024 * 2;
constexpr size_t WS_WIN1  = WS_WOUT0 + (size_t)1024 * 1024 * 2;
constexpr size_t WS_WOUT1 = WS_WIN1 + (size_t)2048 * 1024 * 2;
constexpr size_t WS_WA    = WS_WOUT1 + (size_t)1024 * 1024 * 2;
constexpr size_t WS_WX    = WS_WA + (size_t)2 * 8 * 128 * 128 * 2;
constexpr size_t WS_WGU   = WS_WX + (size_t)2 * 8 * 128 * 128 * 2;
constexpr size_t WS_WD    = WS_WGU + (size_t)2 * 16 * 1024 * 1024 * 2;
constexpr size_t WS_XS    = WS_WD + (size_t)2 * 16 * 1024 * 512 * 2;
constexpr size_t WS_HB    = WS_XS + (size_t)R * 1024 * 4;
constexpr size_t WS_REGA  = WS_HB + (size_t)R * 1024 * 2;
constexpr size_t RA_ZC    = 0;
constexpr size_t RA_Q     = RA_ZC + (size_t)R * 1536 * 2;
constexpr size_t RA_K     = RA_Q + (size_t)16 * SK * 64 * 2;
constexpr size_t RA_VT    = RA_K + (size_t)16 * SK * 64 * 2;
constexpr size_t RA_END0  = RA_VT + (size_t)8 * 128 * SK * 2;
constexpr size_t RA_ACT   = 0;
constexpr size_t RA_Y     = 0;
constexpr size_t RA_U     = RA_Y + (size_t)NL * 1024 * 2;
constexpr size_t RA_BS0   = RA_U + (size_t)R * 1024 * 2;
constexpr size_t WS_OM1B  = WS_REGA + RA_END0;
constexpr size_t WS_END   = WS_OM1B + (size_t)128 * 4 * 32768;
static_assert(RA_BS0 + (size_t)256 * 4 * 8 * 1024 * 4 <= RA_END0 && (size_t)20480 * 1024 * 2 <= RA_END0, "region A overlays");
static_assert((size_t)256 * 4 * 8 * 1024 * 4 <= (size_t)16 * 1024 * 1024 * 2, "b of direction 1 fits layer 0's gate/up weights");
static_assert(WS_END <= 352000000ull, "workspace budget");

constexpr int LDS_BYTES = 147456 + 1024 + 1024;
constexpr int LDS_USER = 1024;

struct CvtJob { const float* src; u16* dst; int nmat, K, N, sstride, dstride, lddst, mode, half, tile0, pad; };
struct Params {
    const float* in[N_IN];
    float* out;
    uchar* ws;
    CvtJob jobs[9];
    int ncvt, ph_lo, ph_hi, pad;
};
struct Ctx { uchar* ws; float* out; const LAS unsigned long long* tab; };
typedef const __attribute__((address_space(1))) float* gcf_t;
DI const float* inp(const Ctx& c, int i) { return (const float*)(gcf_t)c.tab[i]; }

extern __shared__ __attribute__((aligned(16))) uchar smem[];
DI int hw_slot() { return (int)(__builtin_amdgcn_s_getreg(((6 - 1) << 11) | 4) & 63u); }
DI int tid_opaque() {
    const int lane = (int)__builtin_amdgcn_mbcnt_hi(~0u, __builtin_amdgcn_mbcnt_lo(~0u, 0u));
    int w = ((volatile LAS int*)smem)[96 + hw_slot()];
    w = __builtin_amdgcn_readfirstlane(w);
    int t = w * 64 + lane; asm volatile("" : "+v"(t)); return t;
}
#define XB_TMO      128
#define XB_XCNT(j)  (256  + 64 * (j))
#define XB_XSUB(j)  (1280 + 64 * (j))
#define XB_XGEN(j)  (2304 + 64 * (j))
#define XB_TOP      3328
#define XB_TOPGEN   3392
#define XCD_BAR_WORDS 3456
#define XB_SPIN_CAP (1u << 20)
DI unsigned xb_ld(unsigned* p)              { return __hip_atomic_load(p, __ATOMIC_RELAXED, __HIP_MEMORY_SCOPE_AGENT); }
DI unsigned xb_add(unsigned* p, unsigned v) { return __hip_atomic_fetch_add(p, v, __ATOMIC_RELAXED, __HIP_MEMORY_SCOPE_AGENT); }
DI unsigned xb_xcc_id() { return (unsigned)__builtin_amdgcn_s_getreg((3 << 11) | 20) & 0xFu; }
#define XB_SPIN(cond, bar) do { unsigned _sp = 0; while (cond) { __builtin_amdgcn_s_sleep(1); \
    if ((++_sp & 255u) == 0u) { if (xb_ld(&(bar)[XB_TMO])) break; if (_sp > XB_SPIN_CAP) { atomicAdd(&(bar)[XB_TMO], 1u); break; } } } } while (0)
struct XcdBarrier { unsigned* bar; unsigned x; volatile LAS unsigned* st; };
DI XcdBarrier xcd_barrier_post(unsigned* bar, volatile LAS unsigned* st) {
    XcdBarrier b; b.bar = bar; b.x = xb_xcc_id(); b.st = st;
    if (tid_opaque() == 0) (void)xb_add(&bar[XB_XCNT(b.x)], 1u);
    return b;
}
DI void xcd_barrier_complete(unsigned* bar, unsigned x, unsigned& nloc, unsigned& nx) {
    const unsigned G = gridDim.x * gridDim.y * gridDim.z;
    unsigned sum, cnt, mine, sp = 0u;
    for (;;) {
        sum = 0u; cnt = 0u; mine = 0u;
#pragma unroll
        for (unsigned j = 0; j < 16; ++j) { const unsigned c = xb_ld(&bar[XB_XCNT(j)]); sum += c; cnt += (c > 0u) ? 1u : 0u; mine = (j == x) ? c : mine; }
        if (sum == G) break;
        __builtin_amdgcn_s_sleep(1);
        if ((++sp & 255u) == 0u) { if (xb_ld(&bar[XB_TMO])) break; if (sp > XB_SPIN_CAP) { atomicAdd(&bar[XB_TMO], 1u); break; } }
    }
    nloc = mine > 0u ? mine : 1u; nx = cnt > 0u ? cnt : 1u;
}
DI void xcd_barrier(const XcdBarrier& b) {
    asm volatile("s_waitcnt vmcnt(0)" ::: "memory");
    __syncthreads();
    if (tid_opaque() == 0) {
        unsigned* bar = b.bar;
        __builtin_amdgcn_s_waitcnt(0);
        unsigned nloc = b.st[0], nx = b.st[1];
        if (nloc == 0u) { xcd_barrier_complete(bar, b.x, nloc, nx); b.st[0] = nloc; b.st[1] = nx; }
        const unsigned old = xb_add(&bar[XB_XSUB(b.x)], 1u);
        const unsigned gen = old / nloc;
        if (old + 1u == (gen + 1u) * nloc) {
            __builtin_amdgcn_fence(__ATOMIC_RELEASE, "agent");
            asm volatile("s_waitcnt vmcnt(0)" ::: "memory");
            const unsigned og = xb_add(&bar[XB_TOP], 1u);
            const unsigned tg = og / nx;
            if (og + 1u == (tg + 1u) * nx) xb_add(&bar[XB_TOPGEN], 1u);
            else XB_SPIN(xb_ld(&bar[XB_TOPGEN]) == tg, bar);
            __builtin_amdgcn_fence(__ATOMIC_ACQUIRE, "agent");
            xb_add(&bar[XB_XGEN(b.x)], 1u);
            asm volatile("s_waitcnt vmcnt(0)" ::: "memory");
        } else {
            XB_SPIN(xb_ld(&bar[XB_XGEN(b.x)]) == gen, bar);
            __builtin_amdgcn_fence(__ATOMIC_ACQUIRE, "agent");
            asm volatile("s_waitcnt vmcnt(0)" ::: "memory");
        }
    }
    __syncthreads();
}

DI float xor32_sum(float x) {
    const unsigned u = __float_as_uint(x);
    const auto r = __builtin_amdgcn_permlane32_swap(u, u, false, false);
    return __uint_as_float(r[0]) + __uint_as_float(r[1]);
}
#define DPP_ADD(v, ctrl) ((v) + __uint_as_float((unsigned)__builtin_amdgcn_update_dpp(0, (int)__float_as_uint(v), (ctrl), 0xf, 0xf, true)))
DI float wave_sum(float v) {
    v = DPP_ADD(v, 0xB1);
    v = DPP_ADD(v, 0x4E);
    v = DPP_ADD(v, 0x141);
    v = DPP_ADD(v, 0x140);
    const unsigned u = __float_as_uint(v);
    return (__uint_as_float(__builtin_amdgcn_readlane(u, 0)) + __uint_as_float(__builtin_amdgcn_readlane(u, 16))) +
           (__uint_as_float(__builtin_amdgcn_readlane(u, 32)) + __uint_as_float(__builtin_amdgcn_readlane(u, 48)));
}
DI int crow(int i, int hh) { return (i & 3) + 8 * (i >> 2) + 4 * hh; }
DI int mod_row(int r) { return r < NL ? (r >> 13) : 2; }
DI float frcp(float x) { return __builtin_amdgcn_rcpf(x); }
DI float fexp(float x) { return __builtin_amdgcn_exp2f(x * 1.4426950408889634f); }
DI float sigmoidf_(float x) { return frcp(1.0f + fexp(-x)); }
DI float one_minus_exp(float x) {
    const float s = -x * (1.0f + x * 0.5f * (1.0f + x * (1.0f / 3.0f) * (1.0f + x * 0.25f * (1.0f + x * 0.2f * (1.0f + x * (1.0f / 6.0f))))));
    const float d = 1.0f - fexp(x);
    return x > -0.125f ? s : d;
}

template <class F>
DI void cvt_list(const Params& P, uchar* lds, int i0, int step, int n, F&& job_of) {
    const int tid = tid_opaque();
    float* tl = (float*)lds;
    f32x4 rv[2];
    auto tile_src = [&](int idx, int& j, int& mat, int& kt, int& nt) -> const float* {
        int t; job_of(idx, j, t);
        const int N = P.jobs[j].N, tn = N >> 6, per = (P.jobs[j].K >> 6) * tn; mat = t / per; t -= mat * per; kt = t / tn; nt = t - kt * tn;
        return P.jobs[j].src + (size_t)mat * P.jobs[j].sstride + (size_t)(kt * 64) * N + nt * 64;
    };
    int u = i0, j = 0, mat = 0, kt = 0, nt = 0;
    __syncthreads();
    if (u < n) { const float* src = tile_src(u, j, mat, kt, nt); const int N = P.jobs[j].N;
#pragma unroll
        for (int i = 0; i < 2; ++i) rv[i] = *(const f32x4*)(src + (size_t)((tid >> 4) + 32 * i) * N + (tid & 15) * 4); }
    for (; u < n; u += step) {
#pragma unroll
        for (int i = 0; i < 2; ++i) { float* q = tl + ((tid >> 4) + 32 * i) * 65 + (tid & 15) * 4; q[0] = rv[i][0]; q[1] = rv[i][1]; q[2] = rv[i][2]; q[3] = rv[i][3]; }
        const CvtJob J = P.jobs[j];
        const int cmat = mat, ckt = kt, cnt_ = nt;
        const int un = u + step;
        if (un < n) { const float* src = tile_src(un, j, mat, kt, nt); const int N = P.jobs[j].N;
#pragma unroll
            for (int i = 0; i < 2; ++i) rv[i] = *(const f32x4*)(src + (size_t)((tid >> 4) + 32 * i) * N + (tid & 15) * 4); }
        __syncthreads();
        const int n_ = tid >> 3, kc = tid & 7;
        float v[8];
#pragma unroll
        for (int e = 0; e < 8; ++e) v[e] = tl[(kc * 8 + e) * 65 + n_];
        const int ng = cnt_ * 64 + n_;
        const int drow = J.mode ? ((ng >> 5) * 64 + J.half * 32 + (ng & 31)) : ng;
        u16* d = J.dst + (size_t)cmat * J.dstride + (size_t)drow * J.lddst + ckt * 64 + kc * 8;
        u32x4 w; w.x = pk2(v[0], v[1]); w.y = pk2(v[2], v[3]); w.z = pk2(v[4], v[5]); w.w = pk2(v[6], v[7]);
        *(u32x4*)d = w;
        __syncthreads();
    }
}
constexpr int MOE_CVT_TILES = 6144;
DI void tail_cvt_dense(const Params& P, uchar* lds, int nunits, int lo, int hi) {
    const int G = gridDim.x, rem = nunits % G;
    int rank = blockIdx.x, nidle = G;
    if (rem != 0) { if ((int)blockIdx.x < rem) return; rank = blockIdx.x - rem; nidle = G - rem; }
    cvt_list(P, lds, lo + rank, nidle, hi, [&](int idx, int& j, int& t) {
        j = 0;
#pragma unroll
        for (int q = 1; q < 6; ++q) if (idx >= P.jobs[q].tile0) j = q;
        t = idx - P.jobs[j].tile0; });
}
DI void tail_cvt_moe(const Params& P, uchar* lds, int nunits, int layer, int lo, int hi) {
    const int G = gridDim.x, rem = nunits % G;
    int rank = blockIdx.x, nidle = G;
    if (rem != 0) { if ((int)blockIdx.x < rem) return; rank = blockIdx.x - rem; nidle = G - rem; }
    cvt_list(P, lds, lo + rank, nidle, hi, [&](int idx, int& j, int& t) { j = 6 + (idx >> 11); t = layer * 2048 + (idx & 2047); });
}

DI void phase_prep(const Params& P, const Ctx& p, uchar* lds) {
    const int tid = tid_opaque();
    float* tl = (float*)lds;
    {
        float* sc = tl;
        float* red = tl + 3072;
        for (int u = blockIdx.x; u < 192; u += gridDim.x) {
            __syncthreads();
            for (int i = tid; i < 3072; i += 512) { const int mr = i >> 10, d = i & 1023; const float c = mr < 2 ? inp(p, I_C)[mr * 1024 + d] : inp(p, I_CCTX)[d]; sc[i] = c * sigmoidf_(c); }
            __syncthreads();
            const int l = u / 96, nc = u % 96, c4 = tid & 15, dg = tid >> 4;
            const float* w = inp(p, I_ADAW) + (size_t)l * 1024 * 6144 + nc * 64 + c4 * 4;
            f32x4 a0 = (f32x4){0.f, 0.f, 0.f, 0.f}, a1 = a0, a2 = a0;
#pragma unroll 16
            for (int dd = 0; dd < 32; ++dd) {
                const int d = dg * 32 + dd; const f32x4 wv = *(const f32x4*)(w + (size_t)d * 6144);
                const float s0 = sc[d], s1 = sc[1024 + d], s2 = sc[2048 + d];
#pragma unroll
                for (int e = 0; e < 4; ++e) { a0[e] += s0 * wv[e]; a1[e] += s1 * wv[e]; a2[e] += s2 * wv[e]; }
            }
            *(f32x4*)(red + (dg * 3 + 0) * 64 + c4 * 4) = a0; *(f32x4*)(red + (dg * 3 + 1) * 64 + c4 * 4) = a1; *(f32x4*)(red + (dg * 3 + 2) * 64 + c4 * 4) = a2;
            __syncthreads();
            if (tid < 192) {
                const int mr = tid >> 6, nn = tid & 63; float s = 0.f;
#pragma unroll
                for (int g = 0; g < 32; ++g) s += red[(g * 3 + mr) * 64 + nn];
                const int ncol = nc * 64 + nn;
                ((float*)(p.ws + WS_MOD))[(l * 3 + mr) * 6144 + ncol] = s + inp(p, I_ADAB)[l * 6144 + ncol];
            }
        }
        __syncthreads();
    }
    cvt_list(P, lds, blockIdx.x, gridDim.x, P.jobs[1].tile0, [&](int idx, int& j, int& t) {
        j = 0;
#pragma unroll
        for (int q = 1; q < 6; ++q) if (idx >= P.jobs[q].tile0) j = q;
        t = idx - P.jobs[j].tile0; });
    for (int i = blockIdx.x * 512 + tid; i < SEQ * 32; i += gridDim.x * 512) {
        const int t = i >> 5, j = i & 31;
        const double pos = (double)(j < 16 ? (t >> 6) : (t & 63));
        const double inv = pow(10000.0, -(double)(j & 15) / 16.0);
        const double a = pos * inv;
        ((f32x2*)(p.ws + WS_ROPE))[i] = (f32x2){(float)cos(a), (float)sin(a)};
    }
}

DI void load_row16(const float* src, int lane, float (&v)[16]) {
#pragma unroll
    for (int j = 0; j < 4; ++j) { const f32x4 x = *(const f32x4*)(src + j * 256 + lane * 4); v[j * 4 + 0] = x[0]; v[j * 4 + 1] = x[1]; v[j * 4 + 2] = x[2]; v[j * 4 + 3] = x[3]; }
}
DI void norm_mod16(float (&v)[16], const float* g, const float* sh, const float* sc, int lane) {
    float ss = 0.f;
#pragma unroll
    for (int i = 0; i < 16; ++i) ss += v[i] * v[i];
    ss = wave_sum(ss);
    const float rstd = rsqrtf(ss * (1.0f / 1024.0f) + EPS);
#pragma unroll
    for (int j = 0; j < 4; ++j) {
        const int c = j * 256 + lane * 4;
        const f32x4 gg = *(const f32x4*)(g + c), s1 = *(const f32x4*)(sc + c), s0 = *(const f32x4*)(sh + c);
#pragma unroll
        for (int e = 0; e < 4; ++e) v[j * 4 + e] = (v[j * 4 + e] * rstd * gg[e]) * (1.0f + s1[e]) + s0[e];
    }
}
DI void store_row16_bf16(u16* dst, int lane, const float (&v)[16]) {
#pragma unroll
    for (int j = 0; j < 4; ++j) { u32x2 w; w.x = pk2(v[j * 4 + 0], v[j * 4 + 1]); w.y = pk2(v[j * 4 + 2], v[j * 4 + 3]); *(u32x2*)(dst + j * 256 + lane * 4) = w; }
}
DI const float* row_src(const Ctx& p, int layer, int r) {
    if (layer == 0) return r < NL ? inp(p, I_X) + (size_t)r * 1024 : inp(p, I_CTX) + (size_t)(r - NL) * 1024;
    return (const float*)(p.ws + WS_XS) + (size_t)r * 1024;
}
DI void phase_norm(const Ctx& p, int layer) {
    const int tid = tid_opaque(), lane = tid & 63, wv = blockIdx.x * 8 + (tid >> 6), nwv = gridDim.x * 8;
    const float* mod = (const float*)(p.ws + WS_MOD);
    u16* hb = (u16*)(p.ws + WS_HB);
    for (int r = wv; r < R; r += nwv) {
        float v[16];
        load_row16(row_src(p, layer, r), lane, v);
        const float* m = mod + (layer * 3 + mod_row(r)) * 6144;
        norm_mod16(v, inp(p, I_NMIX) + layer * 1024, m, m + 1024, lane);
        store_row16_bf16(hb + (size_t)r * 1024, lane, v);
    }
}
DI void phase_router(const Ctx& p, uchar* lds, int layer, int cnt_slot = -1) {
    const int tid = tid_opaque(), lane = tid & 63, wid = tid >> 6, wv = blockIdx.x * 8 + wid, nwv = gridDim.x * 8;
    const float* mod = (const float*)(p.ws + WS_MOD);
    u16* hb = (u16*)(p.ws + WS_HB);
    const float* xs = (const float*)(p.ws + WS_XS);
    const int nrows = layer == 0 ? R : NL;
    const float* wg = inp(p, I_MWGRP) + layer * 1024 * 4;
    const float* wr = inp(p, I_MWRT) + layer * 1024 * 16;
    const float* gnorm = inp(p, I_NFFN) + layer * 1024;
    int* cnt = (int*)(p.ws + WS_CTL + CTL_CNT) + (cnt_slot >= 0 ? cnt_slot : layer) * 1024;
    int* list = (int*)(p.ws + WS_LIST);
    f32x2* route = (f32x2*)(p.ws + WS_ROUTE);
    float* wrl = (float*)lds;
    float* wgl = wrl + 16384;
    float* hs = (float*)(lds + 81920 + wid * 8192);
    __syncthreads();
#pragma unroll
    for (int i = 0; i < 8; ++i) *(f32x4*)(wrl + (i * 512 + tid) * 4) = *(const f32x4*)(wr + (i * 512 + tid) * 4);
#pragma unroll
    for (int i = 0; i < 2; ++i) *(f32x4*)(wgl + (i * 512 + tid) * 4) = *(const f32x4*)(wg + (i * 512 + tid) * 4);
    __syncthreads();
    float bg[4], br[4];
#pragma unroll
    for (int o = 0; o < 4; ++o) { bg[o] = inp(p, I_MBGRP)[layer * 4 + o]; br[o] = inp(p, I_MBRT)[layer * 16 + (lane & 3) * 4 + o]; }
    for (int r0 = wv * 2; r0 < nrows; r0 += nwv * 2) {
        const float* m = mod + (layer * 3 + mod_row(r0)) * 6144;
        float v0[16], v1[16];
        load_row16(xs + (size_t)r0 * 1024, lane, v0);
        load_row16(xs + (size_t)(r0 + 1) * 1024, lane, v1);
        norm_mod16(v0, gnorm, m + 3 * 1024, m + 4 * 1024, lane);
        norm_mod16(v1, gnorm, m + 3 * 1024, m + 4 * 1024, lane);
        store_row16_bf16(hb + (size_t)r0 * 1024, lane, v0);
        store_row16_bf16(hb + (size_t)(r0 + 1) * 1024, lane, v1);
#pragma unroll
        for (int j = 0; j < 4; ++j) {
            *(f32x4*)(hs + (j * 256 + lane * 4) * 2) = (f32x4){v0[j * 4], v1[j * 4], v0[j * 4 + 1], v1[j * 4 + 1]};
            *(f32x4*)(hs + (j * 256 + lane * 4) * 2 + 4) = (f32x4){v0[j * 4 + 2], v1[j * 4 + 2], v0[j * 4 + 3], v1[j * 4 + 3]};
        }
        float ar[2][4], ag[2][4];
#pragma unroll
        for (int q = 0; q < 2; ++q)
#pragma unroll
            for (int o = 0; o < 4; ++o) { ar[q][o] = 0.f; ag[q][o] = 0.f; }
#pragma unroll 8
        for (int it = 0; it < 64; ++it) {
            const f32x4 w4 = *(const f32x4*)(wrl + (it * 64 + lane) * 4);
            const f32x2 x2 = *(const f32x2*)(hs + (it * 16 + (lane >> 2)) * 2);
#pragma unroll
            for (int o = 0; o < 4; ++o) { ar[0][o] += x2.x * w4[o]; ar[1][o] += x2.y * w4[o]; }
        }
#pragma unroll 8
        for (int it = 0; it < 16; ++it) {
            const f32x4 w4 = *(const f32x4*)(wgl + (it * 64 + lane) * 4);
            const f32x2 x2 = *(const f32x2*)(hs + (it * 64 + lane) * 2);
#pragma unroll
            for (int o = 0; o < 4; ++o) { ag[0][o] += x2.x * w4[o]; ag[1][o] += x2.y * w4[o]; }
        }
#pragma unroll
        for (int q = 0; q < 2; ++q)
#pragma unroll
            for (int o = 0; o < 4; ++o) {
                ag[q][o] = wave_sum(ag[q][o]);
                float v = ar[q][o]; v += __shfl_xor(v, 4); v += __shfl_xor(v, 8); v += __shfl_xor(v, 16); v = xor32_sum(v); ar[q][o] = v;
            }
#pragma unroll
        for (int q = 0; q < 2; ++q) {
            float gl[4];
#pragma unroll
            for (int o = 0; o < 4; ++o) gl[o] = ag[q][o] + bg[o];
            int gi = 0; float gm = gl[0];
#pragma unroll
            for (int o = 1; o < 4; ++o) if (gl[o] > gm) { gm = gl[o]; gi = o; }
            float gs = 0.f;
#pragma unroll
            for (int o = 0; o < 4; ++o) gs += __expf(gl[o] - gm);
            const float psel = 1.0f / gs;
            float el[4];
#pragma unroll
            for (int o = 0; o < 4; ++o) el[o] = __shfl(ar[q][o] + br[o], gi);
            int i1 = 0; float m1 = el[0];
#pragma unroll
            for (int o = 1; o < 4; ++o) if (el[o] > m1) { m1 = el[o]; i1 = o; }
            int i2 = -1; float m2 = -3.0e38f;
#pragma unroll
            for (int o = 0; o < 4; ++o) if (o != i1 && el[o] > m2) { m2 = el[o]; i2 = o; }
            if (lane == 0) {
                const int r = r0 + q;
                const float e2 = __expf(m2 - m1);
                const float w1 = psel / (1.0f + e2), w2 = psel * e2 / (1.0f + e2);
                const int lo = i1 < i2 ? i1 : i2, hi = i1 < i2 ? i2 : i1;
                const float wlo = i1 < i2 ? w1 : w2, whi = i1 < i2 ? w2 : w1;
                const int pi = lo == 0 ? (hi - 1) : (lo == 1 ? (hi + 1) : 5);
                const int bucket = gi * 6 + pi;
                const int pos = atomicAdd(cnt + bucket * 32, 1);
                list[(size_t)bucket * R + pos] = r;
                route[r] = (f32x2){wlo, whi};
            }
        }
    }
}

constexpr int LROW = 144;
constexpr int GEMM_A = 128 * 128, GEMM_B = 256 * 128, GEMM_STAGE = GEMM_A + GEMM_B;
constexpr int EPI_PITCH = 272, EPI_WAVE = 64 * EPI_PITCH;
static_assert(8 * EPI_WAVE <= 3 * GEMM_STAGE, "epilogue strips overlay the GEMM stages");
#define WAIT_V(n) asm volatile("s_waitcnt vmcnt(%0)" ::"n"(n) : "memory")
#define WAIT_L(n) asm volatile("s_waitcnt lgkmcnt(%0)" ::"n"(n) : "memory")
#define RAW_BARRIER() do { WAIT_L(0); __builtin_amdgcn_s_barrier(); } while (0)

template <class Epi>
DI void gemm_tile(uchar* lds, const u16* a0, const u16* a1, const u16* b0, const u16* b1, const u16* b2, const u16* b3, int nk, int ksplit, long bjump, Epi&& epi) {
    const int tid = tid_opaque(), lane = tid & 63, wid = tid >> 6, wr = wid >> 2, wc = wid & 3, l31 = lane & 31, hh = lane >> 5;
    const int lch = (lane & 7) ^ ((((wid & 1) << 3) + (lane >> 3)) >> 1);
    a0 += lch * 8; a1 += lch * 8; b0 += lch * 8; b1 += lch * 8; b2 += lch * 8; b3 += lch * 8;
    const unsigned pw = (unsigned)__builtin_amdgcn_readfirstlane(wid) * 1024u;
    const int sw = (l31 >> 1) & 7;
    unsigned xo[4];
#pragma unroll
    for (int ks = 0; ks < 4; ++ks) xo[ks] = (unsigned)(((ks * 2 + hh) ^ sw) << 4);
    const unsigned aro = (unsigned)((wr * 64 + l31) * 128), bro = (unsigned)(GEMM_A + (wc * 64 + l31) * 128);
    f32x16 acc[2][2];
#pragma unroll
    for (int a = 0; a < 2; ++a)
#pragma unroll
        for (int b = 0; b < 2; ++b)
#pragma unroll
            for (int i = 0; i < 16; ++i) acc[a][b][i] = 0.f;
#define GEMM_DMA(st_, kt_) do { const int kq_ = (kt_); const long bo_ = (long)kq_ * 64 + (kq_ >= ksplit ? bjump : 0); uchar* s_ = lds + (st_) * GEMM_STAGE + pw; \
        __builtin_amdgcn_global_load_lds((const unsigned*)(a0 + kq_ * 64), (LAS unsigned*)(s_), 16, 0, 0); \
        __builtin_amdgcn_global_load_lds((const unsigned*)(a1 + kq_ * 64), (LAS unsigned*)(s_ + 8192), 16, 0, 0); \
        __builtin_amdgcn_global_load_lds((const unsigned*)(b0 + bo_), (LAS unsigned*)(s_ + GEMM_A), 16, 0, 0); \
        __builtin_amdgcn_global_load_lds((const unsigned*)(b1 + bo_), (LAS unsigned*)(s_ + GEMM_A + 8192), 16, 0, 0); \
        __builtin_amdgcn_global_load_lds((const unsigned*)(b2 + bo_), (LAS unsigned*)(s_ + GEMM_A + 16384), 16, 0, 0); \
        __builtin_amdgcn_global_load_lds((const unsigned*)(b3 + bo_), (LAS unsigned*)(s_ + GEMM_A + 24576), 16, 0, 0); } while (0)
    RAW_BARRIER();
    GEMM_DMA(0, 0); GEMM_DMA(1, 1);
    WAIT_V(6);
    RAW_BARRIER();
    int cur = 0;
#pragma unroll 1
    for (int kt = 0; kt < nk; ++kt) {
        const int nxt = cur == 0 ? 2 : cur - 1;
        if (kt + 2 < nk) GEMM_DMA(nxt, kt + 2);
        const uchar* s = lds + cur * GEMM_STAGE;
#pragma unroll
        for (int ks = 0; ks < 4; ++ks) {
            const bf16x8 fa0 = *(const bf16x8*)(s + aro + xo[ks]), fa1 = *(const bf16x8*)(s + aro + 4096 + xo[ks]);
            const bf16x8 fb0 = *(const bf16x8*)(s + bro + xo[ks]), fb1 = *(const bf16x8*)(s + bro + 4096 + xo[ks]);
            acc[0][0] = MFMA32(fb0, fa0, acc[0][0]); acc[0][1] = MFMA32(fb0, fa1, acc[0][1]);
            acc[1][0] = MFMA32(fb1, fa0, acc[1][0]); acc[1][1] = MFMA32(fb1, fa1, acc[1][1]);
        }
        if (kt + 2 < nk) WAIT_V(6); else WAIT_V(0);
        RAW_BARRIER();
        cur = cur == 2 ? 0 : cur + 1;
    }
#if PROBE_GEMM2X == 1
    {
        f32x16 d[2][2];
        for (int a = 0; a < 2; ++a) for (int b = 0; b < 2; ++b) for (int i = 0; i < 16; ++i) d[a][b][i] = 0.f;
        RAW_BARRIER(); GEMM_DMA(0, 0); GEMM_DMA(1, 1); WAIT_V(6); RAW_BARRIER();
        int cur2 = 0;
#pragma unroll 1
        for (int kt = 0; kt < nk; ++kt) {
            const int nxt = cur2 == 0 ? 2 : cur2 - 1;
            if (kt + 2 < nk) GEMM_DMA(nxt, kt + 2);
            const uchar* s = lds + cur2 * GEMM_STAGE;
#pragma unroll
            for (int ks = 0; ks < 4; ++ks) {
                const bf16x8 fa0 = *(const bf16x8*)(s + aro + xo[ks]), fa1 = *(const bf16x8*)(s + aro + 4096 + xo[ks]);
                const bf16x8 fb0 = *(const bf16x8*)(s + bro + xo[ks]), fb1 = *(const bf16x8*)(s + bro + 4096 + xo[ks]);
                d[0][0] = MFMA32(fb0, fa0, d[0][0]); d[0][1] = MFMA32(fb0, fa1, d[0][1]);
                d[1][0] = MFMA32(fb1, fa0, d[1][0]); d[1][1] = MFMA32(fb1, fa1, d[1][1]);
            }
            if (kt + 2 < nk) WAIT_V(6); else WAIT_V(0);
            RAW_BARRIER();
            cur2 = cur2 == 2 ? 0 : cur2 + 1;
        }
        asm volatile("" :: "v"(d[0][0]), "v"(d[0][1]), "v"(d[1][0]), "v"(d[1][1]));
    }
#elif PROBE_GEMM2X == 2
    {
        f32x4 d[4][4];
        for (int a = 0; a < 4; ++a) for (int b = 0; b < 4; ++b) d[a][b] = (f32x4){0.f, 0.f, 0.f, 0.f};
        RAW_BARRIER(); GEMM_DMA(0, 0); GEMM_DMA(1, 1); WAIT_V(6); RAW_BARRIER();
        int cur2 = 0;
#pragma unroll 1
        for (int kt = 0; kt < nk; ++kt) {
            const int nxt = cur2 == 0 ? 2 : cur2 - 1;
            if (kt + 2 < nk) GEMM_DMA(nxt, kt + 2);
            const uchar* s = lds + cur2 * GEMM_STAGE;
#pragma unroll
            for (int kp = 0; kp < 2; ++kp) {
                bf16x8 fa[4], fb[4];
                fa[0] = *(const bf16x8*)(s + aro + xo[2 * kp]); fa[1] = *(const bf16x8*)(s + aro + 4096 + xo[2 * kp]); fa[2] = *(const bf16x8*)(s + aro + xo[2 * kp + 1]); fa[3] = *(const bf16x8*)(s + aro + 4096 + xo[2 * kp + 1]);
                fb[0] = *(const bf16x8*)(s + bro + xo[2 * kp]); fb[1] = *(const bf16x8*)(s + bro + 4096 + xo[2 * kp]); fb[2] = *(const bf16x8*)(s + bro + xo[2 * kp + 1]); fb[3] = *(const bf16x8*)(s + bro + 4096 + xo[2 * kp + 1]);
#pragma unroll
                for (int a = 0; a < 4; ++a)
#pragma unroll
                    for (int b = 0; b < 4; ++b) d[a][b] = __builtin_amdgcn_mfma_f32_16x16x32_bf16(fb[b], fa[a], d[a][b], 0, 0, 0);
            }
            if (kt + 2 < nk) WAIT_V(6); else WAIT_V(0);
            RAW_BARRIER();
            cur2 = cur2 == 2 ? 0 : cur2 + 1;
        }
        asm volatile("" :: "v"(d[0][0]), "v"(d[0][1]), "v"(d[0][2]), "v"(d[0][3]), "v"(d[1][0]), "v"(d[1][1]), "v"(d[1][2]), "v"(d[1][3]));
        asm volatile("" :: "v"(d[2][0]), "v"(d[2][1]), "v"(d[2][2]), "v"(d[2][3]), "v"(d[3][0]), "v"(d[3][1]), "v"(d[3][2]), "v"(d[3][3]));
    }
#endif
    epi(acc, wr * 64, wc, lane, lds + wid * EPI_WAVE);
}

constexpr int G2_A = 256 * 64, G2_STAGE = 2 * G2_A;
template <class Epi>
DI void gemm_tile256(uchar* lds, const u16* a0, const u16* a1, const u16* b0, const u16* b1, int nk, int ksplit, long bjump, Epi&& epi) {
    const int tid = tid_opaque(), lane = tid & 63, wid = tid >> 6, wr = wid >> 2, wc = wid & 3, l31 = lane & 31, hh = lane >> 5;
    const int lch = (lane & 3) ^ ((lane >> 4) & 3);
    a0 += lch * 8; a1 += lch * 8; b0 += lch * 8; b1 += lch * 8;
    const unsigned pw = (unsigned)__builtin_amdgcn_readfirstlane(wid) * 1024u;
    const int sw = (l31 >> 2) & 3;
    const unsigned xo0 = (unsigned)(((0 + hh) ^ sw) << 4), xo1 = (unsigned)(((2 + hh) ^ sw) << 4);
    const unsigned aro = (unsigned)((wr * 128 + l31) * 64), bro = (unsigned)(G2_A + (wc * 64 + l31) * 64);
    f32x16 acc[2][4];
#pragma unroll
    for (int a = 0; a < 2; ++a)
#pragma unroll
        for (int b = 0; b < 4; ++b)
#pragma unroll
            for (int i = 0; i < 16; ++i) acc[a][b][i] = 0.f;
#define G2_DMA(st_, kt_) do { const int kq_ = (kt_); const long bo_ = (long)kq_ * 32 + (kq_ >= ksplit ? bjump : 0); uchar* s_ = lds + (st_) * G2_STAGE + pw; \
        __builtin_amdgcn_global_load_lds((const unsigned*)(a0 + kq_ * 32), (LAS unsigned*)(s_), 16, 0, 0); \
        __builtin_amdgcn_global_load_lds((const unsigned*)(a1 + kq_ * 32), (LAS unsigned*)(s_ + 8192), 16, 0, 0); \
        __builtin_amdgcn_global_load_lds((const unsigned*)(b0 + bo_), (LAS unsigned*)(s_ + G2_A), 16, 0, 0); \
        __builtin_amdgcn_global_load_lds((const unsigned*)(b1 + bo_), (LAS unsigned*)(s_ + G2_A + 8192), 16, 0, 0); } while (0)
    RAW_BARRIER();
    G2_DMA(0, 0); G2_DMA(1, 1); G2_DMA(2, 2);
    WAIT_V(8);
    RAW_BARRIER();
#pragma unroll 1
    for (int kt = 0; kt < nk; ++kt) {
        if (kt + 3 < nk) G2_DMA((kt + 3) & 3, kt + 3);
        const uchar* s = lds + (kt & 3) * G2_STAGE;
#pragma unroll
        for (int ks = 0; ks < 2; ++ks) {
            const unsigned xo = ks ? xo1 : xo0;
            bf16x8 fa[4], fb[2];
#pragma unroll
            for (int mb = 0; mb < 4; ++mb) fa[mb] = *(const bf16x8*)(s + aro + mb * 2048 + xo);
#pragma unroll
            for (int nb = 0; nb < 2; ++nb) fb[nb] = *(const bf16x8*)(s + bro + nb * 2048 + xo);
#pragma unroll
            for (int nb = 0; nb < 2; ++nb)
#pragma unroll
                for (int mb = 0; mb < 4; ++mb) acc[nb][mb] = MFMA32(fb[nb], fa[mb], acc[nb][mb]);
        }
        if (kt + 3 < nk) WAIT_V(8); else if (kt + 2 < nk) WAIT_V(4); else WAIT_V(0);
        RAW_BARRIER();
    }
#pragma unroll
    for (int half = 0; half < 2; ++half) {
        f32x16 t[2][2];
#pragma unroll
        for (int nb = 0; nb < 2; ++nb)
#pragma unroll
            for (int mb = 0; mb < 2; ++mb) t[nb][mb] = acc[nb][2 * half + mb];
        epi(t, wr * 128 + half * 64, wc, lane, lds + wid * EPI_WAVE);
    }
}

DI void epi_put4(uchar* w, int row, int col, float a, float b, float c, float d) { *(f32x4*)(w + row * EPI_PITCH + col * 4) = (f32x4){a, b, c, d}; }
DI void epi_stage(uchar* w, const f32x16 (&acc)[2][2], int l31, int hh) {
#pragma unroll
    for (int mb = 0; mb < 2; ++mb)
#pragma unroll
        for (int nb = 0; nb < 2; ++nb)
#pragma unroll
            for (int g = 0; g < 4; ++g) epi_put4(w, mb * 32 + l31, nb * 32 + 8 * g + 4 * hh, acc[nb][mb][4 * g], acc[nb][mb][4 * g + 1], acc[nb][mb][4 * g + 2], acc[nb][mb][4 * g + 3]);
}
template <class F> DI void epi_rows4(const uchar* w, int lane, F&& f) {
#pragma unroll
    for (int it = 0; it < 16; ++it) { const int row = it * 4 + (lane >> 4), col = (lane & 15) * 4; f(row, col, *(const f32x4*)(w + row * EPI_PITCH + col * 4)); }
}
template <int NC, class F> DI void epi_rows8(const uchar* w, int lane, F&& f) {
    constexpr int LPR = NC / 8, RPI = 64 / LPR;
#pragma unroll
    for (int it = 0; it < 64 / RPI; ++it) { const int row = it * RPI + lane / LPR, col = (lane % LPR) * 8; f(row, col, *(const f32x4*)(w + row * EPI_PITCH + col * 4), *(const f32x4*)(w + row * EPI_PITCH + col * 4 + 16)); }
}
DI u32x4 pack8(const f32x4& a, const f32x4& b) { u32x4 r; r.x = pk2(a[0], a[1]); r.y = pk2(a[2], a[3]); r.z = pk2(b[0], b[1]); r.w = pk2(b[2], b[3]); return r; }

#define MFMA16(a, b, c) __builtin_amdgcn_mfma_f32_16x16x32_bf16((a), (b), (c), 0, 0, 0)
constexpr int P8_HT = 16384;
DI void p8_rc(int tid, int& r0, int& c) { const int wid = tid >> 6, lane = tid & 63; r0 = (wid >> 1) * 16 + (lane >> 2); c = (wid & 1) * 32 + (((lane & 3) ^ ((lane >> 5) << 1)) << 3); }
DI void glds16(const uchar* g, uchar* s) { __builtin_amdgcn_global_load_lds((const unsigned*)g, (LAS unsigned*)s, 16, 0, 0); }
template <class Epi>
DI void gemm_tile8p(uchar* lds, const uchar* abase, unsigned a0_0, unsigned a1_0, unsigned a0_1, unsigned a1_1, int ac1_0, int ac0_1, int ac1_1,
                    const uchar* bbase, unsigned bo, int bc1_0, int bc0_1, int bc1_1, int nk, int ksplit, long bjump, Epi&& epi) {
    constexpr int ac0_0 = 0, bc0_0 = 0;
    const int tid = tid_opaque(), lane = tid & 63, wid = tid >> 6, wr = wid >> 2, wc = wid & 3, fr = lane & 15, fq = lane >> 4;
    const unsigned pw = (unsigned)__builtin_amdgcn_readfirstlane(wid) * 1024u;
    const unsigned lp = (unsigned)((fr * 64 + fq * 16) ^ ((fr >> 3) << 5));
    const unsigned la = (unsigned)wr * 8192u + lp, lb = (unsigned)wc * 4096u + lp;
    f32x4 acc[2][2][4][2];
#pragma unroll
    for (int a = 0; a < 2; ++a)
#pragma unroll
        for (int b = 0; b < 2; ++b)
#pragma unroll
            for (int m = 0; m < 4; ++m)
#pragma unroll
                for (int n = 0; n < 2; ++n) acc[a][b][m][n] = (f32x4){0.f, 0.f, 0.f, 0.f};
    bf16x8 At[4][2], B0[2][2], B1[2][2];
#define P8_SA(b, h) (((b) * 2 + (h)) * P8_HT)
#define P8_SB(b, h) ((4 + (b) * 2 + (h)) * P8_HT)
#define P8_STAGE_A(b, h, kt) do { const uchar* g_ = abase + (size_t)(kt) * 128; uchar* s_ = lds + P8_SA(b, h) + pw; glds16(g_ + ac0_##h + a0_##h, s_); glds16(g_ + ac1_##h + a1_##h, s_ + 8192); } while (0)
#define P8_STAGE_B(b, h, kt) do { const int kq_ = (kt); const uchar* g_ = bbase + (size_t)kq_ * 128 + (kq_ >= ksplit ? bjump : 0); uchar* s_ = lds + P8_SB(b, h) + pw; glds16(g_ + bc0_##h + bo, s_); glds16(g_ + bc1_##h + bo, s_ + 8192); } while (0)
#define P8_LDA(dst, b, h) do { _Pragma("unroll") for (int m = 0; m < 4; ++m) { _Pragma("unroll") for (int k = 0; k < 2; ++k) dst[m][k] = *(const bf16x8*)(lds + P8_SA(b, h) + la + (m * 2 + k) * 1024); } } while (0)
#define P8_LDB(dst, b, h) do { _Pragma("unroll") for (int n = 0; n < 2; ++n) { _Pragma("unroll") for (int k = 0; k < 2; ++k) dst[n][k] = *(const bf16x8*)(lds + P8_SB(b, h) + lb + (n * 2 + k) * 1024); } } while (0)
#define P8_MMA(ai, bj, Bx) do { __builtin_amdgcn_s_setprio(1); \
        _Pragma("unroll") for (int m = 0; m < 4; ++m) { _Pragma("unroll") for (int n = 0; n < 2; ++n) { _Pragma("unroll") for (int k = 0; k < 2; ++k) acc[ai][bj][m][n] = MFMA16(Bx[n][k], At[m][k], acc[ai][bj][m][n]); } } \
        __builtin_amdgcn_s_setprio(0); } while (0)
#define P8_BAR() __builtin_amdgcn_s_barrier()
#define P8_SCHED() __builtin_amdgcn_sched_barrier(0)
    RAW_BARRIER();
    P8_STAGE_B(0, 0, 0); P8_STAGE_A(0, 0, 0); P8_STAGE_B(0, 1, 0); P8_STAGE_A(0, 1, 0);
    if (wr == 1) P8_BAR();
    WAIT_V(4); P8_BAR();
    P8_STAGE_B(1, 0, 1); P8_STAGE_A(1, 0, 1); P8_STAGE_B(1, 1, 1);
    WAIT_V(6); P8_BAR();
#pragma unroll 1
    for (int t = 0; t < nk - 2; t += 2) {
        P8_LDB(B0, 0, 0); P8_SCHED(); P8_LDA(At, 0, 0); P8_STAGE_A(1, 1, t + 1);
        WAIT_L(8); P8_BAR(); WAIT_L(0); P8_MMA(0, 0, B0); P8_BAR(); P8_SCHED();
        P8_LDB(B1, 0, 1); P8_STAGE_B(0, 0, t + 2);
        P8_BAR(); WAIT_L(0); P8_MMA(0, 1, B1); P8_BAR();
        P8_LDA(At, 0, 1); P8_STAGE_A(0, 0, t + 2);
        P8_BAR(); WAIT_L(0); P8_MMA(1, 0, B0); P8_BAR(); P8_SCHED();
        P8_STAGE_B(0, 1, t + 2);
        WAIT_V(6); P8_BAR(); P8_MMA(1, 1, B1); P8_BAR();
        P8_LDB(B0, 1, 0); P8_SCHED(); P8_LDA(At, 1, 0); P8_STAGE_A(0, 1, t + 2);
        WAIT_L(8); P8_BAR(); WAIT_L(0); P8_MMA(0, 0, B0); P8_BAR(); P8_SCHED();
        P8_LDB(B1, 1, 1); P8_STAGE_B(1, 0, t + 3);
        P8_BAR(); WAIT_L(0); P8_MMA(0, 1, B1); P8_BAR();
        P8_LDA(At, 1, 1); P8_STAGE_A(1, 0, t + 3);
        P8_BAR(); WAIT_L(0); P8_MMA(1, 0, B0); P8_BAR(); P8_SCHED();
        P8_STAGE_B(1, 1, t + 3);
        WAIT_V(6); P8_BAR(); P8_MMA(1, 1, B1); P8_BAR();
    }
    {
        P8_LDB(B0, 0, 0); P8_LDA(At, 0, 0); P8_STAGE_A(1, 1, nk - 1);
        P8_BAR(); WAIT_L(0); P8_MMA(0, 0, B0); P8_BAR();
        P8_LDB(B1, 0, 1); P8_BAR(); WAIT_L(0); P8_MMA(0, 1, B1); P8_BAR();
        P8_LDA(At, 0, 1); WAIT_V(4); P8_BAR(); WAIT_L(0); P8_MMA(1, 0, B0); P8_MMA(1, 1, B1); P8_BAR();
    }
    {
        P8_LDB(B0, 1, 0); P8_LDA(At, 1, 0); WAIT_V(2); P8_BAR(); WAIT_L(0); P8_MMA(0, 0, B0); P8_BAR();
        P8_LDB(B1, 1, 1); WAIT_V(0); P8_BAR(); WAIT_L(0); P8_MMA(0, 1, B1); P8_BAR();
        P8_LDA(At, 1, 1); P8_BAR(); WAIT_L(0); P8_MMA(1, 0, B0); P8_MMA(1, 1, B1); P8_BAR();
    }
    if (wr == 0) P8_BAR();
    RAW_BARRIER();
    uchar* w = lds + wid * EPI_WAVE;
#pragma unroll
    for (int ai = 0; ai < 2; ++ai) {
#pragma unroll
        for (int bj = 0; bj < 2; ++bj)
#pragma unroll
            for (int m = 0; m < 4; ++m)
#pragma unroll
                for (int n = 0; n < 2; ++n) *(f32x4*)(w + (m * 16 + fr) * EPI_PITCH + (bj * 32 + n * 16 + fq * 4) * 4) = acc[ai][bj][m][n];
        epi(wr * 128 + ai * 64, wc, lane, w);
    }
}
DI void epi_unstage(const uchar* w, f32x16 (&t)[2][2], int l31, int hh) {
#pragma unroll
    for (int mb = 0; mb < 2; ++mb)
#pragma unroll
        for (int nb = 0; nb < 2; ++nb)
#pragma unroll
            for (int g = 0; g < 4; ++g) { const f32x4 v = *(const f32x4*)(w + (mb * 32 + l31) * EPI_PITCH + (nb * 32 + 8 * g + 4 * hh) * 4); t[nb][mb][4 * g] = v[0]; t[nb][mb][4 * g + 1] = v[1]; t[nb][mb][4 * g + 2] = v[2]; t[nb][mb][4 * g + 3] = v[3]; }
}

DI void rect_unit(int v, int MT, int NT, int& mt, int& nt) {
    if (gridDim.x != 256) { mt = v / NT; nt = v % NT; return; }
    const int r = v >> 8, b = v & 255, x = b & 7, y = b >> 3;
    const int q = r * 8 + x, nqn = NT >> 2, qm = q / nqn, qn = q - qm * nqn;
    mt = qm * 8 + (y & 7); nt = qn * 4 + (y >> 3);
}
DI void phase_inproj0(const Params& P, const Ctx& p, uchar* lds) {
    const int tid = tid_opaque();
    const u16* hb = (const u16*)(p.ws + WS_HB);
    const u16* w = (const u16*)(p.ws + WS_WIN0);
    u16* zc = (u16*)(p.ws + WS_REGA + RA_ZC);
    u16* qa = (u16*)(p.ws + WS_REGA + RA_Q);
    u16* ka = (u16*)(p.ws + WS_REGA + RA_K);
    u16* vt = (u16*)(p.ws + WS_REGA + RA_VT);
    const f32x2* rope = (const f32x2*)(p.ws + WS_ROPE);
    const int rs = tid >> 3;
    for (int u = blockIdx.x; u < 768 + 48; u += gridDim.x) {
        const bool big = u < 768;
        int mt, nt; if (big) rect_unit(u, 64, 12, mt, nt); else { mt = (u - 768) / 12; nt = (u - 768) % 12; }
        const int m0 = big ? mt * 256 : NL + mt * 128, n0 = nt * 256;
        auto epi =
            [&](f32x16 (&acc)[2][2], int roff, int wc, int lane, uchar* w) {
                const int l31 = lane & 31, hh = lane >> 5, nw = n0 + wc * 64;
                const int row0 = m0 + roff;
                int b, spos0; if (row0 < NL) { b = row0 >> 13; spos0 = row0 & 8191; } else { b = (row0 - NL) >> 8; spos0 = SEQ + ((row0 - NL) & 255); }
                if (nw < 1536) {
                    epi_stage(w, acc, l31, hh);
                    epi_rows8<64>(w, lane, [&](int row, int col, const f32x4& v0, const f32x4& v1) { *(u32x4*)(zc + (size_t)(row0 + row) * 1536 + nw + col) = pack8(v0, v1); });
                } else if (nw < 2560) {
                    const bool isq = nw < 2048;
                    const int cg = (nw - (isq ? 1536 : 2048)) >> 6, head = cg >> 1, map = cg & 1;
                    const float* gain = isq ? inp(p, I_QN) : inp(p, I_KN);
                    const float osc = isq ? QSCALE : 1.0f;
#pragma unroll
                    for (int mb = 0; mb < 2; ++mb) {
                        float ss = 0.f;
#pragma unroll
                        for (int nb = 0; nb < 2; ++nb)
#pragma unroll
                            for (int i = 0; i < 16; ++i) ss += acc[nb][mb][i] * acc[nb][mb][i];
                        ss = xor32_sum(ss);
                        const float rstd = rsqrtf(ss * (1.0f / 64.0f) + EPS);
                        const int spos = spos0 + mb * 32 + l31;
#pragma unroll
                        for (int g = 0; g < 4; ++g) {
                            const int d0 = 8 * g + 4 * hh;
                            const f32x4 g1v = *(const f32x4*)(gain + d0), g2v = *(const f32x4*)(gain + 32 + d0);
                            f32x4 csa = (f32x4){1.f, 0.f, 1.f, 0.f}, csb = csa;
                            if (row0 < NL) { csa = *(const f32x4*)((const float*)(rope + spos * 32 + d0)); csb = *(const f32x4*)((const float*)(rope + spos * 32 + d0 + 2)); }
                            float o1[4], o2[4];
#pragma unroll
                            for (int e = 0; e < 4; ++e) {
                                const float v1 = acc[0][mb][4 * g + e] * rstd * g1v[e], v2 = acc[1][mb][4 * g + e] * rstd * g2v[e];
                                const float cs = e < 2 ? csa[2 * e] : csb[2 * (e - 2)], sn = e < 2 ? csa[2 * e + 1] : csb[2 * (e - 2) + 1];
                                o1[e] = (v1 * cs - v2 * sn) * osc; o2[e] = (v2 * cs + v1 * sn) * osc;
                            }
                            epi_put4(w, mb * 32 + l31, d0, o1[0], o1[1], o1[2], o1[3]);
                            epi_put4(w, mb * 32 + l31, 32 + d0, o2[0], o2[1], o2[2], o2[3]);
                        }
                    }
                    u16* dst = (isq ? qa : ka) + ((size_t)(((b * 4 + head) * 2 + map)) * SK + spos0) * 64;
                    epi_rows8<64>(w, lane, [&](int row, int col, const f32x4& v0, const f32x4& v1) { *(u32x4*)(dst + (size_t)row * 64 + col) = pack8(v0, v1); });
                } else {
                    const int head = (nw - 2560) >> 7, vb0 = (nw - 2560) & 127;
#pragma unroll
                    for (int mb = 0; mb < 2; ++mb) {
                        const int tok = mb * 32 + l31, tp = (tok & ~12) | (((tok >> 3) & 1) << 2) | (((tok >> 2) & 1) << 3);
#pragma unroll
                        for (int nb = 0; nb < 2; ++nb)
#pragma unroll
                            for (int i = 0; i < 16; ++i) *(u16*)(w + (nb * 32 + crow(i, hh)) * 144 + tp * 2) = f2b(acc[nb][mb][i]);
                    }
                    u16* dst = vt + ((size_t)(b * 4 + head) * 128 + vb0) * SK + spos0;
#pragma unroll
                    for (int it = 0; it < 8; ++it) { const int v = it * 8 + (lane >> 3), c8 = lane & 7; *(u32x4*)(dst + (size_t)v * SK + c8 * 8) = *(const u32x4*)(w + v * 144 + c8 * 16); }
                }
            };
        if (big) {
            int r0, c; p8_rc(tid, r0, c);
            const unsigned ao = (unsigned)(r0 * 2048 + c * 2), bo = (unsigned)((((r0 >> 5) * 64 + (r0 & 31)) * 2048) + c * 2);
            gemm_tile8p(lds, (const uchar*)(hb + (size_t)m0 * 1024), ao, ao, ao, ao, 128 * 2048, 64 * 2048, 192 * 2048,
                        (const uchar*)(w + (size_t)n0 * 1024), bo, 128 * 2048, 32 * 2048, 160 * 2048, 16, 1 << 30, 0,
                        [&](int roff, int wc, int lane, uchar* w) {
                            const int nw = n0 + wc * 64;
                            if (nw < 1536) { const int row0 = m0 + roff; epi_rows8<64>(w, lane, [&](int row, int col, const f32x4& v0, const f32x4& v1) { *(u32x4*)(zc + (size_t)(row0 + row) * 1536 + nw + col) = pack8(v0, v1); }); }
                            else { f32x16 t[2][2]; epi_unstage(w, t, lane & 31, lane >> 5); epi(t, roff, wc, lane, w); } });
        } else {
            const u16* ab = hb + (size_t)(m0 + rs) * 1024;
            const u16* bb = w + (size_t)(n0 + rs) * 1024;
            gemm_tile(lds, ab, ab + 64 * 1024, bb, bb + 64 * 1024, bb + 128 * 1024, bb + 192 * 1024, 16, 1 << 30, 0, epi);
        }
    }
    tail_cvt_moe(P, lds, 768 + 48, 0, 0, MOE_CVT_TILES / 2);
    tail_cvt_dense(P, lds, 768 + 48, P.jobs[1].tile0, P.jobs[2].tile0);
}

constexpr int ATT_K = 64 * 128, ATT_V = 128 * 128;
constexpr int ATT_STAGE = 2 * ATT_K + ATT_V;
DI void attn_unit(const Ctx& p, uchar* lds, int bh, int q0, int key0, int ntile, int out_row0) {
    const int tid = tid_opaque();
    const int lane = tid & 63, wid = tid >> 6, l31 = lane & 31, hh = lane >> 5, m = wid >> 2, g = wid & 3;
    const u16* qa = (const u16*)(p.ws + WS_REGA + RA_Q);
    const u16* ka = (const u16*)(p.ws + WS_REGA + RA_K);
    const u16* vt = (const u16*)(p.ws + WS_REGA + RA_VT);
    uchar* qs = lds + 2 * ATT_STAGE + wid * 8192 + lane * 16;
    RAW_BARRIER();
    {
        const u16* qp = qa + ((size_t)(bh * 2 + m) * SK + q0 + g * 64 + l31) * 64 + hh * 8;
#pragma unroll
        for (int rg = 0; rg < 2; ++rg)
#pragma unroll
            for (int ks = 0; ks < 4; ++ks) *(bf16x8*)(qs + (rg * 4 + ks) * 1024) = *(const bf16x8*)(qp + rg * 32 * 64 + ks * 16);
    }
    const int lch = (lane & 7) ^ ((((wid & 1) << 3) + (lane >> 3)) >> 1);
    const u16* kp = ka + ((size_t)(bh * 2) * SK + key0 + wid * 8 + (lane >> 3)) * 64 + lch * 8;
    const u16* vp = vt + ((size_t)bh * 128 + wid * 8 + (lane >> 3)) * SK + key0 + lch * 8;
    const unsigned pw = (unsigned)__builtin_amdgcn_readfirstlane(wid) * 1024u;
    const int sw = (l31 >> 1) & 7;
    unsigned xo[4];
#pragma unroll
    for (int ks = 0; ks < 4; ++ks) xo[ks] = (unsigned)(((ks * 2 + hh) ^ sw) << 4);
    const unsigned kro = (unsigned)(m * ATT_K + l31 * 128), vro = (unsigned)(2 * ATT_K + l31 * 128);
    f32x16 O[2][4];
#pragma unroll
    for (int rg = 0; rg < 2; ++rg)
#pragma unroll
        for (int vb = 0; vb < 4; ++vb)
#pragma unroll
            for (int i = 0; i < 16; ++i) O[rg][vb][i] = 0.f;
    float lsum0 = 0.f, lsum1 = 0.f;
#define ATT_DMA(st_, t_) do { const int tq_ = (t_); uchar* s_ = lds + (st_) * ATT_STAGE + pw; \
        __builtin_amdgcn_global_load_lds((const unsigned*)(kp + (size_t)tq_ * 4096), (LAS unsigned*)(s_), 16, 0, 0); \
        __builtin_amdgcn_global_load_lds((const unsigned*)(kp + (size_t)SK * 64 + (size_t)tq_ * 4096), (LAS unsigned*)(s_ + ATT_K), 16, 0, 0); \
        __builtin_amdgcn_global_load_lds((const unsigned*)(vp + tq_ * 64), (LAS unsigned*)(s_ + 2 * ATT_K), 16, 0, 0); \
        __builtin_amdgcn_global_load_lds((const unsigned*)(vp + (size_t)64 * SK + tq_ * 64), (LAS unsigned*)(s_ + 2 * ATT_K + 8192), 16, 0, 0); } while (0)
    ATT_DMA(0, 0);
    WAIT_V(0);
    RAW_BARRIER();
#pragma unroll 1
    for (int t = 0; t < ntile; ++t) {
        if (t + 1 < ntile) ATT_DMA((t + 1) & 1, t + 1);
        const uchar* s = lds + (t & 1) * ATT_STAGE;
#pragma unroll 1
        for (int kb = 0; kb < 2; ++kb) {
            bf16x8 P[2][2];
#pragma unroll
            for (int rg = 0; rg < 2; ++rg) {
                f32x16 S;
#pragma unroll
                for (int i = 0; i < 16; ++i) S[i] = 0.f;
#pragma unroll
                for (int ks = 0; ks < 4; ++ks) { const bf16x8 kf = *(const bf16x8*)(s + kro + kb * 4096 + xo[ks]); const bf16x8 q = *(const bf16x8*)(qs + (rg * 4 + ks) * 1024); S = MFMA32(kf, q, S); }
                float ls = 0.f;
#pragma unroll
                for (int i = 0; i < 16; ++i) { S[i] = __builtin_amdgcn_exp2f(S[i]); ls += S[i]; }
                if (rg == 0) lsum0 += ls; else lsum1 += ls;
#pragma unroll
                for (int s2 = 0; s2 < 2; ++s2) {
                    u32x4 pw4; pw4.x = pk2(S[8 * s2], S[8 * s2 + 1]); pw4.y = pk2(S[8 * s2 + 2], S[8 * s2 + 3]); pw4.z = pk2(S[8 * s2 + 4], S[8 * s2 + 5]); pw4.w = pk2(S[8 * s2 + 6], S[8 * s2 + 7]);
                    P[rg][s2] = __builtin_bit_cast(bf16x8, pw4);
                }
            }
#pragma unroll
            for (int s2 = 0; s2 < 2; ++s2)
#pragma unroll
                for (int vb = 0; vb < 4; ++vb) {
                    const bf16x8 vf = *(const bf16x8*)(s + vro + vb * 4096 + (unsigned)(((4 * kb + 2 * s2 + hh) ^ sw) << 4));
                    O[0][vb] = MFMA32(vf, P[0][s2], O[0][vb]); O[1][vb] = MFMA32(vf, P[1][s2], O[1][vb]);
                }
        }
        WAIT_V(0);
        RAW_BARRIER();
    }
    lsum0 = xor32_sum(lsum0); lsum1 = xor32_sum(lsum1);
    const int tid2 = tid_opaque(), lane2 = tid2 & 63, wid2 = tid2 >> 6, e_l31 = lane2 & 31, e_hh = lane2 >> 5, e_m = wid2 >> 2, e_g = wid2 & 3;
    float lam;
    { float d1 = inp(p, I_LQ1)[lane2] * inp(p, I_LK1)[lane2], d2 = inp(p, I_LQ2)[lane2] * inp(p, I_LK2)[lane2]; d1 = wave_sum(d1); d2 = wave_sum(d2); lam = fexp(d1) - fexp(d2) + LAM_INIT0; }
    float* comb = (float*)lds + (size_t)e_g * 8192 + lane2;
    if (e_m == 1) {
#pragma unroll
        for (int rg = 0; rg < 2; ++rg) {
            const float sc = lam / (rg ? lsum1 : lsum0);
#pragma unroll
            for (int vb = 0; vb < 4; ++vb) {
#pragma unroll
                for (int i = 0; i < 16; ++i) comb[((rg * 4 + vb) * 16 + i) * 64] = O[rg][vb][i] * sc;
                __builtin_amdgcn_sched_barrier(0);
            }
        }
    }
    RAW_BARRIER();
    if (e_m == 0) {
        const float* snl = (const float*)(lds + 131072);
        const int h = bh & 3;
#pragma unroll
        for (int rg = 0; rg < 2; ++rg) {
            const float i0 = 1.0f / (rg ? lsum1 : lsum0);
            float ss = 0.f;
#pragma unroll
            for (int vb = 0; vb < 4; ++vb) {
#pragma unroll
                for (int i = 0; i < 16; ++i) { const float o = O[rg][vb][i] * i0 - comb[((rg * 4 + vb) * 16 + i) * 64]; O[rg][vb][i] = o; ss += o * o; }
                __builtin_amdgcn_sched_barrier(0);
            }
            ss = xor32_sum(ss);
            const float rstd = rsqrtf(ss * (1.0f / 128.0f) + EPS) * (1.0f - LAM_INIT0);
            u16* dst = (u16*)(p.ws + WS_HB) + (size_t)(out_row0 + e_g * 64 + rg * 32 + e_l31) * 1024 + 512 + h * 128;
#pragma unroll
            for (int vb = 0; vb < 4; ++vb)
#pragma unroll
                for (int gq = 0; gq < 4; ++gq) {
                    const int v0 = vb * 32 + 8 * gq + 4 * e_hh;
                    const f32x4 gn = *(const f32x4*)(snl + v0);
                    u32x2 w; w.x = pk2(O[rg][vb][4 * gq] * rstd * gn[0], O[rg][vb][4 * gq + 1] * rstd * gn[1]); w.y = pk2(O[rg][vb][4 * gq + 2] * rstd * gn[2], O[rg][vb][4 * gq + 3] * rstd * gn[3]);
                    *(u32x2*)(dst + v0) = w;
                }
        }
    }
}
DI void phase_attn(const Ctx& p, uchar* lds) {
    const int tid = tid_opaque();
    if (tid < 128) ((float*)(lds + 131072))[tid] = inp(p, I_SUBN)[tid];
    for (int u = blockIdx.x; u < 264; u += gridDim.x) {
        const bool lat = u < 256;
        const int bh = u & 7, qb = u >> 3;
        attn_unit(p, lds, bh, lat ? qb * 256 : SEQ, lat ? 0 : SEQ, lat ? 132 : 4, lat ? (bh >> 2) * SEQ + qb * 256 : NL + (bh >> 2) * CTXL);
    }
    {
        const u16* zc = (const u16*)(p.ws + WS_REGA + RA_ZC);
        u16* hb = (u16*)(p.ws + WS_HB);
        const int c = tid_opaque();
        const float w0 = inp(p, I_EVCW)[c], w1 = inp(p, I_EVCW)[512 + c], w2 = inp(p, I_EVCW)[1024 + c], bias = inp(p, I_EVCB)[c];
        for (int u = blockIdx.x; u < 256; u += gridDim.x) {
            const int r0 = u * 66;
            auto prod = [&](int r) -> float { return b2f(zc[(size_t)r * 1536 + 512 + c]) * b2f(zc[(size_t)r * 1536 + 1024 + c]); };
            auto first = [&](int r) -> bool { return r < NL ? (r & 8191) == 0 : ((r - NL) & 255) == 0; };
            auto last = [&](int r) -> bool { return r < NL ? (r & 8191) == 8191 : ((r - NL) & 255) == 255; };
            float pp = first(r0) ? 0.f : prod(r0 - 1), pc = prod(r0);
#pragma unroll 2
            for (int r = r0; r < r0 + 66; ++r) {
                const float pn = last(r) ? 0.f : prod(r + 1);
                const float cv = bias + w0 * (first(r) ? 0.f : pp) + w1 * pc + w2 * pn;
                hb[(size_t)r * 1024 + c] = f2b(b2f(zc[(size_t)r * 1536 + c]) * cv);
                pp = pc; pc = pn;
            }
        }
    }
}

DI void phase_outproj(const Params& P, const Ctx& p, uchar* lds, int layer) {
    const int tid = tid_opaque();
    const u16* hb = (const u16*)(p.ws + WS_HB);
    const u16* w = (const u16*)(p.ws + (layer == 0 ? WS_WOUT0 : WS_WOUT1));
    float* xs = (float*)(p.ws + WS_XS);
    const float* mod = (const float*)(p.ws + WS_MOD);
    const int nbig = 256, nunits = nbig + (layer == 0 ? 16 : 0);
    for (int u = blockIdx.x; u < nunits; u += gridDim.x) {
        const bool big = u < nbig;
        int mt, nt; if (big) rect_unit(u, 64, 4, mt, nt); else { mt = (u - nbig) >> 2; nt = u & 3; }
        const int m0 = big ? mt * 256 : NL + mt * 128, n0 = nt * 256;
        auto epi_body =
            [&](int roff, int wc, int lane, uchar* w) {
                const int row0 = m0 + roff, nw = n0 + wc * 64;
                const float* g1 = mod + (layer * 3 + mod_row(row0)) * 6144 + 2048 + nw;
                const float* src = row_src(p, layer, row0) + nw;
                f32x4 xi[16], gg = *(const f32x4*)(g1 + (lane & 15) * 4);
#pragma unroll
                for (int it = 0; it < 16; ++it) xi[it] = *(const f32x4*)(src + (size_t)(it * 4 + (lane >> 4)) * 1024 + (lane & 15) * 4);
#pragma unroll
                for (int it = 0; it < 16; ++it) {
                    const int row = it * 4 + (lane >> 4), col = (lane & 15) * 4;
                    const f32x4 v = *(const f32x4*)(w + row * EPI_PITCH + col * 4);
                    f32x4 o;
#pragma unroll
                    for (int e = 0; e < 4; ++e) o[e] = xi[it][e] + gg[e] * v[e];
                    *(f32x4*)(xs + (size_t)(row0 + row) * 1024 + nw + col) = o;
                }
            };
        auto epi = [&](f32x16 (&acc)[2][2], int roff, int wc, int lane, uchar* w) { epi_stage(w, acc, lane & 31, lane >> 5); epi_body(roff, wc, lane, w); };
        if (big) {
            int r0, c; p8_rc(tid, r0, c);
            const unsigned ao = (unsigned)(r0 * 2048 + c * 2), bo = (unsigned)((((r0 >> 5) * 64 + (r0 & 31)) * 2048) + c * 2);
            gemm_tile8p(lds, (const uchar*)(hb + (size_t)m0 * 1024), ao, ao, ao, ao, 128 * 2048, 64 * 2048, 192 * 2048,
                        (const uchar*)(w + (size_t)n0 * 1024), bo, 128 * 2048, 32 * 2048, 160 * 2048, 16, 1 << 30, 0, epi_body);
        } else {
            const int rs = tid >> 3;
            const u16* ab = hb + (size_t)(m0 + rs) * 1024;
            const u16* bb = w + (size_t)(n0 + rs) * 1024;
            gemm_tile(lds, ab, ab + 64 * 1024, bb, bb + 64 * 1024, bb + 128 * 1024, bb + 192 * 1024, 16, 1 << 30, 0, epi);
        }
    }
    if (layer == 0) tail_cvt_moe(P, lds, nunits, 0, MOE_CVT_TILES / 2, MOE_CVT_TILES);
}

struct TileInfo { int bucket, mt, cnt, ntiles; };
DI int moe_ntiles(const int* cnt) { int s = 0; for (int b = 0; b < 24; ++b) s += (cnt[b * 32] + 127) >> 7; return s; }
DI TileInfo moe_tile(const int* cnt, int t) {
    TileInfo ti; ti.bucket = 0; ti.mt = 0; ti.cnt = 0; ti.ntiles = 0;
    int base = 0;
    for (int b = 0; b < 24; ++b) { const int c = cnt[b * 32], n = (c + 127) >> 7; if (t >= base && t < base + n) { ti.bucket = b; ti.mt = t - base; ti.cnt = c; } base += n; }
    ti.ntiles = base; return ti;
}
DI void bucket_experts(int bucket, int& ea, int& eb) {
    const int g = bucket / 6, pi = bucket - g * 6;
    const int lo = pi < 3 ? 0 : (pi < 5 ? 1 : 2), hi = pi < 3 ? pi + 1 : (pi < 5 ? pi - 1 : 3);
    ea = g * 4 + lo; eb = g * 4 + hi;
}
struct MoeUnit { int bucket, t, mt, cnt, big, nt; };
DI int moe_units(const int* cnt, int NT, int G, int& B, int& NBIG) {
    int b2 = 0, s1 = 0;
    for (int b = 0; b < 24; ++b) { const int n = (cnt[b * 32] + 127) >> 7; b2 += n >> 1; s1 += n & 1; }
    B = b2;
    const int cand = b2 * NT;
    int best = 1 << 30; NBIG = 0;
    for (int k = 0; k <= (cand + G - 1) / G; ++k) {
        const int nb = k * G < cand ? k * G : cand, U = 2 * cand + s1 * NT - nb;
        const int rb = (nb + G - 1) / G, ru = (U + G - 1) / G, cost = rb * 7 + (ru - rb) * 5;
        if (cost < best) { best = cost; NBIG = nb; }
    }
    return 2 * cand + s1 * NT - NBIG;
}
DI MoeUnit moe_unit(const int* cnt, int u, int NT, int B, int NBIG) {
    const int sh = NT == 8 ? 3 : 2;
    int kind, idx, half = 0, nt;
    if (u < NBIG) {
        kind = 0; idx = u >> sh; nt = u & (NT - 1);
        if (gridDim.x == 256 && u < (NBIG & ~255)) { const int r = u >> 8, b = u & 255, x = b & 7, y = b >> 3; idx = (r << (8 - sh)) + x * (32 >> sh) + (y >> sh); nt = y & (NT - 1); }
    }
    else {
        int v = u - NBIG; const int npl = B - (NBIG >> sh);
        if (v < npl * 2 * NT) { kind = 1; idx = (NBIG >> sh) + (v >> (sh + 1)); half = (v >> sh) & 1; nt = v & (NT - 1); }
        else { v -= npl * 2 * NT; kind = 2; idx = v >> sh; nt = v & (NT - 1); }
    }
    MoeUnit r; r.bucket = 0; r.t = 0; r.mt = 0; r.cnt = 0; r.big = kind == 0; r.nt = nt;
    int pb = 0, ps = 0, pt = 0;
    for (int b = 0; b < 24; ++b) {
        const int c = cnt[b * 32], n = (c + 127) >> 7, np = n >> 1, sg = n & 1;
        if (kind != 2) { if (idx >= pb && idx < pb + np) { r.bucket = b; r.mt = 2 * (idx - pb) + half; r.t = pt + r.mt; r.cnt = c; } }
        else if (sg && idx == ps) { r.bucket = b; r.mt = n - 1; r.t = pt + n - 1; r.cnt = c; }
        pb += np; ps += sg; pt += n;
    }
    return r;
}
constexpr int MOE_TOK = 3 * GEMM_STAGE;
DI void phase_moe_up(const Params& P, const Ctx& p, uchar* lds, int layer) {
    const int tid = tid_opaque();
    const int* cnt = (const int*)(p.ws + WS_CTL + CTL_CNT) + layer * 1024;
    const int* list = (const int*)(p.ws + WS_LIST);
    const f32x2* route = (const f32x2*)(p.ws + WS_ROUTE);
    const u16* hb = (const u16*)(p.ws + WS_HB);
    const u16* wgu = (const u16*)(p.ws + WS_WGU) + (size_t)layer * 16 * 1024 * 1024;
    u16* act = (u16*)(p.ws + WS_REGA + RA_ACT);
    int* tok = (int*)(lds + MOE_TOK);
    const int rs = tid >> 3;
    int B, NBIG;
    const int U = moe_units(cnt, 8, gridDim.x, B, NBIG);
    for (int u = blockIdx.x; u < U; u += gridDim.x) {
        const MoeUnit mu = moe_unit(cnt, u, 8, B, NBIG);
        const int nt = mu.nt;
        int ea, eb; bucket_experts(mu.bucket, ea, eb);
        __syncthreads();
        if (tid < (mu.big ? 256 : 128)) { const int pos = mu.mt * 128 + tid; tok[tid] = list[(size_t)mu.bucket * R + (pos < mu.cnt ? pos : 0)]; }
        __syncthreads();
        const int e = nt < 4 ? ea : eb;
        auto epi_body =
            [&](int roff, int wc, int lane, uchar* w) {
                u16* dst = act + ((size_t)mu.t * 128 + roff) * 1024 + (nt >= 4 ? 512 : 0) + (nt & 3) * 128 + wc * 32;
                const int col = (lane & 3) * 8;
                f32x2 rw[4];
#pragma unroll
                for (int it = 0; it < 4; ++it) rw[it] = route[tok[roff + it * 16 + (lane >> 2)]];
#pragma unroll
                for (int it = 0; it < 4; ++it) {
                    const int row = it * 16 + (lane >> 2);
                    const float wgt = nt < 4 ? rw[it].x : rw[it].y;
                    const uchar* wp = w + row * EPI_PITCH + col * 4;
                    const f32x4 g0 = *(const f32x4*)wp, g1 = *(const f32x4*)(wp + 16), u0 = *(const f32x4*)(wp + 128), u1 = *(const f32x4*)(wp + 144);
                    f32x4 o0, o1;
#pragma unroll
                    for (int e2 = 0; e2 < 4; ++e2) { o0[e2] = g0[e2] * sigmoidf_(g0[e2]) * u0[e2] * wgt; o1[e2] = g1[e2] * sigmoidf_(g1[e2]) * u1[e2] * wgt; }
                    *(u32x4*)(dst + (size_t)row * 1024 + col) = pack8(o0, o1);
                }
            };
        if (mu.big) {
            int r0, c; p8_rc(tid, r0, c);
            const unsigned bo = (unsigned)((((r0 >> 5) * 64 + (r0 & 31)) * 2048) + c * 2);
            const unsigned a00 = (unsigned)tok[r0] * 2048u + c * 2, a10 = (unsigned)tok[128 + r0] * 2048u + c * 2, a01 = (unsigned)tok[64 + r0] * 2048u + c * 2, a11 = (unsigned)tok[192 + r0] * 2048u + c * 2;
            gemm_tile8p(lds, (const uchar*)hb, a00, a10, a01, a11, 0, 0, 0,
                        (const uchar*)(wgu + ((size_t)e * 1024 + (nt & 3) * 256) * 1024), bo, 128 * 2048, 32 * 2048, 160 * 2048, 16, 1 << 30, 0, epi_body);
        } else {
            const u16* a0 = hb + (size_t)tok[rs] * 1024;
            const u16* a1 = hb + (size_t)tok[rs + 64] * 1024;
            const u16* bb = wgu + ((size_t)e * 1024 + (nt & 3) * 256 + rs) * 1024;
            gemm_tile(lds, a0, a1, bb, bb + 64 * 1024, bb + 128 * 1024, bb + 192 * 1024, 16, 1 << 30, 0,
                [&](f32x16 (&acc)[2][2], int roff, int wc, int lane, uchar* w) { epi_stage(w, acc, lane & 31, lane >> 5); epi_body(roff, wc, lane, w); });
        }
    }
    if (layer == 0) tail_cvt_dense(P, lds, U, P.jobs[2].tile0, P.jobs[6].tile0);
}
DI void phase_moe_down(const Params& P, const Ctx& p, uchar* lds, int layer) {
    const int tid = tid_opaque();
    const int* cnt = (const int*)(p.ws + WS_CTL + CTL_CNT) + layer * 1024;
    const int* list = (const int*)(p.ws + WS_LIST);
    const u16* wd = (const u16*)(p.ws + WS_WD) + (size_t)layer * 16 * 1024 * 512;
    const u16* act = (const u16*)(p.ws + WS_REGA + RA_ACT);
    float* xs = (float*)(p.ws + WS_XS);
    float* dsto = layer == 0 ? xs : p.out;
    const float* mod = (const float*)(p.ws + WS_MOD);
    int* tok = (int*)(lds + MOE_TOK);
    const int rs = tid >> 3;
    int B, NBIG;
    const int U = moe_units(cnt, 4, gridDim.x, B, NBIG);
    for (int u = blockIdx.x; u < U; u += gridDim.x) {
        const MoeUnit mu = moe_unit(cnt, u, 4, B, NBIG);
        const int nt = mu.nt, n0 = nt * 256;
        int ea, eb; bucket_experts(mu.bucket, ea, eb);
        __syncthreads();
        if (tid < (mu.big ? 256 : 128)) { const int pos = mu.mt * 128 + tid; tok[tid] = pos < mu.cnt ? list[(size_t)mu.bucket * R + pos] : -1; }
        __syncthreads();
        const long bjump = (long)(eb - ea) * 1024 * 512 - 512;
        auto epi_body =
            [&](int roff, int wc, int lane, uchar* w) {
                const int nw = n0 + wc * 64 + (lane & 15) * 4;
                int tk[16]; f32x4 xi[16];
#pragma unroll
                for (int it = 0; it < 16; ++it) {
                    tk[it] = tok[roff + it * 4 + (lane >> 4)];
                    xi[it] = (f32x4){0.f, 0.f, 0.f, 0.f};
                    if (tk[it] >= 0) xi[it] = *(const f32x4*)(xs + (size_t)tk[it] * 1024 + nw);
                }
#pragma unroll
                for (int it = 0; it < 16; ++it) {
                    const int row = it * 4 + (lane >> 4);
                    if (tk[it] >= 0) {
                        const f32x4 gg = *(const f32x4*)(mod + (layer * 3 + mod_row(tk[it])) * 6144 + 5 * 1024 + nw);
                        const f32x4 v = *(const f32x4*)(w + row * EPI_PITCH + (lane & 15) * 16);
                        f32x4 o;
#pragma unroll
                        for (int e = 0; e < 4; ++e) o[e] = xi[it][e] + gg[e] * v[e];
                        *(f32x4*)(dsto + (size_t)tk[it] * 1024 + nw) = o;
                    }
                }
            };
        if (mu.big) {
            int r0, c; p8_rc(tid, r0, c);
            const unsigned ao = (unsigned)(r0 * 2048 + c * 2), bo = (unsigned)((((r0 >> 5) * 64 + (r0 & 31)) * 1024) + c * 2);
            gemm_tile8p(lds, (const uchar*)(act + (size_t)mu.t * 128 * 1024), ao, ao, ao, ao, 128 * 2048, 64 * 2048, 192 * 2048,
                        (const uchar*)(wd + ((size_t)ea * 1024 + n0) * 512), bo, 128 * 1024, 32 * 1024, 160 * 1024, 16, 8, bjump * 2, epi_body);
        } else {
            const u16* ab = act + ((size_t)mu.t * 128 + rs) * 1024;
            const u16* bb = wd + ((size_t)ea * 1024 + n0 + rs) * 512;
            gemm_tile(lds, ab, ab + 64 * 1024, bb, bb + 64 * 512, bb + 128 * 512, bb + 192 * 512, 16, 8, bjump,
                [&](f32x16 (&acc)[2][2], int roff, int wc, int lane, uchar* w) { epi_stage(w, acc, lane & 31, lane >> 5); epi_body(roff, wc, lane, w); });
        }
    }
    if (layer == 0) tail_cvt_moe(P, lds, U, 1, 0, MOE_CVT_TILES / 2);
}

DI void phase_inproj1(const Params& P, const Ctx& p, uchar* lds) {
    const int tid = tid_opaque();
    const u16* hb = (const u16*)(p.ws + WS_HB);
    const u16* w = (const u16*)(p.ws + WS_WIN1);
    u16* yb = (u16*)(p.ws + WS_REGA + RA_Y);
    u16* ub = (u16*)(p.ws + WS_REGA + RA_U);
    const int rs = tid >> 3;
    for (int u = blockIdx.x; u < 512 + 16; u += gridDim.x) {
        const bool big = u < 512;
        int mt, nt; if (big) rect_unit(u, 64, 8, mt, nt); else { mt = (u - 512) >> 2; nt = 4 + ((u - 512) & 3); }
        const int m0 = big ? mt * 256 : NL + mt * 128, n0 = nt * 256;
        auto epi_body =
            [&](int roff, int wc, int lane, uchar* w) {
                const int row0 = m0 + roff, nw = n0 + wc * 64;
                if (nt < 4) {
                    epi_rows8<64>(w, lane, [&](int row, int col, const f32x4& v0, const f32x4& v1) {
                        f32x4 a, b2;
#pragma unroll
                        for (int e = 0; e < 4; ++e) { const float x = v0[e], y = v1[e]; a[e] = x * sigmoidf_(1.5957691216057308f * (x + 0.044715f * x * x * x)); b2[e] = y * sigmoidf_(1.5957691216057308f * (y + 0.044715f * y * y * y)); }
                        *(u32x4*)(yb + (size_t)(row0 + row) * 1024 + nw + col) = pack8(a, b2); });
                } else {
                    epi_rows8<64>(w, lane, [&](int row, int col, const f32x4& v0, const f32x4& v1) { *(u32x4*)(ub + (size_t)(row0 + row) * 1024 + nw - 1024 + col) = pack8(v0, v1); });
                }
            };
        if (big) {
            int r0, c; p8_rc(tid, r0, c);
            const unsigned ao = (unsigned)(r0 * 2048 + c * 2), bo = (unsigned)((((r0 >> 5) * 64 + (r0 & 31)) * 2048) + c * 2);
            gemm_tile8p(lds, (const uchar*)(hb + (size_t)m0 * 1024), ao, ao, ao, ao, 128 * 2048, 64 * 2048, 192 * 2048,
                        (const uchar*)(w + (size_t)n0 * 1024), bo, 128 * 2048, 32 * 2048, 160 * 2048, 16, 1 << 30, 0, epi_body);
        } else {
            const u16* ab = hb + (size_t)(m0 + rs) * 1024;
            const u16* bb = w + (size_t)(n0 + rs) * 1024;
            gemm_tile(lds, ab, ab + 64 * 1024, bb, bb + 64 * 1024, bb + 128 * 1024, bb + 192 * 1024, 16, 1 << 30, 0,
                [&](f32x16 (&acc)[2][2], int roff, int wc, int lane, uchar* w) { epi_stage(w, acc, lane & 31, lane >> 5); epi_body(roff, wc, lane, w); });
        }
    }
    tail_cvt_moe(P, lds, 512 + 16, 1, MOE_CVT_TILES / 2, MOE_CVT_TILES);
}

constexpr int LRU_U = 0, LRU_UC = 36864, UROW = 272, UC_BLK = 64 * UROW  , UC_DIR = 2 * UC_BLK;
DI int lru_perm(int r) { return ((r >> 2) & 1) * 16 + (r >> 3) * 4 + (r & 3); }
DI unsigned* lru_bsave(const Ctx& p, int dir, int c, int cblk, int wid) {
    unsigned* base = (unsigned*)(p.ws + (dir == 0 ? WS_REGA + RA_BS0 : WS_WGU));
    return base + ((size_t)(c * 4 + cblk) * 8 + wid) * 1024;
}
DI u32x4* lru_osave(const Ctx& p, int dir, int c, int cblk, int wid, int q, int lane) {
    if (dir == 0) return (u32x4*)(p.ws + WS_HB + ((size_t)(c * 64 + (wid * 4 + q) * 2 + (lane >> 5)) * 2048 + cblk * 512 + (lane & 31) * 16));
    uchar* base = p.ws + (c < 128 ? WS_WD : WS_OM1B);
    return (u32x4*)(base + ((size_t)((c & 127) * 4 + cblk) * 32768 + ((wid * 4 + q) * 64 + lane) * 16));
}
struct LruW { bf16x8 fa[8], fx[8]; };
DI void lru_wload(const Ctx& p, int dir, int cblk, int wid, int lane, LruW& w, int which = 3) {
    const int l31 = lane & 31, hh = lane >> 5, bl = wid >> 2, jq = wid & 3, blkg = cblk * 2 + bl;
    const u16* wa = (const u16*)(p.ws + WS_WA) + ((size_t)(dir * 8 + blkg) * 128 + jq * 32 + l31) * 128 + hh * 8;
    const u16* wx = (const u16*)(p.ws + WS_WX) + ((size_t)(dir * 8 + blkg) * 128 + jq * 32 + l31) * 128 + hh * 8;
    if (which & 1) {
#pragma unroll
        for (int ks = 0; ks < 8; ++ks) w.fa[ks] = *(const bf16x8*)(wa + ks * 16);
    }
    if (which & 2) {
#pragma unroll
        for (int ks = 0; ks < 8; ++ks) w.fx[ks] = *(const bf16x8*)(wx + ks * 16);
    }
    __builtin_amdgcn_sched_barrier(0);
}
template <class Hook, class Hook2>
DI void lru_gates(const Ctx& p, const uchar* lds, int dir, int cblk, int wid, int lane, const LruW& w, float (&a)[2][16], float (&b)[2][16], unsigned* bsave, Hook&& hook, Hook2&& hook2) {
    const int l31 = lane & 31, hh = lane >> 5, bl = wid >> 2, jq = wid & 3;
    const int chl = bl * 128 + jq * 32 + l31;
    const int ch = cblk * 256 + chl;
    const uchar* uc = lds + LRU_UC + dir * UC_DIR + bl * UC_BLK;
    f32x16 dr[2], di[2];
#pragma unroll
    for (int rb = 0; rb < 2; ++rb)
#pragma unroll
        for (int i = 0; i < 16; ++i) { dr[rb][i] = 0.f; di[rb][i] = 0.f; }
    const int tk = lru_perm(l31);
#pragma unroll
    for (int ks = 0; ks < 8; ++ks) {
#pragma unroll
        for (int rb = 0; rb < 2; ++rb) dr[rb] = MFMA32(*(const bf16x8*)(uc + (rb * 32 + tk) * UROW + ks * 32 + hh * 16), w.fa[ks], dr[rb]);
    }
#pragma unroll
    for (int ks = 0; ks < 8; ++ks) {
#pragma unroll
        for (int rb = 0; rb < 2; ++rb) di[rb] = MFMA32(*(const bf16x8*)(uc + (rb * 32 + tk) * UROW + ks * 32 + hh * 16), w.fx[ks], di[rb]);
    }
    __builtin_amdgcn_sched_barrier(0);
    hook();
    const float nl2 = -1.4426950408889634f;
    const float kba = inp(p, I_ODBA)[dir * 1024 + ch] * nl2, kbx = inp(p, I_ODBX)[dir * 1024 + ch] * nl2;
    const float sp8 = 8.0f * log1pf(__expf(-inp(p, I_ODLAM)[dir * 1024 + ch]));
    const float c1 = sp8 * nl2;
    const int cofs = (jq * 32 + l31) * 2;
#pragma unroll
    for (int rb = 0; rb < 2; ++rb)
#pragma unroll
        for (int i = 0; i < 16; ++i) {
            const int token = rb * 32 + hh * 16 + i;
            const float r = frcp(1.0f + __builtin_amdgcn_exp2f(__builtin_fmaf(dr[rb][i], nl2, kba)));
            const float av = __builtin_amdgcn_exp2f(c1 * r);
            a[rb][i] = av;
            const float om = __builtin_fmaf(-av, av, 1.0f);
            const float ucv = b2f(*(const u16*)(uc + token * UROW + cofs));
            const float ig = frcp(1.0f + __builtin_amdgcn_exp2f(__builtin_fmaf(di[rb][i], nl2, kbx)));
            b[rb][i] = __builtin_amdgcn_sqrtf(om) * (ig * ucv);
        }
    __builtin_amdgcn_sched_barrier(0);
    hook2();
    if (bsave) {
#pragma unroll
        for (int q = 0; q < 4; ++q) {
            u32x4 v;
#pragma unroll
            for (int e = 0; e < 4; ++e) { const int j = q * 4 + e, rb = j >> 3, i = (j & 7) * 2; v[e] = pk2(b[rb][i], b[rb][i + 1]); }
            ((u32x4*)bsave)[q * 64 + lane] = v;
        }
    }
}
constexpr int LRU_U2 = 106496;
DI void lru_seq(int c, int& s0, int& s1) { if (c < 256) { s0 = (c >> 7) * SEQ; s1 = s0 + SEQ; } else { s0 = NL + ((c - 256) >> 2) * CTXL; s1 = s0 + CTXL; } }
DI void lru_dma(const Ctx& p, uchar* lds, int c, int cblk, int buf) {
    const int tid = tid_opaque(), lane = tid & 63, wid = tid >> 6;
    const u16* ub = (const u16*)(p.ws + WS_REGA + RA_U);
    int s0, s1; lru_seq(c, s0, s1);
    const int w0 = __builtin_amdgcn_readfirstlane(wid);
    uchar* dst = lds + (buf ? LRU_U2 : LRU_U);
#pragma unroll
    for (int k = 0; k < 5; ++k) {
        const int i = w0 + 8 * k;
        if (i < 35) {
            int row = c * 64 - 3 + 2 * i + (lane >> 5);
            row = row < s0 ? s0 : (row >= s1 ? s1 - 1 : row);
            __builtin_amdgcn_global_load_lds((const unsigned*)(ub + (size_t)row * 1024 + cblk * 256 + (lane & 31) * 8), (LAS unsigned*)(dst + i * 1024), 16, 0, 0);
        }
    }
}
DI void lru_conv(const Ctx& p, uchar* lds, int c, int cblk, int buf, bool counted = false) {
    const int tid = tid_opaque();
    const int row0 = c * 64;
    int s0, s1; lru_seq(c, s0, s1);
    const uchar* ut = lds + (buf ? LRU_U2 : LRU_U);
    if (counted) WAIT_V(8); else WAIT_V(0);
    __syncthreads();
    const int c8 = tid & 31, tq = tid >> 5, t0 = tq * 4;
    float uv[10][8];
#pragma unroll
    for (int rr = 0; rr < 10; ++rr) {
        u32x4 v = *(const u32x4*)(ut + (t0 + rr) * 512 + c8 * 16);
        const int row = row0 - 3 + t0 + rr;
        if (row < s0 || row >= s1) v = (u32x4){0u, 0u, 0u, 0u};
        uv[rr][0] = blo(v.x); uv[rr][1] = bhi(v.x); uv[rr][2] = blo(v.y); uv[rr][3] = bhi(v.y); uv[rr][4] = blo(v.z); uv[rr][5] = bhi(v.z); uv[rr][6] = blo(v.w); uv[rr][7] = bhi(v.w);
    }
#pragma unroll
    for (int dir = 0; dir < 2; ++dir) {
        const float* cw = inp(p, I_ODCW) + dir * 4096 + cblk * 256 + c8 * 8;
        const float* cb = inp(p, I_ODCB) + dir * 1024 + cblk * 256 + c8 * 8;
        float w[4][8], bs[8];
#pragma unroll
        for (int k = 0; k < 4; ++k) { const f32x4 x0 = *(const f32x4*)(cw + k * 1024), x1 = *(const f32x4*)(cw + k * 1024 + 4); w[k][0] = x0[0]; w[k][1] = x0[1]; w[k][2] = x0[2]; w[k][3] = x0[3]; w[k][4] = x1[0]; w[k][5] = x1[1]; w[k][6] = x1[2]; w[k][7] = x1[3]; }
        { const f32x4 x0 = *(const f32x4*)cb, x1 = *(const f32x4*)(cb + 4); bs[0] = x0[0]; bs[1] = x0[1]; bs[2] = x0[2]; bs[3] = x0[3]; bs[4] = x1[0]; bs[5] = x1[1]; bs[6] = x1[2]; bs[7] = x1[3]; }
#pragma unroll
        for (int tt = 0; tt < 4; ++tt) {
            float o[8];
#pragma unroll
            for (int e = 0; e < 8; ++e) {
                float s = bs[e];
#pragma unroll
                for (int k = 0; k < 4; ++k) s += w[k][e] * uv[tt + k + (dir ? 3 : 0)][e];
                o[e] = s;
            }
            const int t = t0 + tt;
            u32x4 wv; wv.x = pk2(o[0], o[1]); wv.y = pk2(o[2], o[3]); wv.z = pk2(o[4], o[5]); wv.w = pk2(o[6], o[7]);
            *(u32x4*)(lds + LRU_UC + dir * UC_DIR + (c8 >> 4) * UC_BLK + t * UROW + (c8 & 15) * 16) = wv;
        }
    }
    __syncthreads();
}
DI void lru_seg(const float (&a)[2][16], const float (&b)[2][16], int dir, int hh, float (&SA)[4], float (&SB)[4]) {
    float oa[2], ob[2];
#pragma unroll
    for (int rb = 0; rb < 2; ++rb) {
        float A = 1.f, B = 0.f;
#pragma unroll
        for (int ii = 0; ii < 16; ++ii) { const int i = dir ? 15 - ii : ii; B = a[rb][i] * B + b[rb][i]; A *= a[rb][i]; }
        oa[rb] = A; ob[rb] = B;
    }
    float pa[2], pb[2];
#pragma unroll
    for (int rb = 0; rb < 2; ++rb) { pa[rb] = __shfl_xor(oa[rb], 32); pb[rb] = __shfl_xor(ob[rb], 32); }
#pragma unroll
    for (int rb = 0; rb < 2; ++rb)
#pragma unroll
        for (int h = 0; h < 2; ++h) {
            const float A = (h == hh) ? oa[rb] : pa[rb], B = (h == hh) ? ob[rb] : pb[rb];
            const int s = dir ? 3 - (rb * 2 + h) : rb * 2 + h;
            SA[s] = A; SB[s] = B;
        }
}
DI void lru_summ_item(int j, int& c, int& cblk, int& role) {
    if (j < 1024) { c = j >> 2; cblk = j & 3; role = -1; } else { const int mini = j - 1024, cu = mini >> 3; c = 256 + (cu >> 2); cblk = cu & 3; role = mini & 7; }
}
template <class F>
DI void lru_summ_wave(const Ctx& p, uchar* lds, int c, int cblk, int role, LruW& w, F&& next_dma) {
    const int tid = tid_opaque(), lane = tid & 63, wid = role < 0 ? (tid >> 6) : role, hh = lane >> 5;
    f32x2* summ = (f32x2*)(p.ws + WS_SUMM);
    const int ch = cblk * 256 + (wid >> 2) * 128 + (wid & 3) * 32 + (lane & 31);
#pragma unroll
    for (int dir = 0; dir < 2; ++dir) {
        float a[2][16], b[2][16];
        unsigned* bs = c < 256 ? lru_bsave(p, dir, c, cblk, wid) : (unsigned*)nullptr;
        if (dir == 0) lru_gates(p, lds, 0, cblk, wid, lane, w, a, b, bs, [&]() { lru_wload(p, 1, cblk, wid, lane, w, 1); }, [&]() { lru_wload(p, 1, cblk, wid, lane, w, 2); });
        else          lru_gates(p, lds, 1, cblk, wid, lane, w, a, b, bs, [&]() { next_dma(); lru_wload(p, 0, cblk, wid, lane, w, 1); }, [&]() { lru_wload(p, 0, cblk, wid, lane, w, 2); });
        if (c < 256) {
#pragma unroll
            for (int q = 0; q < 4; ++q) {
                u32x4 v;
#pragma unroll
                for (int e = 0; e < 4; ++e) { const int j = q * 4 + e, rb = j >> 3, i = (j & 7) * 2; v[e] = pk2(1.0f - a[rb][i], 1.0f - a[rb][i + 1]); }
                *lru_osave(p, dir, c, cblk, wid, q, lane) = v;
            }
        }
        float SA[4], SB[4];
        lru_seg(a, b, dir, hh, SA, SB);
        float A = 1.f, B = 0.f;
#pragma unroll
        for (int s = 0; s < 4; ++s) { B = SA[s] * B + SB[s]; A *= SA[s]; }
        if (hh == 0) summ[((size_t)dir * 264 + c) * 1024 + ch] = (f32x2){A, B};
    }
}
DI void phase_lru_summ(const Ctx& p, uchar* lds) {
    const int tid = tid_opaque(), lane = tid & 63, wid = tid >> 6;
    constexpr int NITEM = 1024 + 32 * 8;
    int c, cblk, role;
    if ((int)blockIdx.x >= NITEM) return;
    lru_summ_item(blockIdx.x, c, cblk, role); lru_dma(p, lds, c, cblk, 0);
    LruW w;
    lru_wload(p, 0, cblk, role < 0 ? wid : role, lane, w);
    int buf = 0;
    bool counted = false;
    for (int j = blockIdx.x; j < NITEM; j += gridDim.x, buf ^= 1) {
        lru_summ_item(j, c, cblk, role);
        lru_conv(p, lds, c, cblk, buf, counted);
        counted = role < 0;
        int c2 = 0, cblk2 = 0, role2 = -1;
        const bool more = j + (int)gridDim.x < NITEM;
        if (more) lru_summ_item(j + gridDim.x, c2, cblk2, role2);
        auto next_dma = [&]() { if (more) lru_dma(p, lds, c2, cblk2, buf ^ 1); };
        if (role < 0) {
            lru_summ_wave(p, lds, c, cblk, -1, w, next_dma);
            if (more && role2 >= 0) lru_wload(p, 0, cblk2, role2, lane, w);
        } else {
            if (wid == 0) lru_summ_wave(p, lds, c, cblk, role, w, next_dma); else next_dma();
            if (more && (cblk2 != cblk || role2 != role)) lru_wload(p, 0, cblk2, role2, lane, w);
        }
    }
    WAIT_V(0);
}
DI void phase_lru_carry(const Ctx& p) {
    const int tid = tid_opaque();
    const f32x2* summ = (const f32x2*)(p.ws + WS_SUMM);
    float* carry = (float*)(p.ws + WS_CARRY);
    for (int g = blockIdx.x * 512 + tid; g < 4096; g += gridDim.x * 512) {
        const int ch = g & 1023, bt = (g >> 10) & 1, dir = g >> 11;
        const f32x2* sd = summ + (size_t)dir * 264 * 1024 + ch;
        float h = 0.f;
        f32x2 s[4];
#pragma unroll
        for (int q = 0; q < 4; ++q) s[q] = sd[(size_t)(256 + bt * 4 + (dir ? 3 - q : q)) * 1024];
#pragma unroll
        for (int q = 0; q < 4; ++q) h = s[q].x * h + s[q].y;
        for (int q0 = 0; q0 < 128; q0 += 16) {
            f32x2 t[16];
#pragma unroll
            for (int q = 0; q < 16; ++q) { const int ci = dir ? 127 - (q0 + q) : q0 + q; t[q] = sd[(size_t)(bt * 128 + ci) * 1024]; }
#pragma unroll
            for (int q = 0; q < 16; ++q) { const int ci = dir ? 127 - (q0 + q) : q0 + q; carry[((size_t)dir * 256 + bt * 128 + ci) * 1024 + ch] = h; h = t[q].x * h + t[q].y; }
        }
    }
}
DI void phase_lru_scan(const Ctx& p, uchar* lds) {
    const int tid = tid_opaque(), lane = tid & 63, wid = tid >> 6, hh = lane >> 5;
    const u16* yb = (const u16*)(p.ws + WS_REGA + RA_Y);
    u16* hb = (u16*)(p.ws + WS_HB);
    for (int u = blockIdx.x; u < 256 * 4; u += gridDim.x) {
        const int c = u >> 2, cblk = u & 3;
        const int ch = cblk * 256 + (wid >> 2) * 128 + (wid & 3) * 32 + (lane & 31);
        float hsum[2][16];
        __syncthreads();
#pragma unroll
        for (int dir = 0; dir < 2; ++dir) {
            const float h0 = ((const float*)(p.ws + WS_CARRY))[((size_t)dir * 256 + c) * 1024 + ch];
            float a[2][16], b[2][16];
            {
                const unsigned* bs = lru_bsave(p, dir, c, cblk, wid);
                unsigned bw[16], ow[16];
#pragma unroll
                for (int q = 0; q < 4; ++q) {
                    const u32x4 vb = ((const u32x4*)bs)[q * 64 + lane], vo = *lru_osave(p, dir, c, cblk, wid, q, lane);
#pragma unroll
                    for (int e = 0; e < 4; ++e) { bw[q * 4 + e] = vb[e]; ow[q * 4 + e] = vo[e]; }
                }
#pragma unroll
                for (int rb = 0; rb < 2; ++rb)
#pragma unroll
                    for (int i = 0; i < 16; ++i) {
                        const unsigned wb = bw[rb * 8 + (i >> 1)], wo = ow[rb * 8 + (i >> 1)];
                        b[rb][i] = (i & 1) ? bhi(wb) : blo(wb);
                        a[rb][i] = 1.0f - ((i & 1) ? bhi(wo) : blo(wo));
                    }
            }
            float SA[4], SB[4];
            lru_seg(a, b, dir, hh, SA, SB);
            float st[4]; st[0] = h0;
#pragma unroll
            for (int s = 1; s < 4; ++s) st[s] = SA[s - 1] * st[s - 1] + SB[s - 1];
#pragma unroll
            for (int rb = 0; rb < 2; ++rb) {
                const int sidx = dir ? 3 - (rb * 2 + hh) : rb * 2 + hh;
                float h = sidx == 0 ? st[0] : (sidx == 1 ? st[1] : (sidx == 2 ? st[2] : st[3]));
#pragma unroll
                for (int ii = 0; ii < 16; ++ii) { const int i = dir ? 15 - ii : ii; h = a[rb][i] * h + b[rb][i]; if (dir == 0) hsum[rb][i] = h; else hsum[rb][i] += h; }
            }
        }
        __syncthreads();
        {
            const int chl = (wid >> 2) * 128 + (wid & 3) * 32 + (lane & 31);
#pragma unroll
            for (int rb = 0; rb < 2; ++rb)
#pragma unroll
                for (int i = 0; i < 16; ++i) *(float*)(lds + (rb * 32 + hh * 16 + i) * 1040 + chl * 4) = hsum[rb][i];
        }
        __syncthreads();
#pragma unroll
        for (int j = 0; j < 4; ++j) {
            const int pi = j * 512 + tid, tk = pi >> 5, c8 = pi & 31;
            const f32x4 h0 = *(const f32x4*)(lds + tk * 1040 + c8 * 32), h1 = *(const f32x4*)(lds + tk * 1040 + c8 * 32 + 16);
            const size_t o = (size_t)(c * 64 + tk) * 1024 + cblk * 256 + c8 * 8;
            const u32x4 yv = *(const u32x4*)(yb + o);
            u32x4 w;
            w.x = pk2(blo(yv.x) * h0[0], bhi(yv.x) * h0[1]); w.y = pk2(blo(yv.y) * h0[2], bhi(yv.y) * h0[3]);
            w.z = pk2(blo(yv.z) * h1[0], bhi(yv.z) * h1[1]); w.w = pk2(blo(yv.w) * h1[2], bhi(yv.w) * h1[3]);
            *(u32x4*)(hb + o) = w;
        }
    }
}

__global__ void __launch_bounds__(512) fwd_mega(const Params P) {
    uchar* lds = smem + LDS_USER;
    LAS unsigned long long* tab = (LAS unsigned long long*)(smem + 64);
    if (threadIdx.x < N_IN) tab[threadIdx.x] = (unsigned long long)P.in[threadIdx.x];
    if ((threadIdx.x & 63) == 0) ((volatile LAS int*)smem)[96 + hw_slot()] = threadIdx.x >> 6;
    const bool multi = (P.ph_hi - P.ph_lo) > 1;
    if (threadIdx.x == 0) { ((volatile LAS unsigned*)smem)[0] = 0u; ((volatile LAS unsigned*)smem)[1] = 0u; ((volatile LAS unsigned*)smem)[2] = 0u; ((volatile LAS unsigned*)smem)[3] = 0u; }
    __syncthreads();
    if (multi) (void)xcd_barrier_post((unsigned*)(P.ws + WS_CTL), (volatile LAS unsigned*)smem);
#define RUN_PHASE(k, call) if (P.ph_lo <= (k) && (k) < P.ph_hi) { { Ctx p; { unsigned long long wsi = (unsigned long long)P.ws; asm volatile("" : "+s"(wsi)); p.ws = (uchar*)(__attribute__((address_space(1))) uchar*)wsi; } p.out = P.out; p.tab = tab; call; } if ((PROBE_REPS >> (k)) & 1) { { XcdBarrier xb_; xb_.bar = (unsigned*)(P.ws + WS_CTL); xb_.x = xb_xcc_id(); xb_.st = (volatile LAS unsigned*)smem; xcd_barrier(xb_); } Ctx p; { unsigned long long wsi = (unsigned long long)P.ws; asm volatile("" : "+s"(wsi)); p.ws = (uchar*)(__attribute__((address_space(1))) uchar*)wsi; } p.out = P.out; p.tab = tab; call; } if (multi && (k) + 1 < P.ph_hi) { XcdBarrier xb_; xb_.bar = (unsigned*)(P.ws + WS_CTL); xb_.x = xb_xcc_id(); xb_.st = (volatile LAS unsigned*)smem; xcd_barrier(xb_); } }
    RUN_PHASE(0, phase_prep(P, p, lds))
    RUN_PHASE(1, phase_norm(p, 0))
    RUN_PHASE(2, phase_inproj0(P, p, lds))
    RUN_PHASE(3, phase_attn(p, lds))
    RUN_PHASE(4, phase_outproj(P, p, lds, 0))
    RUN_PHASE(5, phase_router(p, lds, 0))
#if PROBE_ROUTER2X
    if (P.ph_lo <= 5 && 5 < P.ph_hi) { Ctx p; { unsigned long long wsi = (unsigned long long)P.ws; asm volatile("" : "+s"(wsi)); p.ws = (uchar*)(__attribute__((address_space(1))) uchar*)wsi; } p.out = P.out; p.tab = tab; phase_router(p, lds, 0, 2); { XcdBarrier xb_; xb_.bar = (unsigned*)(P.ws + WS_CTL); xb_.x = xb_xcc_id(); xb_.st = (volatile LAS unsigned*)smem; xcd_barrier(xb_); } }
#endif
    RUN_PHASE(6, phase_moe_up(P, p, lds, 0))
    RUN_PHASE(7, phase_moe_down(P, p, lds, 0))
    RUN_PHASE(8, phase_norm(p, 1))
    RUN_PHASE(9, phase_inproj1(P, p, lds))
    RUN_PHASE(10, phase_lru_summ(p, lds))
    RUN_PHASE(11, phase_lru_carry(p))
    RUN_PHASE(12, phase_lru_scan(p, lds))
    RUN_PHASE(13, phase_outproj(P, p, lds, 1))
    RUN_PHASE(14, phase_router(p, lds, 1))
    RUN_PHASE(15, phase_moe_up(P, p, lds, 1))
    RUN_PHASE(16, phase_moe_down(P, p, lds, 1))
}

extern "C" void kernel_launch(void* const* d_in, const int* in_sizes, int n_in, void* d_out, int out_size, void* d_ws, size_t ws_size, hipStream_t stream) {
    static int grid = 0;
    if (grid == 0) {
        if (n_in != N_IN || out_size != NL * D || ws_size < WS_END) { fprintf(stderr, "kernel_launch: unexpected shapes (n_in %d, out %d, ws %zu, need %zu)\n", n_in, out_size, ws_size, (size_t)WS_END); grid = -1; return; }
        int dev = 0, cus = 0, per_cu = 0;
        if (hipGetDevice(&dev) != hipSuccess || hipDeviceGetAttribute(&cus, hipDeviceAttributeMultiprocessorCount, dev) != hipSuccess) { grid = -1; return; }
        if (hipFuncSetAttribute((const void*)fwd_mega, hipFuncAttributeMaxDynamicSharedMemorySize, LDS_BYTES) != hipSuccess) { fprintf(stderr, "kernel_launch: hipFuncSetAttribute failed\n"); grid = -1; return; }
        if (hipOccupancyMaxActiveBlocksPerMultiprocessor(&per_cu, (const void*)fwd_mega, 512, LDS_BYTES) != hipSuccess || per_cu < 1) { fprintf(stderr, "kernel_launch: occupancy query says %d\n", per_cu); (void)hipGetLastError(); grid = -1; return; }
        grid = cus;
    }
    if (grid < 0) return;
    if (hipMemsetAsync((char*)d_ws + WS_CTL, 0, CTL_BYTES, stream) != hipSuccess) return;
    Params p{};
    for (int i = 0; i < N_IN; ++i) p.in[i] = (const float*)d_in[i];
    p.out = (float*)d_out; p.ws = (uchar*)d_ws;
    uchar* ws = (uchar*)d_ws;
    int t0 = 0;
    auto job = [&](int j, const float* src, size_t dst_off, int nmat, int K, int N, int sstride, int dstride, int lddst, int mode, int half) {
        CvtJob& J = p.jobs[j]; J.src = src; J.dst = (u16*)(ws + dst_off); J.nmat = nmat; J.K = K; J.N = N; J.sstride = sstride; J.dstride = dstride; J.lddst = lddst; J.mode = mode; J.half = half; J.tile0 = t0; J.pad = 0;
        t0 += nmat * (K / 64) * (N / 64);
    };
    job(0, p.in[I_EVWIN], WS_WIN0, 1, 1024, 3072, 0, 0, 1024, 0, 0);
    job(1, p.in[I_EVWOUT], WS_WOUT0, 1, 1024, 1024, 0, 0, 1024, 0, 0);
    job(2, p.in[I_ODWIN], WS_WIN1, 1, 1024, 2048, 0, 0, 1024, 0, 0);
    job(3, p.in[I_ODWOUT], WS_WOUT1, 1, 1024, 1024, 0, 0, 1024, 0, 0);
    job(4, p.in[I_ODWA], WS_WA, 16, 128, 128, 16384, 16384, 128, 0, 0);
    job(5, p.in[I_ODWX], WS_WX, 16, 128, 128, 16384, 16384, 128, 0, 0);
    job(6, p.in[I_MGATE], WS_WGU, 32, 1024, 512, 524288, 1048576, 1024, 1, 0);
    job(7, p.in[I_MUP], WS_WGU, 32, 1024, 512, 524288, 1048576, 1024, 1, 1);
    job(8, p.in[I_MDOWN], WS_WD, 32, 512, 1024, 524288, 524288, 512, 0, 0);
    p.ncvt = t0;
    const int nl = N_LAUNCHES;
    for (int li = 0; li < nl; ++li) {
        p.ph_lo = li * NPH / nl; p.ph_hi = (li + 1) * NPH / nl;
        hipLaunchKernelGGL(fwd_mega, dim3(grid), dim3(512), LDS_BYTES, stream, p);
    }
}
```

```cpp
#include <hip/hip_runtime.h>
#include <stdint.h>
#include <stdio.h>

#define DI __device__ __forceinline__
#define LAS __attribute__((address_space(3)))
typedef unsigned short u16;
typedef unsigned char uchar;
typedef short bf16x8 __attribute__((ext_vector_type(8)));
typedef float f32x16 __attribute__((ext_vector_type(16)));
typedef float f32x4 __attribute__((ext_vector_type(4)));
typedef float f32x2 __attribute__((ext_vector_type(2)));
typedef __bf16 bf2_t __attribute__((ext_vector_type(2)));
typedef unsigned u32x2 __attribute__((ext_vector_type(2)));
typedef unsigned u32x4 __attribute__((ext_vector_type(4)));

#ifndef N_LAUNCHES
#define N_LAUNCHES 1
#endif
#ifndef PROBE_GEMM2X
#define PROBE_GEMM2X 0
#endif
#ifndef PROBE_ROUTER2X
#define PROBE_ROUTER2X 0
#endif
#ifndef PROBE_REPS
#define PROBE_REPS 0x0000
#endif

DI unsigned pk2(float a, float b) { f32x2 v = {a, b}; bf2_t r = __builtin_convertvector(v, bf2_t); return __builtin_bit_cast(unsigned, r); }
DI u16 f2b(float a) { __bf16 r = (__bf16)a; return __builtin_bit_cast(u16, r); }
DI float b2f(u16 v) { return __uint_as_float(((unsigned)v) << 16); }
DI float blo(unsigned v) { return __uint_as_float(v << 16); }
DI float bhi(unsigned v) { return __uint_as_float(v & 0xffff0000u); }
#define MFMA32(a, b, c) __builtin_amdgcn_mfma_f32_32x32x16_bf16((a), (b), (c), 0, 0, 0)

constexpr int D = 1024, NL = 16384, NC = 512, R = 16896, SEQ = 8192, CTXL = 256, SK = 8448;
constexpr int NPH = 17;
constexpr float EPS = 1e-6f;
constexpr float LAM_INIT0 = 0.2f;
constexpr float QSCALE = 0.125f * 1.4426950408889634f;

enum { I_X = 0, I_C, I_CTX, I_CCTX, I_ADAW, I_ADAB, I_NMIX, I_NFFN, I_EVWIN, I_EVCW, I_EVCB, I_QN, I_KN, I_LQ1, I_LK1, I_LQ2, I_LK2, I_SUBN, I_EVWOUT,
       I_ODWIN, I_ODCW, I_ODCB, I_ODWA, I_ODBA, I_ODWX, I_ODBX, I_ODLAM, I_ODWOUT, I_MWGRP, I_MBGRP, I_MWRT, I_MBRT, I_MGATE, I_MUP, I_MDOWN, N_IN };

constexpr size_t al256(size_t x) { return (x + 255) & ~(size_t)255; }
constexpr size_t WS_CTL   = 0;
constexpr size_t CTL_BYTES = 65536;
constexpr size_t CTL_CNT  = 16384;
constexpr size_t WS_MOD   = WS_CTL + CTL_BYTES;
constexpr size_t WS_ROPE  = WS_MOD + al256(2 * 3 * 6144 * 4);
constexpr size_t WS_ROUTE = WS_ROPE + (size_t)SEQ * 32 * 8;
constexpr size_t WS_LIST  = WS_ROUTE + al256((size_t)R * 8);
constexpr size_t WS_SUMM  = WS_LIST + al256((size_t)24 * R * 4);
constexpr size_t WS_CARRY = WS_SUMM + (size_t)2 * 264 * 1024 * 8;
constexpr size_t WS_WIN0  = WS_CARRY + (size_t)2 * 256 * 1024 * 4;
constexpr size_t WS_WOUT0 = WS_WIN0 + (size_t)3072 * 1024 * 2;
constexpr size_t WS_WIN1  = WS_WOUT0 + (size_t)1024 * 1024 * 2;
constexpr size_t WS_WOUT1 = WS_WIN1 + (size_t)2048 * 1024 * 2;
constexpr size_t WS_WA    = WS_WOUT1 + (size_t)1024 * 1024 * 2;
constexpr size_t WS_WX    = WS_WA + (size_t)2 * 8 * 128 * 128 * 2;
constexpr size_t WS_WGU   = WS_WX + (size_t)2 * 8 * 128 * 128 * 2;
constexpr size_t WS_WD    = WS_WGU + (size_t)2 * 16 * 1024 * 1024 * 2;
constexpr size_t WS_XS    = WS_WD + (size_t)2 * 16 * 1024 * 512 * 2;
constexpr size_t WS_HB    = WS_XS + (size_t)R * 1024 * 4;
constexpr size_t WS_REGA  = WS_HB + (size_t)R * 1024 * 2;
constexpr size_t RA_ZC    = 0;
constexpr size_t RA_Q     = RA_ZC + (size_t)R * 1536 * 2;
constexpr size_t RA_K     = RA_Q + (size_t)16 * SK * 64 * 2;
constexpr size_t RA_VT    = RA_K + (size_t)16 * SK * 64 * 2;
constexpr size_t RA_END0  = RA_VT + (size_t)8 * 128 * SK * 2;
constexpr size_t RA_ACT   = 0;
constexpr size_t RA_Y     = 0;
constexpr size_t RA_U     = RA_Y + (size_t)NL * 1024 * 2;
constexpr size_t RA_BS0   = RA_U + (size_t)R * 1024 * 2;
constexpr size_t WS_OM1B  = WS_REGA + RA_END0;
constexpr size_t WS_END   = WS_OM1B + (size_t)128 * 4 * 32768;
static_assert(RA_BS0 + (size_t)256 * 4 * 8 * 1024 * 4 <= RA_END0 && (size_t)20480 * 1024 * 2 <= RA_END0, "region A overlays");
static_assert((size_t)256 * 4 * 8 * 1024 * 4 <= (size_t)16 * 1024 * 1024 * 2, "b of direction 1 fits layer 0's gate/up weights");
static_assert(WS_END <= 352000000ull, "workspace budget");

constexpr int LDS_BYTES = 147456 + 1024 + 1024;
constexpr int LDS_USER = 1024;

struct CvtJob { const float* src; u16* dst; int nmat, K, N, sstride, dstride, lddst, mode, half, tile0, pad; };
struct Params {
    const float* in[N_IN];
    float* out;
    uchar* ws;
    CvtJob jobs[9];
    int ncvt, ph_lo, ph_hi, pad;
};
struct Ctx { uchar* ws; float* out; const LAS unsigned long long* tab; };
typedef const __attribute__((address_space(1))) float* gcf_t;
DI const float* inp(const Ctx& c, int i) { return (const float*)(gcf_t)c.tab[i]; }

extern __shared__ __attribute__((aligned(16))) uchar smem[];
DI int hw_slot() { return (int)(__builtin_amdgcn_s_getreg(((6 - 1) << 11) | 4) & 63u); }
DI int tid_opaque() {
    const int lane = (int)__builtin_amdgcn_mbcnt_hi(~0u, __builtin_amdgcn_mbcnt_lo(~0u, 0u));
    int w = ((volatile LAS int*)smem)[96 + hw_slot()];
    w = __builtin_amdgcn_readfirstlane(w);
    int t = w * 64 + lane; asm volatile("" : "+v"(t)); return t;
}
#define XB_TMO      128
#define XB_XCNT(j)  (256  + 64 * (j))
#define XB_XSUB(j)  (1280 + 64 * (j))
#define XB_XGEN(j)  (2304 + 64 * (j))
#define XB_TOP      3328
#define XB_TOPGEN   3392
#define XCD_BAR_WORDS 3456
#define XB_SPIN_CAP (1u << 20)
DI unsigned xb_ld(unsigned* p)              { return __hip_atomic_load(p, __ATOMIC_RELAXED, __HIP_MEMORY_SCOPE_AGENT); }
DI unsigned xb_add(unsigned* p, unsigned v) { return __hip_atomic_fetch_add(p, v, __ATOMIC_RELAXED, __HIP_MEMORY_SCOPE_AGENT); }
DI unsigned xb_xcc_id() { return (unsigned)__builtin_amdgcn_s_getreg((3 << 11) | 20) & 0xFu; }
#define XB_SPIN(cond, bar) do { unsigned _sp = 0; while (cond) { __builtin_amdgcn_s_sleep(1); \
    if ((++_sp & 255u) == 0u) { if (xb_ld(&(bar)[XB_TMO])) break; if (_sp > XB_SPIN_CAP) { atomicAdd(&(bar)[XB_TMO], 1u); break; } } } } while (0)
struct XcdBarrier { unsigned* bar; unsigned x; volatile LAS unsigned* st; };
DI XcdBarrier xcd_barrier_post(unsigned* bar, volatile LAS unsigned* st) {
    XcdBarrier b; b.bar = bar; b.x = xb_xcc_id(); b.st = st;
    if (tid_opaque() == 0) (void)xb_add(&bar[XB_XCNT(b.x)], 1u);
    return b;
}
DI void xcd_barrier_complete(unsigned* bar, unsigned x, unsigned& nloc, unsigned& nx) {
    const unsigned G = gridDim.x * gridDim.y * gridDim.z;
    unsigned sum, cnt, mine, sp = 0u;
    for (;;) {
        sum = 0u; cnt = 0u; mine = 0u;
#pragma unroll
        for (unsigned j = 0; j < 16; ++j) { const unsigned c = xb_ld(&bar[XB_XCNT(j)]); sum += c; cnt += (c > 0u) ? 1u : 0u; mine = (j == x) ? c : mine; }
        if (sum == G) break;
        __builtin_amdgcn_s_sleep(1);
        if ((++sp & 255u) == 0u) { if (xb_ld(&bar[XB_TMO])) break; if (sp > XB_SPIN_CAP) { atomicAdd(&bar[XB_TMO], 1u); break; } }
    }
    nloc = mine > 0u ? mine : 1u; nx = cnt > 0u ? cnt : 1u;
}
DI void xcd_barrier(const XcdBarrier& b) {
    asm volatile("s_waitcnt vmcnt(0)" ::: "memory");
    __syncthreads();
    if (tid_opaque() == 0) {
        unsigned* bar = b.bar;
        __builtin_amdgcn_s_waitcnt(0);
        unsigned nloc = b.st[0], nx = b.st[1];
        if (nloc == 0u) { xcd_barrier_complete(bar, b.x, nloc, nx); b.st[0] = nloc; b.st[1] = nx; }
        const unsigned old = xb_add(&bar[XB_XSUB(b.x)], 1u);
        const unsigned gen = old / nloc;
        if (old + 1u == (gen + 1u) * nloc) {
            __builtin_amdgcn_fence(__ATOMIC_RELEASE, "agent");
            asm volatile("s_waitcnt vmcnt(0)" ::: "memory");
            const unsigned og = xb_add(&bar[XB_TOP], 1u);
            const unsigned tg = og / nx;
            if (og + 1u == (tg + 1u) * nx) xb_add(&bar[XB_TOPGEN], 1u);
            else XB_SPIN(xb_ld(&bar[XB_TOPGEN]) == tg, bar);
            __builtin_amdgcn_fence(__ATOMIC_ACQUIRE, "agent");
            xb_add(&bar[XB_XGEN(b.x)], 1u);
            asm volatile("s_waitcnt vmcnt(0)" ::: "memory");
        } else {
            XB_SPIN(xb_ld(&bar[XB_XGEN(b.x)]) == gen, bar);
            __builtin_amdgcn_fence(__ATOMIC_ACQUIRE, "agent");
            asm volatile("s_waitcnt vmcnt(0)" ::: "memory");
        }
    }
    __syncthreads();
}

DI float xor32_sum(float x) {
    const unsigned u = __float_as_uint(x);
    const auto r = __builtin_amdgcn_permlane32_swap(u, u, false, false);
    return __uint_as_float(r[0]) + __uint_as_float(r[1]);
}
#define DPP_ADD(v, ctrl) ((v) + __uint_as_float((unsigned)__builtin_amdgcn_update_dpp(0, (int)__float_as_uint(v), (ctrl), 0xf, 0xf, true)))
DI float wave_sum(float v) {
    v = DPP_ADD(v, 0xB1);
    v = DPP_ADD(v, 0x4E);
    v = DPP_ADD(v, 0x141);
    v = DPP_ADD(v, 0x140);
    const unsigned u = __float_as_uint(v);
    return (__uint_as_float(__builtin_amdgcn_readlane(u, 0)) + __uint_as_float(__builtin_amdgcn_readlane(u, 16))) +
           (__uint_as_float(__builtin_amdgcn_readlane(u, 32)) + __uint_as_float(__builtin_amdgcn_readlane(u, 48)));
}
DI int crow(int i, int hh) { return (i & 3) + 8 * (i >> 2) + 4 * hh; }
DI int mod_row(int r) { return r < NL ? (r >> 13) : 2; }
DI float frcp(float x) { return __builtin_amdgcn_rcpf(x); }
DI float fexp(float x) { return __builtin_amdgcn_exp2f(x * 1.4426950408889634f); }
DI float sigmoidf_(float x) { return frcp(1.0f + fexp(-x)); }
DI float one_minus_exp(float x) {
    const float s = -x * (1.0f + x * 0.5f * (1.0f + x * (1.0f / 3.0f) * (1.0f + x * 0.25f * (1.0f + x * 0.2f * (1.0f + x * (1.0f / 6.0f))))));
    const float d = 1.0f - fexp(x);
    return x > -0.125f ? s : d;
}

template <class F>
DI void cvt_list(const Params& P, uchar* lds, int i0, int step, int n, F&& job_of) {
    const int tid = tid_opaque();
    float* tl = (float*)lds;
    f32x4 rv[2];
    auto tile_src = [&](int idx, int& j, int& mat, int& kt, int& nt) -> const float* {
        int t; job_of(idx, j, t);
        const int N = P.jobs[j].N, tn = N >> 6, per = (P.jobs[j].K >> 6) * tn; mat = t / per; t -= mat * per; kt = t / tn; nt = t - kt * tn;
        return P.jobs[j].src + (size_t)mat * P.jobs[j].sstride + (size_t)(kt * 64) * N + nt * 64;
    };
    int u = i0, j = 0, mat = 0, kt = 0, nt = 0;
    __syncthreads();
    if (u < n) { const float* src = tile_src(u, j, mat, kt, nt); const int N = P.jobs[j].N;
#pragma unroll
        for (int i = 0; i < 2; ++i) rv[i] = *(const f32x4*)(src + (size_t)((tid >> 4) + 32 * i) * N + (tid & 15) * 4); }
    for (; u < n; u += step) {
#pragma unroll
        for (int i = 0; i < 2; ++i) { float* q = tl + ((tid >> 4) + 32 * i) * 65 + (tid & 15) * 4; q[0] = rv[i][0]; q[1] = rv[i][1]; q[2] = rv[i][2]; q[3] = rv[i][3]; }
        const CvtJob J = P.jobs[j];
        const int cmat = mat, ckt = kt, cnt_ = nt;
        const int un = u + step;
        if (un < n) { const float* src = tile_src(un, j, mat, kt, nt); const int N = P.jobs[j].N;
#pragma unroll
            for (int i = 0; i < 2; ++i) rv[i] = *(const f32x4*)(src + (size_t)((tid >> 4) + 32 * i) * N + (tid & 15) * 4); }
        __syncthreads();
        const int n_ = tid >> 3, kc = tid & 7;
        float v[8];
#pragma unroll
        for (int e = 0; e < 8; ++e) v[e] = tl[(kc * 8 + e) * 65 + n_];
        const int ng = cnt_ * 64 + n_;
        const int drow = J.mode ? ((ng >> 5) * 64 + J.half * 32 + (ng & 31)) : ng;
        u16* d = J.dst + (size_t)cmat * J.dstride + (size_t)drow * J.lddst + ckt * 64 + kc * 8;
        u32x4 w; w.x = pk2(v[0], v[1]); w.y = pk2(v[2], v[3]); w.z = pk2(v[4], v[5]); w.w = pk2(v[6], v[7]);
        *(u32x4*)d = w;
        __syncthreads();
    }
}
constexpr int MOE_CVT_TILES = 6144;
DI void tail_cvt_dense(const Params& P, uchar* lds, int nunits, int lo, int hi) {
    const int G = gridDim.x, rem = nunits % G;
    int rank = blockIdx.x, nidle = G;
    if (rem != 0) { if ((int)blockIdx.x < rem) return; rank = blockIdx.x - rem; nidle = G - rem; }
    cvt_list(P, lds, lo + rank, nidle, hi, [&](int idx, int& j, int& t) {
        j = 0;
#pragma unroll
        for (int q = 1; q < 6; ++q) if (idx >= P.jobs[q].tile0) j = q;
        t = idx - P.jobs[j].tile0; });
}
DI void tail_cvt_moe(const Params& P, uchar* lds, int nunits, int layer, int lo, int hi) {
    const int G = gridDim.x, rem = nunits % G;
    int rank = blockIdx.x, nidle = G;
    if (rem != 0) { if ((int)blockIdx.x < rem) return; rank = blockIdx.x - rem; nidle = G - rem; }
    cvt_list(P, lds, lo + rank, nidle, hi, [&](int idx, int& j, int& t) { j = 6 + (idx >> 11); t = layer * 2048 + (idx & 2047); });
}

DI void phase_prep(const Params& P, const Ctx& p, uchar* lds) {
    const int tid = tid_opaque();
    float* tl = (float*)lds;
    {
        float* sc = tl;
        float* red = tl + 3072;
        for (int u = blockIdx.x; u < 192; u += gridDim.x) {
            __syncthreads();
            for (int i = tid; i < 3072; i += 512) { const int mr = i >> 10, d = i & 1023; const float c = mr < 2 ? inp(p, I_C)[mr * 1024 + d] : inp(p, I_CCTX)[d]; sc[i] = c * sigmoidf_(c); }
            __syncthreads();
            const int l = u / 96, nc = u % 96, c4 = tid & 15, dg = tid >> 4;
            const float* w = inp(p, I_ADAW) + (size_t)l * 1024 * 6144 + nc * 64 + c4 * 4;
            f32x4 a0 = (f32x4){0.f, 0.f, 0.f, 0.f}, a1 = a0, a2 = a0;
#pragma unroll 16
            for (int dd = 0; dd < 32; ++dd) {
                const int d = dg * 32 + dd; const f32x4 wv = *(const f32x4*)(w + (size_t)d * 6144);
                const float s0 = sc[d], s1 = sc[1024 + d], s2 = sc[2048 + d];
#pragma unroll
                for (int e = 0; e < 4; ++e) { a0[e] += s0 * wv[e]; a1[e] += s1 * wv[e]; a2[e] += s2 * wv[e]; }
            }
            *(f32x4*)(red + (dg * 3 + 0) * 64 + c4 * 4) = a0; *(f32x4*)(red + (dg * 3 + 1) * 64 + c4 * 4) = a1; *(f32x4*)(red + (dg * 3 + 2) * 64 + c4 * 4) = a2;
            __syncthreads();
            if (tid < 192) {
                const int mr = tid >> 6, nn = tid & 63; float s = 0.f;
#pragma unroll
                for (int g = 0; g < 32; ++g) s += red[(g * 3 + mr) * 64 + nn];
                const int ncol = nc * 64 + nn;
                ((float*)(p.ws + WS_MOD))[(l * 3 + mr) * 6144 + ncol] = s + inp(p, I_ADAB)[l * 6144 + ncol];
            }
        }
        __syncthreads();
    }
    cvt_list(P, lds, blockIdx.x, gridDim.x, P.jobs[1].tile0, [&](int idx, int& j, int& t) {
        j = 0;
#pragma unroll
        for (int q = 1; q < 6; ++q) if (idx >= P.jobs[q].tile0) j = q;
        t = idx - P.jobs[j].tile0; });
    for (int i = blockIdx.x * 512 + tid; i < SEQ * 32; i += gridDim.x * 512) {
        const int t = i >> 5, j = i & 31;
        const double pos = (double)(j < 16 ? (t >> 6) : (t & 63));
        const double inv = pow(10000.0, -(double)(j & 15) / 16.0);
        const double a = pos * inv;
        ((f32x2*)(p.ws + WS_ROPE))[i] = (f32x2){(float)cos(a), (float)sin(a)};
    }
}

DI void load_row16(const float* src, int lane, float (&v)[16]) {
#pragma unroll
    for (int j = 0; j < 4; ++j) { const f32x4 x = *(const f32x4*)(src + j * 256 + lane * 4); v[j * 4 + 0] = x[0]; v[j * 4 + 1] = x[1]; v[j * 4 + 2] = x[2]; v[j * 4 + 3] = x[3]; }
}
DI void norm_mod16(float (&v)[16], const float* g, const float* sh, const float* sc, int lane) {
    float ss = 0.f;
#pragma unroll
    for (int i = 0; i < 16; ++i) ss += v[i] * v[i];
    ss = wave_sum(ss);
    const float rstd = rsqrtf(ss * (1.0f / 1024.0f) + EPS);
#pragma unroll
    for (int j = 0; j < 4; ++j) {
        const int c = j * 256 + lane * 4;
        const f32x4 gg = *(const f32x4*)(g + c), s1 = *(const f32x4*)(sc + c), s0 = *(const f32x4*)(sh + c);
#pragma unroll
        for (int e = 0; e < 4; ++e) v[j * 4 + e] = (v[j * 4 + e] * rstd * gg[e]) * (1.0f + s1[e]) + s0[e];
    }
}
DI void store_row16_bf16(u16* dst, int lane, const float (&v)[16]) {
#pragma unroll
    for (int j = 0; j < 4; ++j) { u32x2 w; w.x = pk2(v[j * 4 + 0], v[j * 4 + 1]); w.y = pk2(v[j * 4 + 2], v[j * 4 + 3]); *(u32x2*)(dst + j * 256 + lane * 4) = w; }
}
DI const float* row_src(const Ctx& p, int layer, int r) {
    if (layer == 0) return r < NL ? inp(p, I_X) + (size_t)r * 1024 : inp(p, I_CTX) + (size_t)(r - NL) * 1024;
    return (const float*)(p.ws + WS_XS) + (size_t)r * 1024;
}
DI void phase_norm(const Ctx& p, int layer) {
    const int tid = tid_opaque(), lane = tid & 63, wv = blockIdx.x * 8 + (tid >> 6), nwv = gridDim.x * 8;
    const float* mod = (const float*)(p.ws + WS_MOD);
    u16* hb = (u16*)(p.ws + WS_HB);
    for (int r = wv; r < R; r += nwv) {
        float v[16];
        load_row16(row_src(p, layer, r), lane, v);
        const float* m = mod + (layer * 3 + mod_row(r)) * 6144;
        norm_mod16(v, inp(p, I_NMIX) + layer * 1024, m, m + 1024, lane);
        store_row16_bf16(hb + (size_t)r * 1024, lane, v);
    }
}
DI void phase_router(const Ctx& p, uchar* lds, int layer, int cnt_slot = -1) {
    const int tid = tid_opaque(), lane = tid & 63, wid = tid >> 6, wv = blockIdx.x * 8 + wid, nwv = gridDim.x * 8;
    const float* mod = (const float*)(p.ws + WS_MOD);
    u16* hb = (u16*)(p.ws + WS_HB);
    const float* xs = (const float*)(p.ws + WS_XS);
    const int nrows = layer == 0 ? R : NL;
    const float* wg = inp(p, I_MWGRP) + layer * 1024 * 4;
    const float* wr = inp(p, I_MWRT) + layer * 1024 * 16;
    const float* gnorm = inp(p, I_NFFN) + layer * 1024;
    int* cnt = (int*)(p.ws + WS_CTL + CTL_CNT) + (cnt_slot >= 0 ? cnt_slot : layer) * 1024;
    int* list = (int*)(p.ws + WS_LIST);
    f32x2* route = (f32x2*)(p.ws + WS_ROUTE);
    float* wrl = (float*)lds;
    float* wgl = wrl + 16384;
    float* hs = (float*)(lds + 81920 + wid * 8192);
    __syncthreads();
#pragma unroll
    for (int i = 0; i < 8; ++i) *(f32x4*)(wrl + (i * 512 + tid) * 4) = *(const f32x4*)(wr + (i * 512 + tid) * 4);
#pragma unroll
    for (int i = 0; i < 2; ++i) *(f32x4*)(wgl + (i * 512 + tid) * 4) = *(const f32x4*)(wg + (i * 512 + tid) * 4);
    __syncthreads();
    float bg[4], br[4];
#pragma unroll
    for (int o = 0; o < 4; ++o) { bg[o] = inp(p, I_MBGRP)[layer * 4 + o]; br[o] = inp(p, I_MBRT)[layer * 16 + (lane & 3) * 4 + o]; }
    for (int r0 = wv * 2; r0 < nrows; r0 += nwv * 2) {
        const float* m = mod + (layer * 3 + mod_row(r0)) * 6144;
        float v0[16], v1[16];
        load_row16(xs + (size_t)r0 * 1024, lane, v0);
        load_row16(xs + (size_t)(r0 + 1) * 1024, lane, v1);
        norm_mod16(v0, gnorm, m + 3 * 1024, m + 4 * 1024, lane);
        norm_mod16(v1, gnorm, m + 3 * 1024, m + 4 * 1024, lane);
        store_row16_bf16(hb + (size_t)r0 * 1024, lane, v0);
        store_row16_bf16(hb + (size_t)(r0 + 1) * 1024, lane, v1);
#pragma unroll
        for (int j = 0; j < 4; ++j) {
            *(f32x4*)(hs + (j * 256 + lane * 4) * 2) = (f32x4){v0[j * 4], v1[j * 4], v0[j * 4 + 1], v1[j * 4 + 1]};
            *(f32x4*)(hs + (j * 256 + lane * 4) * 2 + 4) = (f32x4){v0[j * 4 + 2], v1[j * 4 + 2], v0[j * 4 + 3], v1[j * 4 + 3]};
        }
        float ar[2][4], ag[2][4];
#pragma unroll
        for (int q = 0; q < 2; ++q)
#pragma unroll
            for (int o = 0; o < 4; ++o) { ar[q][o] = 0.f; ag[q][o] = 0.f; }
#pragma unroll 8
        for (int it = 0; it < 64; ++it) {
            const f32x4 w4 = *(const f32x4*)(wrl + (it * 64 + lane) * 4);
            const f32x2 x2 = *(const f32x2*)(hs + (it * 16 + (lane >> 2)) * 2);
#pragma unroll
            for (int o = 0; o < 4; ++o) { ar[0][o] += x2.x * w4[o]; ar[1][o] += x2.y * w4[o]; }
        }
#pragma unroll 8
        for (int it = 0; it < 16; ++it) {
            const f32x4 w4 = *(const f32x4*)(wgl + (it * 64 + lane) * 4);
            const f32x2 x2 = *(const f32x2*)(hs + (it * 64 + lane) * 2);
#pragma unroll
            for (int o = 0; o < 4; ++o) { ag[0][o] += x2.x * w4[o]; ag[1][o] += x2.y * w4[o]; }
        }
#pragma unroll
        for (int q = 0; q < 2; ++q)
#pragma unroll
            for (int o = 0; o < 4; ++o) {
                ag[q][o] = wave_sum(ag[q][o]);
                float v = ar[q][o]; v += __shfl_xor(v, 4); v += __shfl_xor(v, 8); v += __shfl_xor(v, 16); v = xor32_sum(v); ar[q][o] = v;
            }
#pragma unroll
        for (int q = 0; q < 2; ++q) {
            float gl[4];
#pragma unroll
            for (int o = 0; o < 4; ++o) gl[o] = ag[q][o] + bg[o];
            int gi = 0; float gm = gl[0];
#pragma unroll
            for (int o = 1; o < 4; ++o) if (gl[o] > gm) { gm = gl[o]; gi = o; }
            float gs = 0.f;
#pragma unroll
            for (int o = 0; o < 4; ++o) gs += __expf(gl[o] - gm);
            const float psel = 1.0f / gs;
            float el[4];
#pragma unroll
            for (int o = 0; o < 4; ++o) el[o] = __shfl(ar[q][o] + br[o], gi);
            int i1 = 0; float m1 = el[0];
#pragma unroll
            for (int o = 1; o < 4; ++o) if (el[o] > m1) { m1 = el[o]; i1 = o; }
            int i2 = -1; float m2 = -3.0e38f;
#pragma unroll
            for (int o = 0; o < 4; ++o) if (o != i1 && el[o] > m2) { m2 = el[o]; i2 = o; }
            if (lane == 0) {
                const int r = r0 + q;
                const float e2 = __expf(m2 - m1);
                const float w1 = psel / (1.0f + e2), w2 = psel * e2 / (1.0f + e2);
                const int lo = i1 < i2 ? i1 : i2, hi = i1 < i2 ? i2 : i1;
                const float wlo = i1 < i2 ? w1 : w2, whi = i1 < i2 ? w2 : w1;
                const int pi = lo == 0 ? (hi - 1) : (lo == 1 ? (hi + 1) : 5);
                const int bucket = gi * 6 + pi;
                const int pos = atomicAdd(cnt + bucket * 32, 1);
                list[(size_t)bucket * R + pos] = r;
                route[r] = (f32x2){wlo, whi};
            }
        }
    }
}

constexpr int LROW = 144;
constexpr int GEMM_A = 128 * 128, GEMM_B = 256 * 128, GEMM_STAGE = GEMM_A + GEMM_B;
constexpr int EPI_PITCH = 272, EPI_WAVE = 64 * EPI_PITCH;
static_assert(8 * EPI_WAVE <= 3 * GEMM_STAGE, "epilogue strips overlay the GEMM stages");
#define WAIT_V(n) asm volatile("s_waitcnt vmcnt(%0)" ::"n"(n) : "memory")
#define WAIT_L(n) asm volatile("s_waitcnt lgkmcnt(%0)" ::"n"(n) : "memory")
#define RAW_BARRIER() do { WAIT_L(0); __builtin_amdgcn_s_barrier(); } while (0)

template <class Epi>
DI void gemm_tile(uchar* lds, const u16* a0, const u16* a1, const u16* b0, const u16* b1, const u16* b2, const u16* b3, int nk, int ksplit, long bjump, Epi&& epi) {
    const int tid = tid_opaque(), lane = tid & 63, wid = tid >> 6, wr = wid >> 2, wc = wid & 3, l31 = lane & 31, hh = lane >> 5;
    const int lch = (lane & 7) ^ ((((wid & 1) << 3) + (lane >> 3)) >> 1);
    a0 += lch * 8; a1 += lch * 8; b0 += lch * 8; b1 += lch * 8; b2 += lch * 8; b3 += lch * 8;
    const unsigned pw = (unsigned)__builtin_amdgcn_readfirstlane(wid) * 1024u;
    const int sw = (l31 >> 1) & 7;
    unsigned xo[4];
#pragma unroll
    for (int ks = 0; ks < 4; ++ks) xo[ks] = (unsigned)(((ks * 2 + hh) ^ sw) << 4);
    const unsigned aro = (unsigned)((wr * 64 + l31) * 128), bro = (unsigned)(GEMM_A + (wc * 64 + l31) * 128);
    f32x16 acc[2][2];
#pragma unroll
    for (int a = 0; a < 2; ++a)
#pragma unroll
        for (int b = 0; b < 2; ++b)
#pragma unroll
            for (int i = 0; i < 16; ++i) acc[a][b][i] = 0.f;
#define GEMM_DMA(st_, kt_) do { const int kq_ = (kt_); const long bo_ = (long)kq_ * 64 + (kq_ >= ksplit ? bjump : 0); uchar* s_ = lds + (st_) * GEMM_STAGE + pw; \
        __builtin_amdgcn_global_load_lds((const unsigned*)(a0 + kq_ * 64), (LAS unsigned*)(s_), 16, 0, 0); \
        __builtin_amdgcn_global_load_lds((const unsigned*)(a1 + kq_ * 64), (LAS unsigned*)(s_ + 8192), 16, 0, 0); \
        __builtin_amdgcn_global_load_lds((const unsigned*)(b0 + bo_), (LAS unsigned*)(s_ + GEMM_A), 16, 0, 0); \
        __builtin_amdgcn_global_load_lds((const unsigned*)(b1 + bo_), (LAS unsigned*)(s_ + GEMM_A + 8192), 16, 0, 0); \
        __builtin_amdgcn_global_load_lds((const unsigned*)(b2 + bo_), (LAS unsigned*)(s_ + GEMM_A + 16384), 16, 0, 0); \
        __builtin_amdgcn_global_load_lds((const unsigned*)(b3 + bo_), (LAS unsigned*)(s_ + GEMM_A + 24576), 16, 0, 0); } while (0)
    RAW_BARRIER();
    GEMM_DMA(0, 0); GEMM_DMA(1, 1);
    WAIT_V(6);
    RAW_BARRIER();
    int cur = 0;
#pragma unroll 1
    for (int kt = 0; kt < nk; ++kt) {
        const int nxt = cur == 0 ? 2 : cur - 1;
        if (kt + 2 < nk) GEMM_DMA(nxt, kt + 2);
        const uchar* s = lds + cur * GEMM_STAGE;
#pragma unroll
        for (int ks = 0; ks < 4; ++ks) {
            const bf16x8 fa0 = *(const bf16x8*)(s + aro + xo[ks]), fa1 = *(const bf16x8*)(s + aro + 4096 + xo[ks]);
            const bf16x8 fb0 = *(const bf16x8*)(s + bro + xo[ks]), fb1 = *(const bf16x8*)(s + bro + 4096 + xo[ks]);
            acc[0][0] = MFMA32(fb0, fa0, acc[0][0]); acc[0][1] = MFMA32(fb0, fa1, acc[0][1]);
            acc[1][0] = MFMA32(fb1, fa0, acc[1][0]); acc[1][1] = MFMA32(fb1, fa1, acc[1][1]);
        }
        if (kt + 2 < nk) WAIT_V(6); else WAIT_V(0);
        RAW_BARRIER();
        cur = cur == 2 ? 0 : cur + 1;
    }
#if PROBE_GEMM2X == 1
    {
        f32x16 d[2][2];
        for (int a = 0; a < 2; ++a) for (int b = 0; b < 2; ++b) for (int i = 0; i < 16; ++i) d[a][b][i] = 0.f;
        RAW_BARRIER(); GEMM_DMA(0, 0); GEMM_DMA(1, 1); WAIT_V(6); RAW_BARRIER();
        int cur2 = 0;
#pragma unroll 1
        for (int kt = 0; kt < nk; ++kt) {
            const int nxt = cur2 == 0 ? 2 : cur2 - 1;
            if (kt + 2 < nk) GEMM_DMA(nxt, kt + 2);
            const uchar* s = lds + cur2 * GEMM_STAGE;
#pragma unroll
            for (int ks = 0; ks < 4; ++ks) {
                const bf16x8 fa0 = *(const bf16x8*)(s + aro + xo[ks]), fa1 = *(const bf16x8*)(s + aro + 4096 + xo[ks]);
                const bf16x8 fb0 = *(const bf16x8*)(s + bro + xo[ks]), fb1 = *(const bf16x8*)(s + bro + 4096 + xo[ks]);
                d[0][0] = MFMA32(fb0, fa0, d[0][0]); d[0][1] = MFMA32(fb0, fa1, d[0][1]);
                d[1][0] = MFMA32(fb1, fa0, d[1][0]); d[1][1] = MFMA32(fb1, fa1, d[1][1]);
            }
            if (kt + 2 < nk) WAIT_V(6); else WAIT_V(0);
            RAW_BARRIER();
            cur2 = cur2 == 2 ? 0 : cur2 + 1;
        }
        asm volatile("" :: "v"(d[0][0]), "v"(d[0][1]), "v"(d[1][0]), "v"(d[1][1]));
    }
#elif PROBE_GEMM2X == 2
    {
        f32x4 d[4][4];
        for (int a = 0; a < 4; ++a) for (int b = 0; b < 4; ++b) d[a][b] = (f32x4){0.f, 0.f, 0.f, 0.f};
        RAW_BARRIER(); GEMM_DMA(0, 0); GEMM_DMA(1, 1); WAIT_V(6); RAW_BARRIER();
        int cur2 = 0;
#pragma unroll 1
        for (int kt = 0; kt < nk; ++kt) {
            const int nxt = cur2 == 0 ? 2 : cur2 - 1;
            if (kt + 2 < nk) GEMM_DMA(nxt, kt + 2);
            const uchar* s = lds + cur2 * GEMM_STAGE;
#pragma unroll
            for (int kp = 0; kp < 2; ++kp) {
                bf16x8 fa[4], fb[4];
                fa[0] = *(const bf16x8*)(s + aro + xo[2 * kp]); fa[1] = *(const bf16x8*)(s + aro + 4096 + xo[2 * kp]); fa[2] = *(const bf16x8*)(s + aro + xo[2 * kp + 1]); fa[3] = *(const bf16x8*)(s + aro + 4096 + xo[2 * kp + 1]);
                fb[0] = *(const bf16x8*)(s + bro + xo[2 * kp]); fb[1] = *(const bf16x8*)(s + bro + 4096 + xo[2 * kp]); fb[2] = *(const bf16x8*)(s + bro + xo[2 * kp + 1]); fb[3] = *(const bf16x8*)(s + bro + 4096 + xo[2 * kp + 1]);
#pragma unroll
                for (int a = 0; a < 4; ++a)
#pragma unroll
                    for (int b = 0; b < 4; ++b) d[a][b] = __builtin_amdgcn_mfma_f32_16x16x32_bf16(fb[b], fa[a], d[a][b], 0, 0, 0);
            }
            if (kt + 2 < nk) WAIT_V(6); else WAIT_V(0);
            RAW_BARRIER();
            cur2 = cur2 == 2 ? 0 : cur2 + 1;
        }
        asm volatile("" :: "v"(d[0][0]), "v"(d[0][1]), "v"(d[0][2]), "v"(d[0][3]), "v"(d[1][0]), "v"(d[1][1]), "v"(d[1][2]), "v"(d[1][3]));
        asm volatile("" :: "v"(d[2][0]), "v"(d[2][1]), "v"(d[2][2]), "v"(d[2][3]), "v"(d[3][0]), "v"(d[3][1]), "v"(d[3][2]), "v"(d[3][3]));
    }
#endif
    epi(acc, wr * 64, wc, lane, lds + wid * EPI_WAVE);
}

constexpr int G2_A = 256 * 64, G2_STAGE = 2 * G2_A;
template <class Epi>
DI void gemm_tile256(uchar* lds, const u16* a0, const u16* a1, const u16* b0, const u16* b1, int nk, int ksplit, long bjump, Epi&& epi) {
    const int tid = tid_opaque(), lane = tid & 63, wid = tid >> 6, wr = wid >> 2, wc = wid & 3, l31 = lane & 31, hh = lane >> 5;
    const int lch = (lane & 3) ^ ((lane >> 4) & 3);
    a0 += lch * 8; a1 += lch * 8; b0 += lch * 8; b1 += lch * 8;
    const unsigned pw = (unsigned)__builtin_amdgcn_readfirstlane(wid) * 1024u;
    const int sw = (l31 >> 2) & 3;
    const unsigned xo0 = (unsigned)(((0 + hh) ^ sw) << 4), xo1 = (unsigned)(((2 + hh) ^ sw) << 4);
    const unsigned aro = (unsigned)((wr * 128 + l31) * 64), bro = (unsigned)(G2_A + (wc * 64 + l31) * 64);
    f32x16 acc[2][4];
#pragma unroll
    for (int a = 0; a < 2; ++a)
#pragma unroll
        for (int b = 0; b < 4; ++b)
#pragma unroll
            for (int i = 0; i < 16; ++i) acc[a][b][i] = 0.f;
#define G2_DMA(st_, kt_) do { const int kq_ = (kt_); const long bo_ = (long)kq_ * 32 + (kq_ >= ksplit ? bjump : 0); uchar* s_ = lds + (st_) * G2_STAGE + pw; \
        __builtin_amdgcn_global_load_lds((const unsigned*)(a0 + kq_ * 32), (LAS unsigned*)(s_), 16, 0, 0); \
        __builtin_amdgcn_global_load_lds((const unsigned*)(a1 + kq_ * 32), (LAS unsigned*)(s_ + 8192), 16, 0, 0); \
        __builtin_amdgcn_global_load_lds((const unsigned*)(b0 + bo_), (LAS unsigned*)(s_ + G2_A), 16, 0, 0); \
        __builtin_amdgcn_global_load_lds((const unsigned*)(b1 + bo_), (LAS unsigned*)(s_ + G2_A + 8192), 16, 0, 0); } while (0)
    RAW_BARRIER();
    G2_DMA(0, 0); G2_DMA(1, 1); G2_DMA(2, 2);
    WAIT_V(8);
    RAW_BARRIER();
#pragma unroll 1
    for (int kt = 0; kt < nk; ++kt) {
        if (kt + 3 < nk) G2_DMA((kt + 3) & 3, kt + 3);
        const uchar* s = lds + (kt & 3) * G2_STAGE;
#pragma unroll
        for (int ks = 0; ks < 2; ++ks) {
            const unsigned xo = ks ? xo1 : xo0;
            bf16x8 fa[4], fb[2];
#pragma unroll
            for (int mb = 0; mb < 4; ++mb) fa[mb] = *(const bf16x8*)(s + aro + mb * 2048 + xo);
#pragma unroll
            for (int nb = 0; nb < 2; ++nb) fb[nb] = *(const bf16x8*)(s + bro + nb * 2048 + xo);
#pragma unroll
            for (int nb = 0; nb < 2; ++nb)
#pragma unroll
                for (int mb = 0; mb < 4; ++mb) acc[nb][mb] = MFMA32(fb[nb], fa[mb], acc[nb][mb]);
        }
        if (kt + 3 < nk) WAIT_V(8); else if (kt + 2 < nk) WAIT_V(4); else WAIT_V(0);
        RAW_BARRIER();
    }
#pragma unroll
    for (int half = 0; half < 2; ++half) {
        f32x16 t[2][2];
#pragma unroll
        for (int nb = 0; nb < 2; ++nb)
#pragma unroll
            for (int mb = 0; mb < 2; ++mb) t[nb][mb] = acc[nb][2 * half + mb];
        epi(t, wr * 128 + half * 64, wc, lane, lds + wid * EPI_WAVE);
    }
}

DI void epi_put4(uchar* w, int row, int col, float a, float b, float c, float d) { *(f32x4*)(w + row * EPI_PITCH + col * 4) = (f32x4){a, b, c, d}; }
DI void epi_stage(uchar* w, const f32x16 (&acc)[2][2], int l31, int hh) {
#pragma unroll
    for (int mb = 0; mb < 2; ++mb)
#pragma unroll
        for (int nb = 0; nb < 2; ++nb)
#pragma unroll
            for (int g = 0; g < 4; ++g) epi_put4(w, mb * 32 + l31, nb * 32 + 8 * g + 4 * hh, acc[nb][mb][4 * g], acc[nb][mb][4 * g + 1], acc[nb][mb][4 * g + 2], acc[nb][mb][4 * g + 3]);
}
template <class F> DI void epi_rows4(const uchar* w, int lane, F&& f) {
#pragma unroll
    for (int it = 0; it < 16; ++it) { const int row = it * 4 + (lane >> 4), col = (lane & 15) * 4; f(row, col, *(const f32x4*)(w + row * EPI_PITCH + col * 4)); }
}
template <int NC, class F> DI void epi_rows8(const uchar* w, int lane, F&& f) {
    constexpr int LPR = NC / 8, RPI = 64 / LPR;
#pragma unroll
    for (int it = 0; it < 64 / RPI; ++it) { const int row = it * RPI + lane / LPR, col = (lane % LPR) * 8; f(row, col, *(const f32x4*)(w + row * EPI_PITCH + col * 4), *(const f32x4*)(w + row * EPI_PITCH + col * 4 + 16)); }
}
DI u32x4 pack8(const f32x4& a, const f32x4& b) { u32x4 r; r.x = pk2(a[0], a[1]); r.y = pk2(a[2], a[3]); r.z = pk2(b[0], b[1]); r.w = pk2(b[2], b[3]); return r; }

#define MFMA16(a, b, c) __builtin_amdgcn_mfma_f32_16x16x32_bf16((a), (b), (c), 0, 0, 0)
constexpr int P8_HT = 16384;
DI void p8_rc(int tid, int& r0, int& c) { const int wid = tid >> 6, lane = tid & 63; r0 = (wid >> 1) * 16 + (lane >> 2); c = (wid & 1) * 32 + (((lane & 3) ^ ((lane >> 5) << 1)) << 3); }
DI void glds16(const uchar* g, uchar* s) { __builtin_amdgcn_global_load_lds((const unsigned*)g, (LAS unsigned*)s, 16, 0, 0); }
template <class Epi>
DI void gemm_tile8p(uchar* lds, const uchar* abase, unsigned a0_0, unsigned a1_0, unsigned a0_1, unsigned a1_1, int ac1_0, int ac0_1, int ac1_1,
                    const uchar* bbase, unsigned bo, int bc1_0, int bc0_1, int bc1_1, int nk, int ksplit, long bjump, Epi&& epi) {
    constexpr int ac0_0 = 0, bc0_0 = 0;
    const int tid = tid_opaque(), lane = tid & 63, wid = tid >> 6, wr = wid >> 2, wc = wid & 3, fr = lane & 15, fq = lane >> 4;
    const unsigned pw = (unsigned)__builtin_amdgcn_readfirstlane(wid) * 1024u;
    const unsigned lp = (unsigned)((fr * 64 + fq * 16) ^ ((fr >> 3) << 5));
    const unsigned la = (unsigned)wr * 8192u + lp, lb = (unsigned)wc * 4096u + lp;
    f32x4 acc[2][2][4][2];
#pragma unroll
    for (int a = 0; a < 2; ++a)
#pragma unroll
        for (int b = 0; b < 2; ++b)
#pragma unroll
            for (int m = 0; m < 4; ++m)
#pragma unroll
                for (int n = 0; n < 2; ++n) acc[a][b][m][n] = (f32x4){0.f, 0.f, 0.f, 0.f};
    bf16x8 At[4][2], B0[2][2], B1[2][2];
#define P8_SA(b, h) (((b) * 2 + (h)) * P8_HT)
#define P8_SB(b, h) ((4 + (b) * 2 + (h)) * P8_HT)
#define P8_STAGE_A(b, h, kt) do { const uchar* g_ = abase + (size_t)(kt) * 128; uchar* s_ = lds + P8_SA(b, h) + pw; glds16(g_ + ac0_##h + a0_##h, s_); glds16(g_ + ac1_##h + a1_##h, s_ + 8192); } while (0)
#define P8_STAGE_B(b, h, kt) do { const int kq_ = (kt); const uchar* g_ = bbase + (size_t)kq_ * 128 + (kq_ >= ksplit ? bjump : 0); uchar* s_ = lds + P8_SB(b, h) + pw; glds16(g_ + bc0_##h + bo, s_); glds16(g_ + bc1_##h + bo, s_ + 8192); } while (0)
#define P8_LDA(dst, b, h) do { _Pragma("unroll") for (int m = 0; m < 4; ++m) { _Pragma("unroll") for (int k = 0; k < 2; ++k) dst[m][k] = *(const bf16x8*)(lds + P8_SA(b, h) + la + (m * 2 + k) * 1024); } } while (0)
#define P8_LDB(dst, b, h) do { _Pragma("unroll") for (int n = 0; n < 2; ++n) { _Pragma("unroll") for (int k = 0; k < 2; ++k) dst[n][k] = *(const bf16x8*)(lds + P8_SB(b, h) + lb + (n * 2 + k) * 1024); } } while (0)
#define P8_MMA(ai, bj, Bx) do { __builtin_amdgcn_s_setprio(1); \
        _Pragma("unroll") for (int m = 0; m < 4; ++m) { _Pragma("unroll") for (int n = 0; n < 2; ++n) { _Pragma("unroll") for (int k = 0; k < 2; ++k) acc[ai][bj][m][n] = MFMA16(Bx[n][k], At[m][k], acc[ai][bj][m][n]); } } \
        __builtin_amdgcn_s_setprio(0); } while (0)
#define P8_BAR() __builtin_amdgcn_s_barrier()
#define P8_SCHED() __builtin_amdgcn_sched_barrier(0)
    RAW_BARRIER();
    P8_STAGE_B(0, 0, 0); P8_STAGE_A(0, 0, 0); P8_STAGE_B(0, 1, 0); P8_STAGE_A(0, 1, 0);
    if (wr == 1) P8_BAR();
    WAIT_V(4); P8_BAR();
    P8_STAGE_B(1, 0, 1); P8_STAGE_A(1, 0, 1); P8_STAGE_B(1, 1, 1);
    WAIT_V(6); P8_BAR();
#pragma unroll 1
    for (int t = 0; t < nk - 2; t += 2) {
        P8_LDB(B0, 0, 0); P8_SCHED(); P8_LDA(At, 0, 0); P8_STAGE_A(1, 1, t + 1);
        WAIT_L(8); P8_BAR(); WAIT_L(0); P8_MMA(0, 0, B0); P8_BAR(); P8_SCHED();
        P8_LDB(B1, 0, 1); P8_STAGE_B(0, 0, t + 2);
        P8_BAR(); WAIT_L(0); P8_MMA(0, 1, B1); P8_BAR();
        P8_LDA(At, 0, 1); P8_STAGE_A(0, 0, t + 2);
        P8_BAR(); WAIT_L(0); P8_MMA(1, 0, B0); P8_BAR(); P8_SCHED();
        P8_STAGE_B(0, 1, t + 2);
        WAIT_V(6); P8_BAR(); P8_MMA(1, 1, B1); P8_BAR();
        P8_LDB(B0, 1, 0); P8_SCHED(); P8_LDA(At, 1, 0); P8_STAGE_A(0, 1, t + 2);
        WAIT_L(8); P8_BAR(); WAIT_L(0); P8_MMA(0, 0, B0); P8_BAR(); P8_SCHED();
        P8_LDB(B1, 1, 1); P8_STAGE_B(1, 0, t + 3);
        P8_BAR(); WAIT_L(0); P8_MMA(0, 1, B1); P8_BAR();
        P8_LDA(At, 1, 1); P8_STAGE_A(1, 0, t + 3);
        P8_BAR(); WAIT_L(0); P8_MMA(1, 0, B0); P8_BAR(); P8_SCHED();
        P8_STAGE_B(1, 1, t + 3);
        WAIT_V(6); P8_BAR(); P8_MMA(1, 1, B1); P8_BAR();
    }
    {
        P8_LDB(B0, 0, 0); P8_LDA(At, 0, 0); P8_STAGE_A(1, 1, nk - 1);
        P8_BAR(); WAIT_L(0); P8_MMA(0, 0, B0); P8_BAR();
        P8_LDB(B1, 0, 1); P8_BAR(); WAIT_L(0); P8_MMA(0, 1, B1); P8_BAR();
        P8_LDA(At, 0, 1); WAIT_V(4); P8_BAR(); WAIT_L(0); P8_MMA(1, 0, B0); P8_MMA(1, 1, B1); P8_BAR();
    }
    {
        P8_LDB(B0, 1, 0); P8_LDA(At, 1, 0); WAIT_V(2); P8_BAR(); WAIT_L(0); P8_MMA(0, 0, B0); P8_BAR();
        P8_LDB(B1, 1, 1); WAIT_V(0); P8_BAR(); WAIT_L(0); P8_MMA(0, 1, B1); P8_BAR();
        P8_LDA(At, 1, 1); P8_BAR(); WAIT_L(0); P8_MMA(1, 0, B0); P8_MMA(1, 1, B1); P8_BAR();
    }
    if (wr == 0) P8_BAR();
    RAW_BARRIER();
    uchar* w = lds + wid * EPI_WAVE;
#pragma unroll
    for (int ai = 0; ai < 2; ++ai) {
#pragma unroll
        for (int bj = 0; bj < 2; ++bj)
#pragma unroll
            for (int m = 0; m < 4; ++m)
#pragma unroll
                for (int n = 0; n < 2; ++n) *(f32x4*)(w + (m * 16 + fr) * EPI_PITCH + (bj * 32 + n * 16 + fq * 4) * 4) = acc[ai][bj][m][n];
        epi(wr * 128 + ai * 64, wc, lane, w);
    }
}
DI void epi_unstage(const uchar* w, f32x16 (&t)[2][2], int l31, int hh) {
#pragma unroll
    for (int mb = 0; mb < 2; ++mb)
#pragma unroll
        for (int nb = 0; nb < 2; ++nb)
#pragma unroll
            for (int g = 0; g < 4; ++g) { const f32x4 v = *(const f32x4*)(w + (mb * 32 + l31) * EPI_PITCH + (nb * 32 + 8 * g + 4 * hh) * 4); t[nb][mb][4 * g] = v[0]; t[nb][mb][4 * g + 1] = v[1]; t[nb][mb][4 * g + 2] = v[2]; t[nb][mb][4 * g + 3] = v[3]; }
}

DI void rect_unit(int v, int MT, int NT, int& mt, int& nt) {
    if (gridDim.x != 256) { mt = v / NT; nt = v % NT; return; }
    const int r = v >> 8, b = v & 255, x = b & 7, y = b >> 3;
    const int q = r * 8 + x, nqn = NT >> 2, qm = q / nqn, qn = q - qm * nqn;
    mt = qm * 8 + (y & 7); nt = qn * 4 + (y >> 3);
}
DI void phase_inproj0(const Params& P, const Ctx& p, uchar* lds) {
    const int tid = tid_opaque();
    const u16* hb = (const u16*)(p.ws + WS_HB);
    const u16* w = (const u16*)(p.ws + WS_WIN0);
    u16* zc = (u16*)(p.ws + WS_REGA + RA_ZC);
    u16* qa = (u16*)(p.ws + WS_REGA + RA_Q);
    u16* ka = (u16*)(p.ws + WS_REGA + RA_K);
    u16* vt = (u16*)(p.ws + WS_REGA + RA_VT);
    const f32x2* rope = (const f32x2*)(p.ws + WS_ROPE);
    const int rs = tid >> 3;
    for (int u = blockIdx.x; u < 768 + 48; u += gridDim.x) {
        const bool big = u < 768;
        int mt, nt; if (big) rect_unit(u, 64, 12, mt, nt); else { mt = (u - 768) / 12; nt = (u - 768) % 12; }
        const int m0 = big ? mt * 256 : NL + mt * 128, n0 = nt * 256;
        auto epi =
            [&](f32x16 (&acc)[2][2], int roff, int wc, int lane, uchar* w) {
                const int l31 = lane & 31, hh = lane >> 5, nw = n0 + wc * 64;
                const int row0 = m0 + roff;
                int b, spos0; if (row0 < NL) { b = row0 >> 13; spos0 = row0 & 8191; } else { b = (row0 - NL) >> 8; spos0 = SEQ + ((row0 - NL) & 255); }
                if (nw < 1536) {
                    epi_stage(w, acc, l31, hh);
                    epi_rows8<64>(w, lane, [&](int row, int col, const f32x4& v0, const f32x4& v1) { *(u32x4*)(zc + (size_t)(row0 + row) * 1536 + nw + col) = pack8(v0, v1); });
                } else if (nw < 2560) {
                    const bool isq = nw < 2048;
                    const int cg = (nw - (isq ? 1536 : 2048)) >> 6, head = cg >> 1, map = cg & 1;
                    const float* gain = isq ? inp(p, I_QN) : inp(p, I_KN);
                    const float osc = isq ? QSCALE : 1.0f;
#pragma unroll
                    for (int mb = 0; mb < 2; ++mb) {
                        float ss = 0.f;
#pragma unroll
                        for (int nb = 0; nb < 2; ++nb)
#pragma unroll
                            for (int i = 0; i < 16; ++i) ss += acc[nb][mb][i] * acc[nb][mb][i];
                        ss = xor32_sum(ss);
                        const float rstd = rsqrtf(ss * (1.0f / 64.0f) + EPS);
                        const int spos = spos0 + mb * 32 + l31;
#pragma unroll
                        for (int g = 0; g < 4; ++g) {
                            const int d0 = 8 * g + 4 * hh;
                            const f32x4 g1v = *(const f32x4*)(gain + d0), g2v = *(const f32x4*)(gain + 32 + d0);
                            f32x4 csa = (f32x4){1.f, 0.f, 1.f, 0.f}, csb = csa;
                            if (row0 < NL) { csa = *(const f32x4*)((const float*)(rope + spos * 32 + d0)); csb = *(const f32x4*)((const float*)(rope + spos * 32 + d0 + 2)); }
                            float o1[4], o2[4];
#pragma unroll
                            for (int e = 0; e < 4; ++e) {
                                const float v1 = acc[0][mb][4 * g + e] * rstd * g1v[e], v2 = acc[1][mb][4 * g + e] * rstd * g2v[e];
                                const float cs = e < 2 ? csa[2 * e] : csb[2 * (e - 2)], sn = e < 2 ? csa[2 * e + 1] : csb[2 * (e - 2) + 1];
                                o1[e] = (v1 * cs - v2 * sn) * osc; o2[e] = (v2 * cs + v1 * sn) * osc;
                            }
                            epi_put4(w, mb * 32 + l31, d0, o1[0], o1[1], o1[2], o1[3]);
                            epi_put4(w, mb * 32 + l31, 32 + d0, o2[0], o2[1], o2[2], o2[3]);
                        }
                    }
                    u16* dst = (isq ? qa : ka) + ((size_t)(((b * 4 + head) * 2 + map)) * SK + spos0) * 64;
                    epi_rows8<64>(w, lane, [&](int row, int col, const f32x4& v0, const f32x4& v1) { *(u32x4*)(dst + (size_t)row * 64 + col) = pack8(v0, v1); });
                } else {
                    const int head = (nw - 2560) >> 7, vb0 = (nw - 2560) & 127;
#pragma unroll
                    for (int mb = 0; mb < 2; ++mb) {
                        const int tok = mb * 32 + l31, tp = (tok & ~12) | (((tok >> 3) & 1) << 2) | (((tok >> 2) & 1) << 3);
#pragma unroll
                        for (int nb = 0; nb < 2; ++nb)
#pragma unroll
                            for (int i = 0; i < 16; ++i) *(u16*)(w + (nb * 32 + crow(i, hh)) * 144 + tp * 2) = f2b(acc[nb][mb][i]);
                    }
                    u16* dst = vt + ((size_t)(b * 4 + head) * 128 + vb0) * SK + spos0;
#pragma unroll
                    for (int it = 0; it < 8; ++it) { const int v = it * 8 + (lane >> 3), c8 = lane & 7; *(u32x4*)(dst + (size_t)v * SK + c8 * 8) = *(const u32x4*)(w + v * 144 + c8 * 16); }
                }
            };
        if (big) {
            int r0, c; p8_rc(tid, r0, c);
            const unsigned ao = (unsigned)(r0 * 2048 + c * 2), bo = (unsigned)((((r0 >> 5) * 64 + (r0 & 31)) * 2048) + c * 2);
            gemm_tile8p(lds, (const uchar*)(hb + (size_t)m0 * 1024), ao, ao, ao, ao, 128 * 2048, 64 * 2048, 192 * 2048,
                        (const uchar*)(w + (size_t)n0 * 1024), bo, 128 * 2048, 32 * 2048, 160 * 2048, 16, 1 << 30, 0,
                        [&](int roff, int wc, int lane, uchar* w) {
                            const int nw = n0 + wc * 64;
                            if (nw < 1536) { const int row0 = m0 + roff; epi_rows8<64>(w, lane, [&](int row, int col, const f32x4& v0, const f32x4& v1) { *(u32x4*)(zc + (size_t)(row0 + row) * 1536 + nw + col) = pack8(v0, v1); }); }
                            else { f32x16 t[2][2]; epi_unstage(w, t, lane & 31, lane >> 5); epi(t, roff, wc, lane, w); } });
        } else {
            const u16* ab = hb + (size_t)(m0 + rs) * 1024;
            const u16* bb = w + (size_t)(n0 + rs) * 1024;
            gemm_tile(lds, ab, ab + 64 * 1024, bb, bb + 64 * 1024, bb + 128 * 1024, bb + 192 * 1024, 16, 1 << 30, 0, epi);
        }
    }
    tail_cvt_moe(P, lds, 768 + 48, 0, 0, MOE_CVT_TILES / 2);
    tail_cvt_dense(P, lds, 768 + 48, P.jobs[1].tile0, P.jobs[2].tile0);
}

constexpr int ATT_K = 64 * 128, ATT_V = 128 * 128;
constexpr int ATT_STAGE = 2 * ATT_K + ATT_V;
DI void attn_unit(const Ctx& p, uchar* lds, int bh, int q0, int key0, int ntile, int out_row0) {
    const int tid = tid_opaque();
    const int lane = tid & 63, wid = tid >> 6, l31 = lane & 31, hh = lane >> 5, m = wid >> 2, g = wid & 3;
    const u16* qa = (const u16*)(p.ws + WS_REGA + RA_Q);
    const u16* ka = (const u16*)(p.ws + WS_REGA + RA_K);
    const u16* vt = (const u16*)(p.ws + WS_REGA + RA_VT);
    uchar* qs = lds + 2 * ATT_STAGE + wid * 8192 + lane * 16;
    RAW_BARRIER();
    {
        const u16* qp = qa + ((size_t)(bh * 2 + m) * SK + q0 + g * 64 + l31) * 64 + hh * 8;
#pragma unroll
        for (int rg = 0; rg < 2; ++rg)
#pragma unroll
            for (int ks = 0; ks < 4; ++ks) *(bf16x8*)(qs + (rg * 4 + ks) * 1024) = *(const bf16x8*)(qp + rg * 32 * 64 + ks * 16);
    }
    const int lch = (lane & 7) ^ ((((wid & 1) << 3) + (lane >> 3)) >> 1);
    const u16* kp = ka + ((size_t)(bh * 2) * SK + key0 + wid * 8 + (lane >> 3)) * 64 + lch * 8;
    const u16* vp = vt + ((size_t)bh * 128 + wid * 8 + (lane >> 3)) * SK + key0 + lch * 8;
    const unsigned pw = (unsigned)__builtin_amdgcn_readfirstlane(wid) * 1024u;
    const int sw = (l31 >> 1) & 7;
    unsigned xo[4];
#pragma unroll
    for (int ks = 0; ks < 4; ++ks) xo[ks] = (unsigned)(((ks * 2 + hh) ^ sw) << 4);
    const unsigned kro = (unsigned)(m * ATT_K + l31 * 128), vro = (unsigned)(2 * ATT_K + l31 * 128);
    f32x16 O[2][4];
#pragma unroll
    for (int rg = 0; rg < 2; ++rg)
#pragma unroll
        for (int vb = 0; vb < 4; ++vb)
#pragma unroll
            for (int i = 0; i < 16; ++i) O[rg][vb][i] = 0.f;
    float lsum0 = 0.f, lsum1 = 0.f;
#define ATT_DMA(st_, t_) do { const int tq_ = (t_); uchar* s_ = lds + (st_) * ATT_STAGE + pw; \
        __builtin_amdgcn_global_load_lds((const unsigned*)(kp + (size_t)tq_ * 4096), (LAS unsigned*)(s_), 16, 0, 0); \
        __builtin_amdgcn_global_load_lds((const unsigned*)(kp + (size_t)SK * 64 + (size_t)tq_ * 4096), (LAS unsigned*)(s_ + ATT_K), 16, 0, 0); \
        __builtin_amdgcn_global_load_lds((const unsigned*)(vp + tq_ * 64), (LAS unsigned*)(s_ + 2 * ATT_K), 16, 0, 0); \
        __builtin_amdgcn_global_load_lds((const unsigned*)(vp + (size_t)64 * SK + tq_ * 64), (LAS unsigned*)(s_ + 2 * ATT_K + 8192), 16, 0, 0); } while (0)
    ATT_DMA(0, 0);
    WAIT_V(0);
    RAW_BARRIER();
#pragma unroll 1
    for (int t = 0; t < ntile; ++t) {
        if (t + 1 < ntile) ATT_DMA((t + 1) & 1, t + 1);
        const uchar* s = lds + (t & 1) * ATT_STAGE;
#pragma unroll 1
        for (int kb = 0; kb < 2; ++kb) {
            bf16x8 P[2][2];
#pragma unroll
            for (int rg = 0; rg < 2; ++rg) {
                f32x16 S;
#pragma unroll
                for (int i = 0; i < 16; ++i) S[i] = 0.f;
#pragma unroll
                for (int ks = 0; ks < 4; ++ks) { const bf16x8 kf = *(const bf16x8*)(s + kro + kb * 4096 + xo[ks]); const bf16x8 q = *(const bf16x8*)(qs + (rg * 4 + ks) * 1024); S = MFMA32(kf, q, S); }
                float ls = 0.f;
#pragma unroll
                for (int i = 0; i < 16; ++i) { S[i] = __builtin_amdgcn_exp2f(S[i]); ls += S[i]; }
                if (rg == 0) lsum0 += ls; else lsum1 += ls;
#pragma unroll
                for (int s2 = 0; s2 < 2; ++s2) {
                    u32x4 pw4; pw4.x = pk2(S[8 * s2], S[8 * s2 + 1]); pw4.y = pk2(S[8 * s2 + 2], S[8 * s2 + 3]); pw4.z = pk2(S[8 * s2 + 4], S[8 * s2 + 5]); pw4.w = pk2(S[8 * s2 + 6], S[8 * s2 + 7]);
                    P[rg][s2] = __builtin_bit_cast(bf16x8, pw4);
                }
            }
#pragma unroll
            for (int s2 = 0; s2 < 2; ++s2)
#pragma unroll
                for (int vb = 0; vb < 4; ++vb) {
                    const bf16x8 vf = *(const bf16x8*)(s + vro + vb * 4096 + (unsigned)(((4 * kb + 2 * s2 + hh) ^ sw) << 4));
                    O[0][vb] = MFMA32(vf, P[0][s2], O[0][vb]); O[1][vb] = MFMA32(vf, P[1][s2], O[1][vb]);
                }
        }
        WAIT_V(0);
        RAW_BARRIER();
    }
    lsum0 = xor32_sum(lsum0); lsum1 = xor32_sum(lsum1);
    const int tid2 = tid_opaque(), lane2 = tid2 & 63, wid2 = tid2 >> 6, e_l31 = lane2 & 31, e_hh = lane2 >> 5, e_m = wid2 >> 2, e_g = wid2 & 3;
    float lam;
    { float d1 = inp(p, I_LQ1)[lane2] * inp(p, I_LK1)[lane2], d2 = inp(p, I_LQ2)[lane2] * inp(p, I_LK2)[lane2]; d1 = wave_sum(d1); d2 = wave_sum(d2); lam = fexp(d1) - fexp(d2) + LAM_INIT0; }
    float* comb = (float*)lds + (size_t)e_g * 8192 + lane2;
    if (e_m == 1) {
#pragma unroll
        for (int rg = 0; rg < 2; ++rg) {
            const float sc = lam / (rg ? lsum1 : lsum0);
#pragma unroll
            for (int vb = 0; vb < 4; ++vb) {
#pragma unroll
                for (int i = 0; i < 16; ++i) comb[((rg * 4 + vb) * 16 + i) * 64] = O[rg][vb][i] * sc;
                __builtin_amdgcn_sched_barrier(0);
            }
        }
    }
    RAW_BARRIER();
    if (e_m == 0) {
        const float* snl = (const float*)(lds + 131072);
        const int h = bh & 3;
#pragma unroll
        for (int rg = 0; rg < 2; ++rg) {
            const float i0 = 1.0f / (rg ? lsum1 : lsum0);
            float ss = 0.f;
#pragma unroll
            for (int vb = 0; vb < 4; ++vb) {
#pragma unroll
                for (int i = 0; i < 16; ++i) { const float o = O[rg][vb][i] * i0 - comb[((rg * 4 + vb) * 16 + i) * 64]; O[rg][vb][i] = o; ss += o * o; }
                __builtin_amdgcn_sched_barrier(0);
            }
            ss = xor32_sum(ss);
            const float rstd = rsqrtf(ss * (1.0f / 128.0f) + EPS) * (1.0f - LAM_INIT0);
            u16* dst = (u16*)(p.ws + WS_HB) + (size_t)(out_row0 + e_g * 64 + rg * 32 + e_l31) * 1024 + 512 + h * 128;
#pragma unroll
            for (int vb = 0; vb < 4; ++vb)
#pragma unroll
                for (int gq = 0; gq < 4; ++gq) {
                    const int v0 = vb * 32 + 8 * gq + 4 * e_hh;
                    const f32x4 gn = *(const f32x4*)(snl + v0);
                    u32x2 w; w.x = pk2(O[rg][vb][4 * gq] * rstd * gn[0], O[rg][vb][4 * gq + 1] * rstd * gn[1]); w.y = pk2(O[rg][vb][4 * gq + 2] * rstd * gn[2], O[rg][vb][4 * gq + 3] * rstd * gn[3]);
                    *(u32x2*)(dst + v0) = w;
                }
        }
    }
}
DI void phase_attn(const Ctx& p, uchar* lds) {
    const int tid = tid_opaque();
    if (tid < 128) ((float*)(lds + 131072))[tid] = inp(p, I_SUBN)[tid];
    for (int u = blockIdx.x; u < 264; u += gridDim.x) {
        const bool lat = u < 256;
        const int bh = u & 7, qb = u >> 3;
        attn_unit(p, lds, bh, lat ? qb * 256 : SEQ, lat ? 0 : SEQ, lat ? 132 : 4, lat ? (bh >> 2) * SEQ + qb * 256 : NL + (bh >> 2) * CTXL);
    }
    {
        const u16* zc = (const u16*)(p.ws + WS_REGA + RA_ZC);
        u16* hb = (u16*)(p.ws + WS_HB);
        const int tid2 = tid_opaque(), lane = tid2 & 63, wid = tid2 >> 6, c8 = lane * 8;
        float w0[8], w1[8], w2[8], bias[8];
        {
            const float* cw = inp(p, I_EVCW) + c8; const float* cb = inp(p, I_EVCB) + c8;
#pragma unroll
            for (int h = 0; h < 2; ++h) {
                const f32x4 a = *(const f32x4*)(cw + 4 * h), b = *(const f32x4*)(cw + 512 + 4 * h), c = *(const f32x4*)(cw + 1024 + 4 * h), d = *(const f32x4*)(cb + 4 * h);
#pragma unroll
                for (int e = 0; e < 4; ++e) { w0[4 * h + e] = a[e]; w1[4 * h + e] = b[e]; w2[4 * h + e] = c[e]; bias[4 * h + e] = d[e]; }
            }
        }
        auto unpack8 = [](const u32x4& v, float (&f)[8]) { f[0] = blo(v.x); f[1] = bhi(v.x); f[2] = blo(v.y); f[3] = bhi(v.y); f[4] = blo(v.z); f[5] = bhi(v.z); f[6] = blo(v.w); f[7] = bhi(v.w); };
        for (int u = blockIdx.x; u < 256; u += gridDim.x) {
            const int rb = u * 66 + wid * 9, nr = wid < 7 ? 9 : 3;
            u32x4 cc[11], cx[11], cg[9];
#pragma unroll
            for (int j = 0; j < 11; ++j) {
                int row = rb - 1 + j; row = row < 0 ? 0 : (row >= R ? R - 1 : row);
                cc[j] = *(const u32x4*)(zc + (size_t)row * 1536 + 512 + c8); cx[j] = *(const u32x4*)(zc + (size_t)row * 1536 + 1024 + c8);
            }
#pragma unroll
            for (int i = 0; i < 9; ++i) { const int row = rb + i < R ? rb + i : R - 1; cg[i] = *(const u32x4*)(zc + (size_t)row * 1536 + c8); }
            float pm[8], pc[8], pn[8];
            { float a[8], b[8]; unpack8(cc[0], a); unpack8(cx[0], b);
#pragma unroll
              for (int e = 0; e < 8; ++e) pm[e] = a[e] * b[e];
              unpack8(cc[1], a); unpack8(cx[1], b);
#pragma unroll
              for (int e = 0; e < 8; ++e) pc[e] = a[e] * b[e]; }
#pragma unroll
            for (int i = 0; i < 9; ++i) {
                { float a[8], b[8]; unpack8(cc[i + 2], a); unpack8(cx[i + 2], b);
#pragma unroll
                  for (int e = 0; e < 8; ++e) pn[e] = a[e] * b[e]; }
                const int r = rb + i;
                const bool first = r < NL ? (r & 8191) == 0 : ((r - NL) & 255) == 0, last = r < NL ? (r & 8191) == 8191 : ((r - NL) & 255) == 255;
                if (i < nr) {
                    float g[8], o[8]; unpack8(cg[i], g);
#pragma unroll
                    for (int e = 0; e < 8; ++e) o[e] = g[e] * (bias[e] + w0[e] * (first ? 0.f : pm[e]) + w1[e] * pc[e] + w2[e] * (last ? 0.f : pn[e]));
                    u32x4 wv; wv.x = pk2(o[0], o[1]); wv.y = pk2(o[2], o[3]); wv.z = pk2(o[4], o[5]); wv.w = pk2(o[6], o[7]);
                    *(u32x4*)(hb + (size_t)r * 1024 + c8) = wv;
                }
#pragma unroll
                for (int e = 0; e < 8; ++e) { pm[e] = pc[e]; pc[e] = pn[e]; }
            }
        }
    }
}

DI void phase_outproj(const Params& P, const Ctx& p, uchar* lds, int layer) {
    const int tid = tid_opaque();
    const u16* hb = (const u16*)(p.ws + WS_HB);
    const u16* w = (const u16*)(p.ws + (layer == 0 ? WS_WOUT0 : WS_WOUT1));
    float* xs = (float*)(p.ws + WS_XS);
    const float* mod = (const float*)(p.ws + WS_MOD);
    const int nbig = 256, nunits = nbig + (layer == 0 ? 16 : 0);
    for (int u = blockIdx.x; u < nunits; u += gridDim.x) {
        const bool big = u < nbig;
        int mt, nt; if (big) rect_unit(u, 64, 4, mt, nt); else { mt = (u - nbig) >> 2; nt = u & 3; }
        const int m0 = big ? mt * 256 : NL + mt * 128, n0 = nt * 256;
        auto epi_body =
            [&](int roff, int wc, int lane, uchar* w) {
                const int row0 = m0 + roff, nw = n0 + wc * 64;
                const float* g1 = mod + (layer * 3 + mod_row(row0)) * 6144 + 2048 + nw;
                const float* src = row_src(p, layer, row0) + nw;
                f32x4 xi[16], gg = *(const f32x4*)(g1 + (lane & 15) * 4);
#pragma unroll
                for (int it = 0; it < 16; ++it) xi[it] = *(const f32x4*)(src + (size_t)(it * 4 + (lane >> 4)) * 1024 + (lane & 15) * 4);
#pragma unroll
                for (int it = 0; it < 16; ++it) {
                    const int row = it * 4 + (lane >> 4), col = (lane & 15) * 4;
                    const f32x4 v = *(const f32x4*)(w + row * EPI_PITCH + col * 4);
                    f32x4 o;
#pragma unroll
                    for (int e = 0; e < 4; ++e) o[e] = xi[it][e] + gg[e] * v[e];
                    *(f32x4*)(xs + (size_t)(row0 + row) * 1024 + nw + col) = o;
                }
            };
        auto epi = [&](f32x16 (&acc)[2][2], int roff, int wc, int lane, uchar* w) { epi_stage(w, acc, lane & 31, lane >> 5); epi_body(roff, wc, lane, w); };
        if (big) {
            int r0, c; p8_rc(tid, r0, c);
            const unsigned ao = (unsigned)(r0 * 2048 + c * 2), bo = (unsigned)((((r0 >> 5) * 64 + (r0 & 31)) * 2048) + c * 2);
            gemm_tile8p(lds, (const uchar*)(hb + (size_t)m0 * 1024), ao, ao, ao, ao, 128 * 2048, 64 * 2048, 192 * 2048,
                        (const uchar*)(w + (size_t)n0 * 1024), bo, 128 * 2048, 32 * 2048, 160 * 2048, 16, 1 << 30, 0, epi_body);
        } else {
            const int rs = tid >> 3;
            const u16* ab = hb + (size_t)(m0 + rs) * 1024;
            const u16* bb = w + (size_t)(n0 + rs) * 1024;
            gemm_tile(lds, ab, ab + 64 * 1024, bb, bb + 64 * 1024, bb + 128 * 1024, bb + 192 * 1024, 16, 1 << 30, 0, epi);
        }
    }
    if (layer == 0) tail_cvt_moe(P, lds, nunits, 0, MOE_CVT_TILES / 2, MOE_CVT_TILES);
}

struct TileInfo { int bucket, mt, cnt, ntiles; };
DI int moe_ntiles(const int* cnt) { int s = 0; for (int b = 0; b < 24; ++b) s += (cnt[b * 32] + 127) >> 7; return s; }
DI TileInfo moe_tile(const int* cnt, int t) {
    TileInfo ti; ti.bucket = 0; ti.mt = 0; ti.cnt = 0; ti.ntiles = 0;
    int base = 0;
    for (int b = 0; b < 24; ++b) { const int c = cnt[b * 32], n = (c + 127) >> 7; if (t >= base && t < base + n) { ti.bucket = b; ti.mt = t - base; ti.cnt = c; } base += n; }
    ti.ntiles = base; return ti;
}
DI void bucket_experts(int bucket, int& ea, int& eb) {
    const int g = bucket / 6, pi = bucket - g * 6;
    const int lo = pi < 3 ? 0 : (pi < 5 ? 1 : 2), hi = pi < 3 ? pi + 1 : (pi < 5 ? pi - 1 : 3);
    ea = g * 4 + lo; eb = g * 4 + hi;
}
struct MoeUnit { int bucket, t, mt, cnt, big, nt; };
DI int moe_units(const int* cnt, int NT, int G, int& B, int& NBIG) {
    int b2 = 0, s1 = 0;
    for (int b = 0; b < 24; ++b) { const int n = (cnt[b * 32] + 127) >> 7; b2 += n >> 1; s1 += n & 1; }
    B = b2;
    const int cand = b2 * NT;
    int best = 1 << 30; NBIG = 0;
    for (int k = 0; k <= (cand + G - 1) / G; ++k) {
        const int nb = k * G < cand ? k * G : cand, U = 2 * cand + s1 * NT - nb;
        const int rb = (nb + G - 1) / G, ru = (U + G - 1) / G, cost = rb * 7 + (ru - rb) * 5;
        if (cost < best) { best = cost; NBIG = nb; }
    }
    return 2 * cand + s1 * NT - NBIG;
}
DI MoeUnit moe_unit(const int* cnt, int u, int NT, int B, int NBIG) {
    const int sh = NT == 8 ? 3 : 2;
    int kind, idx, half = 0, nt;
    if (u < NBIG) {
        kind = 0; idx = u >> sh; nt = u & (NT - 1);
        if (gridDim.x == 256 && u < (NBIG & ~255)) { const int r = u >> 8, b = u & 255, x = b & 7, y = b >> 3; idx = (r << (8 - sh)) + x * (32 >> sh) + (y >> sh); nt = y & (NT - 1); }
    }
    else {
        int v = u - NBIG; const int npl = B - (NBIG >> sh);
        if (v < npl * 2 * NT) { kind = 1; idx = (NBIG >> sh) + (v >> (sh + 1)); half = (v >> sh) & 1; nt = v & (NT - 1); }
        else { v -= npl * 2 * NT; kind = 2; idx = v >> sh; nt = v & (NT - 1); }
    }
    MoeUnit r; r.bucket = 0; r.t = 0; r.mt = 0; r.cnt = 0; r.big = kind == 0; r.nt = nt;
    int pb = 0, ps = 0, pt = 0;
    for (int b = 0; b < 24; ++b) {
        const int c = cnt[b * 32], n = (c + 127) >> 7, np = n >> 1, sg = n & 1;
        if (kind != 2) { if (idx >= pb && idx < pb + np) { r.bucket = b; r.mt = 2 * (idx - pb) + half; r.t = pt + r.mt; r.cnt = c; } }
        else if (sg && idx == ps) { r.bucket = b; r.mt = n - 1; r.t = pt + n - 1; r.cnt = c; }
        pb += np; ps += sg; pt += n;
    }
    return r;
}
constexpr int MOE_TOK = 3 * GEMM_STAGE;
DI void phase_moe_up(const Params& P, const Ctx& p, uchar* lds, int layer) {
    const int tid = tid_opaque();
    const int* cnt = (const int*)(p.ws + WS_CTL + CTL_CNT) + layer * 1024;
    const int* list = (const int*)(p.ws + WS_LIST);
    const f32x2* route = (const f32x2*)(p.ws + WS_ROUTE);
    const u16* hb = (const u16*)(p.ws + WS_HB);
    const u16* wgu = (const u16*)(p.ws + WS_WGU) + (size_t)layer * 16 * 1024 * 1024;
    u16* act = (u16*)(p.ws + WS_REGA + RA_ACT);
    int* tok = (int*)(lds + MOE_TOK);
    const int rs = tid >> 3;
    int B, NBIG;
    const int U = moe_units(cnt, 8, gridDim.x, B, NBIG);
    for (int u = blockIdx.x; u < U; u += gridDim.x) {
        const MoeUnit mu = moe_unit(cnt, u, 8, B, NBIG);
        const int nt = mu.nt;
        int ea, eb; bucket_experts(mu.bucket, ea, eb);
        __syncthreads();
        if (tid < (mu.big ? 256 : 128)) { const int pos = mu.mt * 128 + tid; tok[tid] = list[(size_t)mu.bucket * R + (pos < mu.cnt ? pos : 0)]; }
        __syncthreads();
        const int e = nt < 4 ? ea : eb;
        auto epi_body =
            [&](int roff, int wc, int lane, uchar* w) {
                u16* dst = act + ((size_t)mu.t * 128 + roff) * 1024 + (nt >= 4 ? 512 : 0) + (nt & 3) * 128 + wc * 32;
                const int col = (lane & 3) * 8;
                f32x2 rw[4];
#pragma unroll
                for (int it = 0; it < 4; ++it) rw[it] = route[tok[roff + it * 16 + (lane >> 2)]];
#pragma unroll
                for (int it = 0; it < 4; ++it) {
                    const int row = it * 16 + (lane >> 2);
                    const float wgt = nt < 4 ? rw[it].x : rw[it].y;
                    const uchar* wp = w + row * EPI_PITCH + col * 4;
                    const f32x4 g0 = *(const f32x4*)wp, g1 = *(const f32x4*)(wp + 16), u0 = *(const f32x4*)(wp + 128), u1 = *(const f32x4*)(wp + 144);
                    f32x4 o0, o1;
#pragma unroll
                    for (int e2 = 0; e2 < 4; ++e2) { o0[e2] = g0[e2] * sigmoidf_(g0[e2]) * u0[e2] * wgt; o1[e2] = g1[e2] * sigmoidf_(g1[e2]) * u1[e2] * wgt; }
                    *(u32x4*)(dst + (size_t)row * 1024 + col) = pack8(o0, o1);
                }
            };
        if (mu.big) {
            int r0, c; p8_rc(tid, r0, c);
            const unsigned bo = (unsigned)((((r0 >> 5) * 64 + (r0 & 31)) * 2048) + c * 2);
            const unsigned a00 = (unsigned)tok[r0] * 2048u + c * 2, a10 = (unsigned)tok[128 + r0] * 2048u + c * 2, a01 = (unsigned)tok[64 + r0] * 2048u + c * 2, a11 = (unsigned)tok[192 + r0] * 2048u + c * 2;
            gemm_tile8p(lds, (const uchar*)hb, a00, a10, a01, a11, 0, 0, 0,
                        (const uchar*)(wgu + ((size_t)e * 1024 + (nt & 3) * 256) * 1024), bo, 128 * 2048, 32 * 2048, 160 * 2048, 16, 1 << 30, 0, epi_body);
        } else {
            const u16* a0 = hb + (size_t)tok[rs] * 1024;
            const u16* a1 = hb + (size_t)tok[rs + 64] * 1024;
            const u16* bb = wgu + ((size_t)e * 1024 + (nt & 3) * 256 + rs) * 1024;
            gemm_tile(lds, a0, a1, bb, bb + 64 * 1024, bb + 128 * 1024, bb + 192 * 1024, 16, 1 << 30, 0,
                [&](f32x16 (&acc)[2][2], int roff, int wc, int lane, uchar* w) { epi_stage(w, acc, lane & 31, lane >> 5); epi_body(roff, wc, lane, w); });
        }
    }
    if (layer == 0) tail_cvt_dense(P, lds, U, P.jobs[2].tile0, P.jobs[6].tile0);
}
DI void phase_moe_down(const Params& P, const Ctx& p, uchar* lds, int layer) {
    const int tid = tid_opaque();
    const int* cnt = (const int*)(p.ws + WS_CTL + CTL_CNT) + layer * 1024;
    const int* list = (const int*)(p.ws + WS_LIST);
    const u16* wd = (const u16*)(p.ws + WS_WD) + (size_t)layer * 16 * 1024 * 512;
    const u16* act = (const u16*)(p.ws + WS_REGA + RA_ACT);
    float* xs = (float*)(p.ws + WS_XS);
    float* dsto = layer == 0 ? xs : p.out;
    const float* mod = (const float*)(p.ws + WS_MOD);
    int* tok = (int*)(lds + MOE_TOK);
    const int rs = tid >> 3;
    int B, NBIG;
    const int U = moe_units(cnt, 4, gridDim.x, B, NBIG);
    for (int u = blockIdx.x; u < U; u += gridDim.x) {
        const MoeUnit mu = moe_unit(cnt, u, 4, B, NBIG);
        const int nt = mu.nt, n0 = nt * 256;
        int ea, eb; bucket_experts(mu.bucket, ea, eb);
        __syncthreads();
        if (tid < (mu.big ? 256 : 128)) { const int pos = mu.mt * 128 + tid; tok[tid] = pos < mu.cnt ? list[(size_t)mu.bucket * R + pos] : -1; }
        __syncthreads();
        const long bjump = (long)(eb - ea) * 1024 * 512 - 512;
        auto epi_body =
            [&](int roff, int wc, int lane, uchar* w) {
                const int nw = n0 + wc * 64 + (lane & 15) * 4;
                int tk[16]; f32x4 xi[16];
#pragma unroll
                for (int it = 0; it < 16; ++it) {
                    tk[it] = tok[roff + it * 4 + (lane >> 4)];
                    xi[it] = (f32x4){0.f, 0.f, 0.f, 0.f};
                    if (tk[it] >= 0) xi[it] = *(const f32x4*)(xs + (size_t)tk[it] * 1024 + nw);
                }
#pragma unroll
                for (int it = 0; it < 16; ++it) {
                    const int row = it * 4 + (lane >> 4);
                    if (tk[it] >= 0) {
                        const f32x4 gg = *(const f32x4*)(mod + (layer * 3 + mod_row(tk[it])) * 6144 + 5 * 1024 + nw);
                        const f32x4 v = *(const f32x4*)(w + row * EPI_PITCH + (lane & 15) * 16);
                        f32x4 o;
#pragma unroll
                        for (int e = 0; e < 4; ++e) o[e] = xi[it][e] + gg[e] * v[e];
                        *(f32x4*)(dsto + (size_t)tk[it] * 1024 + nw) = o;
                    }
                }
            };
        if (mu.big) {
            int r0, c; p8_rc(tid, r0, c);
            const unsigned ao = (unsigned)(r0 * 2048 + c * 2), bo = (unsigned)((((r0 >> 5) * 64 + (r0 & 31)) * 1024) + c * 2);
            gemm_tile8p(lds, (const uchar*)(act + (size_t)mu.t * 128 * 1024), ao, ao, ao, ao, 128 * 2048, 64 * 2048, 192 * 2048,
                        (const uchar*)(wd + ((size_t)ea * 1024 + n0) * 512), bo, 128 * 1024, 32 * 1024, 160 * 1024, 16, 8, bjump * 2, epi_body);
        } else {
            const u16* ab = act + ((size_t)mu.t * 128 + rs) * 1024;
            const u16* bb = wd + ((size_t)ea * 1024 + n0 + rs) * 512;
            gemm_tile(lds, ab, ab + 64 * 1024, bb, bb + 64 * 512, bb + 128 * 512, bb + 192 * 512, 16, 8, bjump,
                [&](f32x16 (&acc)[2][2], int roff, int wc, int lane, uchar* w) { epi_stage(w, acc, lane & 31, lane >> 5); epi_body(roff, wc, lane, w); });
        }
    }
    if (layer == 0) tail_cvt_moe(P, lds, U, 1, 0, MOE_CVT_TILES / 2);
}

DI void phase_inproj1(const Params& P, const Ctx& p, uchar* lds) {
    const int tid = tid_opaque();
    const u16* hb = (const u16*)(p.ws + WS_HB);
    const u16* w = (const u16*)(p.ws + WS_WIN1);
    u16* yb = (u16*)(p.ws + WS_REGA + RA_Y);
    u16* ub = (u16*)(p.ws + WS_REGA + RA_U);
    const int rs = tid >> 3;
    for (int u = blockIdx.x; u < 512 + 16; u += gridDim.x) {
        const bool big = u < 512;
        int mt, nt; if (big) rect_unit(u, 64, 8, mt, nt); else { mt = (u - 512) >> 2; nt = 4 + ((u - 512) & 3); }
        const int m0 = big ? mt * 256 : NL + mt * 128, n0 = nt * 256;
        auto epi_body =
            [&](int roff, int wc, int lane, uchar* w) {
                const int row0 = m0 + roff, nw = n0 + wc * 64;
                if (nt < 4) {
                    epi_rows8<64>(w, lane, [&](int row, int col, const f32x4& v0, const f32x4& v1) {
                        f32x4 a, b2;
#pragma unroll
                        for (int e = 0; e < 4; ++e) { const float x = v0[e], y = v1[e]; a[e] = x * sigmoidf_(1.5957691216057308f * (x + 0.044715f * x * x * x)); b2[e] = y * sigmoidf_(1.5957691216057308f * (y + 0.044715f * y * y * y)); }
                        *(u32x4*)(yb + (size_t)(row0 + row) * 1024 + nw + col) = pack8(a, b2); });
                } else {
                    epi_rows8<64>(w, lane, [&](int row, int col, const f32x4& v0, const f32x4& v1) { *(u32x4*)(ub + (size_t)(row0 + row) * 1024 + nw - 1024 + col) = pack8(v0, v1); });
                }
            };
        if (big) {
            int r0, c; p8_rc(tid, r0, c);
            const unsigned ao = (unsigned)(r0 * 2048 + c * 2), bo = (unsigned)((((r0 >> 5) * 64 + (r0 & 31)) * 2048) + c * 2);
            gemm_tile8p(lds, (const uchar*)(hb + (size_t)m0 * 1024), ao, ao, ao, ao, 128 * 2048, 64 * 2048, 192 * 2048,
                        (const uchar*)(w + (size_t)n0 * 1024), bo, 128 * 2048, 32 * 2048, 160 * 2048, 16, 1 << 30, 0, epi_body);
        } else {
            const u16* ab = hb + (size_t)(m0 + rs) * 1024;
            const u16* bb = w + (size_t)(n0 + rs) * 1024;
            gemm_tile(lds, ab, ab + 64 * 1024, bb, bb + 64 * 1024, bb + 128 * 1024, bb + 192 * 1024, 16, 1 << 30, 0,
                [&](f32x16 (&acc)[2][2], int roff, int wc, int lane, uchar* w) { epi_stage(w, acc, lane & 31, lane >> 5); epi_body(roff, wc, lane, w); });
        }
    }
    tail_cvt_moe(P, lds, 512 + 16, 1, MOE_CVT_TILES / 2, MOE_CVT_TILES);
}

constexpr int LRU_U = 0, LRU_UC = 36864, UROW = 272, UC_BLK = 64 * UROW  , UC_DIR = 2 * UC_BLK;
DI int lru_perm(int r) { return ((r >> 2) & 1) * 16 + (r >> 3) * 4 + (r & 3); }
DI unsigned* lru_bsave(const Ctx& p, int dir, int c, int cblk, int wid) {
    unsigned* base = (unsigned*)(p.ws + (dir == 0 ? WS_REGA + RA_BS0 : WS_WGU));
    return base + ((size_t)(c * 4 + cblk) * 8 + wid) * 1024;
}
DI u32x4* lru_osave(const Ctx& p, int dir, int c, int cblk, int wid, int q, int lane) {
    if (dir == 0) return (u32x4*)(p.ws + WS_HB + ((size_t)(c * 64 + (wid * 4 + q) * 2 + (lane >> 5)) * 2048 + cblk * 512 + (lane & 31) * 16));
    uchar* base = p.ws + (c < 128 ? WS_WD : WS_OM1B);
    return (u32x4*)(base + ((size_t)((c & 127) * 4 + cblk) * 32768 + ((wid * 4 + q) * 64 + lane) * 16));
}
struct LruW { bf16x8 fa[8], fx[8]; };
DI void lru_wload(const Ctx& p, int dir, int cblk, int wid, int lane, LruW& w, int which = 3) {
    const int l31 = lane & 31, hh = lane >> 5, bl = wid >> 2, jq = wid & 3, blkg = cblk * 2 + bl;
    const u16* wa = (const u16*)(p.ws + WS_WA) + ((size_t)(dir * 8 + blkg) * 128 + jq * 32 + l31) * 128 + hh * 8;
    const u16* wx = (const u16*)(p.ws + WS_WX) + ((size_t)(dir * 8 + blkg) * 128 + jq * 32 + l31) * 128 + hh * 8;
    if (which & 1) {
#pragma unroll
        for (int ks = 0; ks < 8; ++ks) w.fa[ks] = *(const bf16x8*)(wa + ks * 16);
    }
    if (which & 2) {
#pragma unroll
        for (int ks = 0; ks < 8; ++ks) w.fx[ks] = *(const bf16x8*)(wx + ks * 16);
    }
    __builtin_amdgcn_sched_barrier(0);
}
template <class Hook, class Hook2>
DI void lru_gates(const Ctx& p, const uchar* lds, int dir, int cblk, int wid, int lane, const LruW& w, float (&a)[2][16], float (&b)[2][16], unsigned* bsave, Hook&& hook, Hook2&& hook2) {
    const int l31 = lane & 31, hh = lane >> 5, bl = wid >> 2, jq = wid & 3;
    const int chl = bl * 128 + jq * 32 + l31;
    const int ch = cblk * 256 + chl;
    const uchar* uc = lds + LRU_UC + dir * UC_DIR + bl * UC_BLK;
    f32x16 dr[2], di[2];
#pragma unroll
    for (int rb = 0; rb < 2; ++rb)
#pragma unroll
        for (int i = 0; i < 16; ++i) { dr[rb][i] = 0.f; di[rb][i] = 0.f; }
    const int tk = lru_perm(l31);
#pragma unroll
    for (int ks = 0; ks < 8; ++ks) {
#pragma unroll
        for (int rb = 0; rb < 2; ++rb) dr[rb] = MFMA32(*(const bf16x8*)(uc + (rb * 32 + tk) * UROW + ks * 32 + hh * 16), w.fa[ks], dr[rb]);
    }
#pragma unroll
    for (int ks = 0; ks < 8; ++ks) {
#pragma unroll
        for (int rb = 0; rb < 2; ++rb) di[rb] = MFMA32(*(const bf16x8*)(uc + (rb * 32 + tk) * UROW + ks * 32 + hh * 16), w.fx[ks], di[rb]);
    }
    __builtin_amdgcn_sched_barrier(0);
    hook();
    const float nl2 = -1.4426950408889634f;
    const float kba = inp(p, I_ODBA)[dir * 1024 + ch] * nl2, kbx = inp(p, I_ODBX)[dir * 1024 + ch] * nl2;
    const float sp8 = 8.0f * log1pf(__expf(-inp(p, I_ODLAM)[dir * 1024 + ch]));
    const float c1 = sp8 * nl2;
    const int cofs = (jq * 32 + l31) * 2;
#pragma unroll
    for (int rb = 0; rb < 2; ++rb)
#pragma unroll
        for (int i = 0; i < 16; ++i) {
            const int token = rb * 32 + hh * 16 + i;
            const float r = frcp(1.0f + __builtin_amdgcn_exp2f(__builtin_fmaf(dr[rb][i], nl2, kba)));
            const float av = __builtin_amdgcn_exp2f(c1 * r);
            a[rb][i] = av;
            const float om = __builtin_fmaf(-av, av, 1.0f);
            const float ucv = b2f(*(const u16*)(uc + token * UROW + cofs));
            const float ig = frcp(1.0f + __builtin_amdgcn_exp2f(__builtin_fmaf(di[rb][i], nl2, kbx)));
            b[rb][i] = __builtin_amdgcn_sqrtf(om) * (ig * ucv);
        }
    __builtin_amdgcn_sched_barrier(0);
    hook2();
    if (bsave) {
#pragma unroll
        for (int q = 0; q < 4; ++q) {
            u32x4 v;
#pragma unroll
            for (int e = 0; e < 4; ++e) { const int j = q * 4 + e, rb = j >> 3, i = (j & 7) * 2; v[e] = pk2(b[rb][i], b[rb][i + 1]); }
            ((u32x4*)bsave)[q * 64 + lane] = v;
        }
    }
}
constexpr int LRU_U2 = 106496;
DI void lru_seq(int c, int& s0, int& s1) { if (c < 256) { s0 = (c >> 7) * SEQ; s1 = s0 + SEQ; } else { s0 = NL + ((c - 256) >> 2) * CTXL; s1 = s0 + CTXL; } }
DI void lru_dma(const Ctx& p, uchar* lds, int c, int cblk, int buf) {
    const int tid = tid_opaque(), lane = tid & 63, wid = tid >> 6;
    const u16* ub = (const u16*)(p.ws + WS_REGA + RA_U);
    int s0, s1; lru_seq(c, s0, s1);
    const int w0 = __builtin_amdgcn_readfirstlane(wid);
    uchar* dst = lds + (buf ? LRU_U2 : LRU_U);
#pragma unroll
    for (int k = 0; k < 5; ++k) {
        const int i = w0 + 8 * k;
        if (i < 35) {
            int row = c * 64 - 3 + 2 * i + (lane >> 5);
            row = row < s0 ? s0 : (row >= s1 ? s1 - 1 : row);
            __builtin_amdgcn_global_load_lds((const unsigned*)(ub + (size_t)row * 1024 + cblk * 256 + (lane & 31) * 8), (LAS unsigned*)(dst + i * 1024), 16, 0, 0);
        }
    }
}
DI void lru_conv(const Ctx& p, uchar* lds, int c, int cblk, int buf, bool counted = false) {
    const int tid = tid_opaque();
    const int row0 = c * 64;
    int s0, s1; lru_seq(c, s0, s1);
    const uchar* ut = lds + (buf ? LRU_U2 : LRU_U);
    if (counted) WAIT_V(8); else WAIT_V(0);
    __syncthreads();
    const int c8 = tid & 31, tq = tid >> 5, t0 = tq * 4;
    float uv[10][8];
#pragma unroll
    for (int rr = 0; rr < 10; ++rr) {
        u32x4 v = *(const u32x4*)(ut + (t0 + rr) * 512 + c8 * 16);
        const int row = row0 - 3 + t0 + rr;
        if (row < s0 || row >= s1) v = (u32x4){0u, 0u, 0u, 0u};
        uv[rr][0] = blo(v.x); uv[rr][1] = bhi(v.x); uv[rr][2] = blo(v.y); uv[rr][3] = bhi(v.y); uv[rr][4] = blo(v.z); uv[rr][5] = bhi(v.z); uv[rr][6] = blo(v.w); uv[rr][7] = bhi(v.w);
    }
#pragma unroll
    for (int dir = 0; dir < 2; ++dir) {
        const float* cw = inp(p, I_ODCW) + dir * 4096 + cblk * 256 + c8 * 8;
        const float* cb = inp(p, I_ODCB) + dir * 1024 + cblk * 256 + c8 * 8;
        float w[4][8], bs[8];
#pragma unroll
        for (int k = 0; k < 4; ++k) { const f32x4 x0 = *(const f32x4*)(cw + k * 1024), x1 = *(const f32x4*)(cw + k * 1024 + 4); w[k][0] = x0[0]; w[k][1] = x0[1]; w[k][2] = x0[2]; w[k][3] = x0[3]; w[k][4] = x1[0]; w[k][5] = x1[1]; w[k][6] = x1[2]; w[k][7] = x1[3]; }
        { const f32x4 x0 = *(const f32x4*)cb, x1 = *(const f32x4*)(cb + 4); bs[0] = x0[0]; bs[1] = x0[1]; bs[2] = x0[2]; bs[3] = x0[3]; bs[4] = x1[0]; bs[5] = x1[1]; bs[6] = x1[2]; bs[7] = x1[3]; }
#pragma unroll
        for (int tt = 0; tt < 4; ++tt) {
            float o[8];
#pragma unroll
            for (int e = 0; e < 8; ++e) {
                float s = bs[e];
#pragma unroll
                for (int k = 0; k < 4; ++k) s += w[k][e] * uv[tt + k + (dir ? 3 : 0)][e];
                o[e] = s;
            }
            const int t = t0 + tt;
            u32x4 wv; wv.x = pk2(o[0], o[1]); wv.y = pk2(o[2], o[3]); wv.z = pk2(o[4], o[5]); wv.w = pk2(o[6], o[7]);
            *(u32x4*)(lds + LRU_UC + dir * UC_DIR + (c8 >> 4) * UC_BLK + t * UROW + (c8 & 15) * 16) = wv;
        }
    }
    __syncthreads();
}
DI void lru_seg(const float (&a)[2][16], const float (&b)[2][16], int dir, int hh, float (&SA)[4], float (&SB)[4]) {
    float oa[2], ob[2];
#pragma unroll
    for (int rb = 0; rb < 2; ++rb) {
        float A = 1.f, B = 0.f;
#pragma unroll
        for (int ii = 0; ii < 16; ++ii) { const int i = dir ? 15 - ii : ii; B = a[rb][i] * B + b[rb][i]; A *= a[rb][i]; }
        oa[rb] = A; ob[rb] = B;
    }
    float pa[2], pb[2];
#pragma unroll
    for (int rb = 0; rb < 2; ++rb) { pa[rb] = __shfl_xor(oa[rb], 32); pb[rb] = __shfl_xor(ob[rb], 32); }
#pragma unroll
    for (int rb = 0; rb < 2; ++rb)
#pragma unroll
        for (int h = 0; h < 2; ++h) {
            const float A = (h == hh) ? oa[rb] : pa[rb], B = (h == hh) ? ob[rb] : pb[rb];
            const int s = dir ? 3 - (rb * 2 + h) : rb * 2 + h;
            SA[s] = A; SB[s] = B;
        }
}
DI void lru_summ_item(int j, int& c, int& cblk, int& role) {
    if (j < 1024) { c = j >> 2; cblk = j & 3; role = -1; } else { const int mini = j - 1024, cu = mini >> 3; c = 256 + (cu >> 2); cblk = cu & 3; role = mini & 7; }
}
template <class F>
DI void lru_summ_wave(const Ctx& p, uchar* lds, int c, int cblk, int role, LruW& w, F&& next_dma) {
    const int tid = tid_opaque(), lane = tid & 63, wid = role < 0 ? (tid >> 6) : role, hh = lane >> 5;
    f32x2* summ = (f32x2*)(p.ws + WS_SUMM);
    const int ch = cblk * 256 + (wid >> 2) * 128 + (wid & 3) * 32 + (lane & 31);
#pragma unroll
    for (int dir = 0; dir < 2; ++dir) {
        float a[2][16], b[2][16];
        unsigned* bs = c < 256 ? lru_bsave(p, dir, c, cblk, wid) : (unsigned*)nullptr;
        if (dir == 0) lru_gates(p, lds, 0, cblk, wid, lane, w, a, b, bs, [&]() { lru_wload(p, 1, cblk, wid, lane, w, 1); }, [&]() { lru_wload(p, 1, cblk, wid, lane, w, 2); });
        else          lru_gates(p, lds, 1, cblk, wid, lane, w, a, b, bs, [&]() { next_dma(); lru_wload(p, 0, cblk, wid, lane, w, 1); }, [&]() { lru_wload(p, 0, cblk, wid, lane, w, 2); });
        if (c < 256) {
#pragma unroll
            for (int q = 0; q < 4; ++q) {
                u32x4 v;
#pragma unroll
                for (int e = 0; e < 4; ++e) { const int j = q * 4 + e, rb = j >> 3, i = (j & 7) * 2; v[e] = pk2(1.0f - a[rb][i], 1.0f - a[rb][i + 1]); }
                *lru_osave(p, dir, c, cblk, wid, q, lane) = v;
            }
        }
        float SA[4], SB[4];
        lru_seg(a, b, dir, hh, SA, SB);
        float A = 1.f, B = 0.f;
#pragma unroll
        for (int s = 0; s < 4; ++s) { B = SA[s] * B + SB[s]; A *= SA[s]; }
        if (hh == 0) summ[((size_t)dir * 264 + c) * 1024 + ch] = (f32x2){A, B};
    }
}
DI void phase_lru_summ(const Ctx& p, uchar* lds) {
    const int tid = tid_opaque(), lane = tid & 63, wid = tid >> 6;
    constexpr int NITEM = 1024 + 32 * 8;
    int c, cblk, role;
    if ((int)blockIdx.x >= NITEM) return;
    lru_summ_item(blockIdx.x, c, cblk, role); lru_dma(p, lds, c, cblk, 0);
    LruW w;
    lru_wload(p, 0, cblk, role < 0 ? wid : role, lane, w);
    int buf = 0;
    bool counted = false;
    for (int j = blockIdx.x; j < NITEM; j += gridDim.x, buf ^= 1) {
        lru_summ_item(j, c, cblk, role);
        lru_conv(p, lds, c, cblk, buf, counted);
        counted = role < 0;
        int c2 = 0, cblk2 = 0, role2 = -1;
        const bool more = j + (int)gridDim.x < NITEM;
        if (more) lru_summ_item(j + gridDim.x, c2, cblk2, role2);
        auto next_dma = [&]() { if (more) lru_dma(p, lds, c2, cblk2, buf ^ 1); };
        if (role < 0) {
            lru_summ_wave(p, lds, c, cblk, -1, w, next_dma);
            if (more && role2 >= 0) lru_wload(p, 0, cblk2, role2, lane, w);
        } else {
            if (wid == 0) lru_summ_wave(p, lds, c, cblk, role, w, next_dma); else next_dma();
            if (more && (cblk2 != cblk || role2 != role)) lru_wload(p, 0, cblk2, role2, lane, w);
        }
    }
    WAIT_V(0);
}
DI void phase_lru_carry(const Ctx& p) {
    const int tid = tid_opaque();
    const f32x2* summ = (const f32x2*)(p.ws + WS_SUMM);
    float* carry = (float*)(p.ws + WS_CARRY);
    for (int g = blockIdx.x * 512 + tid; g < 4096; g += gridDim.x * 512) {
        const int ch = g & 1023, bt = (g >> 10) & 1, dir = g >> 11;
        const f32x2* sd = summ + (size_t)dir * 264 * 1024 + ch;
        float h = 0.f;
        f32x2 s[4];
#pragma unroll
        for (int q = 0; q < 4; ++q) s[q] = sd[(size_t)(256 + bt * 4 + (dir ? 3 - q : q)) * 1024];
#pragma unroll
        for (int q = 0; q < 4; ++q) h = s[q].x * h + s[q].y;
        for (int q0 = 0; q0 < 128; q0 += 16) {
            f32x2 t[16];
#pragma unroll
            for (int q = 0; q < 16; ++q) { const int ci = dir ? 127 - (q0 + q) : q0 + q; t[q] = sd[(size_t)(bt * 128 + ci) * 1024]; }
#pragma unroll
            for (int q = 0; q < 16; ++q) { const int ci = dir ? 127 - (q0 + q) : q0 + q; carry[((size_t)dir * 256 + bt * 128 + ci) * 1024 + ch] = h; h = t[q].x * h + t[q].y; }
        }
    }
}
DI void phase_lru_scan(const Ctx& p, uchar* lds) {
    const int tid = tid_opaque(), lane = tid & 63, wid = tid >> 6, hh = lane >> 5;
    const u16* yb = (const u16*)(p.ws + WS_REGA + RA_Y);
    u16* hb = (u16*)(p.ws + WS_HB);
    for (int u = blockIdx.x; u < 256 * 4; u += gridDim.x) {
        const int c = u >> 2, cblk = u & 3;
        const int ch = cblk * 256 + (wid >> 2) * 128 + (wid & 3) * 32 + (lane & 31);
        float hsum[2][16];
        __syncthreads();
#pragma unroll
        for (int dir = 0; dir < 2; ++dir) {
            const float h0 = ((const float*)(p.ws + WS_CARRY))[((size_t)dir * 256 + c) * 1024 + ch];
            float a[2][16], b[2][16];
            {
                const unsigned* bs = lru_bsave(p, dir, c, cblk, wid);
                unsigned bw[16], ow[16];
#pragma unroll
                for (int q = 0; q < 4; ++q) {
                    const u32x4 vb = ((const u32x4*)bs)[q * 64 + lane], vo = *lru_osave(p, dir, c, cblk, wid, q, lane);
#pragma unroll
                    for (int e = 0; e < 4; ++e) { bw[q * 4 + e] = vb[e]; ow[q * 4 + e] = vo[e]; }
                }
#pragma unroll
                for (int rb = 0; rb < 2; ++rb)
#pragma unroll
                    for (int i = 0; i < 16; ++i) {
                        const unsigned wb = bw[rb * 8 + (i >> 1)], wo = ow[rb * 8 + (i >> 1)];
                        b[rb][i] = (i & 1) ? bhi(wb) : blo(wb);
                        a[rb][i] = 1.0f - ((i & 1) ? bhi(wo) : blo(wo));
                    }
            }
            float SA[4], SB[4];
            lru_seg(a, b, dir, hh, SA, SB);
            float st[4]; st[0] = h0;
#pragma unroll
            for (int s = 1; s < 4; ++s) st[s] = SA[s - 1] * st[s - 1] + SB[s - 1];
#pragma unroll
            for (int rb = 0; rb < 2; ++rb) {
                const int sidx = dir ? 3 - (rb * 2 + hh) : rb * 2 + hh;
                float h = sidx == 0 ? st[0] : (sidx == 1 ? st[1] : (sidx == 2 ? st[2] : st[3]));
#pragma unroll
                for (int ii = 0; ii < 16; ++ii) { const int i = dir ? 15 - ii : ii; h = a[rb][i] * h + b[rb][i]; if (dir == 0) hsum[rb][i] = h; else hsum[rb][i] += h; }
            }
        }
        __syncthreads();
        {
            const int chl = (wid >> 2) * 128 + (wid & 3) * 32 + (lane & 31);
#pragma unroll
            for (int rb = 0; rb < 2; ++rb)
#pragma unroll
                for (int i = 0; i < 16; ++i) *(float*)(lds + (rb * 32 + hh * 16 + i) * 1040 + chl * 4) = hsum[rb][i];
        }
        __syncthreads();
#pragma unroll
        for (int j = 0; j < 4; ++j) {
            const int pi = j * 512 + tid, tk = pi >> 5, c8 = pi & 31;
            const f32x4 h0 = *(const f32x4*)(lds + tk * 1040 + c8 * 32), h1 = *(const f32x4*)(lds + tk * 1040 + c8 * 32 + 16);
            const size_t o = (size_t)(c * 64 + tk) * 1024 + cblk * 256 + c8 * 8;
            const u32x4 yv = *(const u32x4*)(yb + o);
            u32x4 w;
            w.x = pk2(blo(yv.x) * h0[0], bhi(yv.x) * h0[1]); w.y = pk2(blo(yv.y) * h0[2], bhi(yv.y) * h0[3]);
            w.z = pk2(blo(yv.z) * h1[0], bhi(yv.z) * h1[1]); w.w = pk2(blo(yv.w) * h1[2], bhi(yv.w) * h1[3]);
            *(u32x4*)(hb + o) = w;
        }
    }
}

__global__ void __launch_bounds__(512) fwd_mega(const Params P) {
    uchar* lds = smem + LDS_USER;
    LAS unsigned long long* tab = (LAS unsigned long long*)(smem + 64);
    if (threadIdx.x < N_IN) tab[threadIdx.x] = (unsigned long long)P.in[threadIdx.x];
    if ((threadIdx.x & 63) == 0) ((volatile LAS int*)smem)[96 + hw_slot()] = threadIdx.x >> 6;
    const bool multi = (P.ph_hi - P.ph_lo) > 1;
    if (threadIdx.x == 0) { ((volatile LAS unsigned*)smem)[0] = 0u; ((volatile LAS unsigned*)smem)[1] = 0u; ((volatile LAS unsigned*)smem)[2] = 0u; ((volatile LAS unsigned*)smem)[3] = 0u; }
    __syncthreads();
    if (multi) (void)xcd_barrier_post((unsigned*)(P.ws + WS_CTL), (volatile LAS unsigned*)smem);
#define RUN_PHASE(k, call) if (P.ph_lo <= (k) && (k) < P.ph_hi) { { Ctx p; { unsigned long long wsi = (unsigned long long)P.ws; asm volatile("" : "+s"(wsi)); p.ws = (uchar*)(__attribute__((address_space(1))) uchar*)wsi; } p.out = P.out; p.tab = tab; call; } if ((PROBE_REPS >> (k)) & 1) { { XcdBarrier xb_; xb_.bar = (unsigned*)(P.ws + WS_CTL); xb_.x = xb_xcc_id(); xb_.st = (volatile LAS unsigned*)smem; xcd_barrier(xb_); } Ctx p; { unsigned long long wsi = (unsigned long long)P.ws; asm volatile("" : "+s"(wsi)); p.ws = (uchar*)(__attribute__((address_space(1))) uchar*)wsi; } p.out = P.out; p.tab = tab; call; } if (multi && (k) + 1 < P.ph_hi) { XcdBarrier xb_; xb_.bar = (unsigned*)(P.ws + WS_CTL); xb_.x = xb_xcc_id(); xb_.st = (volatile LAS unsigned*)smem; xcd_barrier(xb_); } }
    RUN_PHASE(0, phase_prep(P, p, lds))
    RUN_PHASE(1, phase_norm(p, 0))
    RUN_PHASE(2, phase_inproj0(P, p, lds))
    RUN_PHASE(3, phase_attn(p, lds))
    RUN_PHASE(4, phase_outproj(P, p, lds, 0))
    RUN_PHASE(5, phase_router(p, lds, 0))
#if PROBE_ROUTER2X
    if (P.ph_lo <= 5 && 5 < P.ph_hi) { Ctx p; { unsigned long long wsi = (unsigned long long)P.ws; asm volatile("" : "+s"(wsi)); p.ws = (uchar*)(__attribute__((address_space(1))) uchar*)wsi; } p.out = P.out; p.tab = tab; phase_router(p, lds, 0, 2); { XcdBarrier xb_; xb_.bar = (unsigned*)(P.ws + WS_CTL); xb_.x = xb_xcc_id(); xb_.st = (volatile LAS unsigned*)smem; xcd_barrier(xb_); } }
#endif
    RUN_PHASE(6, phase_moe_up(P, p, lds, 0))
    RUN_PHASE(7, phase_moe_down(P, p, lds, 0))
    RUN_PHASE(8, phase_norm(p, 1))
    RUN_PHASE(9, phase_inproj1(P, p, lds))
    RUN_PHASE(10, phase_lru_summ(p, lds))
    RUN_PHASE(11, phase_lru_carry(p))
    RUN_PHASE(12, phase_lru_scan(p, lds))
    RUN_PHASE(13, phase_outproj(P, p, lds, 1))
    RUN_PHASE(14, phase_router(p, lds, 1))
    RUN_PHASE(15, phase_moe_up(P, p, lds, 1))
    RUN_PHASE(16, phase_moe_down(P, p, lds, 1))
}

extern "C" void kernel_launch(void* const* d_in, const int* in_sizes, int n_in, void* d_out, int out_size, void* d_ws, size_t ws_size, hipStream_t stream) {
    static int grid = 0;
    if (grid == 0) {
        if (n_in != N_IN || out_size != NL * D || ws_size < WS_END) { fprintf(stderr, "kernel_launch: unexpected shapes (n_in %d, out %d, ws %zu, need %zu)\n", n_in, out_size, ws_size, (size_t)WS_END); grid = -1; return; }
        int dev = 0, cus = 0, per_cu = 0;
        if (hipGetDevice(&dev) != hipSuccess || hipDeviceGetAttribute(&cus, hipDeviceAttributeMultiprocessorCount, dev) != hipSuccess) { grid = -1; return; }
        if (hipFuncSetAttribute((const void*)fwd_mega, hipFuncAttributeMaxDynamicSharedMemorySize, LDS_BYTES) != hipSuccess) { fprintf(stderr, "kernel_launch: hipFuncSetAttribute failed\n"); grid = -1; return; }
        if (hipOccupancyMaxActiveBlocksPerMultiprocessor(&per_cu, (const void*)fwd_mega, 512, LDS_BYTES) != hipSuccess || per_cu < 1) { fprintf(stderr, "kernel_launch: occupancy query says %d\n", per_cu); (void)hipGetLastError(); grid = -1; return; }
        grid = cus;
    }
    if (grid < 0) return;
    if (hipMemsetAsync((char*)d_ws + WS_CTL, 0, CTL_BYTES, stream) != hipSuccess) return;
    Params p{};
    for (int i = 0; i < N_IN; ++i) p.in[i] = (const float*)d_in[i];
    p.out = (float*)d_out; p.ws = (uchar*)d_ws;
    uchar* ws = (uchar*)d_ws;
    int t0 = 0;
    auto job = [&](int j, const float* src, size_t dst_off, int nmat, int K, int N, int sstride, int dstride, int lddst, int mode, int half) {
        CvtJob& J = p.jobs[j]; J.src = src; J.dst = (u16*)(ws + dst_off); J.nmat = nmat; J.K = K; J.N = N; J.sstride = sstride; J.dstride = dstride; J.lddst = lddst; J.mode = mode; J.half = half; J.tile0 = t0; J.pad = 0;
        t0 += nmat * (K / 64) * (N / 64);
    };
    job(0, p.in[I_EVWIN], WS_WIN0, 1, 1024, 3072, 0, 0, 1024, 0, 0);
    job(1, p.in[I_EVWOUT], WS_WOUT0, 1, 1024, 1024, 0, 0, 1024, 0, 0);
    job(2, p.in[I_ODWIN], WS_WIN1, 1, 1024, 2048, 0, 0, 1024, 0, 0);
    job(3, p.in[I_ODWOUT], WS_WOUT1, 1, 1024, 1024, 0, 0, 1024, 0, 0);
    job(4, p.in[I_ODWA], WS_WA, 16, 128, 128, 16384, 16384, 128, 0, 0);
    job(5, p.in[I_ODWX], WS_WX, 16, 128, 128, 16384, 16384, 128, 0, 0);
    job(6, p.in[I_MGATE], WS_WGU, 32, 1024, 512, 524288, 1048576, 1024, 1, 0);
    job(7, p.in[I_MUP], WS_WGU, 32, 1024, 512, 524288, 1048576, 1024, 1, 1);
    job(8, p.in[I_MDOWN], WS_WD, 32, 512, 1024, 524288, 524288, 512, 0, 0);
    p.ncvt = t0;
    const int nl = N_LAUNCHES;
    for (int li = 0; li < nl; ++li) {
        p.ph_lo = li * NPH / nl; p.ph_hi = (li + 1) * NPH / nl;
        hipLaunchKernelGGL(fwd_mega, dim3(grid), dim3(512), LDS_BYTES, stream, p);
    }
}
```

```cpp
#include <hip/hip_runtime.h>
#include <stdint.h>
#include <stdio.h>

#define DI __device__ __forceinline__
#define LAS __attribute__((address_space(3)))
typedef unsigned short u16;
typedef unsigned char uchar;
typedef short bf16x8 __attribute__((ext_vector_type(8)));
typedef float f32x16 __attribute__((ext_vector_type(16)));
typedef float f32x4 __attribute__((ext_vector_type(4)));
typedef float f32x2 __attribute__((ext_vector_type(2)));
typedef __bf16 bf2_t __attribute__((ext_vector_type(2)));
typedef unsigned u32x2 __attribute__((ext_vector_type(2)));
typedef unsigned u32x4 __attribute__((ext_vector_type(4)));

#ifndef N_LAUNCHES
#define N_LAUNCHES 1
#endif
#ifndef PROBE_GEMM2X
#define PROBE_GEMM2X 0
#endif
#ifndef PROBE_ROUTER2X
#define PROBE_ROUTER2X 0
#endif
#ifndef PROBE_REPS
#define PROBE_REPS 0x0000
#endif

DI unsigned pk2(float a, float b) { f32x2 v = {a, b}; bf2_t r = __builtin_convertvector(v, bf2_t); return __builtin_bit_cast(unsigned, r); }
DI u16 f2b(float a) { __bf16 r = (__bf16)a; return __builtin_bit_cast(u16, r); }
DI float b2f(u16 v) { return __uint_as_float(((unsigned)v) << 16); }
DI float blo(unsigned v) { return __uint_as_float(v << 16); }
DI float bhi(unsigned v) { return __uint_as_float(v & 0xffff0000u); }
#define MFMA32(a, b, c) __builtin_amdgcn_mfma_f32_32x32x16_bf16((a), (b), (c), 0, 0, 0)

constexpr int D = 1024, NL = 16384, NC = 512, R = 16896, SEQ = 8192, CTXL = 256, SK = 8448;
constexpr int NPH = 17;
constexpr float EPS = 1e-6f;
constexpr float LAM_INIT0 = 0.2f;
constexpr float QSCALE = 0.125f * 1.4426950408889634f;

enum { I_X = 0, I_C, I_CTX, I_CCTX, I_ADAW, I_ADAB, I_NMIX, I_NFFN, I_EVWIN, I_EVCW, I_EVCB, I_QN, I_KN, I_LQ1, I_LK1, I_LQ2, I_LK2, I_SUBN, I_EVWOUT,
       I_ODWIN, I_ODCW, I_ODCB, I_ODWA, I_ODBA, I_ODWX, I_ODBX, I_ODLAM, I_ODWOUT, I_MWGRP, I_MBGRP, I_MWRT, I_MBRT, I_MGATE, I_MUP, I_MDOWN, N_IN };

constexpr size_t al256(size_t x) { return (x + 255) & ~(size_t)255; }
constexpr size_t WS_CTL   = 0;
constexpr size_t CTL_BYTES = 65536;
constexpr size_t CTL_CNT  = 16384;
constexpr size_t WS_MOD   = WS_CTL + CTL_BYTES;
constexpr size_t WS_ROPE  = WS_MOD + al256(2 * 3 * 6144 * 4);
constexpr size_t WS_ROUTE = WS_ROPE + (size_t)SEQ * 32 * 8;
constexpr size_t WS_LIST  = WS_ROUTE + al256((size_t)R * 8);
constexpr size_t WS_SUMM  = WS_LIST + al256((size_t)24 * R * 4);
constexpr size_t WS_CARRY = WS_SUMM + (size_t)2 * 264 * 1024 * 8;
constexpr size_t WS_WIN0  = WS_CARRY + (size_t)2 * 256 * 1024 * 4;
constexpr size_t WS_WOUT0 = WS_WIN0 + (size_t)3072 * 1024 * 2;
constexpr size_t WS_WIN1  = WS_WOUT0 + (size_t)1024 * 1024 * 2;
constexpr size_t WS_WOUT1 = WS_WIN1 + (size_t)2048 * 1024 * 2;
constexpr size_t WS_WA    = WS_WOUT1 + (size_t)1024 * 1024 * 2;
constexpr size_t WS_WX    = WS_WA + (size_t)2 * 8 * 128 * 128 * 2;
constexpr size_t WS_WGU   = WS_WX + (size_t)2 * 8 * 128 * 128 * 2;
constexpr size_t WS_WD    = WS_WGU + (size_t)2 * 16 * 1024 * 1024 * 2;
constexpr size_t WS_XS    = WS_WD + (size_t)2 * 16 * 1024 * 512 * 2;
constexpr size_t WS_HB    = WS_XS + (size_t)R * 1024 * 4;
constexpr size_t WS_REGA  = WS_HB + (size_t)R * 1024 * 2;
constexpr size_t RA_ZC    = 0;
constexpr size_t RA_Q     = RA_ZC + (size_t)R * 1536 * 2;
constexpr size_t RA_K     = RA_Q + (size_t)16 * SK * 64 * 2;
constexpr size_t RA_VT    = RA_K + (size_t)16 * SK * 64 * 2;
constexpr size_t RA_END0  = RA_VT + (size_t)8 * 128 * SK * 2;
constexpr size_t RA_ACT   = 0;
constexpr size_t RA_Y     = 0;
constexpr size_t RA_U     = RA_Y + (size_t)NL * 1024 * 2;
constexpr size_t RA_BS0   = RA_U + (size_t)R * 1024 * 2;
constexpr size_t WS_OM1B  = WS_REGA + RA_END0;
constexpr size_t WS_END   = WS_OM1B + (size_t)128 * 4 * 32768;
static_assert(RA_BS0 + (size_t)256 * 4 * 8 * 1024 * 4 <= RA_END0 && (size_t)20480 * 1024 * 2 <= RA_END0, "region A overlays");
static_assert((size_t)256 * 4 * 8 * 1024 * 4 <= (size_t)16 * 1024 * 1024 * 2, "b of direction 1 fits layer 0's gate/up weights");
static_assert(WS_END <= 352000000ull, "workspace budget");

constexpr int LDS_BYTES = 147456 + 1024 + 1024;
constexpr int LDS_USER = 1024;

struct CvtJob { const float* src; u16* dst; int nmat, K, N, sstride, dstride, lddst, mode, half, tile0, pad; };
struct Params {
    const float* in[N_IN];
    float* out;
    uchar* ws;
    CvtJob jobs[9];
    int ncvt, ph_lo, ph_hi, pad;
};
struct Ctx { uchar* ws; float* out; const LAS unsigned long long* tab; };
typedef const __attribute__((address_space(1))) float* gcf_t;
DI const float* inp(const Ctx& c, int i) { return (const float*)(gcf_t)c.tab[i]; }

extern __shared__ __attribute__((aligned(16))) uchar smem[];
DI int hw_slot() { return (int)(__builtin_amdgcn_s_getreg(((6 - 1) << 11) | 4) & 63u); }
DI int tid_opaque() {
    const int lane = (int)__builtin_amdgcn_mbcnt_hi(~0u, __builtin_amdgcn_mbcnt_lo(~0u, 0u));
    int w = ((volatile LAS int*)smem)[96 + hw_slot()];
    w = __builtin_amdgcn_readfirstlane(w);
    int t = w * 64 + lane; asm volatile("" : "+v"(t)); return t;
}
#define XB_TMO      128
#define XB_XCNT(j)  (256  + 64 * (j))
#define XB_XSUB(j)  (1280 + 64 * (j))
#define XB_XGEN(j)  (2304 + 64 * (j))
#define XB_TOP      3328
#define XB_TOPGEN   3392
#define XCD_BAR_WORDS 3456
#define XB_SPIN_CAP (1u << 20)
DI unsigned xb_ld(unsigned* p)              { return __hip_atomic_load(p, __ATOMIC_RELAXED, __HIP_MEMORY_SCOPE_AGENT); }
DI unsigned xb_add(unsigned* p, unsigned v) { return __hip_atomic_fetch_add(p, v, __ATOMIC_RELAXED, __HIP_MEMORY_SCOPE_AGENT); }
DI unsigned xb_xcc_id() { return (unsigned)__builtin_amdgcn_s_getreg((3 << 11) | 20) & 0xFu; }
#define XB_SPIN(cond, bar) do { unsigned _sp = 0; while (cond) { __builtin_amdgcn_s_sleep(1); \
    if ((++_sp & 255u) == 0u) { if (xb_ld(&(bar)[XB_TMO])) break; if (_sp > XB_SPIN_CAP) { atomicAdd(&(bar)[XB_TMO], 1u); break; } } } } while (0)
struct XcdBarrier { unsigned* bar; unsigned x; volatile LAS unsigned* st; };
DI XcdBarrier xcd_barrier_post(unsigned* bar, volatile LAS unsigned* st) {
    XcdBarrier b; b.bar = bar; b.x = xb_xcc_id(); b.st = st;
    if (tid_opaque() == 0) (void)xb_add(&bar[XB_XCNT(b.x)], 1u);
    return b;
}
DI void xcd_barrier_complete(unsigned* bar, unsigned x, unsigned& nloc, unsigned& nx) {
    const unsigned G = gridDim.x * gridDim.y * gridDim.z;
    unsigned sum, cnt, mine, sp = 0u;
    for (;;) {
        sum = 0u; cnt = 0u; mine = 0u;
#pragma unroll
        for (unsigned j = 0; j < 16; ++j) { const unsigned c = xb_ld(&bar[XB_XCNT(j)]); sum += c; cnt += (c > 0u) ? 1u : 0u; mine = (j == x) ? c : mine; }
        if (sum == G) break;
        __builtin_amdgcn_s_sleep(1);
        if ((++sp & 255u) == 0u) { if (xb_ld(&bar[XB_TMO])) break; if (sp > XB_SPIN_CAP) { atomicAdd(&bar[XB_TMO], 1u); break; } }
    }
    nloc = mine > 0u ? mine : 1u; nx = cnt > 0u ? cnt : 1u;
}
DI void xcd_barrier(const XcdBarrier& b) {
    asm volatile("s_waitcnt vmcnt(0)" ::: "memory");
    __syncthreads();
    if (tid_opaque() == 0) {
        unsigned* bar = b.bar;
        __builtin_amdgcn_s_waitcnt(0);
        unsigned nloc = b.st[0], nx = b.st[1];
        if (nloc == 0u) { xcd_barrier_complete(bar, b.x, nloc, nx); b.st[0] = nloc; b.st[1] = nx; }
        const unsigned old = xb_add(&bar[XB_XSUB(b.x)], 1u);
        const unsigned gen = old / nloc;
        if (old + 1u == (gen + 1u) * nloc) {
            __builtin_amdgcn_fence(__ATOMIC_RELEASE, "agent");
            asm volatile("s_waitcnt vmcnt(0)" ::: "memory");
            const unsigned og = xb_add(&bar[XB_TOP], 1u);
            const unsigned tg = og / nx;
            if (og + 1u == (tg + 1u) * nx) xb_add(&bar[XB_TOPGEN], 1u);
            else XB_SPIN(xb_ld(&bar[XB_TOPGEN]) == tg, bar);
            __builtin_amdgcn_fence(__ATOMIC_ACQUIRE, "agent");
            xb_add(&bar[XB_XGEN(b.x)], 1u);
            asm volatile("s_waitcnt vmcnt(0)" ::: "memory");
        } else {
            XB_SPIN(xb_ld(&bar[XB_XGEN(b.x)]) == gen, bar);
            __builtin_amdgcn_fence(__ATOMIC_ACQUIRE, "agent");
            asm volatile("s_waitcnt vmcnt(0)" ::: "memory");
        }
    }
    __syncthreads();
}

DI float xor32_sum(float x) {
    const unsigned u = __float_as_uint(x);
    const auto r = __builtin_amdgcn_permlane32_swap(u, u, false, false);
    return __uint_as_float(r[0]) + __uint_as_float(r[1]);
}
#define DPP_ADD(v, ctrl) ((v) + __uint_as_float((unsigned)__builtin_amdgcn_update_dpp(0, (int)__float_as_uint(v), (ctrl), 0xf, 0xf, true)))
DI float wave_sum(float v) {
    v = DPP_ADD(v, 0xB1);
    v = DPP_ADD(v, 0x4E);
    v = DPP_ADD(v, 0x141);
    v = DPP_ADD(v, 0x140);
    const unsigned u = __float_as_uint(v);
    return (__uint_as_float(__builtin_amdgcn_readlane(u, 0)) + __uint_as_float(__builtin_amdgcn_readlane(u, 16))) +
           (__uint_as_float(__builtin_amdgcn_readlane(u, 32)) + __uint_as_float(__builtin_amdgcn_readlane(u, 48)));
}
DI int crow(int i, int hh) { return (i & 3) + 8 * (i >> 2) + 4 * hh; }
DI int mod_row(int r) { return r < NL ? (r >> 13) : 2; }
DI float frcp(float x) { return __builtin_amdgcn_rcpf(x); }
DI float fexp(float x) { return __builtin_amdgcn_exp2f(x * 1.4426950408889634f); }
DI float sigmoidf_(float x) { return frcp(1.0f + fexp(-x)); }
DI float one_minus_exp(float x) {
    const float s = -x * (1.0f + x * 0.5f * (1.0f + x * (1.0f / 3.0f) * (1.0f + x * 0.25f * (1.0f + x * 0.2f * (1.0f + x * (1.0f / 6.0f))))));
    const float d = 1.0f - fexp(x);
    return x > -0.125f ? s : d;
}

template <class F>
DI void cvt_list(const Params& P, uchar* lds, int i0, int step, int n, F&& job_of) {
    const int tid = tid_opaque();
    float* tl = (float*)lds;
    f32x4 rv[2];
    auto tile_src = [&](int idx, int& j, int& mat, int& kt, int& nt) -> const float* {
        int t; job_of(idx, j, t);
        const int N = P.jobs[j].N, tn = N >> 6, per = (P.jobs[j].K >> 6) * tn; mat = t / per; t -= mat * per; kt = t / tn; nt = t - kt * tn;
        return P.jobs[j].src + (size_t)mat * P.jobs[j].sstride + (size_t)(kt * 64) * N + nt * 64;
    };
    int u = i0, j = 0, mat = 0, kt = 0, nt = 0;
    __syncthreads();
    if (u < n) { const float* src = tile_src(u, j, mat, kt, nt); const int N = P.jobs[j].N;
#pragma unroll
        for (int i = 0; i < 2; ++i) rv[i] = *(const f32x4*)(src + (size_t)((tid >> 4) + 32 * i) * N + (tid & 15) * 4); }
    for (; u < n; u += step) {
#pragma unroll
        for (int i = 0; i < 2; ++i) { float* q = tl + ((tid >> 4) + 32 * i) * 65 + (tid & 15) * 4; q[0] = rv[i][0]; q[1] = rv[i][1]; q[2] = rv[i][2]; q[3] = rv[i][3]; }
        const CvtJob J = P.jobs[j];
        const int cmat = mat, ckt = kt, cnt_ = nt;
        const int un = u + step;
        if (un < n) { const float* src = tile_src(un, j, mat, kt, nt); const int N = P.jobs[j].N;
#pragma unroll
            for (int i = 0; i < 2; ++i) rv[i] = *(const f32x4*)(src + (size_t)((tid >> 4) + 32 * i) * N + (tid & 15) * 4); }
        __syncthreads();
        const int n_ = tid >> 3, kc = tid & 7;
        float v[8];
#pragma unroll
        for (int e = 0; e < 8; ++e) v[e] = tl[(kc * 8 + e) * 65 + n_];
        const int ng = cnt_ * 64 + n_;
        const int drow = J.mode ? ((ng >> 5) * 64 + J.half * 32 + (ng & 31)) : ng;
        u16* d = J.dst + (size_t)cmat * J.dstride + (size_t)drow * J.lddst + ckt * 64 + kc * 8;
        u32x4 w; w.x = pk2(v[0], v[1]); w.y = pk2(v[2], v[3]); w.z = pk2(v[4], v[5]); w.w = pk2(v[6], v[7]);
        *(u32x4*)d = w;
        __syncthreads();
    }
}
constexpr int MOE_CVT_TILES = 6144;
DI void tail_cvt_dense(const Params& P, uchar* lds, int nunits, int lo, int hi) {
    const int G = gridDim.x, rem = nunits % G;
    int rank = blockIdx.x, nidle = G;
    if (rem != 0) { if ((int)blockIdx.x < rem) return; rank = blockIdx.x - rem; nidle = G - rem; }
    cvt_list(P, lds, lo + rank, nidle, hi, [&](int idx, int& j, int& t) {
        j = 0;
#pragma unroll
        for (int q = 1; q < 6; ++q) if (idx >= P.jobs[q].tile0) j = q;
        t = idx - P.jobs[j].tile0; });
}
DI void tail_cvt_moe(const Params& P, uchar* lds, int nunits, int layer, int lo, int hi) {
    const int G = gridDim.x, rem = nunits % G;
    int rank = blockIdx.x, nidle = G;
    if (rem != 0) { if ((int)blockIdx.x < rem) return; rank = blockIdx.x - rem; nidle = G - rem; }
    cvt_list(P, lds, lo + rank, nidle, hi, [&](int idx, int& j, int& t) { j = 6 + (idx >> 11); t = layer * 2048 + (idx & 2047); });
}

DI void phase_prep(const Params& P, const Ctx& p, uchar* lds) {
    const int tid = tid_opaque();
    float* tl = (float*)lds;
    {
        float* sc = tl;
        float* red = tl + 3072;
        for (int u = blockIdx.x; u < 192; u += gridDim.x) {
            __syncthreads();
            for (int i = tid; i < 3072; i += 512) { const int mr = i >> 10, d = i & 1023; const float c = mr < 2 ? inp(p, I_C)[mr * 1024 + d] : inp(p, I_CCTX)[d]; sc[i] = c * sigmoidf_(c); }
            __syncthreads();
            const int l = u / 96, nc = u % 96, c4 = tid & 15, dg = tid >> 4;
            const float* w = inp(p, I_ADAW) + (size_t)l * 1024 * 6144 + nc * 64 + c4 * 4;
            f32x4 a0 = (f32x4){0.f, 0.f, 0.f, 0.f}, a1 = a0, a2 = a0;
#pragma unroll 16
            for (int dd = 0; dd < 32; ++dd) {
                const int d = dg * 32 + dd; const f32x4 wv = *(const f32x4*)(w + (size_t)d * 6144);
                const float s0 = sc[d], s1 = sc[1024 + d], s2 = sc[2048 + d];
#pragma unroll
                for (int e = 0; e < 4; ++e) { a0[e] += s0 * wv[e]; a1[e] += s1 * wv[e]; a2[e] += s2 * wv[e]; }
            }
            *(f32x4*)(red + (dg * 3 + 0) * 64 + c4 * 4) = a0; *(f32x4*)(red + (dg * 3 + 1) * 64 + c4 * 4) = a1; *(f32x4*)(red + (dg * 3 + 2) * 64 + c4 * 4) = a2;
            __syncthreads();
            if (tid < 192) {
                const int mr = tid >> 6, nn = tid & 63; float s = 0.f;
#pragma unroll
                for (int g = 0; g < 32; ++g) s += red[(g * 3 + mr) * 64 + nn];
                const int ncol = nc * 64 + nn;
                ((float*)(p.ws + WS_MOD))[(l * 3 + mr) * 6144 + ncol] = s + inp(p, I_ADAB)[l * 6144 + ncol];
            }
        }
        __syncthreads();
    }
    cvt_list(P, lds, blockIdx.x, gridDim.x, P.jobs[1].tile0, [&](int idx, int& j, int& t) {
        j = 0;
#pragma unroll
        for (int q = 1; q < 6; ++q) if (idx >= P.jobs[q].tile0) j = q;
        t = idx - P.jobs[j].tile0; });
    for (int i = blockIdx.x * 512 + tid; i < SEQ * 32; i += gridDim.x * 512) {
        const int t = i >> 5, j = i & 31;
        const double pos = (double)(j < 16 ? (t >> 6) : (t & 63));
        const double inv = pow(10000.0, -(double)(j & 15) / 16.0);
        const double a = pos * inv;
        ((f32x2*)(p.ws + WS_ROPE))[i] = (f32x2){(float)cos(a), (float)sin(a)};
    }
}

DI void load_row16(const float* src, int lane, float (&v)[16]) {
#pragma unroll
    for (int j = 0; j < 4; ++j) { const f32x4 x = *(const f32x4*)(src + j * 256 + lane * 4); v[j * 4 + 0] = x[0]; v[j * 4 + 1] = x[1]; v[j * 4 + 2] = x[2]; v[j * 4 + 3] = x[3]; }
}
DI void norm_mod16(float (&v)[16], const float* g, const float* sh, const float* sc, int lane) {
    float ss = 0.f;
#pragma unroll
    for (int i = 0; i < 16; ++i) ss += v[i] * v[i];
    ss = wave_sum(ss);
    const float rstd = rsqrtf(ss * (1.0f / 1024.0f) + EPS);
#pragma unroll
    for (int j = 0; j < 4; ++j) {
        const int c = j * 256 + lane * 4;
        const f32x4 gg = *(const f32x4*)(g + c), s1 = *(const f32x4*)(sc + c), s0 = *(const f32x4*)(sh + c);
#pragma unroll
        for (int e = 0; e < 4; ++e) v[j * 4 + e] = (v[j * 4 + e] * rstd * gg[e]) * (1.0f + s1[e]) + s0[e];
    }
}
DI void store_row16_bf16(u16* dst, int lane, const float (&v)[16]) {
#pragma unroll
    for (int j = 0; j < 4; ++j) { u32x2 w; w.x = pk2(v[j * 4 + 0], v[j * 4 + 1]); w.y = pk2(v[j * 4 + 2], v[j * 4 + 3]); *(u32x2*)(dst + j * 256 + lane * 4) = w; }
}
DI const float* row_src(const Ctx& p, int layer, int r) {
    if (layer == 0) return r < NL ? inp(p, I_X) + (size_t)r * 1024 : inp(p, I_CTX) + (size_t)(r - NL) * 1024;
    return (const float*)(p.ws + WS_XS) + (size_t)r * 1024;
}
DI void phase_norm(const Ctx& p, int layer) {
    const int tid = tid_opaque(), lane = tid & 63, wv = blockIdx.x * 8 + (tid >> 6), nwv = gridDim.x * 8;
    const float* mod = (const float*)(p.ws + WS_MOD);
    u16* hb = (u16*)(p.ws + WS_HB);
    for (int r = wv; r < R; r += nwv) {
        float v[16];
        load_row16(row_src(p, layer, r), lane, v);
        const float* m = mod + (layer * 3 + mod_row(r)) * 6144;
        norm_mod16(v, inp(p, I_NMIX) + layer * 1024, m, m + 1024, lane);
        store_row16_bf16(hb + (size_t)r * 1024, lane, v);
    }
}
DI void phase_router(const Ctx& p, uchar* lds, int layer, int cnt_slot = -1) {
    const int tid = tid_opaque(), lane = tid & 63, wid = tid >> 6, wv = blockIdx.x * 8 + wid, nwv = gridDim.x * 8;
    const float* mod = (const float*)(p.ws + WS_MOD);
    u16* hb = (u16*)(p.ws + WS_HB);
    const float* xs = (const float*)(p.ws + WS_XS);
    const int nrows = layer == 0 ? R : NL;
    const float* wg = inp(p, I_MWGRP) + layer * 1024 * 4;
    const float* wr = inp(p, I_MWRT) + layer * 1024 * 16;
    const float* gnorm = inp(p, I_NFFN) + layer * 1024;
    int* cnt = (int*)(p.ws + WS_CTL + CTL_CNT) + (cnt_slot >= 0 ? cnt_slot : layer) * 1024;
    int* list = (int*)(p.ws + WS_LIST);
    f32x2* route = (f32x2*)(p.ws + WS_ROUTE);
    float* wrl = (float*)lds;
    float* wgl = wrl + 16384;
    float* hs = (float*)(lds + 81920 + wid * 8192);
    __syncthreads();
#pragma unroll
    for (int i = 0; i < 8; ++i) *(f32x4*)(wrl + (i * 512 + tid) * 4) = *(const f32x4*)(wr + (i * 512 + tid) * 4);
#pragma unroll
    for (int i = 0; i < 2; ++i) *(f32x4*)(wgl + (i * 512 + tid) * 4) = *(const f32x4*)(wg + (i * 512 + tid) * 4);
    __syncthreads();
    float bg[4], br[4];
#pragma unroll
    for (int o = 0; o < 4; ++o) { bg[o] = inp(p, I_MBGRP)[layer * 4 + o]; br[o] = inp(p, I_MBRT)[layer * 16 + (lane & 3) * 4 + o]; }
    for (int r0 = wv * 2; r0 < nrows; r0 += nwv * 2) {
        const float* m = mod + (layer * 3 + mod_row(r0)) * 6144;
        float v0[16], v1[16];
        load_row16(xs + (size_t)r0 * 1024, lane, v0);
        load_row16(xs + (size_t)(r0 + 1) * 1024, lane, v1);
        norm_mod16(v0, gnorm, m + 3 * 1024, m + 4 * 1024, lane);
        norm_mod16(v1, gnorm, m + 3 * 1024, m + 4 * 1024, lane);
        store_row16_bf16(hb + (size_t)r0 * 1024, lane, v0);
        store_row16_bf16(hb + (size_t)(r0 + 1) * 1024, lane, v1);
#pragma unroll
        for (int j = 0; j < 4; ++j) {
            *(f32x4*)(hs + (j * 256 + lane * 4) * 2) = (f32x4){v0[j * 4], v1[j * 4], v0[j * 4 + 1], v1[j * 4 + 1]};
            *(f32x4*)(hs + (j * 256 + lane * 4) * 2 + 4) = (f32x4){v0[j * 4 + 2], v1[j * 4 + 2], v0[j * 4 + 3], v1[j * 4 + 3]};
        }
        float ar[2][4], ag[2][4];
#pragma unroll
        for (int q = 0; q < 2; ++q)
#pragma unroll
            for (int o = 0; o < 4; ++o) { ar[q][o] = 0.f; ag[q][o] = 0.f; }
#pragma unroll 8
        for (int it = 0; it < 64; ++it) {
            const f32x4 w4 = *(const f32x4*)(wrl + (it * 64 + lane) * 4);
            const f32x2 x2 = *(const f32x2*)(hs + (it * 16 + (lane >> 2)) * 2);
#pragma unroll
            for (int o = 0; o < 4; ++o) { ar[0][o] += x2.x * w4[o]; ar[1][o] += x2.y * w4[o]; }
        }
#pragma unroll 8
        for (int it = 0; it < 16; ++it) {
            const f32x4 w4 = *(const f32x4*)(wgl + (it * 64 + lane) * 4);
            const f32x2 x2 = *(const f32x2*)(hs + (it * 64 + lane) * 2);
#pragma unroll
            for (int o = 0; o < 4; ++o) { ag[0][o] += x2.x * w4[o]; ag[1][o] += x2.y * w4[o]; }
        }
#pragma unroll
        for (int q = 0; q < 2; ++q)
#pragma unroll
            for (int o = 0; o < 4; ++o) {
                ag[q][o] = wave_sum(ag[q][o]);
                float v = ar[q][o]; v += __shfl_xor(v, 4); v += __shfl_xor(v, 8); v += __shfl_xor(v, 16); v = xor32_sum(v); ar[q][o] = v;
            }
#pragma unroll
        for (int q = 0; q < 2; ++q) {
            float gl[4];
#pragma unroll
            for (int o = 0; o < 4; ++o) gl[o] = ag[q][o] + bg[o];
            int gi = 0; float gm = gl[0];
#pragma unroll
            for (int o = 1; o < 4; ++o) if (gl[o] > gm) { gm = gl[o]; gi = o; }
            float gs = 0.f;
#pragma unroll
            for (int o = 0; o < 4; ++o) gs += __expf(gl[o] - gm);
            const float psel = 1.0f / gs;
            float el[4];
#pragma unroll
            for (int o = 0; o < 4; ++o) el[o] = __shfl(ar[q][o] + br[o], gi);
            int i1 = 0; float m1 = el[0];
#pragma unroll
            for (int o = 1; o < 4; ++o) if (el[o] > m1) { m1 = el[o]; i1 = o; }
            int i2 = -1; float m2 = -3.0e38f;
#pragma unroll
            for (int o = 0; o < 4; ++o) if (o != i1 && el[o] > m2) { m2 = el[o]; i2 = o; }
            if (lane == 0) {
                const int r = r0 + q;
                const float e2 = __expf(m2 - m1);
                const float w1 = psel / (1.0f + e2), w2 = psel * e2 / (1.0f + e2);
                const int lo = i1 < i2 ? i1 : i2, hi = i1 < i2 ? i2 : i1;
                const float wlo = i1 < i2 ? w1 : w2, whi = i1 < i2 ? w2 : w1;
                const int pi = lo == 0 ? (hi - 1) : (lo == 1 ? (hi + 1) : 5);
                const int bucket = gi * 6 + pi;
                const int pos = atomicAdd(cnt + bucket * 32, 1);
                list[(size_t)bucket * R + pos] = r;
                route[r] = (f32x2){wlo, whi};
            }
        }
    }
}

constexpr int LROW = 144;
constexpr int GEMM_A = 128 * 128, GEMM_B = 256 * 128, GEMM_STAGE = GEMM_A + GEMM_B;
constexpr int EPI_PITCH = 272, EPI_WAVE = 64 * EPI_PITCH;
static_assert(8 * EPI_WAVE <= 3 * GEMM_STAGE, "epilogue strips overlay the GEMM stages");
#define WAIT_V(n) asm volatile("s_waitcnt vmcnt(%0)" ::"n"(n) : "memory")
#define WAIT_L(n) asm volatile("s_waitcnt lgkmcnt(%0)" ::"n"(n) : "memory")
#define RAW_BARRIER() do { WAIT_L(0); __builtin_amdgcn_s_barrier(); } while (0)

template <class Epi>
DI void gemm_tile(uchar* lds, const u16* a0, const u16* a1, const u16* b0, const u16* b1, const u16* b2, const u16* b3, int nk, int ksplit, long bjump, Epi&& epi) {
    const int tid = tid_opaque(), lane = tid & 63, wid = tid >> 6, wr = wid >> 2, wc = wid & 3, l31 = lane & 31, hh = lane >> 5;
    const int lch = (lane & 7) ^ ((((wid & 1) << 3) + (lane >> 3)) >> 1);
    a0 += lch * 8; a1 += lch * 8; b0 += lch * 8; b1 += lch * 8; b2 += lch * 8; b3 += lch * 8;
    const unsigned pw = (unsigned)__builtin_amdgcn_readfirstlane(wid) * 1024u;
    const int sw = (l31 >> 1) & 7;
    unsigned xo[4];
#pragma unroll
    for (int ks = 0; ks < 4; ++ks) xo[ks] = (unsigned)(((ks * 2 + hh) ^ sw) << 4);
    const unsigned aro = (unsigned)((wr * 64 + l31) * 128), bro = (unsigned)(GEMM_A + (wc * 64 + l31) * 128);
    f32x16 acc[2][2];
#pragma unroll
    for (int a = 0; a < 2; ++a)
#pragma unroll
        for (int b = 0; b < 2; ++b)
#pragma unroll
            for (int i = 0; i < 16; ++i) acc[a][b][i] = 0.f;
#define GEMM_DMA(st_, kt_) do { const int kq_ = (kt_); const long bo_ = (long)kq_ * 64 + (kq_ >= ksplit ? bjump : 0); uchar* s_ = lds + (st_) * GEMM_STAGE + pw; \
        __builtin_amdgcn_global_load_lds((const unsigned*)(a0 + kq_ * 64), (LAS unsigned*)(s_), 16, 0, 0); \
        __builtin_amdgcn_global_load_lds((const unsigned*)(a1 + kq_ * 64), (LAS unsigned*)(s_ + 8192), 16, 0, 0); \
        __builtin_amdgcn_global_load_lds((const unsigned*)(b0 + bo_), (LAS unsigned*)(s_ + GEMM_A), 16, 0, 0); \
        __builtin_amdgcn_global_load_lds((const unsigned*)(b1 + bo_), (LAS unsigned*)(s_ + GEMM_A + 8192), 16, 0, 0); \
        __builtin_amdgcn_global_load_lds((const unsigned*)(b2 + bo_), (LAS unsigned*)(s_ + GEMM_A + 16384), 16, 0, 0); \
        __builtin_amdgcn_global_load_lds((const unsigned*)(b3 + bo_), (LAS unsigned*)(s_ + GEMM_A + 24576), 16, 0, 0); } while (0)
    RAW_BARRIER();
    GEMM_DMA(0, 0); GEMM_DMA(1, 1);
    WAIT_V(6);
    RAW_BARRIER();
    int cur = 0;
#pragma unroll 1
    for (int kt = 0; kt < nk; ++kt) {
        const int nxt = cur == 0 ? 2 : cur - 1;
        if (kt + 2 < nk) GEMM_DMA(nxt, kt + 2);
        const uchar* s = lds + cur * GEMM_STAGE;
#pragma unroll
        for (int ks = 0; ks < 4; ++ks) {
            const bf16x8 fa0 = *(const bf16x8*)(s + aro + xo[ks]), fa1 = *(const bf16x8*)(s + aro + 4096 + xo[ks]);
            const bf16x8 fb0 = *(const bf16x8*)(s + bro + xo[ks]), fb1 = *(const bf16x8*)(s + bro + 4096 + xo[ks]);
            acc[0][0] = MFMA32(fb0, fa0, acc[0][0]); acc[0][1] = MFMA32(fb0, fa1, acc[0][1]);
            acc[1][0] = MFMA32(fb1, fa0, acc[1][0]); acc[1][1] = MFMA32(fb1, fa1, acc[1][1]);
        }
        if (kt + 2 < nk) WAIT_V(6); else WAIT_V(0);
        RAW_BARRIER();
        cur = cur == 2 ? 0 : cur + 1;
    }
#if PROBE_GEMM2X == 1
    {
        f32x16 d[2][2];
        for (int a = 0; a < 2; ++a) for (int b = 0; b < 2; ++b) for (int i = 0; i < 16; ++i) d[a][b][i] = 0.f;
        RAW_BARRIER(); GEMM_DMA(0, 0); GEMM_DMA(1, 1); WAIT_V(6); RAW_BARRIER();
        int cur2 = 0;
#pragma unroll 1
        for (int kt = 0; kt < nk; ++kt) {
            const int nxt = cur2 == 0 ? 2 : cur2 - 1;
            if (kt + 2 < nk) GEMM_DMA(nxt, kt + 2);
            const uchar* s = lds + cur2 * GEMM_STAGE;
#pragma unroll
            for (int ks = 0; ks < 4; ++ks) {
                const bf16x8 fa0 = *(const bf16x8*)(s + aro + xo[ks]), fa1 = *(const bf16x8*)(s + aro + 4096 + xo[ks]);
                const bf16x8 fb0 = *(const bf16x8*)(s + bro + xo[ks]), fb1 = *(const bf16x8*)(s + bro + 4096 + xo[ks]);
                d[0][0] = MFMA32(fb0, fa0, d[0][0]); d[0][1] = MFMA32(fb0, fa1, d[0][1]);
                d[1][0] = MFMA32(fb1, fa0, d[1][0]); d[1][1] = MFMA32(fb1, fa1, d[1][1]);
            }
            if (kt + 2 < nk) WAIT_V(6); else WAIT_V(0);
            RAW_BARRIER();
            cur2 = cur2 == 2 ? 0 : cur2 + 1;
        }
        asm volatile("" :: "v"(d[0][0]), "v"(d[0][1]), "v"(d[1][0]), "v"(d[1][1]));
    }
#elif PROBE_GEMM2X == 2
    {
        f32x4 d[4][4];
        for (int a = 0; a < 4; ++a) for (int b = 0; b < 4; ++b) d[a][b] = (f32x4){0.f, 0.f, 0.f, 0.f};
        RAW_BARRIER(); GEMM_DMA(0, 0); GEMM_DMA(1, 1); WAIT_V(6); RAW_BARRIER();
        int cur2 = 0;
#pragma unroll 1
        for (int kt = 0; kt < nk; ++kt) {
            const int nxt = cur2 == 0 ? 2 : cur2 - 1;
            if (kt + 2 < nk) GEMM_DMA(nxt, kt + 2);
            const uchar* s = lds + cur2 * GEMM_STAGE;
#pragma unroll
            for (int kp = 0; kp < 2; ++kp) {
                bf16x8 fa[4], fb[4];
                fa[0] = *(const bf16x8*)(s + aro + xo[2 * kp]); fa[1] = *(const bf16x8*)(s + aro + 4096 + xo[2 * kp]); fa[2] = *(const bf16x8*)(s + aro + xo[2 * kp + 1]); fa[3] = *(const bf16x8*)(s + aro + 4096 + xo[2 * kp + 1]);
                fb[0] = *(const bf16x8*)(s + bro + xo[2 * kp]); fb[1] = *(const bf16x8*)(s + bro + 4096 + xo[2 * kp]); fb[2] = *(const bf16x8*)(s + bro + xo[2 * kp + 1]); fb[3] = *(const bf16x8*)(s + bro + 4096 + xo[2 * kp + 1]);
#pragma unroll
                for (int a = 0; a < 4; ++a)
#pragma unroll
                    for (int b = 0; b < 4; ++b) d[a][b] = __builtin_amdgcn_mfma_f32_16x16x32_bf16(fb[b], fa[a], d[a][b], 0, 0, 0);
            }
            if (kt + 2 < nk) WAIT_V(6); else WAIT_V(0);
            RAW_BARRIER();
            cur2 = cur2 == 2 ? 0 : cur2 + 1;
        }
        asm volatile("" :: "v"(d[0][0]), "v"(d[0][1]), "v"(d[0][2]), "v"(d[0][3]), "v"(d[1][0]), "v"(d[1][1]), "v"(d[1][2]), "v"(d[1][3]));
        asm volatile("" :: "v"(d[2][0]), "v"(d[2][1]), "v"(d[2][2]), "v"(d[2][3]), "v"(d[3][0]), "v"(d[3][1]), "v"(d[3][2]), "v"(d[3][3]));
    }
#endif
    epi(acc, wr * 64, wc, lane, lds + wid * EPI_WAVE);
}

constexpr int G2_A = 256 * 64, G2_STAGE = 2 * G2_A;
template <class Epi>
DI void gemm_tile256(uchar* lds, const u16* a0, const u16* a1, const u16* b0, const u16* b1, int nk, int ksplit, long bjump, Epi&& epi) {
    const int tid = tid_opaque(), lane = tid & 63, wid = tid >> 6, wr = wid >> 2, wc = wid & 3, l31 = lane & 31, hh = lane >> 5;
    const int lch = (lane & 3) ^ ((lane >> 4) & 3);
    a0 += lch * 8; a1 += lch * 8; b0 += lch * 8; b1 += lch * 8;
    const unsigned pw = (unsigned)__builtin_amdgcn_readfirstlane(wid) * 1024u;
    const int sw = (l31 >> 2) & 3;
    const unsigned xo0 = (unsigned)(((0 + hh) ^ sw) << 4), xo1 = (unsigned)(((2 + hh) ^ sw) << 4);
    const unsigned aro = (unsigned)((wr * 128 + l31) * 64), bro = (unsigned)(G2_A + (wc * 64 + l31) * 64);
    f32x16 acc[2][4];
#pragma unroll
    for (int a = 0; a < 2; ++a)
#pragma unroll
        for (int b = 0; b < 4; ++b)
#pragma unroll
            for (int i = 0; i < 16; ++i) acc[a][b][i] = 0.f;
#define G2_DMA(st_, kt_) do { const int kq_ = (kt_); const long bo_ = (long)kq_ * 32 + (kq_ >= ksplit ? bjump : 0); uchar* s_ = lds + (st_) * G2_STAGE + pw; \
        __builtin_amdgcn_global_load_lds((const unsigned*)(a0 + kq_ * 32), (LAS unsigned*)(s_), 16, 0, 0); \
        __builtin_amdgcn_global_load_lds((const unsigned*)(a1 + kq_ * 32), (LAS unsigned*)(s_ + 8192), 16, 0, 0); \
        __builtin_amdgcn_global_load_lds((const unsigned*)(b0 + bo_), (LAS unsigned*)(s_ + G2_A), 16, 0, 0); \
        __builtin_amdgcn_global_load_lds((const unsigned*)(b1 + bo_), (LAS unsigned*)(s_ + G2_A + 8192), 16, 0, 0); } while (0)
    RAW_BARRIER();
    G2_DMA(0, 0); G2_DMA(1, 1); G2_DMA(2, 2);
    WAIT_V(8);
    RAW_BARRIER();
#pragma unroll 1
    for (int kt = 0; kt < nk; ++kt) {
        if (kt + 3 < nk) G2_DMA((kt + 3) & 3, kt + 3);
        const uchar* s = lds + (kt & 3) * G2_STAGE;
#pragma unroll
        for (int ks = 0; ks < 2; ++ks) {
            const unsigned xo = ks ? xo1 : xo0;
            bf16x8 fa[4], fb[2];
#pragma unroll
            for (int mb = 0; mb < 4; ++mb) fa[mb] = *(const bf16x8*)(s + aro + mb * 2048 + xo);
#pragma unroll
            for (int nb = 0; nb < 2; ++nb) fb[nb] = *(const bf16x8*)(s + bro + nb * 2048 + xo);
#pragma unroll
            for (int nb = 0; nb < 2; ++nb)
#pragma unroll
                for (int mb = 0; mb < 4; ++mb) acc[nb][mb] = MFMA32(fb[nb], fa[mb], acc[nb][mb]);
        }
        if (kt + 3 < nk) WAIT_V(8); else if (kt + 2 < nk) WAIT_V(4); else WAIT_V(0);
        RAW_BARRIER();
    }
#pragma unroll
    for (int half = 0; half < 2; ++half) {
        f32x16 t[2][2];
#pragma unroll
        for (int nb = 0; nb < 2; ++nb)
#pragma unroll
            for (int mb = 0; mb < 2; ++mb) t[nb][mb] = acc[nb][2 * half + mb];
        epi(t, wr * 128 + half * 64, wc, lane, lds + wid * EPI_WAVE);
    }
}

DI void epi_put4(uchar* w, int row, int col, float a, float b, float c, float d) { *(f32x4*)(w + row * EPI_PITCH + col * 4) = (f32x4){a, b, c, d}; }
DI void epi_stage(uchar* w, const f32x16 (&acc)[2][2], int l31, int hh) {
#pragma unroll
    for (int mb = 0; mb < 2; ++mb)
#pragma unroll
        for (int nb = 0; nb < 2; ++nb)
#pragma unroll
            for (int g = 0; g < 4; ++g) epi_put4(w, mb * 32 + l31, nb * 32 + 8 * g + 4 * hh, acc[nb][mb][4 * g], acc[nb][mb][4 * g + 1], acc[nb][mb][4 * g + 2], acc[nb][mb][4 * g + 3]);
}
template <class F> DI void epi_rows4(const uchar* w, int lane, F&& f) {
#pragma unroll
    for (int it = 0; it < 16; ++it) { const int row = it * 4 + (lane >> 4), col = (lane & 15) * 4; f(row, col, *(const f32x4*)(w + row * EPI_PITCH + col * 4)); }
}
template <int NC, class F> DI void epi_rows8(const uchar* w, int lane, F&& f) {
    constexpr int LPR = NC / 8, RPI = 64 / LPR;
#pragma unroll
    for (int it = 0; it < 64 / RPI; ++it) { const int row = it * RPI + lane / LPR, col = (lane % LPR) * 8; f(row, col, *(const f32x4*)(w + row * EPI_PITCH + col * 4), *(const f32x4*)(w + row * EPI_PITCH + col * 4 + 16)); }
}
DI u32x4 pack8(const f32x4& a, const f32x4& b) { u32x4 r; r.x = pk2(a[0], a[1]); r.y = pk2(a[2], a[3]); r.z = pk2(b[0], b[1]); r.w = pk2(b[2], b[3]); return r; }

#define MFMA16(a, b, c) __builtin_amdgcn_mfma_f32_16x16x32_bf16((a), (b), (c), 0, 0, 0)
constexpr int P8_HT = 16384;
DI void p8_rc(int tid, int& r0, int& c) { const int wid = tid >> 6, lane = tid & 63; r0 = (wid >> 1) * 16 + (lane >> 2); c = (wid & 1) * 32 + (((lane & 3) ^ ((lane >> 5) << 1)) << 3); }
DI void glds16(const uchar* g, uchar* s) { __builtin_amdgcn_global_load_lds((const unsigned*)g, (LAS unsigned*)s, 16, 0, 0); }
template <class Epi>
DI void gemm_tile8p(uchar* lds, const uchar* abase, unsigned a0_0, unsigned a1_0, unsigned a0_1, unsigned a1_1, int ac1_0, int ac0_1, int ac1_1,
                    const uchar* bbase, unsigned bo, int bc1_0, int bc0_1, int bc1_1, int nk, int ksplit, long bjump, Epi&& epi) {
    constexpr int ac0_0 = 0, bc0_0 = 0;
    const int tid = tid_opaque(), lane = tid & 63, wid = tid >> 6, wr = wid >> 2, wc = wid & 3, fr = lane & 15, fq = lane >> 4;
    const unsigned pw = (unsigned)__builtin_amdgcn_readfirstlane(wid) * 1024u;
    const unsigned lp = (unsigned)((fr * 64 + fq * 16) ^ ((fr >> 3) << 5));
    const unsigned la = (unsigned)wr * 8192u + lp, lb = (unsigned)wc * 4096u + lp;
    f32x4 acc[2][2][4][2];
#pragma unroll
    for (int a = 0; a < 2; ++a)
#pragma unroll
        for (int b = 0; b < 2; ++b)
#pragma unroll
            for (int m = 0; m < 4; ++m)
#pragma unroll
                for (int n = 0; n < 2; ++n) acc[a][b][m][n] = (f32x4){0.f, 0.f, 0.f, 0.f};
    bf16x8 At[4][2], B0[2][2], B1[2][2];
#define P8_SA(b, h) (((b) * 2 + (h)) * P8_HT)
#define P8_SB(b, h) ((4 + (b) * 2 + (h)) * P8_HT)
#define P8_STAGE_A(b, h, kt) do { const uchar* g_ = abase + (size_t)(kt) * 128; uchar* s_ = lds + P8_SA(b, h) + pw; glds16(g_ + ac0_##h + a0_##h, s_); glds16(g_ + ac1_##h + a1_##h, s_ + 8192); } while (0)
#define P8_STAGE_B(b, h, kt) do { const int kq_ = (kt); const uchar* g_ = bbase + (size_t)kq_ * 128 + (kq_ >= ksplit ? bjump : 0); uchar* s_ = lds + P8_SB(b, h) + pw; glds16(g_ + bc0_##h + bo, s_); glds16(g_ + bc1_##h + bo, s_ + 8192); } while (0)
#define P8_LDA(dst, b, h) do { _Pragma("unroll") for (int m = 0; m < 4; ++m) { _Pragma("unroll") for (int k = 0; k < 2; ++k) dst[m][k] = *(const bf16x8*)(lds + P8_SA(b, h) + la + (m * 2 + k) * 1024); } } while (0)
#define P8_LDB(dst, b, h) do { _Pragma("unroll") for (int n = 0; n < 2; ++n) { _Pragma("unroll") for (int k = 0; k < 2; ++k) dst[n][k] = *(const bf16x8*)(lds + P8_SB(b, h) + lb + (n * 2 + k) * 1024); } } while (0)
#define P8_MMA(ai, bj, Bx) do { __builtin_amdgcn_s_setprio(1); \
        _Pragma("unroll") for (int m = 0; m < 4; ++m) { _Pragma("unroll") for (int n = 0; n < 2; ++n) { _Pragma("unroll") for (int k = 0; k < 2; ++k) acc[ai][bj][m][n] = MFMA16(Bx[n][k], At[m][k], acc[ai][bj][m][n]); } } \
        __builtin_amdgcn_s_setprio(0); } while (0)
#define P8_BAR() __builtin_amdgcn_s_barrier()
#define P8_SCHED() __builtin_amdgcn_sched_barrier(0)
    RAW_BARRIER();
    P8_STAGE_B(0, 0, 0); P8_STAGE_A(0, 0, 0); P8_STAGE_B(0, 1, 0); P8_STAGE_A(0, 1, 0);
    if (wr == 1) P8_BAR();
    WAIT_V(4); P8_BAR();
    P8_STAGE_B(1, 0, 1); P8_STAGE_A(1, 0, 1); P8_STAGE_B(1, 1, 1);
    WAIT_V(6); P8_BAR();
#pragma unroll 1
    for (int t = 0; t < nk - 2; t += 2) {
        P8_LDB(B0, 0, 0); P8_SCHED(); P8_LDA(At, 0, 0); P8_STAGE_A(1, 1, t + 1);
        WAIT_L(8); P8_BAR(); WAIT_L(0); P8_MMA(0, 0, B0); P8_BAR(); P8_SCHED();
        P8_LDB(B1, 0, 1); P8_STAGE_B(0, 0, t + 2);
        P8_BAR(); WAIT_L(0); P8_MMA(0, 1, B1); P8_BAR();
        P8_LDA(At, 0, 1); P8_STAGE_A(0, 0, t + 2);
        P8_BAR(); WAIT_L(0); P8_MMA(1, 0, B0); P8_BAR(); P8_SCHED();
        P8_STAGE_B(0, 1, t + 2);
        WAIT_V(6); P8_BAR(); P8_MMA(1, 1, B1); P8_BAR();
        P8_LDB(B0, 1, 0); P8_SCHED(); P8_LDA(At, 1, 0); P8_STAGE_A(0, 1, t + 2);
        WAIT_L(8); P8_BAR(); WAIT_L(0); P8_MMA(0, 0, B0); P8_BAR(); P8_SCHED();
        P8_LDB(B1, 1, 1); P8_STAGE_B(1, 0, t + 3);
        P8_BAR(); WAIT_L(0); P8_MMA(0, 1, B1); P8_BAR();
        P8_LDA(At, 1, 1); P8_STAGE_A(1, 0, t + 3);
        P8_BAR(); WAIT_L(0); P8_MMA(1, 0, B0); P8_BAR(); P8_SCHED();
        P8_STAGE_B(1, 1, t + 3);
        WAIT_V(6); P8_BAR(); P8_MMA(1, 1, B1); P8_BAR();
    }
    {
        P8_LDB(B0, 0, 0); P8_LDA(At, 0, 0); P8_STAGE_A(1, 1, nk - 1);
        P8_BAR(); WAIT_L(0); P8_MMA(0, 0, B0); P8_BAR();
        P8_LDB(B1, 0, 1); P8_BAR(); WAIT_L(0); P8_MMA(0, 1, B1); P8_BAR();
        P8_LDA(At, 0, 1); WAIT_V(4); P8_BAR(); WAIT_L(0); P8_MMA(1, 0, B0); P8_MMA(1, 1, B1); P8_BAR();
    }
    {
        P8_LDB(B0, 1, 0); P8_LDA(At, 1, 0); WAIT_V(2); P8_BAR(); WAIT_L(0); P8_MMA(0, 0, B0); P8_BAR();
        P8_LDB(B1, 1, 1); WAIT_V(0); P8_BAR(); WAIT_L(0); P8_MMA(0, 1, B1); P8_BAR();
        P8_LDA(At, 1, 1); P8_BAR(); WAIT_L(0); P8_MMA(1, 0, B0); P8_MMA(1, 1, B1); P8_BAR();
    }
    if (wr == 0) P8_BAR();
    RAW_BARRIER();
    uchar* w = lds + wid * EPI_WAVE;
#pragma unroll
    for (int ai = 0; ai < 2; ++ai) {
#pragma unroll
        for (int bj = 0; bj < 2; ++bj)
#pragma unroll
            for (int m = 0; m < 4; ++m)
#pragma unroll
                for (int n = 0; n < 2; ++n) *(f32x4*)(w + (m * 16 + fr) * EPI_PITCH + (bj * 32 + n * 16 + fq * 4) * 4) = acc[ai][bj][m][n];
        epi(wr * 128 + ai * 64, wc, lane, w);
    }
}
DI void epi_unstage(const uchar* w, f32x16 (&t)[2][2], int l31, int hh) {
#pragma unroll
    for (int mb = 0; mb < 2; ++mb)
#pragma unroll
        for (int nb = 0; nb < 2; ++nb)
#pragma unroll
            for (int g = 0; g < 4; ++g) { const f32x4 v = *(const f32x4*)(w + (mb * 32 + l31) * EPI_PITCH + (nb * 32 + 8 * g + 4 * hh) * 4); t[nb][mb][4 * g] = v[0]; t[nb][mb][4 * g + 1] = v[1]; t[nb][mb][4 * g + 2] = v[2]; t[nb][mb][4 * g + 3] = v[3]; }
}

DI void rect_unit(int v, int MT, int NT, int& mt, int& nt) {
    if (gridDim.x != 256) { mt = v / NT; nt = v % NT; return; }
    const int r = v >> 8, b = v & 255, x = b & 7, y = b >> 3;
    const int q = r * 8 + x, nqn = NT >> 2, qm = q / nqn, qn = q - qm * nqn;
    mt = qm * 8 + (y & 7); nt = qn * 4 + (y >> 3);
}
DI void phase_inproj0(const Params& P, const Ctx& p, uchar* lds) {
    const int tid = tid_opaque();
    const u16* hb = (const u16*)(p.ws + WS_HB);
    const u16* w = (const u16*)(p.ws + WS_WIN0);
    u16* zc = (u16*)(p.ws + WS_REGA + RA_ZC);
    u16* qa = (u16*)(p.ws + WS_REGA + RA_Q);
    u16* ka = (u16*)(p.ws + WS_REGA + RA_K);
    u16* vt = (u16*)(p.ws + WS_REGA + RA_VT);
    const f32x2* rope = (const f32x2*)(p.ws + WS_ROPE);
    const int rs = tid >> 3;
    for (int u = blockIdx.x; u < 768 + 48; u += gridDim.x) {
        const bool big = u < 768;
        int mt, nt; if (big) rect_unit(u, 64, 12, mt, nt); else { mt = (u - 768) / 12; nt = (u - 768) % 12; }
        const int m0 = big ? mt * 256 : NL + mt * 128, n0 = nt * 256;
        auto epi =
            [&](f32x16 (&acc)[2][2], int roff, int wc, int lane, uchar* w) {
                const int l31 = lane & 31, hh = lane >> 5, nw = n0 + wc * 64;
                const int row0 = m0 + roff;
                int b, spos0; if (row0 < NL) { b = row0 >> 13; spos0 = row0 & 8191; } else { b = (row0 - NL) >> 8; spos0 = SEQ + ((row0 - NL) & 255); }
                if (nw < 1536) {
                    epi_stage(w, acc, l31, hh);
                    epi_rows8<64>(w, lane, [&](int row, int col, const f32x4& v0, const f32x4& v1) { *(u32x4*)(zc + (size_t)(row0 + row) * 1536 + nw + col) = pack8(v0, v1); });
                } else if (nw < 2560) {
                    const bool isq = nw < 2048;
                    const int cg = (nw - (isq ? 1536 : 2048)) >> 6, head = cg >> 1, map = cg & 1;
                    const float* gain = isq ? inp(p, I_QN) : inp(p, I_KN);
                    const float osc = isq ? QSCALE : 1.0f;
#pragma unroll
                    for (int mb = 0; mb < 2; ++mb) {
                        float ss = 0.f;
#pragma unroll
                        for (int nb = 0; nb < 2; ++nb)
#pragma unroll
                            for (int i = 0; i < 16; ++i) ss += acc[nb][mb][i] * acc[nb][mb][i];
                        ss = xor32_sum(ss);
                        const float rstd = rsqrtf(ss * (1.0f / 64.0f) + EPS);
                        const int spos = spos0 + mb * 32 + l31;
#pragma unroll
                        for (int g = 0; g < 4; ++g) {
                            const int d0 = 8 * g + 4 * hh;
                            const f32x4 g1v = *(const f32x4*)(gain + d0), g2v = *(const f32x4*)(gain + 32 + d0);
                            f32x4 csa = (f32x4){1.f, 0.f, 1.f, 0.f}, csb = csa;
                            if (row0 < NL) { csa = *(const f32x4*)((const float*)(rope + spos * 32 + d0)); csb = *(const f32x4*)((const float*)(rope + spos * 32 + d0 + 2)); }
                            float o1[4], o2[4];
#pragma unroll
                            for (int e = 0; e < 4; ++e) {
                                const float v1 = acc[0][mb][4 * g + e] * rstd * g1v[e], v2 = acc[1][mb][4 * g + e] * rstd * g2v[e];
                                const float cs = e < 2 ? csa[2 * e] : csb[2 * (e - 2)], sn = e < 2 ? csa[2 * e + 1] : csb[2 * (e - 2) + 1];
                                o1[e] = (v1 * cs - v2 * sn) * osc; o2[e] = (v2 * cs + v1 * sn) * osc;
                            }
                            epi_put4(w, mb * 32 + l31, d0, o1[0], o1[1], o1[2], o1[3]);
                            epi_put4(w, mb * 32 + l31, 32 + d0, o2[0], o2[1], o2[2], o2[3]);
                        }
                    }
                    u16* dst = (isq ? qa : ka) + ((size_t)(((b * 4 + head) * 2 + map)) * SK + spos0) * 64;
                    epi_rows8<64>(w, lane, [&](int row, int col, const f32x4& v0, const f32x4& v1) { *(u32x4*)(dst + (size_t)row * 64 + col) = pack8(v0, v1); });
                } else {
                    const int head = (nw - 2560) >> 7, vb0 = (nw - 2560) & 127;
#pragma unroll
                    for (int mb = 0; mb < 2; ++mb) {
                        const int tok = mb * 32 + l31, tp = (tok & ~12) | (((tok >> 3) & 1) << 2) | (((tok >> 2) & 1) << 3);
#pragma unroll
                        for (int nb = 0; nb < 2; ++nb)
#pragma unroll
                            for (int i = 0; i < 16; ++i) *(u16*)(w + (nb * 32 + crow(i, hh)) * 144 + tp * 2) = f2b(acc[nb][mb][i]);
                    }
                    u16* dst = vt + ((size_t)(b * 4 + head) * 128 + vb0) * SK + spos0;
#pragma unroll
                    for (int it = 0; it < 8; ++it) { const int v = it * 8 + (lane >> 3), c8 = lane & 7; *(u32x4*)(dst + (size_t)v * SK + c8 * 8) = *(const u32x4*)(w + v * 144 + c8 * 16); }
                }
            };
        if (big) {
            int r0, c; p8_rc(tid, r0, c);
            const unsigned ao = (unsigned)(r0 * 2048 + c * 2), bo = (unsigned)((((r0 >> 5) * 64 + (r0 & 31)) * 2048) + c * 2);
            gemm_tile8p(lds, (const uchar*)(hb + (size_t)m0 * 1024), ao, ao, ao, ao, 128 * 2048, 64 * 2048, 192 * 2048,
                        (const uchar*)(w + (size_t)n0 * 1024), bo, 128 * 2048, 32 * 2048, 160 * 2048, 16, 1 << 30, 0,
                        [&](int roff, int wc, int lane, uchar* w) {
                            const int nw = n0 + wc * 64;
                            if (nw < 1536) { const int row0 = m0 + roff; epi_rows8<64>(w, lane, [&](int row, int col, const f32x4& v0, const f32x4& v1) { *(u32x4*)(zc + (size_t)(row0 + row) * 1536 + nw + col) = pack8(v0, v1); }); }
                            else { f32x16 t[2][2]; epi_unstage(w, t, lane & 31, lane >> 5); epi(t, roff, wc, lane, w); } });
        } else {
            const u16* ab = hb + (size_t)(m0 + rs) * 1024;
            const u16* bb = w + (size_t)(n0 + rs) * 1024;
            gemm_tile(lds, ab, ab + 64 * 1024, bb, bb + 64 * 1024, bb + 128 * 1024, bb + 192 * 1024, 16, 1 << 30, 0, epi);
        }
    }
    tail_cvt_moe(P, lds, 768 + 48, 0, 0, MOE_CVT_TILES / 2);
    tail_cvt_dense(P, lds, 768 + 48, P.jobs[1].tile0, P.jobs[2].tile0);
}

constexpr int ATT_K = 64 * 128, ATT_V = 128 * 128;
constexpr int ATT_STAGE = 2 * ATT_K + ATT_V;
DI void attn_unit(const Ctx& p, uchar* lds, int bh, int q0, int key0, int ntile, int out_row0) {
    const int tid = tid_opaque();
    const int lane = tid & 63, wid = tid >> 6, l31 = lane & 31, hh = lane >> 5, m = wid >> 2, g = wid & 3;
    const u16* qa = (const u16*)(p.ws + WS_REGA + RA_Q);
    const u16* ka = (const u16*)(p.ws + WS_REGA + RA_K);
    const u16* vt = (const u16*)(p.ws + WS_REGA + RA_VT);
    uchar* qs = lds + 2 * ATT_STAGE + wid * 8192 + lane * 16;
    RAW_BARRIER();
    {
        const u16* qp = qa + ((size_t)(bh * 2 + m) * SK + q0 + g * 64 + l31) * 64 + hh * 8;
#pragma unroll
        for (int rg = 0; rg < 2; ++rg)
#pragma unroll
            for (int ks = 0; ks < 4; ++ks) *(bf16x8*)(qs + (rg * 4 + ks) * 1024) = *(const bf16x8*)(qp + rg * 32 * 64 + ks * 16);
    }
    const int lch = (lane & 7) ^ ((((wid & 1) << 3) + (lane >> 3)) >> 1);
    const u16* kp = ka + ((size_t)(bh * 2) * SK + key0 + wid * 8 + (lane >> 3)) * 64 + lch * 8;
    const u16* vp = vt + ((size_t)bh * 128 + wid * 8 + (lane >> 3)) * SK + key0 + lch * 8;
    const unsigned pw = (unsigned)__builtin_amdgcn_readfirstlane(wid) * 1024u;
    const int sw = (l31 >> 1) & 7;
    unsigned xo[4];
#pragma unroll
    for (int ks = 0; ks < 4; ++ks) xo[ks] = (unsigned)(((ks * 2 + hh) ^ sw) << 4);
    const unsigned kro = (unsigned)(m * ATT_K + l31 * 128), vro = (unsigned)(2 * ATT_K + l31 * 128);
    f32x16 O[2][4];
#pragma unroll
    for (int rg = 0; rg < 2; ++rg)
#pragma unroll
        for (int vb = 0; vb < 4; ++vb)
#pragma unroll
            for (int i = 0; i < 16; ++i) O[rg][vb][i] = 0.f;
    float lsum0 = 0.f, lsum1 = 0.f;
#define ATT_DMA(st_, t_) do { const int tq_ = (t_); uchar* s_ = lds + (st_) * ATT_STAGE + pw; \
        __builtin_amdgcn_global_load_lds((const unsigned*)(kp + (size_t)tq_ * 4096), (LAS unsigned*)(s_), 16, 0, 0); \
        __builtin_amdgcn_global_load_lds((const unsigned*)(kp + (size_t)SK * 64 + (size_t)tq_ * 4096), (LAS unsigned*)(s_ + ATT_K), 16, 0, 0); \
        __builtin_amdgcn_global_load_lds((const unsigned*)(vp + tq_ * 64), (LAS unsigned*)(s_ + 2 * ATT_K), 16, 0, 0); \
        __builtin_amdgcn_global_load_lds((const unsigned*)(vp + (size_t)64 * SK + tq_ * 64), (LAS unsigned*)(s_ + 2 * ATT_K + 8192), 16, 0, 0); } while (0)
    ATT_DMA(0, 0);
    WAIT_V(0);
    RAW_BARRIER();
#pragma unroll 1
    for (int t = 0; t < ntile; ++t) {
        if (t + 1 < ntile) ATT_DMA((t + 1) & 1, t + 1);
        const uchar* s = lds + (t & 1) * ATT_STAGE;
#pragma unroll 1
        for (int kb = 0; kb < 2; ++kb) {
            bf16x8 P[2][2];
#pragma unroll
            for (int rg = 0; rg < 2; ++rg) {
                f32x16 S;
#pragma unroll
                for (int i = 0; i < 16; ++i) S[i] = 0.f;
#pragma unroll
                for (int ks = 0; ks < 4; ++ks) { const bf16x8 kf = *(const bf16x8*)(s + kro + kb * 4096 + xo[ks]); const bf16x8 q = *(const bf16x8*)(qs + (rg * 4 + ks) * 1024); S = MFMA32(kf, q, S); }
                float ls = 0.f;
#pragma unroll
                for (int i = 0; i < 16; ++i) { S[i] = __builtin_amdgcn_exp2f(S[i]); ls += S[i]; }
                if (rg == 0) lsum0 += ls; else lsum1 += ls;
#pragma unroll
                for (int s2 = 0; s2 < 2; ++s2) {
                    u32x4 pw4; pw4.x = pk2(S[8 * s2], S[8 * s2 + 1]); pw4.y = pk2(S[8 * s2 + 2], S[8 * s2 + 3]); pw4.z = pk2(S[8 * s2 + 4], S[8 * s2 + 5]); pw4.w = pk2(S[8 * s2 + 6], S[8 * s2 + 7]);
                    P[rg][s2] = __builtin_bit_cast(bf16x8, pw4);
                }
            }
#pragma unroll
            for (int s2 = 0; s2 < 2; ++s2)
#pragma unroll
                for (int vb = 0; vb < 4; ++vb) {
                    const bf16x8 vf = *(const bf16x8*)(s + vro + vb * 4096 + (unsigned)(((4 * kb + 2 * s2 + hh) ^ sw) << 4));
                    O[0][vb] = MFMA32(vf, P[0][s2], O[0][vb]); O[1][vb] = MFMA32(vf, P[1][s2], O[1][vb]);
                }
        }
        WAIT_V(0);
        RAW_BARRIER();
    }
    lsum0 = xor32_sum(lsum0); lsum1 = xor32_sum(lsum1);
    const int tid2 = tid_opaque(), lane2 = tid2 & 63, wid2 = tid2 >> 6, e_l31 = lane2 & 31, e_hh = lane2 >> 5, e_m = wid2 >> 2, e_g = wid2 & 3;
    float lam;
    { float d1 = inp(p, I_LQ1)[lane2] * inp(p, I_LK1)[lane2], d2 = inp(p, I_LQ2)[lane2] * inp(p, I_LK2)[lane2]; d1 = wave_sum(d1); d2 = wave_sum(d2); lam = fexp(d1) - fexp(d2) + LAM_INIT0; }
    float* comb = (float*)lds + (size_t)e_g * 8192 + lane2;
    if (e_m == 1) {
#pragma unroll
        for (int rg = 0; rg < 2; ++rg) {
            const float sc = lam / (rg ? lsum1 : lsum0);
#pragma unroll
            for (int vb = 0; vb < 4; ++vb) {
#pragma unroll
                for (int i = 0; i < 16; ++i) comb[((rg * 4 + vb) * 16 + i) * 64] = O[rg][vb][i] * sc;
                __builtin_amdgcn_sched_barrier(0);
            }
        }
    }
    RAW_BARRIER();
    if (e_m == 0) {
        const float* snl = (const float*)(lds + 131072);
        const int h = bh & 3;
#pragma unroll
        for (int rg = 0; rg < 2; ++rg) {
            const float i0 = 1.0f / (rg ? lsum1 : lsum0);
            float ss = 0.f;
#pragma unroll
            for (int vb = 0; vb < 4; ++vb) {
#pragma unroll
                for (int i = 0; i < 16; ++i) { const float o = O[rg][vb][i] * i0 - comb[((rg * 4 + vb) * 16 + i) * 64]; O[rg][vb][i] = o; ss += o * o; }
                __builtin_amdgcn_sched_barrier(0);
            }
            ss = xor32_sum(ss);
            const float rstd = rsqrtf(ss * (1.0f / 128.0f) + EPS) * (1.0f - LAM_INIT0);
            u16* dst = (u16*)(p.ws + WS_HB) + (size_t)(out_row0 + e_g * 64 + rg * 32 + e_l31) * 1024 + 512 + h * 128;
#pragma unroll
            for (int vb = 0; vb < 4; ++vb)
#pragma unroll
                for (int gq = 0; gq < 4; ++gq) {
                    const int v0 = vb * 32 + 8 * gq + 4 * e_hh;
                    const f32x4 gn = *(const f32x4*)(snl + v0);
                    u32x2 w; w.x = pk2(O[rg][vb][4 * gq] * rstd * gn[0], O[rg][vb][4 * gq + 1] * rstd * gn[1]); w.y = pk2(O[rg][vb][4 * gq + 2] * rstd * gn[2], O[rg][vb][4 * gq + 3] * rstd * gn[3]);
                    *(u32x2*)(dst + v0) = w;
                }
        }
    }
}
DI void phase_attn(const Ctx& p, uchar* lds) {
    const int tid = tid_opaque();
    if (tid < 128) ((float*)(lds + 131072))[tid] = inp(p, I_SUBN)[tid];
    for (int u = blockIdx.x; u < 264; u += gridDim.x) {
        const bool lat = u < 256;
        const int bh = u & 7, qb = u >> 3;
        attn_unit(p, lds, bh, lat ? qb * 256 : SEQ, lat ? 0 : SEQ, lat ? 132 : 4, lat ? (bh >> 2) * SEQ + qb * 256 : NL + (bh >> 2) * CTXL);
    }
    {
        const u16* zc = (const u16*)(p.ws + WS_REGA + RA_ZC);
        u16* hb = (u16*)(p.ws + WS_HB);
        const int tid2 = tid_opaque(), lane = tid2 & 63, wid = tid2 >> 6, c8 = lane * 8;
        float w0[8], w1[8], w2[8], bias[8];
        {
            const float* cw = inp(p, I_EVCW) + c8; const float* cb = inp(p, I_EVCB) + c8;
#pragma unroll
            for (int h = 0; h < 2; ++h) {
                const f32x4 a = *(const f32x4*)(cw + 4 * h), b = *(const f32x4*)(cw + 512 + 4 * h), c = *(const f32x4*)(cw + 1024 + 4 * h), d = *(const f32x4*)(cb + 4 * h);
#pragma unroll
                for (int e = 0; e < 4; ++e) { w0[4 * h + e] = a[e]; w1[4 * h + e] = b[e]; w2[4 * h + e] = c[e]; bias[4 * h + e] = d[e]; }
            }
        }
        auto unpack8 = [](const u32x4& v, float (&f)[8]) { f[0] = blo(v.x); f[1] = bhi(v.x); f[2] = blo(v.y); f[3] = bhi(v.y); f[4] = blo(v.z); f[5] = bhi(v.z); f[6] = blo(v.w); f[7] = bhi(v.w); };
        for (int u = blockIdx.x; u < 256; u += gridDim.x) {
            const int rb = u * 66 + wid * 9, nr = wid < 7 ? 9 : 3;
            u32x4 cc[11], cx[11], cg[9];
#pragma unroll
            for (int j = 0; j < 11; ++j) {
                int row = rb - 1 + j; row = row < 0 ? 0 : (row >= R ? R - 1 : row);
                cc[j] = *(const u32x4*)(zc + (size_t)row * 1536 + 512 + c8); cx[j] = *(const u32x4*)(zc + (size_t)row * 1536 + 1024 + c8);
            }
#pragma unroll
            for (int i = 0; i < 9; ++i) { const int row = rb + i < R ? rb + i : R - 1; cg[i] = *(const u32x4*)(zc + (size_t)row * 1536 + c8); }
            float pm[8], pc[8], pn[8];
            { float a[8], b[8]; unpack8(cc[0], a); unpack8(cx[0], b);
#pragma unroll
              for (int e = 0; e < 8; ++e) pm[e] = a[e] * b[e];
              unpack8(cc[1], a); unpack8(cx[1], b);
#pragma unroll
              for (int e = 0; e < 8; ++e) pc[e] = a[e] * b[e]; }
#pragma unroll
            for (int i = 0; i < 9; ++i) {
                { float a[8], b[8]; unpack8(cc[i + 2], a); unpack8(cx[i + 2], b);
#pragma unroll
                  for (int e = 0; e < 8; ++e) pn[e] = a[e] * b[e]; }
                const int r = rb + i;
                const bool first = r < NL ? (r & 8191) == 0 : ((r - NL) & 255) == 0, last = r < NL ? (r & 8191) == 8191 : ((r - NL) & 255) == 255;
                if (i < nr) {
                    float g[8], o[8]; unpack8(cg[i], g);
#pragma unroll
                    for (int e = 0; e < 8; ++e) o[e] = g[e] * (bias[e] + w0[e] * (first ? 0.f : pm[e]) + w1[e] * pc[e] + w2[e] * (last ? 0.f : pn[e]));
                    u32x4 wv; wv.x = pk2(o[0], o[1]); wv.y = pk2(o[2], o[3]); wv.z = pk2(o[4], o[5]); wv.w = pk2(o[6], o[7]);
                    *(u32x4*)(hb + (size_t)r * 1024 + c8) = wv;
                }
#pragma unroll
                for (int e = 0; e < 8; ++e) { pm[e] = pc[e]; pc[e] = pn[e]; }
            }
        }
    }
}

DI void phase_outproj(const Params& P, const Ctx& p, uchar* lds, int layer) {
    const int tid = tid_opaque();
    const u16* hb = (const u16*)(p.ws + WS_HB);
    const u16* w = (const u16*)(p.ws + (layer == 0 ? WS_WOUT0 : WS_WOUT1));
    float* xs = (float*)(p.ws + WS_XS);
    const float* mod = (const float*)(p.ws + WS_MOD);
    const int nbig = 256, nunits = nbig + (layer == 0 ? 16 : 0);
    for (int u = blockIdx.x; u < nunits; u += gridDim.x) {
        const bool big = u < nbig;
        int mt, nt; if (big) rect_unit(u, 64, 4, mt, nt); else { mt = (u - nbig) >> 2; nt = u & 3; }
        const int m0 = big ? mt * 256 : NL + mt * 128, n0 = nt * 256;
        auto epi_body =
            [&](int roff, int wc, int lane, uchar* w) {
                const int row0 = m0 + roff, nw = n0 + wc * 64;
                const float* g1 = mod + (layer * 3 + mod_row(row0)) * 6144 + 2048 + nw;
                const float* src = row_src(p, layer, row0) + nw;
                f32x4 xi[16], gg = *(const f32x4*)(g1 + (lane & 15) * 4);
#pragma unroll
                for (int it = 0; it < 16; ++it) xi[it] = *(const f32x4*)(src + (size_t)(it * 4 + (lane >> 4)) * 1024 + (lane & 15) * 4);
#pragma unroll
                for (int it = 0; it < 16; ++it) {
                    const int row = it * 4 + (lane >> 4), col = (lane & 15) * 4;
                    const f32x4 v = *(const f32x4*)(w + row * EPI_PITCH + col * 4);
                    f32x4 o;
#pragma unroll
                    for (int e = 0; e < 4; ++e) o[e] = xi[it][e] + gg[e] * v[e];
                    *(f32x4*)(xs + (size_t)(row0 + row) * 1024 + nw + col) = o;
                }
            };
        auto epi = [&](f32x16 (&acc)[2][2], int roff, int wc, int lane, uchar* w) { epi_stage(w, acc, lane & 31, lane >> 5); epi_body(roff, wc, lane, w); };
        if (big) {
            int r0, c; p8_rc(tid, r0, c);
            const unsigned ao = (unsigned)(r0 * 2048 + c * 2), bo = (unsigned)((((r0 >> 5) * 64 + (r0 & 31)) * 2048) + c * 2);
            gemm_tile8p(lds, (const uchar*)(hb + (size_t)m0 * 1024), ao, ao, ao, ao, 128 * 2048, 64 * 2048, 192 * 2048,
                        (const uchar*)(w + (size_t)n0 * 1024), bo, 128 * 2048, 32 * 2048, 160 * 2048, 16, 1 << 30, 0, epi_body);
        } else {
            const int rs = tid >> 3;
            const u16* ab = hb + (size_t)(m0 + rs) * 1024;
            const u16* bb = w + (size_t)(n0 + rs) * 1024;
            gemm_tile(lds, ab, ab + 64 * 1024, bb, bb + 64 * 1024, bb + 128 * 1024, bb + 192 * 1024, 16, 1 << 30, 0, epi);
        }
    }
    if (layer == 0) tail_cvt_moe(P, lds, nunits, 0, MOE_CVT_TILES / 2, MOE_CVT_TILES);
}

struct TileInfo { int bucket, mt, cnt, ntiles; };
DI int moe_ntiles(const int* cnt) { int s = 0; for (int b = 0; b < 24; ++b) s += (cnt[b * 32] + 127) >> 7; return s; }
DI TileInfo moe_tile(const int* cnt, int t) {
    TileInfo ti; ti.bucket = 0; ti.mt = 0; ti.cnt = 0; ti.ntiles = 0;
    int base = 0;
    for (int b = 0; b < 24; ++b) { const int c = cnt[b * 32], n = (c + 127) >> 7; if (t >= base && t < base + n) { ti.bucket = b; ti.mt = t - base; ti.cnt = c; } base += n; }
    ti.ntiles = base; return ti;
}
DI void bucket_experts(int bucket, int& ea, int& eb) {
    const int g = bucket / 6, pi = bucket - g * 6;
    const int lo = pi < 3 ? 0 : (pi < 5 ? 1 : 2), hi = pi < 3 ? pi + 1 : (pi < 5 ? pi - 1 : 3);
    ea = g * 4 + lo; eb = g * 4 + hi;
}
struct MoeUnit { int bucket, t, mt, cnt, big, nt; };
typedef const volatile LAS int* lcnt_t;
DI int moe_units(lcnt_t cnt, int NT, int G, int& B, int& NBIG) {
    int b2 = 0, s1 = 0;
    for (int b = 0; b < 24; ++b) { const int n = (cnt[b] + 127) >> 7; b2 += n >> 1; s1 += n & 1; }
    B = b2;
    const int cand = b2 * NT;
    int best = 1 << 30; NBIG = 0;
    for (int k = 0; k <= (cand + G - 1) / G; ++k) {
        const int nb = k * G < cand ? k * G : cand, U = 2 * cand + s1 * NT - nb;
        const int rb = (nb + G - 1) / G, ru = (U + G - 1) / G, cost = rb * 7 + (ru - rb) * 5;
        if (cost < best) { best = cost; NBIG = nb; }
    }
    return 2 * cand + s1 * NT - NBIG;
}
DI MoeUnit moe_unit(lcnt_t cnt, int u, int NT, int B, int NBIG) {
    const int sh = NT == 8 ? 3 : 2;
    int kind, idx, half = 0, nt;
    if (u < NBIG) {
        kind = 0; idx = u >> sh; nt = u & (NT - 1);
        if (gridDim.x == 256 && u < (NBIG & ~255)) { const int r = u >> 8, b = u & 255, x = b & 7, y = b >> 3; idx = (r << (8 - sh)) + x * (32 >> sh) + (y >> sh); nt = y & (NT - 1); }
    }
    else {
        int v = u - NBIG; const int npl = B - (NBIG >> sh);
        if (v < npl * 2 * NT) { kind = 1; idx = (NBIG >> sh) + (v >> (sh + 1)); half = (v >> sh) & 1; nt = v & (NT - 1); }
        else { v -= npl * 2 * NT; kind = 2; idx = v >> sh; nt = v & (NT - 1); }
    }
    MoeUnit r; r.bucket = 0; r.t = 0; r.mt = 0; r.cnt = 0; r.big = kind == 0; r.nt = nt;
    int pb = 0, ps = 0, pt = 0;
    for (int b = 0; b < 24; ++b) {
        const int c = cnt[b], n = (c + 127) >> 7, np = n >> 1, sg = n & 1;
        if (kind != 2) { if (idx >= pb && idx < pb + np) { r.bucket = b; r.mt = 2 * (idx - pb) + half; r.t = pt + r.mt; r.cnt = c; } }
        else if (sg && idx == ps) { r.bucket = b; r.mt = n - 1; r.t = pt + n - 1; r.cnt = c; }
        pb += np; ps += sg; pt += n;
    }
    return r;
}
constexpr int MOE_TOK = 3 * GEMM_STAGE;
DI void phase_moe_up(const Params& P, const Ctx& p, uchar* lds, int layer) {
    const int tid = tid_opaque();
    const int* cnt = (const int*)(p.ws + WS_CTL + CTL_CNT) + layer * 1024;
    const int* list = (const int*)(p.ws + WS_LIST);
    const f32x2* route = (const f32x2*)(p.ws + WS_ROUTE);
    const u16* hb = (const u16*)(p.ws + WS_HB);
    const u16* wgu = (const u16*)(p.ws + WS_WGU) + (size_t)layer * 16 * 1024 * 1024;
    u16* act = (u16*)(p.ws + WS_REGA + RA_ACT);
    int* tok = (int*)(lds + MOE_TOK);
    const int rs = tid >> 3;
    lcnt_t lc = (lcnt_t)(smem + 640);
    __syncthreads();
    if (tid < 24) ((volatile LAS int*)(smem + 640))[tid] = cnt[tid * 32];
    __syncthreads();
    int B, NBIG;
    const int U = moe_units(lc, 8, gridDim.x, B, NBIG);
    for (int u = blockIdx.x; u < U; u += gridDim.x) {
        const MoeUnit mu = moe_unit(lc, u, 8, B, NBIG);
        const int nt = mu.nt;
        int ea, eb; bucket_experts(mu.bucket, ea, eb);
        __syncthreads();
        if (tid < (mu.big ? 256 : 128)) { const int pos = mu.mt * 128 + tid; tok[tid] = list[(size_t)mu.bucket * R + (pos < mu.cnt ? pos : 0)]; }
        __syncthreads();
        const int e = nt < 4 ? ea : eb;
        auto epi_body =
            [&](int roff, int wc, int lane, uchar* w) {
                u16* dst = act + ((size_t)mu.t * 128 + roff) * 1024 + (nt >= 4 ? 512 : 0) + (nt & 3) * 128 + wc * 32;
                const int col = (lane & 3) * 8;
                f32x2 rw[4];
#pragma unroll
                for (int it = 0; it < 4; ++it) rw[it] = route[tok[roff + it * 16 + (lane >> 2)]];
#pragma unroll
                for (int it = 0; it < 4; ++it) {
                    const int row = it * 16 + (lane >> 2);
                    const float wgt = nt < 4 ? rw[it].x : rw[it].y;
                    const uchar* wp = w + row * EPI_PITCH + col * 4;
                    const f32x4 g0 = *(const f32x4*)wp, g1 = *(const f32x4*)(wp + 16), u0 = *(const f32x4*)(wp + 128), u1 = *(const f32x4*)(wp + 144);
                    f32x4 o0, o1;
#pragma unroll
                    for (int e2 = 0; e2 < 4; ++e2) { o0[e2] = g0[e2] * sigmoidf_(g0[e2]) * u0[e2] * wgt; o1[e2] = g1[e2] * sigmoidf_(g1[e2]) * u1[e2] * wgt; }
                    *(u32x4*)(dst + (size_t)row * 1024 + col) = pack8(o0, o1);
                }
            };
        if (mu.big) {
            int r0, c; p8_rc(tid, r0, c);
            const unsigned bo = (unsigned)((((r0 >> 5) * 64 + (r0 & 31)) * 2048) + c * 2);
            const unsigned a00 = (unsigned)tok[r0] * 2048u + c * 2, a10 = (unsigned)tok[128 + r0] * 2048u + c * 2, a01 = (unsigned)tok[64 + r0] * 2048u + c * 2, a11 = (unsigned)tok[192 + r0] * 2048u + c * 2;
            gemm_tile8p(lds, (const uchar*)hb, a00, a10, a01, a11, 0, 0, 0,
                        (const uchar*)(wgu + ((size_t)e * 1024 + (nt & 3) * 256) * 1024), bo, 128 * 2048, 32 * 2048, 160 * 2048, 16, 1 << 30, 0, epi_body);
        } else {
            const u16* a0 = hb + (size_t)tok[rs] * 1024;
            const u16* a1 = hb + (size_t)tok[rs + 64] * 1024;
            const u16* bb = wgu + ((size_t)e * 1024 + (nt & 3) * 256 + rs) * 1024;
            gemm_tile(lds, a0, a1, bb, bb + 64 * 1024, bb + 128 * 1024, bb + 192 * 1024, 16, 1 << 30, 0,
                [&](f32x16 (&acc)[2][2], int roff, int wc, int lane, uchar* w) { epi_stage(w, acc, lane & 31, lane >> 5); epi_body(roff, wc, lane, w); });
        }
    }
    if (layer == 0) tail_cvt_dense(P, lds, U, P.jobs[2].tile0, P.jobs[6].tile0);
}
DI void phase_moe_down(const Params& P, const Ctx& p, uchar* lds, int layer) {
    const int tid = tid_opaque();
    const int* cnt = (const int*)(p.ws + WS_CTL + CTL_CNT) + layer * 1024;
    const int* list = (const int*)(p.ws + WS_LIST);
    const u16* wd = (const u16*)(p.ws + WS_WD) + (size_t)layer * 16 * 1024 * 512;
    const u16* act = (const u16*)(p.ws + WS_REGA + RA_ACT);
    float* xs = (float*)(p.ws + WS_XS);
    float* dsto = layer == 0 ? xs : p.out;
    const float* mod = (const float*)(p.ws + WS_MOD);
    int* tok = (int*)(lds + MOE_TOK);
    const int rs = tid >> 3;
    lcnt_t lc = (lcnt_t)(smem + 640);
    __syncthreads();
    if (tid < 24) ((volatile LAS int*)(smem + 640))[tid] = cnt[tid * 32];
    __syncthreads();
    int B, NBIG;
    const int U = moe_units(lc, 4, gridDim.x, B, NBIG);
    for (int u = blockIdx.x; u < U; u += gridDim.x) {
        const MoeUnit mu = moe_unit(lc, u, 4, B, NBIG);
        const int nt = mu.nt, n0 = nt * 256;
        int ea, eb; bucket_experts(mu.bucket, ea, eb);
        __syncthreads();
        if (tid < (mu.big ? 256 : 128)) { const int pos = mu.mt * 128 + tid; tok[tid] = pos < mu.cnt ? list[(size_t)mu.bucket * R + pos] : -1; }
        __syncthreads();
        const long bjump = (long)(eb - ea) * 1024 * 512 - 512;
        auto epi_body =
            [&](int roff, int wc, int lane, uchar* w) {
                const int nw = n0 + wc * 64 + (lane & 15) * 4;
                int tk[16]; f32x4 xi[16];
#pragma unroll
                for (int it = 0; it < 16; ++it) {
                    tk[it] = tok[roff + it * 4 + (lane >> 4)];
                    xi[it] = (f32x4){0.f, 0.f, 0.f, 0.f};
                    if (tk[it] >= 0) xi[it] = *(const f32x4*)(xs + (size_t)tk[it] * 1024 + nw);
                }
#pragma unroll
                for (int it = 0; it < 16; ++it) {
                    const int row = it * 4 + (lane >> 4);
                    if (tk[it] >= 0) {
                        const f32x4 gg = *(const f32x4*)(mod + (layer * 3 + mod_row(tk[it])) * 6144 + 5 * 1024 + nw);
                        const f32x4 v = *(const f32x4*)(w + row * EPI_PITCH + (lane & 15) * 16);
                        f32x4 o;
#pragma unroll
                        for (int e = 0; e < 4; ++e) o[e] = xi[it][e] + gg[e] * v[e];
                        *(f32x4*)(dsto + (size_t)tk[it] * 1024 + nw) = o;
                    }
                }
            };
        if (mu.big) {
            int r0, c; p8_rc(tid, r0, c);
            const unsigned ao = (unsigned)(r0 * 2048 + c * 2), bo = (unsigned)((((r0 >> 5) * 64 + (r0 & 31)) * 1024) + c * 2);
            gemm_tile8p(lds, (const uchar*)(act + (size_t)mu.t * 128 * 1024), ao, ao, ao, ao, 128 * 2048, 64 * 2048, 192 * 2048,
                        (const uchar*)(wd + ((size_t)ea * 1024 + n0) * 512), bo, 128 * 1024, 32 * 1024, 160 * 1024, 16, 8, bjump * 2, epi_body);
        } else {
            const u16* ab = act + ((size_t)mu.t * 128 + rs) * 1024;
            const u16* bb = wd + ((size_t)ea * 1024 + n0 + rs) * 512;
            gemm_tile(lds, ab, ab + 64 * 1024, bb, bb + 64 * 512, bb + 128 * 512, bb + 192 * 512, 16, 8, bjump,
                [&](f32x16 (&acc)[2][2], int roff, int wc, int lane, uchar* w) { epi_stage(w, acc, lane & 31, lane >> 5); epi_body(roff, wc, lane, w); });
        }
    }
    if (layer == 0) tail_cvt_moe(P, lds, U, 1, 0, MOE_CVT_TILES / 2);
}

DI void phase_inproj1(const Params& P, const Ctx& p, uchar* lds) {
    const int tid = tid_opaque();
    const u16* hb = (const u16*)(p.ws + WS_HB);
    const u16* w = (const u16*)(p.ws + WS_WIN1);
    u16* yb = (u16*)(p.ws + WS_REGA + RA_Y);
    u16* ub = (u16*)(p.ws + WS_REGA + RA_U);
    const int rs = tid >> 3;
    for (int u = blockIdx.x; u < 512 + 16; u += gridDim.x) {
        const bool big = u < 512;
        int mt, nt; if (big) rect_unit(u, 64, 8, mt, nt); else { mt = (u - 512) >> 2; nt = 4 + ((u - 512) & 3); }
        const int m0 = big ? mt * 256 : NL + mt * 128, n0 = nt * 256;
        auto epi_body =
            [&](int roff, int wc, int lane, uchar* w) {
                const int row0 = m0 + roff, nw = n0 + wc * 64;
                if (nt < 4) {
                    epi_rows8<64>(w, lane, [&](int row, int col, const f32x4& v0, const f32x4& v1) {
                        f32x4 a, b2;
#pragma unroll
                        for (int e = 0; e < 4; ++e) { const float x = v0[e], y = v1[e]; a[e] = x * sigmoidf_(1.5957691216057308f * (x + 0.044715f * x * x * x)); b2[e] = y * sigmoidf_(1.5957691216057308f * (y + 0.044715f * y * y * y)); }
                        *(u32x4*)(yb + (size_t)(row0 + row) * 1024 + nw + col) = pack8(a, b2); });
                } else {
                    epi_rows8<64>(w, lane, [&](int row, int col, const f32x4& v0, const f32x4& v1) { *(u32x4*)(ub + (size_t)(row0 + row) * 1024 + nw - 1024 + col) = pack8(v0, v1); });
                }
            };
        if (big) {
            int r0, c; p8_rc(tid, r0, c);
            const unsigned ao = (unsigned)(r0 * 2048 + c * 2), bo = (unsigned)((((r0 >> 5) * 64 + (r0 & 31)) * 2048) + c * 2);
            gemm_tile8p(lds, (const uchar*)(hb + (size_t)m0 * 1024), ao, ao, ao, ao, 128 * 2048, 64 * 2048, 192 * 2048,
                        (const uchar*)(w + (size_t)n0 * 1024), bo, 128 * 2048, 32 * 2048, 160 * 2048, 16, 1 << 30, 0, epi_body);
        } else {
            const u16* ab = hb + (size_t)(m0 + rs) * 1024;
            const u16* bb = w + (size_t)(n0 + rs) * 1024;
            gemm_tile(lds, ab, ab + 64 * 1024, bb, bb + 64 * 1024, bb + 128 * 1024, bb + 192 * 1024, 16, 1 << 30, 0,
                [&](f32x16 (&acc)[2][2], int roff, int wc, int lane, uchar* w) { epi_stage(w, acc, lane & 31, lane >> 5); epi_body(roff, wc, lane, w); });
        }
    }
    tail_cvt_moe(P, lds, 512 + 16, 1, MOE_CVT_TILES / 2, MOE_CVT_TILES);
}

constexpr int LRU_U = 0, LRU_UC = 36864, UROW = 272, UC_BLK = 64 * UROW  , UC_DIR = 2 * UC_BLK;
DI int lru_perm(int r) { return ((r >> 2) & 1) * 16 + (r >> 3) * 4 + (r & 3); }
DI unsigned* lru_bsave(const Ctx& p, int dir, int c, int cblk, int wid) {
    unsigned* base = (unsigned*)(p.ws + (dir == 0 ? WS_REGA + RA_BS0 : WS_WGU));
    return base + ((size_t)(c * 4 + cblk) * 8 + wid) * 1024;
}
DI u32x4* lru_osave(const Ctx& p, int dir, int c, int cblk, int wid, int q, int lane) {
    if (dir == 0) return (u32x4*)(p.ws + WS_HB + ((size_t)(c * 64 + (wid * 4 + q) * 2 + (lane >> 5)) * 2048 + cblk * 512 + (lane & 31) * 16));
    uchar* base = p.ws + (c < 128 ? WS_WD : WS_OM1B);
    return (u32x4*)(base + ((size_t)((c & 127) * 4 + cblk) * 32768 + ((wid * 4 + q) * 64 + lane) * 16));
}
struct LruW { bf16x8 fa[8], fx[8]; };
DI void lru_wload(const Ctx& p, int dir, int cblk, int wid, int lane, LruW& w, int which = 3) {
    const int l31 = lane & 31, hh = lane >> 5, bl = wid >> 2, jq = wid & 3, blkg = cblk * 2 + bl;
    const u16* wa = (const u16*)(p.ws + WS_WA) + ((size_t)(dir * 8 + blkg) * 128 + jq * 32 + l31) * 128 + hh * 8;
    const u16* wx = (const u16*)(p.ws + WS_WX) + ((size_t)(dir * 8 + blkg) * 128 + jq * 32 + l31) * 128 + hh * 8;
    if (which & 1) {
#pragma unroll
        for (int ks = 0; ks < 8; ++ks) w.fa[ks] = *(const bf16x8*)(wa + ks * 16);
    }
    if (which & 2) {
#pragma unroll
        for (int ks = 0; ks < 8; ++ks) w.fx[ks] = *(const bf16x8*)(wx + ks * 16);
    }
    __builtin_amdgcn_sched_barrier(0);
}
template <class Hook, class Hook2>
DI void lru_gates(const Ctx& p, const uchar* lds, int dir, int cblk, int wid, int lane, const LruW& w, float (&a)[2][16], float (&b)[2][16], unsigned* bsave, Hook&& hook, Hook2&& hook2) {
    const int l31 = lane & 31, hh = lane >> 5, bl = wid >> 2, jq = wid & 3;
    const int chl = bl * 128 + jq * 32 + l31;
    const int ch = cblk * 256 + chl;
    const uchar* uc = lds + LRU_UC + dir * UC_DIR + bl * UC_BLK;
    f32x16 dr[2], di[2];
#pragma unroll
    for (int rb = 0; rb < 2; ++rb)
#pragma unroll
        for (int i = 0; i < 16; ++i) { dr[rb][i] = 0.f; di[rb][i] = 0.f; }
    const int tk = lru_perm(l31);
#pragma unroll
    for (int ks = 0; ks < 8; ++ks) {
#pragma unroll
        for (int rb = 0; rb < 2; ++rb) dr[rb] = MFMA32(*(const bf16x8*)(uc + (rb * 32 + tk) * UROW + ks * 32 + hh * 16), w.fa[ks], dr[rb]);
    }
#pragma unroll
    for (int ks = 0; ks < 8; ++ks) {
#pragma unroll
        for (int rb = 0; rb < 2; ++rb) di[rb] = MFMA32(*(const bf16x8*)(uc + (rb * 32 + tk) * UROW + ks * 32 + hh * 16), w.fx[ks], di[rb]);
    }
    __builtin_amdgcn_sched_barrier(0);
    hook();
    const float nl2 = -1.4426950408889634f;
    const float kba = inp(p, I_ODBA)[dir * 1024 + ch] * nl2, kbx = inp(p, I_ODBX)[dir * 1024 + ch] * nl2;
    const float sp8 = 8.0f * log1pf(__expf(-inp(p, I_ODLAM)[dir * 1024 + ch]));
    const float c1 = sp8 * nl2;
    const int cofs = (jq * 32 + l31) * 2;
#pragma unroll
    for (int rb = 0; rb < 2; ++rb)
#pragma unroll
        for (int i = 0; i < 16; ++i) {
            const int token = rb * 32 + hh * 16 + i;
            const float r = frcp(1.0f + __builtin_amdgcn_exp2f(__builtin_fmaf(dr[rb][i], nl2, kba)));
            const float av = __builtin_amdgcn_exp2f(c1 * r);
            a[rb][i] = av;
            const float om = __builtin_fmaf(-av, av, 1.0f);
            const float ucv = b2f(*(const u16*)(uc + token * UROW + cofs));
            const float ig = frcp(1.0f + __builtin_amdgcn_exp2f(__builtin_fmaf(di[rb][i], nl2, kbx)));
            b[rb][i] = __builtin_amdgcn_sqrtf(om) * (ig * ucv);
        }
    __builtin_amdgcn_sched_barrier(0);
    hook2();
    if (bsave) {
#pragma unroll
        for (int q = 0; q < 4; ++q) {
            u32x4 v;
#pragma unroll
            for (int e = 0; e < 4; ++e) { const int j = q * 4 + e, rb = j >> 3, i = (j & 7) * 2; v[e] = pk2(b[rb][i], b[rb][i + 1]); }
            ((u32x4*)bsave)[q * 64 + lane] = v;
        }
    }
}
constexpr int LRU_U2 = 106496;
DI void lru_seq(int c, int& s0, int& s1) { if (c < 256) { s0 = (c >> 7) * SEQ; s1 = s0 + SEQ; } else { s0 = NL + ((c - 256) >> 2) * CTXL; s1 = s0 + CTXL; } }
DI void lru_dma(const Ctx& p, uchar* lds, int c, int cblk, int buf) {
    const int tid = tid_opaque(), lane = tid & 63, wid = tid >> 6;
    const u16* ub = (const u16*)(p.ws + WS_REGA + RA_U);
    int s0, s1; lru_seq(c, s0, s1);
    const int w0 = __builtin_amdgcn_readfirstlane(wid);
    uchar* dst = lds + (buf ? LRU_U2 : LRU_U);
#pragma unroll
    for (int k = 0; k < 5; ++k) {
        const int i = w0 + 8 * k;
        if (i < 35) {
            int row = c * 64 - 3 + 2 * i + (lane >> 5);
            row = row < s0 ? s0 : (row >= s1 ? s1 - 1 : row);
            __builtin_amdgcn_global_load_lds((const unsigned*)(ub + (size_t)row * 1024 + cblk * 256 + (lane & 31) * 8), (LAS unsigned*)(dst + i * 1024), 16, 0, 0);
        }
    }
}
DI void lru_conv(const Ctx& p, uchar* lds, int c, int cblk, int buf, bool counted = false) {
    const int tid = tid_opaque();
    const int row0 = c * 64;
    int s0, s1; lru_seq(c, s0, s1);
    const uchar* ut = lds + (buf ? LRU_U2 : LRU_U);
    if (counted) WAIT_V(8); else WAIT_V(0);
    __syncthreads();
    const int c8 = tid & 31, tq = tid >> 5, t0 = tq * 4;
    float uv[10][8];
#pragma unroll
    for (int rr = 0; rr < 10; ++rr) {
        u32x4 v = *(const u32x4*)(ut + (t0 + rr) * 512 + c8 * 16);
        const int row = row0 - 3 + t0 + rr;
        if (row < s0 || row >= s1) v = (u32x4){0u, 0u, 0u, 0u};
        uv[rr][0] = blo(v.x); uv[rr][1] = bhi(v.x); uv[rr][2] = blo(v.y); uv[rr][3] = bhi(v.y); uv[rr][4] = blo(v.z); uv[rr][5] = bhi(v.z); uv[rr][6] = blo(v.w); uv[rr][7] = bhi(v.w);
    }
#pragma unroll
    for (int dir = 0; dir < 2; ++dir) {
        const float* cw = inp(p, I_ODCW) + dir * 4096 + cblk * 256 + c8 * 8;
        const float* cb = inp(p, I_ODCB) + dir * 1024 + cblk * 256 + c8 * 8;
        float w[4][8], bs[8];
#pragma unroll
        for (int k = 0; k < 4; ++k) { const f32x4 x0 = *(const f32x4*)(cw + k * 1024), x1 = *(const f32x4*)(cw + k * 1024 + 4); w[k][0] = x0[0]; w[k][1] = x0[1]; w[k][2] = x0[2]; w[k][3] = x0[3]; w[k][4] = x1[0]; w[k][5] = x1[1]; w[k][6] = x1[2]; w[k][7] = x1[3]; }
        { const f32x4 x0 = *(const f32x4*)cb, x1 = *(const f32x4*)(cb + 4); bs[0] = x0[0]; bs[1] = x0[1]; bs[2] = x0[2]; bs[3] = x0[3]; bs[4] = x1[0]; bs[5] = x1[1]; bs[6] = x1[2]; bs[7] = x1[3]; }
#pragma unroll
        for (int tt = 0; tt < 4; ++tt) {
            float o[8];
#pragma unroll
            for (int e = 0; e < 8; ++e) {
                float s = bs[e];
#pragma unroll
                for (int k = 0; k < 4; ++k) s += w[k][e] * uv[tt + k + (dir ? 3 : 0)][e];
                o[e] = s;
            }
            const int t = t0 + tt;
            u32x4 wv; wv.x = pk2(o[0], o[1]); wv.y = pk2(o[2], o[3]); wv.z = pk2(o[4], o[5]); wv.w = pk2(o[6], o[7]);
            *(u32x4*)(lds + LRU_UC + dir * UC_DIR + (c8 >> 4) * UC_BLK + t * UROW + (c8 & 15) * 16) = wv;
        }
    }
    __syncthreads();
}
DI void lru_seg(const float (&a)[2][16], const float (&b)[2][16], int dir, int hh, float (&SA)[4], float (&SB)[4]) {
    float oa[2], ob[2];
#pragma unroll
    for (int rb = 0; rb < 2; ++rb) {
        float A = 1.f, B = 0.f;
#pragma unroll
        for (int ii = 0; ii < 16; ++ii) { const int i = dir ? 15 - ii : ii; B = a[rb][i] * B + b[rb][i]; A *= a[rb][i]; }
        oa[rb] = A; ob[rb] = B;
    }
    float pa[2], pb[2];
#pragma unroll
    for (int rb = 0; rb < 2; ++rb) { pa[rb] = __shfl_xor(oa[rb], 32); pb[rb] = __shfl_xor(ob[rb], 32); }
#pragma unroll
    for (int rb = 0; rb < 2; ++rb)
#pragma unroll
        for (int h = 0; h < 2; ++h) {
            const float A = (h == hh) ? oa[rb] : pa[rb], B = (h == hh) ? ob[rb] : pb[rb];
            const int s = dir ? 3 - (rb * 2 + h) : rb * 2 + h;
            SA[s] = A; SB[s] = B;
        }
}
DI void lru_summ_item(int j, int& c, int& cblk, int& role) {
    if (j < 1024) { c = j >> 2; cblk = j & 3; role = -1; } else { const int mini = j - 1024, cu = mini >> 3; c = 256 + (cu >> 2); cblk = cu & 3; role = mini & 7; }
}
template <class F>
DI void lru_summ_wave(const Ctx& p, uchar* lds, int c, int cblk, int role, LruW& w, F&& next_dma) {
    const int tid = tid_opaque(), lane = tid & 63, wid = role < 0 ? (tid >> 6) : role, hh = lane >> 5;
    f32x2* summ = (f32x2*)(p.ws + WS_SUMM);
    const int ch = cblk * 256 + (wid >> 2) * 128 + (wid & 3) * 32 + (lane & 31);
#pragma unroll
    for (int dir = 0; dir < 2; ++dir) {
        float a[2][16], b[2][16];
        unsigned* bs = c < 256 ? lru_bsave(p, dir, c, cblk, wid) : (unsigned*)nullptr;
        if (dir == 0) lru_gates(p, lds, 0, cblk, wid, lane, w, a, b, bs, [&]() { lru_wload(p, 1, cblk, wid, lane, w, 1); }, [&]() { lru_wload(p, 1, cblk, wid, lane, w, 2); });
        else          lru_gates(p, lds, 1, cblk, wid, lane, w, a, b, bs, [&]() { next_dma(); lru_wload(p, 0, cblk, wid, lane, w, 1); }, [&]() { lru_wload(p, 0, cblk, wid, lane, w, 2); });
        if (c < 256) {
#pragma unroll
            for (int q = 0; q < 4; ++q) {
                u32x4 v;
#pragma unroll
                for (int e = 0; e < 4; ++e) { const int j = q * 4 + e, rb = j >> 3, i = (j & 7) * 2; v[e] = pk2(1.0f - a[rb][i], 1.0f - a[rb][i + 1]); }
                *lru_osave(p, dir, c, cblk, wid, q, lane) = v;
            }
        }
        float SA[4], SB[4];
        lru_seg(a, b, dir, hh, SA, SB);
        float A = 1.f, B = 0.f;
#pragma unroll
        for (int s = 0; s < 4; ++s) { B = SA[s] * B + SB[s]; A *= SA[s]; }
        if (hh == 0) summ[((size_t)dir * 264 + c) * 1024 + ch] = (f32x2){A, B};
    }
}
DI void phase_lru_summ(const Ctx& p, uchar* lds) {
    const int tid = tid_opaque(), lane = tid & 63, wid = tid >> 6;
    constexpr int NITEM = 1024 + 32 * 8;
    int c, cblk, role;
    if ((int)blockIdx.x >= NITEM) return;
    lru_summ_item(blockIdx.x, c, cblk, role); lru_dma(p, lds, c, cblk, 0);
    LruW w;
    lru_wload(p, 0, cblk, role < 0 ? wid : role, lane, w);
    int buf = 0;
    bool counted = false;
    for (int j = blockIdx.x; j < NITEM; j += gridDim.x, buf ^= 1) {
        lru_summ_item(j, c, cblk, role);
        lru_conv(p, lds, c, cblk, buf, counted);
        counted = role < 0;
        int c2 = 0, cblk2 = 0, role2 = -1;
        const bool more = j + (int)gridDim.x < NITEM;
        if (more) lru_summ_item(j + gridDim.x, c2, cblk2, role2);
        auto next_dma = [&]() { if (more) lru_dma(p, lds, c2, cblk2, buf ^ 1); };
        if (role < 0) {
            lru_summ_wave(p, lds, c, cblk, -1, w, next_dma);
            if (more && role2 >= 0) lru_wload(p, 0, cblk2, role2, lane, w);
        } else {
            if (wid == 0) lru_summ_wave(p, lds, c, cblk, role, w, next_dma); else next_dma();
            if (more && (cblk2 != cblk || role2 != role)) lru_wload(p, 0, cblk2, role2, lane, w);
        }
    }
    WAIT_V(0);
}
DI void phase_lru_carry(const Ctx& p) {
    const int tid = tid_opaque();
    const f32x2* summ = (const f32x2*)(p.ws + WS_SUMM);
    float* carry = (float*)(p.ws + WS_CARRY);
    for (int g = blockIdx.x * 512 + tid; g < 4096; g += gridDim.x * 512) {
        const int ch = g & 1023, bt = (g >> 10) & 1, dir = g >> 11;
        const f32x2* sd = summ + (size_t)dir * 264 * 1024 + ch;
        float h = 0.f;
        f32x2 s[4];
#pragma unroll
        for (int q = 0; q < 4; ++q) s[q] = sd[(size_t)(256 + bt * 4 + (dir ? 3 - q : q)) * 1024];
#pragma unroll
        for (int q = 0; q < 4; ++q) h = s[q].x * h + s[q].y;
        for (int q0 = 0; q0 < 128; q0 += 16) {
            f32x2 t[16];
#pragma unroll
            for (int q = 0; q < 16; ++q) { const int ci = dir ? 127 - (q0 + q) : q0 + q; t[q] = sd[(size_t)(bt * 128 + ci) * 1024]; }
#pragma unroll
            for (int q = 0; q < 16; ++q) { const int ci = dir ? 127 - (q0 + q) : q0 + q; carry[((size_t)dir * 256 + bt * 128 + ci) * 1024 + ch] = h; h = t[q].x * h + t[q].y; }
        }
    }
}
DI void phase_lru_scan(const Ctx& p, uchar* lds) {
    const int tid = tid_opaque(), lane = tid & 63, wid = tid >> 6, hh = lane >> 5;
    const u16* yb = (const u16*)(p.ws + WS_REGA + RA_Y);
    u16* hb = (u16*)(p.ws + WS_HB);
    for (int u = blockIdx.x; u < 256 * 4; u += gridDim.x) {
        const int c = u >> 2, cblk = u & 3;
        const int ch = cblk * 256 + (wid >> 2) * 128 + (wid & 3) * 32 + (lane & 31);
        float hsum[2][16];
        __syncthreads();
#pragma unroll
        for (int dir = 0; dir < 2; ++dir) {
            const float h0 = ((const float*)(p.ws + WS_CARRY))[((size_t)dir * 256 + c) * 1024 + ch];
            float a[2][16], b[2][16];
            {
                const unsigned* bs = lru_bsave(p, dir, c, cblk, wid);
                unsigned bw[16], ow[16];
#pragma unroll
                for (int q = 0; q < 4; ++q) {
                    const u32x4 vb = ((const u32x4*)bs)[q * 64 + lane], vo = *lru_osave(p, dir, c, cblk, wid, q, lane);
#pragma unroll
                    for (int e = 0; e < 4; ++e) { bw[q * 4 + e] = vb[e]; ow[q * 4 + e] = vo[e]; }
                }
#pragma unroll
                for (int rb = 0; rb < 2; ++rb)
#pragma unroll
                    for (int i = 0; i < 16; ++i) {
                        const unsigned wb = bw[rb * 8 + (i >> 1)], wo = ow[rb * 8 + (i >> 1)];
                        b[rb][i] = (i & 1) ? bhi(wb) : blo(wb);
                        a[rb][i] = 1.0f - ((i & 1) ? bhi(wo) : blo(wo));
                    }
            }
            float SA[4], SB[4];
            lru_seg(a, b, dir, hh, SA, SB);
            float st[4]; st[0] = h0;
#pragma unroll
            for (int s = 1; s < 4; ++s) st[s] = SA[s - 1] * st[s - 1] + SB[s - 1];
#pragma unroll
            for (int rb = 0; rb < 2; ++rb) {
                const int sidx = dir ? 3 - (rb * 2 + hh) : rb * 2 + hh;
                float h = sidx == 0 ? st[0] : (sidx == 1 ? st[1] : (sidx == 2 ? st[2] : st[3]));
#pragma unroll
                for (int ii = 0; ii < 16; ++ii) { const int i = dir ? 15 - ii : ii; h = a[rb][i] * h + b[rb][i]; if (dir == 0) hsum[rb][i] = h; else hsum[rb][i] += h; }
            }
        }
        __syncthreads();
        {
            const int chl = (wid >> 2) * 128 + (wid & 3) * 32 + (lane & 31);
#pragma unroll
            for (int rb = 0; rb < 2; ++rb)
#pragma unroll
                for (int i = 0; i < 16; ++i) *(float*)(lds + (rb * 32 + hh * 16 + i) * 1040 + chl * 4) = hsum[rb][i];
        }
        __syncthreads();
#pragma unroll
        for (int j = 0; j < 4; ++j) {
            const int pi = j * 512 + tid, tk = pi >> 5, c8 = pi & 31;
            const f32x4 h0 = *(const f32x4*)(lds + tk * 1040 + c8 * 32), h1 = *(const f32x4*)(lds + tk * 1040 + c8 * 32 + 16);
            const size_t o = (size_t)(c * 64 + tk) * 1024 + cblk * 256 + c8 * 8;
            const u32x4 yv = *(const u32x4*)(yb + o);
            u32x4 w;
            w.x = pk2(blo(yv.x) * h0[0], bhi(yv.x) * h0[1]); w.y = pk2(blo(yv.y) * h0[2], bhi(yv.y) * h0[3]);
            w.z = pk2(blo(yv.z) * h1[0], bhi(yv.z) * h1[1]); w.w = pk2(blo(yv.w) * h1[2], bhi(yv.w) * h1[3]);
            *(u32x4*)(hb + o) = w;
        }
    }
}

__global__ void __launch_bounds__(512) fwd_mega(const Params P) {
    uchar* lds = smem + LDS_USER;
    LAS unsigned long long* tab = (LAS unsigned long long*)(smem + 64);
    if (threadIdx.x < N_IN) tab[threadIdx.x] = (unsigned long long)P.in[threadIdx.x];
    if ((threadIdx.x & 63) == 0) ((volatile LAS int*)smem)[96 + hw_slot()] = threadIdx.x >> 6;
    const bool multi = (P.ph_hi - P.ph_lo) > 1;
    if (threadIdx.x == 0) { ((volatile LAS unsigned*)smem)[0] = 0u; ((volatile LAS unsigned*)smem)[1] = 0u; ((volatile LAS unsigned*)smem)[2] = 0u; ((volatile LAS unsigned*)smem)[3] = 0u; }
    __syncthreads();
    if (multi) (void)xcd_barrier_post((unsigned*)(P.ws + WS_CTL), (volatile LAS unsigned*)smem);
#define RUN_PHASE(k, call) if (P.ph_lo <= (k) && (k) < P.ph_hi) { { Ctx p; { unsigned long long wsi = (unsigned long long)P.ws; asm volatile("" : "+s"(wsi)); p.ws = (uchar*)(__attribute__((address_space(1))) uchar*)wsi; } p.out = P.out; p.tab = tab; call; } if ((PROBE_REPS >> (k)) & 1) { { XcdBarrier xb_; xb_.bar = (unsigned*)(P.ws + WS_CTL); xb_.x = xb_xcc_id(); xb_.st = (volatile LAS unsigned*)smem; xcd_barrier(xb_); } Ctx p; { unsigned long long wsi = (unsigned long long)P.ws; asm volatile("" : "+s"(wsi)); p.ws = (uchar*)(__attribute__((address_space(1))) uchar*)wsi; } p.out = P.out; p.tab = tab; call; } if (multi && (k) + 1 < P.ph_hi) { XcdBarrier xb_; xb_.bar = (unsigned*)(P.ws + WS_CTL); xb_.x = xb_xcc_id(); xb_.st = (volatile LAS unsigned*)smem; xcd_barrier(xb_); } }
    RUN_PHASE(0, phase_prep(P, p, lds))
    RUN_PHASE(1, phase_norm(p, 0))
    RUN_PHASE(2, phase_inproj0(P, p, lds))
    RUN_PHASE(3, phase_attn(p, lds))
    RUN_PHASE(4, phase_outproj(P, p, lds, 0))
    RUN_PHASE(5, phase_router(p, lds, 0))
#if PROBE_ROUTER2X
    if (P.ph_lo <= 5 && 5 < P.ph_hi) { Ctx p; { unsigned long long wsi = (unsigned long long)P.ws; asm volatile("" : "+s"(wsi)); p.ws = (uchar*)(__attribute__((address_space(1))) uchar*)wsi; } p.out = P.out; p.tab = tab; phase_router(p, lds, 0, 2); { XcdBarrier xb_; xb_.bar = (unsigned*)(P.ws + WS_CTL); xb_.x = xb_xcc_id(); xb_.st = (volatile LAS unsigned*)smem; xcd_barrier(xb_); } }
#endif
    RUN_PHASE(6, phase_moe_up(P, p, lds, 0))
    RUN_PHASE(7, phase_moe_down(P, p, lds, 0))
    RUN_PHASE(8, phase_norm(p, 1))
    RUN_PHASE(9, phase_inproj1(P, p, lds))
    RUN_PHASE(10, phase_lru_summ(p, lds))
    RUN_PHASE(11, phase_lru_carry(p))
    RUN_PHASE(12, phase_lru_scan(p, lds))
    RUN_PHASE(13, phase_outproj(P, p, lds, 1))
    RUN_PHASE(14, phase_router(p, lds, 1))
    RUN_PHASE(15, phase_moe_up(P, p, lds, 1))
    RUN_PHASE(16, phase_moe_down(P, p, lds, 1))
}

extern "C" void kernel_launch(void* const* d_in, const int* in_sizes, int n_in, void* d_out, int out_size, void* d_ws, size_t ws_size, hipStream_t stream) {
    static int grid = 0;
    if (grid == 0) {
        if (n_in != N_IN || out_size != NL * D || ws_size < WS_END) { fprintf(stderr, "kernel_launch: unexpected shapes (n_in %d, out %d, ws %zu, need %zu)\n", n_in, out_size, ws_size, (size_t)WS_END); grid = -1; return; }
        int dev = 0, cus = 0, per_cu = 0;
        if (hipGetDevice(&dev) != hipSuccess || hipDeviceGetAttribute(&cus, hipDeviceAttributeMultiprocessorCount, dev) != hipSuccess) { grid = -1; return; }
        if (hipFuncSetAttribute((const void*)fwd_mega, hipFuncAttributeMaxDynamicSharedMemorySize, LDS_BYTES) != hipSuccess) { fprintf(stderr, "kernel_launch: hipFuncSetAttribute failed\n"); grid = -1; return; }
        if (hipOccupancyMaxActiveBlocksPerMultiprocessor(&per_cu, (const void*)fwd_mega, 512, LDS_BYTES) != hipSuccess || per_cu < 1) { fprintf(stderr, "kernel_launch: occupancy query says %d\n", per_cu); (void)hipGetLastError(); grid = -1; return; }
        grid = cus;
    }
    if (grid < 0) return;
    if (hipMemsetAsync((char*)d_ws + WS_CTL, 0, CTL_BYTES, stream) != hipSuccess) return;
    Params p{};
    for (int i = 0; i < N_IN; ++i) p.in[i] = (const float*)d_in[i];
    p.out = (float*)d_out; p.ws = (uchar*)d_ws;
    uchar* ws = (uchar*)d_ws;
    int t0 = 0;
    auto job = [&](int j, const float* src, size_t dst_off, int nmat, int K, int N, int sstride, int dstride, int lddst, int mode, int half) {
        CvtJob& J = p.jobs[j]; J.src = src; J.dst = (u16*)(ws + dst_off); J.nmat = nmat; J.K = K; J.N = N; J.sstride = sstride; J.dstride = dstride; J.lddst = lddst; J.mode = mode; J.half = half; J.tile0 = t0; J.pad = 0;
        t0 += nmat * (K / 64) * (N / 64);
    };
    job(0, p.in[I_EVWIN], WS_WIN0, 1, 1024, 3072, 0, 0, 1024, 0, 0);
    job(1, p.in[I_EVWOUT], WS_WOUT0, 1, 1024, 1024, 0, 0, 1024, 0, 0);
    job(2, p.in[I_ODWIN], WS_WIN1, 1, 1024, 2048, 0, 0, 1024, 0, 0);
    job(3, p.in[I_ODWOUT], WS_WOUT1, 1, 1024, 1024, 0, 0, 1024, 0, 0);
    job(4, p.in[I_ODWA], WS_WA, 16, 128, 128, 16384, 16384, 128, 0, 0);
    job(5, p.in[I_ODWX], WS_WX, 16, 128, 128, 16384, 16384, 128, 0, 0);
    job(6, p.in[I_MGATE], WS_WGU, 32, 1024, 512, 524288, 1048576, 1024, 1, 0);
    job(7, p.in[I_MUP], WS_WGU, 32, 1024, 512, 524288, 1048576, 1024, 1, 1);
    job(8, p.in[I_MDOWN], WS_WD, 32, 512, 1024, 524288, 524288, 512, 0, 0);
    p.ncvt = t0;
    const int nl = N_LAUNCHES;
    for (int li = 0; li < nl; ++li) {
        p.ph_lo = li * NPH / nl; p.ph_hi = (li + 1) * NPH / nl;
        hipLaunchKernelGGL(fwd_mega, dim3(grid), dim3(512), LDS_BYTES, stream, p);
    }
}
```

```cpp
#include <hip/hip_runtime.h>
#include <stdint.h>
#include <stdio.h>

#define DI __device__ __forceinline__
#define LAS __attribute__((address_space(3)))
typedef unsigned short u16;
typedef unsigned char uchar;
typedef short bf16x8 __attribute__((ext_vector_type(8)));
typedef float f32x16 __attribute__((ext_vector_type(16)));
typedef float f32x4 __attribute__((ext_vector_type(4)));
typedef float f32x2 __attribute__((ext_vector_type(2)));
typedef __bf16 bf2_t __attribute__((ext_vector_type(2)));
typedef unsigned u32x2 __attribute__((ext_vector_type(2)));
typedef unsigned u32x4 __attribute__((ext_vector_type(4)));

#ifndef N_LAUNCHES
#define N_LAUNCHES 1
#endif
#ifndef PROBE_GEMM2X
#define PROBE_GEMM2X 0
#endif
#ifndef PROBE_ROUTER2X
#define PROBE_ROUTER2X 0
#endif
#ifndef PROBE_REPS
#define PROBE_REPS 0x0000
#endif

DI unsigned pk2(float a, float b) { f32x2 v = {a, b}; bf2_t r = __builtin_convertvector(v, bf2_t); return __builtin_bit_cast(unsigned, r); }
DI u16 f2b(float a) { __bf16 r = (__bf16)a; return __builtin_bit_cast(u16, r); }
DI float b2f(u16 v) { return __uint_as_float(((unsigned)v) << 16); }
DI float blo(unsigned v) { return __uint_as_float(v << 16); }
DI float bhi(unsigned v) { return __uint_as_float(v & 0xffff0000u); }
#define MFMA32(a, b, c) __builtin_amdgcn_mfma_f32_32x32x16_bf16((a), (b), (c), 0, 0, 0)

constexpr int D = 1024, NL = 16384, NC = 512, R = 16896, SEQ = 8192, CTXL = 256, SK = 8448;
constexpr int NPH = 17;
constexpr float EPS = 1e-6f;
constexpr float LAM_INIT0 = 0.2f;
constexpr float QSCALE = 0.125f * 1.4426950408889634f;

enum { I_X = 0, I_C, I_CTX, I_CCTX, I_ADAW, I_ADAB, I_NMIX, I_NFFN, I_EVWIN, I_EVCW, I_EVCB, I_QN, I_KN, I_LQ1, I_LK1, I_LQ2, I_LK2, I_SUBN, I_EVWOUT,
       I_ODWIN, I_ODCW, I_ODCB, I_ODWA, I_ODBA, I_ODWX, I_ODBX, I_ODLAM, I_ODWOUT, I_MWGRP, I_MBGRP, I_MWRT, I_MBRT, I_MGATE, I_MUP, I_MDOWN, N_IN };

constexpr size_t al256(size_t x) { return (x + 255) & ~(size_t)255; }
constexpr size_t WS_CTL   = 0;
constexpr size_t CTL_BYTES = 65536;
constexpr size_t CTL_CNT  = 16384;
constexpr size_t WS_MOD   = WS_CTL + CTL_BYTES;
constexpr size_t WS_ROPE  = WS_MOD + al256(2 * 3 * 6144 * 4);
constexpr size_t WS_ROUTE = WS_ROPE + (size_t)SEQ * 32 * 8;
constexpr size_t WS_LIST  = WS_ROUTE + al256((size_t)R * 8);
constexpr size_t WS_SUMM  = WS_LIST + al256((size_t)24 * R * 4);
constexpr size_t WS_CARRY = WS_SUMM + (size_t)2 * 264 * 1024 * 8;
constexpr size_t WS_WIN0  = WS_CARRY + (size_t)2 * 256 * 1024 * 4;
constexpr size_t WS_WOUT0 = WS_WIN0 + (size_t)3072 * 1024 * 2;
constexpr size_t WS_WIN1  = WS_WOUT0 + (size_t)1024 * 1024 * 2;
constexpr size_t WS_WOUT1 = WS_WIN1 + (size_t)2048 * 1024 * 2;
constexpr size_t WS_WA    = WS_WOUT1 + (size_t)1024 * 1024 * 2;
constexpr size_t WS_WX    = WS_WA + (size_t)2 * 8 * 128 * 128 * 2;
constexpr size_t WS_WGU   = WS_WX + (size_t)2 * 8 * 128 * 128 * 2;
constexpr size_t WS_WD    = WS_WGU + (size_t)2 * 16 * 1024 * 1024 * 2;
constexpr size_t WS_XS    = WS_WD + (size_t)2 * 16 * 1024 * 512 * 2;
constexpr size_t WS_HB    = WS_XS + (size_t)R * 1024 * 4;
constexpr size_t WS_REGA  = WS_HB + (size_t)R * 1024 * 2;
constexpr size_t RA_ZC    = 0;
constexpr size_t RA_Q     = RA_ZC + (size_t)R * 1536 * 2;
constexpr size_t RA_K     = RA_Q + (size_t)16 * SK * 64 * 2;
constexpr size_t RA_VT    = RA_K + (size_t)16 * SK * 64 * 2;
constexpr size_t RA_END0  = RA_VT + (size_t)8 * 128 * SK * 2;
constexpr size_t RA_ACT   = 0;
constexpr size_t RA_Y     = 0;
constexpr size_t RA_U     = RA_Y + (size_t)NL * 1024 * 2;
constexpr size_t RA_BS0   = RA_U + (size_t)R * 1024 * 2;
constexpr size_t WS_OM1B  = WS_REGA + RA_END0;
constexpr size_t WS_END   = WS_OM1B + (size_t)128 * 4 * 32768;
static_assert(RA_BS0 + (size_t)256 * 4 * 8 * 1024 * 4 <= RA_END0 && (size_t)20480 * 1024 * 2 <= RA_END0, "region A overlays");
static_assert((size_t)256 * 4 * 8 * 1024 * 4 <= (size_t)16 * 1024 * 1024 * 2, "b of direction 1 fits layer 0's gate/up weights");
static_assert(WS_END <= 352000000ull, "workspace budget");

constexpr int LDS_BYTES = 147456 + 1024 + 1024;
constexpr int LDS_USER = 1024;

struct CvtJob { const float* src; u16* dst; int nmat, K, N, sstride, dstride, lddst, mode, half, tile0, pad; };
struct Params {
    const float* in[N_IN];
    float* out;
    uchar* ws;
    CvtJob jobs[9];
    int ncvt, ph_lo, ph_hi, pad;
};
struct Ctx { uchar* ws; float* out; const LAS unsigned long long* tab; };
typedef const __attribute__((address_space(1))) float* gcf_t;
DI const float* inp(const Ctx& c, int i) { return (const float*)(gcf_t)c.tab[i]; }

extern __shared__ __attribute__((aligned(16))) uchar smem[];
DI int hw_slot() { return (int)(__builtin_amdgcn_s_getreg(((6 - 1) << 11) | 4) & 63u); }
DI int tid_opaque() {
    const int lane = (int)__builtin_amdgcn_mbcnt_hi(~0u, __builtin_amdgcn_mbcnt_lo(~0u, 0u));
    int w = ((volatile LAS int*)smem)[96 + hw_slot()];
    w = __builtin_amdgcn_readfirstlane(w);
    int t = w * 64 + lane; asm volatile("" : "+v"(t)); return t;
}
#define XB_TMO      128
#define XB_XCNT(j)  (256  + 64 * (j))
#define XB_XSUB(j)  (1280 + 64 * (j))
#define XB_XGEN(j)  (2304 + 64 * (j))
#define XB_TOP      3328
#define XB_TOPGEN   3392
#define XCD_BAR_WORDS 3456
#define XB_SPIN_CAP (1u << 20)
DI unsigned xb_ld(unsigned* p)              { return __hip_atomic_load(p, __ATOMIC_RELAXED, __HIP_MEMORY_SCOPE_AGENT); }
DI unsigned xb_add(unsigned* p, unsigned v) { return __hip_atomic_fetch_add(p, v, __ATOMIC_RELAXED, __HIP_MEMORY_SCOPE_AGENT); }
DI unsigned xb_xcc_id() { return (unsigned)__builtin_amdgcn_s_getreg((3 << 11) | 20) & 0xFu; }
#define XB_SPIN(cond, bar) do { unsigned _sp = 0; while (cond) { __builtin_amdgcn_s_sleep(1); \
    if ((++_sp & 255u) == 0u) { if (xb_ld(&(bar)[XB_TMO])) break; if (_sp > XB_SPIN_CAP) { atomicAdd(&(bar)[XB_TMO], 1u); break; } } } } while (0)
struct XcdBarrier { unsigned* bar; unsigned x; volatile LAS unsigned* st; };
DI XcdBarrier xcd_barrier_post(unsigned* bar, volatile LAS unsigned* st) {
    XcdBarrier b; b.bar = bar; b.x = xb_xcc_id(); b.st = st;
    if (tid_opaque() == 0) (void)xb_add(&bar[XB_XCNT(b.x)], 1u);
    return b;
}
DI void xcd_barrier_complete(unsigned* bar, unsigned x, unsigned& nloc, unsigned& nx) {
    const unsigned G = gridDim.x * gridDim.y * gridDim.z;
    unsigned sum, cnt, mine, sp = 0u;
    for (;;) {
        sum = 0u; cnt = 0u; mine = 0u;
#pragma unroll
        for (unsigned j = 0; j < 16; ++j) { const unsigned c = xb_ld(&bar[XB_XCNT(j)]); sum += c; cnt += (c > 0u) ? 1u : 0u; mine = (j == x) ? c : mine; }
        if (sum == G) break;
        __builtin_amdgcn_s_sleep(1);
        if ((++sp & 255u) == 0u) { if (xb_ld(&bar[XB_TMO])) break; if (sp > XB_SPIN_CAP) { atomicAdd(&bar[XB_TMO], 1u); break; } }
    }
    nloc = mine > 0u ? mine : 1u; nx = cnt > 0u ? cnt : 1u;
}
DI void xcd_barrier(const XcdBarrier& b) {
    asm volatile("s_waitcnt vmcnt(0)" ::: "memory");
    __syncthreads();
    if (tid_opaque() == 0) {
        unsigned* bar = b.bar;
        __builtin_amdgcn_s_waitcnt(0);
        unsigned nloc = b.st[0], nx = b.st[1];
        if (nloc == 0u) { xcd_barrier_complete(bar, b.x, nloc, nx); b.st[0] = nloc; b.st[1] = nx; }
        const unsigned old = xb_add(&bar[XB_XSUB(b.x)], 1u);
        const unsigned gen = old / nloc;
        if (old + 1u == (gen + 1u) * nloc) {
            __builtin_amdgcn_fence(__ATOMIC_RELEASE, "agent");
            asm volatile("s_waitcnt vmcnt(0)" ::: "memory");
            const unsigned og = xb_add(&bar[XB_TOP], 1u);
            const unsigned tg = og / nx;
            if (og + 1u == (tg + 1u) * nx) xb_add(&bar[XB_TOPGEN], 1u);
            else XB_SPIN(xb_ld(&bar[XB_TOPGEN]) == tg, bar);
            __builtin_amdgcn_fence(__ATOMIC_ACQUIRE, "agent");
            xb_add(&bar[XB_XGEN(b.x)], 1u);
            asm volatile("s_waitcnt vmcnt(0)" ::: "memory");
        } else {
            XB_SPIN(xb_ld(&bar[XB_XGEN(b.x)]) == gen, bar);
            __builtin_amdgcn_fence(__ATOMIC_ACQUIRE, "agent");
            asm volatile("s_waitcnt vmcnt(0)" ::: "memory");
        }
    }
    __syncthreads();
}

DI float xor32_sum(float x) {
    const unsigned u = __float_as_uint(x);
    const auto r = __builtin_amdgcn_permlane32_swap(u, u, false, false);
    return __uint_as_float(r[0]) + __uint_as_float(r[1]);
}
#define DPP_ADD(v, ctrl) ((v) + __uint_as_float((unsigned)__builtin_amdgcn_update_dpp(0, (int)__float_as_uint(v), (ctrl), 0xf, 0xf, true)))
DI float wave_sum(float v) {
    v = DPP_ADD(v, 0xB1);
    v = DPP_ADD(v, 0x4E);
    v = DPP_ADD(v, 0x141);
    v = DPP_ADD(v, 0x140);
    const unsigned u = __float_as_uint(v);
    return (__uint_as_float(__builtin_amdgcn_readlane(u, 0)) + __uint_as_float(__builtin_amdgcn_readlane(u, 16))) +
           (__uint_as_float(__builtin_amdgcn_readlane(u, 32)) + __uint_as_float(__builtin_amdgcn_readlane(u, 48)));
}
DI int crow(int i, int hh) { return (i & 3) + 8 * (i >> 2) + 4 * hh; }
DI int mod_row(int r) { return r < NL ? (r >> 13) : 2; }
DI float frcp(float x) { return __builtin_amdgcn_rcpf(x); }
DI float fexp(float x) { return __builtin_amdgcn_exp2f(x * 1.4426950408889634f); }
DI float sigmoidf_(float x) { return frcp(1.0f + fexp(-x)); }
DI float one_minus_exp(float x) {
    const float s = -x * (1.0f + x * 0.5f * (1.0f + x * (1.0f / 3.0f) * (1.0f + x * 0.25f * (1.0f + x * 0.2f * (1.0f + x * (1.0f / 6.0f))))));
    const float d = 1.0f - fexp(x);
    return x > -0.125f ? s : d;
}

template <class F>
DI void cvt_list(const Params& P, uchar* lds, int i0, int step, int n, F&& job_of) {
    const int tid = tid_opaque();
    float* tl = (float*)lds;
    f32x4 rv[2];
    auto tile_src = [&](int idx, int& j, int& mat, int& kt, int& nt) -> const float* {
        int t; job_of(idx, j, t);
        const int N = P.jobs[j].N, tn = N >> 6, per = (P.jobs[j].K >> 6) * tn; mat = t / per; t -= mat * per; kt = t / tn; nt = t - kt * tn;
        return P.jobs[j].src + (size_t)mat * P.jobs[j].sstride + (size_t)(kt * 64) * N + nt * 64;
    };
    int u = i0, j = 0, mat = 0, kt = 0, nt = 0;
    __syncthreads();
    if (u < n) { const float* src = tile_src(u, j, mat, kt, nt); const int N = P.jobs[j].N;
#pragma unroll
        for (int i = 0; i < 2; ++i) rv[i] = *(const f32x4*)(src + (size_t)((tid >> 4) + 32 * i) * N + (tid & 15) * 4); }
    for (; u < n; u += step) {
#pragma unroll
        for (int i = 0; i < 2; ++i) { float* q = tl + ((tid >> 4) + 32 * i) * 65 + (tid & 15) * 4; q[0] = rv[i][0]; q[1] = rv[i][1]; q[2] = rv[i][2]; q[3] = rv[i][3]; }
        const CvtJob J = P.jobs[j];
        const int cmat = mat, ckt = kt, cnt_ = nt;
        const int un = u + step;
        if (un < n) { const float* src = tile_src(un, j, mat, kt, nt); const int N = P.jobs[j].N;
#pragma unroll
            for (int i = 0; i < 2; ++i) rv[i] = *(const f32x4*)(src + (size_t)((tid >> 4) + 32 * i) * N + (tid & 15) * 4); }
        __syncthreads();
        const int n_ = tid >> 3, kc = tid & 7;
        float v[8];
#pragma unroll
        for (int e = 0; e < 8; ++e) v[e] = tl[(kc * 8 + e) * 65 + n_];
        const int ng = cnt_ * 64 + n_;
        const int drow = J.mode ? ((ng >> 5) * 64 + J.half * 32 + (ng & 31)) : ng;
        u16* d = J.dst + (size_t)cmat * J.dstride + (size_t)drow * J.lddst + ckt * 64 + kc * 8;
        u32x4 w; w.x = pk2(v[0], v[1]); w.y = pk2(v[2], v[3]); w.z = pk2(v[4], v[5]); w.w = pk2(v[6], v[7]);
        *(u32x4*)d = w;
        __syncthreads();
    }
}
constexpr int MOE_CVT_TILES = 6144;
DI void tail_cvt_dense(const Params& P, uchar* lds, int nunits, int lo, int hi) {
    const int G = gridDim.x, rem = nunits % G;
    int rank = blockIdx.x, nidle = G;
    if (rem != 0) { if ((int)blockIdx.x < rem) return; rank = blockIdx.x - rem; nidle = G - rem; }
    cvt_list(P, lds, lo + rank, nidle, hi, [&](int idx, int& j, int& t) {
        j = 0;
#pragma unroll
        for (int q = 1; q < 6; ++q) if (idx >= P.jobs[q].tile0) j = q;
        t = idx - P.jobs[j].tile0; });
}
DI void tail_cvt_moe(const Params& P, uchar* lds, int nunits, int layer, int lo, int hi) {
    const int G = gridDim.x, rem = nunits % G;
    int rank = blockIdx.x, nidle = G;
    if (rem != 0) { if ((int)blockIdx.x < rem) return; rank = blockIdx.x - rem; nidle = G - rem; }
    cvt_list(P, lds, lo + rank, nidle, hi, [&](int idx, int& j, int& t) { j = 6 + (idx >> 11); t = layer * 2048 + (idx & 2047); });
}

DI void phase_prep(const Params& P, const Ctx& p, uchar* lds) {
    const int tid = tid_opaque();
    float* tl = (float*)lds;
    {
        float* sc = tl;
        float* red = tl + 3072;
        for (int u = blockIdx.x; u < 192; u += gridDim.x) {
            __syncthreads();
            for (int i = tid; i < 3072; i += 512) { const int mr = i >> 10, d = i & 1023; const float c = mr < 2 ? inp(p, I_C)[mr * 1024 + d] : inp(p, I_CCTX)[d]; sc[i] = c * sigmoidf_(c); }
            __syncthreads();
            const int l = u / 96, nc = u % 96, c4 = tid & 15, dg = tid >> 4;
            const float* w = inp(p, I_ADAW) + (size_t)l * 1024 * 6144 + nc * 64 + c4 * 4;
            f32x4 a0 = (f32x4){0.f, 0.f, 0.f, 0.f}, a1 = a0, a2 = a0;
#pragma unroll 16
            for (int dd = 0; dd < 32; ++dd) {
                const int d = dg * 32 + dd; const f32x4 wv = *(const f32x4*)(w + (size_t)d * 6144);
                const float s0 = sc[d], s1 = sc[1024 + d], s2 = sc[2048 + d];
#pragma unroll
                for (int e = 0; e < 4; ++e) { a0[e] += s0 * wv[e]; a1[e] += s1 * wv[e]; a2[e] += s2 * wv[e]; }
            }
            *(f32x4*)(red + (dg * 3 + 0) * 64 + c4 * 4) = a0; *(f32x4*)(red + (dg * 3 + 1) * 64 + c4 * 4) = a1; *(f32x4*)(red + (dg * 3 + 2) * 64 + c4 * 4) = a2;
            __syncthreads();
            if (tid < 192) {
                const int mr = tid >> 6, nn = tid & 63; float s = 0.f;
#pragma unroll
                for (int g = 0; g < 32; ++g) s += red[(g * 3 + mr) * 64 + nn];
                const int ncol = nc * 64 + nn;
                ((float*)(p.ws + WS_MOD))[(l * 3 + mr) * 6144 + ncol] = s + inp(p, I_ADAB)[l * 6144 + ncol];
            }
        }
        __syncthreads();
    }
    const int ntile0 = P.jobs[1].tile0;
    const bool split = gridDim.x == 256 && ntile0 == 768;
    const bool has_unit = (int)blockIdx.x < 192;
    int ci0 = blockIdx.x, cstep = gridDim.x, cn = ntile0;
    if (split) { if (has_unit) { cstep = 192; cn = 384; } else { ci0 = 384 + ((int)blockIdx.x - 192); cstep = 64; } }
    cvt_list(P, lds, ci0, cstep, cn, [&](int idx, int& j, int& t) {
        j = 0;
#pragma unroll
        for (int q = 1; q < 6; ++q) if (idx >= P.jobs[q].tile0) j = q;
        t = idx - P.jobs[j].tile0; });
    if (!split || !has_unit) {
        const int rb0 = split ? (int)blockIdx.x - 192 : (int)blockIdx.x, rbn = split ? 64 : (int)gridDim.x;
        for (int i = rb0 * 512 + tid; i < SEQ * 32; i += rbn * 512) {
            const int t = i >> 5, j = i & 31;
            const float pos = (float)(j < 16 ? (t >> 6) : (t & 63));
            const float inv = exp2f(-(float)(j & 15) * (13.287712379549449f / 16.0f));
            float sn, cs; sincosf(pos * inv, &sn, &cs);
            ((f32x2*)(p.ws + WS_ROPE))[i] = (f32x2){cs, sn};
        }
    }
}

DI void load_row16(const float* src, int lane, float (&v)[16]) {
#pragma unroll
    for (int j = 0; j < 4; ++j) { const f32x4 x = *(const f32x4*)(src + j * 256 + lane * 4); v[j * 4 + 0] = x[0]; v[j * 4 + 1] = x[1]; v[j * 4 + 2] = x[2]; v[j * 4 + 3] = x[3]; }
}
DI void norm_mod16(float (&v)[16], const float* g, const float* sh, const float* sc, int lane) {
    float ss = 0.f;
#pragma unroll
    for (int i = 0; i < 16; ++i) ss += v[i] * v[i];
    ss = wave_sum(ss);
    const float rstd = rsqrtf(ss * (1.0f / 1024.0f) + EPS);
#pragma unroll
    for (int j = 0; j < 4; ++j) {
        const int c = j * 256 + lane * 4;
        const f32x4 gg = *(const f32x4*)(g + c), s1 = *(const f32x4*)(sc + c), s0 = *(const f32x4*)(sh + c);
#pragma unroll
        for (int e = 0; e < 4; ++e) v[j * 4 + e] = (v[j * 4 + e] * rstd * gg[e]) * (1.0f + s1[e]) + s0[e];
    }
}
DI void store_row16_bf16(u16* dst, int lane, const float (&v)[16]) {
#pragma unroll
    for (int j = 0; j < 4; ++j) { u32x2 w; w.x = pk2(v[j * 4 + 0], v[j * 4 + 1]); w.y = pk2(v[j * 4 + 2], v[j * 4 + 3]); *(u32x2*)(dst + j * 256 + lane * 4) = w; }
}
DI const float* row_src(const Ctx& p, int layer, int r) {
    if (layer == 0) return r < NL ? inp(p, I_X) + (size_t)r * 1024 : inp(p, I_CTX) + (size_t)(r - NL) * 1024;
    return (const float*)(p.ws + WS_XS) + (size_t)r * 1024;
}
DI void phase_norm(const Ctx& p, int layer) {
    const int tid = tid_opaque(), lane = tid & 63, wv = blockIdx.x * 8 + (tid >> 6), nwv = gridDim.x * 8;
    const float* mod = (const float*)(p.ws + WS_MOD);
    u16* hb = (u16*)(p.ws + WS_HB);
    for (int r = wv; r < R; r += nwv) {
        float v[16];
        load_row16(row_src(p, layer, r), lane, v);
        const float* m = mod + (layer * 3 + mod_row(r)) * 6144;
        norm_mod16(v, inp(p, I_NMIX) + layer * 1024, m, m + 1024, lane);
        store_row16_bf16(hb + (size_t)r * 1024, lane, v);
    }
}
DI void phase_router(const Ctx& p, uchar* lds, int layer, int cnt_slot = -1) {
    const int tid = tid_opaque(), lane = tid & 63, wid = tid >> 6, wv = blockIdx.x * 8 + wid, nwv = gridDim.x * 8;
    const float* mod = (const float*)(p.ws + WS_MOD);
    u16* hb = (u16*)(p.ws + WS_HB);
    const float* xs = (const float*)(p.ws + WS_XS);
    const int nrows = layer == 0 ? R : NL;
    const float* wg = inp(p, I_MWGRP) + layer * 1024 * 4;
    const float* wr = inp(p, I_MWRT) + layer * 1024 * 16;
    const float* gnorm = inp(p, I_NFFN) + layer * 1024;
    int* cnt = (int*)(p.ws + WS_CTL + CTL_CNT) + (cnt_slot >= 0 ? cnt_slot : layer) * 1024;
    int* list = (int*)(p.ws + WS_LIST);
    f32x2* route = (f32x2*)(p.ws + WS_ROUTE);
    float* wrl = (float*)lds;
    float* wgl = wrl + 16384;
    float* hs = (float*)(lds + 81920 + wid * 8192);
    __syncthreads();
#pragma unroll
    for (int i = 0; i < 8; ++i) *(f32x4*)(wrl + (i * 512 + tid) * 4) = *(const f32x4*)(wr + (i * 512 + tid) * 4);
#pragma unroll
    for (int i = 0; i < 2; ++i) *(f32x4*)(wgl + (i * 512 + tid) * 4) = *(const f32x4*)(wg + (i * 512 + tid) * 4);
    __syncthreads();
    float bg[4], br[4];
#pragma unroll
    for (int o = 0; o < 4; ++o) { bg[o] = inp(p, I_MBGRP)[layer * 4 + o]; br[o] = inp(p, I_MBRT)[layer * 16 + (lane & 3) * 4 + o]; }
    for (int r0 = wv * 2; r0 < nrows; r0 += nwv * 2) {
        const float* m = mod + (layer * 3 + mod_row(r0)) * 6144;
        float v0[16], v1[16];
        load_row16(xs + (size_t)r0 * 1024, lane, v0);
        load_row16(xs + (size_t)(r0 + 1) * 1024, lane, v1);
        norm_mod16(v0, gnorm, m + 3 * 1024, m + 4 * 1024, lane);
        norm_mod16(v1, gnorm, m + 3 * 1024, m + 4 * 1024, lane);
        store_row16_bf16(hb + (size_t)r0 * 1024, lane, v0);
        store_row16_bf16(hb + (size_t)(r0 + 1) * 1024, lane, v1);
#pragma unroll
        for (int j = 0; j < 4; ++j) {
            *(f32x4*)(hs + (j * 256 + lane * 4) * 2) = (f32x4){v0[j * 4], v1[j * 4], v0[j * 4 + 1], v1[j * 4 + 1]};
            *(f32x4*)(hs + (j * 256 + lane * 4) * 2 + 4) = (f32x4){v0[j * 4 + 2], v1[j * 4 + 2], v0[j * 4 + 3], v1[j * 4 + 3]};
        }
        float ar[2][4], ag[2][4];
#pragma unroll
        for (int q = 0; q < 2; ++q)
#pragma unroll
            for (int o = 0; o < 4; ++o) { ar[q][o] = 0.f; ag[q][o] = 0.f; }
#pragma unroll 8
        for (int it = 0; it < 64; ++it) {
            const f32x4 w4 = *(const f32x4*)(wrl + (it * 64 + lane) * 4);
            const f32x2 x2 = *(const f32x2*)(hs + (it * 16 + (lane >> 2)) * 2);
#pragma unroll
            for (int o = 0; o < 4; ++o) { ar[0][o] += x2.x * w4[o]; ar[1][o] += x2.y * w4[o]; }
        }
#pragma unroll 8
        for (int it = 0; it < 16; ++it) {
            const f32x4 w4 = *(const f32x4*)(wgl + (it * 64 + lane) * 4);
            const f32x2 x2 = *(const f32x2*)(hs + (it * 64 + lane) * 2);
#pragma unroll
            for (int o = 0; o < 4; ++o) { ag[0][o] += x2.x * w4[o]; ag[1][o] += x2.y * w4[o]; }
        }
#pragma unroll
        for (int q = 0; q < 2; ++q)
#pragma unroll
            for (int o = 0; o < 4; ++o) {
                ag[q][o] = wave_sum(ag[q][o]);
                float v = ar[q][o]; v += __shfl_xor(v, 4); v += __shfl_xor(v, 8); v += __shfl_xor(v, 16); v = xor32_sum(v); ar[q][o] = v;
            }
#pragma unroll
        for (int q = 0; q < 2; ++q) {
            float gl[4];
#pragma unroll
            for (int o = 0; o < 4; ++o) gl[o] = ag[q][o] + bg[o];
            int gi = 0; float gm = gl[0];
#pragma unroll
            for (int o = 1; o < 4; ++o) if (gl[o] > gm) { gm = gl[o]; gi = o; }
            float gs = 0.f;
#pragma unroll
            for (int o = 0; o < 4; ++o) gs += __expf(gl[o] - gm);
            const float psel = 1.0f / gs;
            float el[4];
#pragma unroll
            for (int o = 0; o < 4; ++o) el[o] = __shfl(ar[q][o] + br[o], gi);
            int i1 = 0; float m1 = el[0];
#pragma unroll
            for (int o = 1; o < 4; ++o) if (el[o] > m1) { m1 = el[o]; i1 = o; }
            int i2 = -1; float m2 = -3.0e38f;
#pragma unroll
            for (int o = 0; o < 4; ++o) if (o != i1 && el[o] > m2) { m2 = el[o]; i2 = o; }
            if (lane == 0) {
                const int r = r0 + q;
                const float e2 = __expf(m2 - m1);
                const float w1 = psel / (1.0f + e2), w2 = psel * e2 / (1.0f + e2);
                const int lo = i1 < i2 ? i1 : i2, hi = i1 < i2 ? i2 : i1;
                const float wlo = i1 < i2 ? w1 : w2, whi = i1 < i2 ? w2 : w1;
                const int pi = lo == 0 ? (hi - 1) : (lo == 1 ? (hi + 1) : 5);
                const int bucket = gi * 6 + pi;
                const int pos = atomicAdd(cnt + bucket * 32, 1);
                list[(size_t)bucket * R + pos] = r;
                route[r] = (f32x2){wlo, whi};
            }
        }
    }
}

constexpr int LROW = 144;
constexpr int GEMM_A = 128 * 128, GEMM_B = 256 * 128, GEMM_STAGE = GEMM_A + GEMM_B;
constexpr int EPI_PITCH = 272, EPI_WAVE = 64 * EPI_PITCH;
static_assert(8 * EPI_WAVE <= 3 * GEMM_STAGE, "epilogue strips overlay the GEMM stages");
#define WAIT_V(n) asm volatile("s_waitcnt vmcnt(%0)" ::"n"(n) : "memory")
#define WAIT_L(n) asm volatile("s_waitcnt lgkmcnt(%0)" ::"n"(n) : "memory")
#define RAW_BARRIER() do { WAIT_L(0); __builtin_amdgcn_s_barrier(); } while (0)

template <class Epi>
DI void gemm_tile(uchar* lds, const u16* a0, const u16* a1, const u16* b0, const u16* b1, const u16* b2, const u16* b3, int nk, int ksplit, long bjump, Epi&& epi) {
    const int tid = tid_opaque(), lane = tid & 63, wid = tid >> 6, wr = wid >> 2, wc = wid & 3, l31 = lane & 31, hh = lane >> 5;
    const int lch = (lane & 7) ^ ((((wid & 1) << 3) + (lane >> 3)) >> 1);
    a0 += lch * 8; a1 += lch * 8; b0 += lch * 8; b1 += lch * 8; b2 += lch * 8; b3 += lch * 8;
    const unsigned pw = (unsigned)__builtin_amdgcn_readfirstlane(wid) * 1024u;
    const int sw = (l31 >> 1) & 7;
    unsigned xo[4];
#pragma unroll
    for (int ks = 0; ks < 4; ++ks) xo[ks] = (unsigned)(((ks * 2 + hh) ^ sw) << 4);
    const unsigned aro = (unsigned)((wr * 64 + l31) * 128), bro = (unsigned)(GEMM_A + (wc * 64 + l31) * 128);
    f32x16 acc[2][2];
#pragma unroll
    for (int a = 0; a < 2; ++a)
#pragma unroll
        for (int b = 0; b < 2; ++b)
#pragma unroll
            for (int i = 0; i < 16; ++i) acc[a][b][i] = 0.f;
#define GEMM_DMA(st_, kt_) do { const int kq_ = (kt_); const long bo_ = (long)kq_ * 64 + (kq_ >= ksplit ? bjump : 0); uchar* s_ = lds + (st_) * GEMM_STAGE + pw; \
        __builtin_amdgcn_global_load_lds((const unsigned*)(a0 + kq_ * 64), (LAS unsigned*)(s_), 16, 0, 0); \
        __builtin_amdgcn_global_load_lds((const unsigned*)(a1 + kq_ * 64), (LAS unsigned*)(s_ + 8192), 16, 0, 0); \
        __builtin_amdgcn_global_load_lds((const unsigned*)(b0 + bo_), (LAS unsigned*)(s_ + GEMM_A), 16, 0, 0); \
        __builtin_amdgcn_global_load_lds((const unsigned*)(b1 + bo_), (LAS unsigned*)(s_ + GEMM_A + 8192), 16, 0, 0); \
        __builtin_amdgcn_global_load_lds((const unsigned*)(b2 + bo_), (LAS unsigned*)(s_ + GEMM_A + 16384), 16, 0, 0); \
        __builtin_amdgcn_global_load_lds((const unsigned*)(b3 + bo_), (LAS unsigned*)(s_ + GEMM_A + 24576), 16, 0, 0); } while (0)
    RAW_BARRIER();
    GEMM_DMA(0, 0); GEMM_DMA(1, 1);
    WAIT_V(6);
    RAW_BARRIER();
    int cur = 0;
#pragma unroll 1
    for (int kt = 0; kt < nk; ++kt) {
        const int nxt = cur == 0 ? 2 : cur - 1;
        if (kt + 2 < nk) GEMM_DMA(nxt, kt + 2);
        const uchar* s = lds + cur * GEMM_STAGE;
#pragma unroll
        for (int ks = 0; ks < 4; ++ks) {
            const bf16x8 fa0 = *(const bf16x8*)(s + aro + xo[ks]), fa1 = *(const bf16x8*)(s + aro + 4096 + xo[ks]);
            const bf16x8 fb0 = *(const bf16x8*)(s + bro + xo[ks]), fb1 = *(const bf16x8*)(s + bro + 4096 + xo[ks]);
            acc[0][0] = MFMA32(fb0, fa0, acc[0][0]); acc[0][1] = MFMA32(fb0, fa1, acc[0][1]);
            acc[1][0] = MFMA32(fb1, fa0, acc[1][0]); acc[1][1] = MFMA32(fb1, fa1, acc[1][1]);
        }
        if (kt + 2 < nk) WAIT_V(6); else WAIT_V(0);
        RAW_BARRIER();
        cur = cur == 2 ? 0 : cur + 1;
    }
#if PROBE_GEMM2X == 1
    {
        f32x16 d[2][2];
        for (int a = 0; a < 2; ++a) for (int b = 0; b < 2; ++b) for (int i = 0; i < 16; ++i) d[a][b][i] = 0.f;
        RAW_BARRIER(); GEMM_DMA(0, 0); GEMM_DMA(1, 1); WAIT_V(6); RAW_BARRIER();
        int cur2 = 0;
#pragma unroll 1
        for (int kt = 0; kt < nk; ++kt) {
            const int nxt = cur2 == 0 ? 2 : cur2 - 1;
            if (kt + 2 < nk) GEMM_DMA(nxt, kt + 2);
            const uchar* s = lds + cur2 * GEMM_STAGE;
#pragma unroll
            for (int ks = 0; ks < 4; ++ks) {
                const bf16x8 fa0 = *(const bf16x8*)(s + aro + xo[ks]), fa1 = *(const bf16x8*)(s + aro + 4096 + xo[ks]);
                const bf16x8 fb0 = *(const bf16x8*)(s + bro + xo[ks]), fb1 = *(const bf16x8*)(s + bro + 4096 + xo[ks]);
                d[0][0] = MFMA32(fb0, fa0, d[0][0]); d[0][1] = MFMA32(fb0, fa1, d[0][1]);
                d[1][0] = MFMA32(fb1, fa0, d[1][0]); d[1][1] = MFMA32(fb1, fa1, d[1][1]);
            }
            if (kt + 2 < nk) WAIT_V(6); else WAIT_V(0);
            RAW_BARRIER();
            cur2 = cur2 == 2 ? 0 : cur2 + 1;
        }
        asm volatile("" :: "v"(d[0][0]), "v"(d[0][1]), "v"(d[1][0]), "v"(d[1][1]));
    }
#elif PROBE_GEMM2X == 2
    {
        f32x4 d[4][4];
        for (int a = 0; a < 4; ++a) for (int b = 0; b < 4; ++b) d[a][b] = (f32x4){0.f, 0.f, 0.f, 0.f};
        RAW_BARRIER(); GEMM_DMA(0, 0); GEMM_DMA(1, 1); WAIT_V(6); RAW_BARRIER();
        int cur2 = 0;
#pragma unroll 1
        for (int kt = 0; kt < nk; ++kt) {
            const int nxt = cur2 == 0 ? 2 : cur2 - 1;
            if (kt + 2 < nk) GEMM_DMA(nxt, kt + 2);
            const uchar* s = lds + cur2 * GEMM_STAGE;
#pragma unroll
            for (int kp = 0; kp < 2; ++kp) {
                bf16x8 fa[4], fb[4];
                fa[0] = *(const bf16x8*)(s + aro + xo[2 * kp]); fa[1] = *(const bf16x8*)(s + aro + 4096 + xo[2 * kp]); fa[2] = *(const bf16x8*)(s + aro + xo[2 * kp + 1]); fa[3] = *(const bf16x8*)(s + aro + 4096 + xo[2 * kp + 1]);
                fb[0] = *(const bf16x8*)(s + bro + xo[2 * kp]); fb[1] = *(const bf16x8*)(s + bro + 4096 + xo[2 * kp]); fb[2] = *(const bf16x8*)(s + bro + xo[2 * kp + 1]); fb[3] = *(const bf16x8*)(s + bro + 4096 + xo[2 * kp + 1]);
#pragma unroll
                for (int a = 0; a < 4; ++a)
#pragma unroll
                    for (int b = 0; b < 4; ++b) d[a][b] = __builtin_amdgcn_mfma_f32_16x16x32_bf16(fb[b], fa[a], d[a][b], 0, 0, 0);
            }
            if (kt + 2 < nk) WAIT_V(6); else WAIT_V(0);
            RAW_BARRIER();
            cur2 = cur2 == 2 ? 0 : cur2 + 1;
        }
        asm volatile("" :: "v"(d[0][0]), "v"(d[0][1]), "v"(d[0][2]), "v"(d[0][3]), "v"(d[1][0]), "v"(d[1][1]), "v"(d[1][2]), "v"(d[1][3]));
        asm volatile("" :: "v"(d[2][0]), "v"(d[2][1]), "v"(d[2][2]), "v"(d[2][3]), "v"(d[3][0]), "v"(d[3][1]), "v"(d[3][2]), "v"(d[3][3]));
    }
#endif
    epi(acc, wr * 64, wc, lane, lds + wid * EPI_WAVE);
}

constexpr int G2_A = 256 * 64, G2_STAGE = 2 * G2_A;
template <class Epi>
DI void gemm_tile256(uchar* lds, const u16* a0, const u16* a1, const u16* b0, const u16* b1, int nk, int ksplit, long bjump, Epi&& epi) {
    const int tid = tid_opaque(), lane = tid & 63, wid = tid >> 6, wr = wid >> 2, wc = wid & 3, l31 = lane & 31, hh = lane >> 5;
    const int lch = (lane & 3) ^ ((lane >> 4) & 3);
    a0 += lch * 8; a1 += lch * 8; b0 += lch * 8; b1 += lch * 8;
    const unsigned pw = (unsigned)__builtin_amdgcn_readfirstlane(wid) * 1024u;
    const int sw = (l31 >> 2) & 3;
    const unsigned xo0 = (unsigned)(((0 + hh) ^ sw) << 4), xo1 = (unsigned)(((2 + hh) ^ sw) << 4);
    const unsigned aro = (unsigned)((wr * 128 + l31) * 64), bro = (unsigned)(G2_A + (wc * 64 + l31) * 64);
    f32x16 acc[2][4];
#pragma unroll
    for (int a = 0; a < 2; ++a)
#pragma unroll
        for (int b = 0; b < 4; ++b)
#pragma unroll
            for (int i = 0; i < 16; ++i) acc[a][b][i] = 0.f;
#define G2_DMA(st_, kt_) do { const int kq_ = (kt_); const long bo_ = (long)kq_ * 32 + (kq_ >= ksplit ? bjump : 0); uchar* s_ = lds + (st_) * G2_STAGE + pw; \
        __builtin_amdgcn_global_load_lds((const unsigned*)(a0 + kq_ * 32), (LAS unsigned*)(s_), 16, 0, 0); \
        __builtin_amdgcn_global_load_lds((const unsigned*)(a1 + kq_ * 32), (LAS unsigned*)(s_ + 8192), 16, 0, 0); \
        __builtin_amdgcn_global_load_lds((const unsigned*)(b0 + bo_), (LAS unsigned*)(s_ + G2_A), 16, 0, 0); \
        __builtin_amdgcn_global_load_lds((const unsigned*)(b1 + bo_), (LAS unsigned*)(s_ + G2_A + 8192), 16, 0, 0); } while (0)
    RAW_BARRIER();
    G2_DMA(0, 0); G2_DMA(1, 1); G2_DMA(2, 2);
    WAIT_V(8);
    RAW_BARRIER();
#pragma unroll 1
    for (int kt = 0; kt < nk; ++kt) {
        if (kt + 3 < nk) G2_DMA((kt + 3) & 3, kt + 3);
        const uchar* s = lds + (kt & 3) * G2_STAGE;
#pragma unroll
        for (int ks = 0; ks < 2; ++ks) {
            const unsigned xo = ks ? xo1 : xo0;
            bf16x8 fa[4], fb[2];
#pragma unroll
            for (int mb = 0; mb < 4; ++mb) fa[mb] = *(const bf16x8*)(s + aro + mb * 2048 + xo);
#pragma unroll
            for (int nb = 0; nb < 2; ++nb) fb[nb] = *(const bf16x8*)(s + bro + nb * 2048 + xo);
#pragma unroll
            for (int nb = 0; nb < 2; ++nb)
#pragma unroll
                for (int mb = 0; mb < 4; ++mb) acc[nb][mb] = MFMA32(fb[nb], fa[mb], acc[nb][mb]);
        }
        if (kt + 3 < nk) WAIT_V(8); else if (kt + 2 < nk) WAIT_V(4); else WAIT_V(0);
        RAW_BARRIER();
    }
#pragma unroll
    for (int half = 0; half < 2; ++half) {
        f32x16 t[2][2];
#pragma unroll
        for (int nb = 0; nb < 2; ++nb)
#pragma unroll
            for (int mb = 0; mb < 2; ++mb) t[nb][mb] = acc[nb][2 * half + mb];
        epi(t, wr * 128 + half * 64, wc, lane, lds + wid * EPI_WAVE);
    }
}

DI void epi_put4(uchar* w, int row, int col, float a, float b, float c, float d) { *(f32x4*)(w + row * EPI_PITCH + col * 4) = (f32x4){a, b, c, d}; }
DI void epi_stage(uchar* w, const f32x16 (&acc)[2][2], int l31, int hh) {
#pragma unroll
    for (int mb = 0; mb < 2; ++mb)
#pragma unroll
        for (int nb = 0; nb < 2; ++nb)
#pragma unroll
            for (int g = 0; g < 4; ++g) epi_put4(w, mb * 32 + l31, nb * 32 + 8 * g + 4 * hh, acc[nb][mb][4 * g], acc[nb][mb][4 * g + 1], acc[nb][mb][4 * g + 2], acc[nb][mb][4 * g + 3]);
}
template <class F> DI void epi_rows4(const uchar* w, int lane, F&& f) {
#pragma unroll
    for (int it = 0; it < 16; ++it) { const int row = it * 4 + (lane >> 4), col = (lane & 15) * 4; f(row, col, *(const f32x4*)(w + row * EPI_PITCH + col * 4)); }
}
template <int NC, class F> DI void epi_rows8(const uchar* w, int lane, F&& f) {
    constexpr int LPR = NC / 8, RPI = 64 / LPR;
#pragma unroll
    for (int it = 0; it < 64 / RPI; ++it) { const int row = it * RPI + lane / LPR, col = (lane % LPR) * 8; f(row, col, *(const f32x4*)(w + row * EPI_PITCH + col * 4), *(const f32x4*)(w + row * EPI_PITCH + col * 4 + 16)); }
}
DI u32x4 pack8(const f32x4& a, const f32x4& b) { u32x4 r; r.x = pk2(a[0], a[1]); r.y = pk2(a[2], a[3]); r.z = pk2(b[0], b[1]); r.w = pk2(b[2], b[3]); return r; }

#define MFMA16(a, b, c) __builtin_amdgcn_mfma_f32_16x16x32_bf16((a), (b), (c), 0, 0, 0)
constexpr int P8_HT = 16384;
DI void p8_rc(int tid, int& r0, int& c) { const int wid = tid >> 6, lane = tid & 63; r0 = (wid >> 1) * 16 + (lane >> 2); c = (wid & 1) * 32 + (((lane & 3) ^ ((lane >> 5) << 1)) << 3); }
DI void glds16(const uchar* g, uchar* s) { __builtin_amdgcn_global_load_lds((const unsigned*)g, (LAS unsigned*)s, 16, 0, 0); }
template <class Epi>
DI void gemm_tile8p(uchar* lds, const uchar* abase, unsigned a0_0, unsigned a1_0, unsigned a0_1, unsigned a1_1, int ac1_0, int ac0_1, int ac1_1,
                    const uchar* bbase, unsigned bo, int bc1_0, int bc0_1, int bc1_1, int nk, int ksplit, long bjump, Epi&& epi) {
    constexpr int ac0_0 = 0, bc0_0 = 0;
    const int tid = tid_opaque(), lane = tid & 63, wid = tid >> 6, wr = wid >> 2, wc = wid & 3, fr = lane & 15, fq = lane >> 4;
    const unsigned pw = (unsigned)__builtin_amdgcn_readfirstlane(wid) * 1024u;
    const unsigned lp = (unsigned)((fr * 64 + fq * 16) ^ ((fr >> 3) << 5));
    const unsigned la = (unsigned)wr * 8192u + lp, lb = (unsigned)wc * 4096u + lp;
    f32x4 acc[2][2][4][2];
#pragma unroll
    for (int a = 0; a < 2; ++a)
#pragma unroll
        for (int b = 0; b < 2; ++b)
#pragma unroll
            for (int m = 0; m < 4; ++m)
#pragma unroll
                for (int n = 0; n < 2; ++n) acc[a][b][m][n] = (f32x4){0.f, 0.f, 0.f, 0.f};
    bf16x8 At[4][2], B0[2][2], B1[2][2];
#define P8_SA(b, h) (((b) * 2 + (h)) * P8_HT)
#define P8_SB(b, h) ((4 + (b) * 2 + (h)) * P8_HT)
#define P8_STAGE_A(b, h, kt) do { const uchar* g_ = abase + (size_t)(kt) * 128; uchar* s_ = lds + P8_SA(b, h) + pw; glds16(g_ + ac0_##h + a0_##h, s_); glds16(g_ + ac1_##h + a1_##h, s_ + 8192); } while (0)
#define P8_STAGE_B(b, h, kt) do { const int kq_ = (kt); const uchar* g_ = bbase + (size_t)kq_ * 128 + (kq_ >= ksplit ? bjump : 0); uchar* s_ = lds + P8_SB(b, h) + pw; glds16(g_ + bc0_##h + bo, s_); glds16(g_ + bc1_##h + bo, s_ + 8192); } while (0)
#define P8_LDA(dst, b, h) do { _Pragma("unroll") for (int m = 0; m < 4; ++m) { _Pragma("unroll") for (int k = 0; k < 2; ++k) dst[m][k] = *(const bf16x8*)(lds + P8_SA(b, h) + la + (m * 2 + k) * 1024); } } while (0)
#define P8_LDB(dst, b, h) do { _Pragma("unroll") for (int n = 0; n < 2; ++n) { _Pragma("unroll") for (int k = 0; k < 2; ++k) dst[n][k] = *(const bf16x8*)(lds + P8_SB(b, h) + lb + (n * 2 + k) * 1024); } } while (0)
#define P8_MMA(ai, bj, Bx) do { __builtin_amdgcn_s_setprio(1); \
        _Pragma("unroll") for (int m = 0; m < 4; ++m) { _Pragma("unroll") for (int n = 0; n < 2; ++n) { _Pragma("unroll") for (int k = 0; k < 2; ++k) acc[ai][bj][m][n] = MFMA16(Bx[n][k], At[m][k], acc[ai][bj][m][n]); } } \
        __builtin_amdgcn_s_setprio(0); } while (0)
#define P8_BAR() __builtin_amdgcn_s_barrier()
#define P8_SCHED() __builtin_amdgcn_sched_barrier(0)
    RAW_BARRIER();
    P8_STAGE_B(0, 0, 0); P8_STAGE_A(0, 0, 0); P8_STAGE_B(0, 1, 0); P8_STAGE_A(0, 1, 0);
    if (wr == 1) P8_BAR();
    WAIT_V(4); P8_BAR();
    P8_STAGE_B(1, 0, 1); P8_STAGE_A(1, 0, 1); P8_STAGE_B(1, 1, 1);
    WAIT_V(6); P8_BAR();
#pragma unroll 1
    for (int t = 0; t < nk - 2; t += 2) {
        P8_LDB(B0, 0, 0); P8_SCHED(); P8_LDA(At, 0, 0); P8_STAGE_A(1, 1, t + 1);
        WAIT_L(8); P8_BAR(); WAIT_L(0); P8_MMA(0, 0, B0); P8_BAR(); P8_SCHED();
        P8_LDB(B1, 0, 1); P8_STAGE_B(0, 0, t + 2);
        P8_BAR(); WAIT_L(0); P8_MMA(0, 1, B1); P8_BAR();
        P8_LDA(At, 0, 1); P8_STAGE_A(0, 0, t + 2);
        P8_BAR(); WAIT_L(0); P8_MMA(1, 0, B0); P8_BAR(); P8_SCHED();
        P8_STAGE_B(0, 1, t + 2);
        WAIT_V(6); P8_BAR(); P8_MMA(1, 1, B1); P8_BAR();
        P8_LDB(B0, 1, 0); P8_SCHED(); P8_LDA(At, 1, 0); P8_STAGE_A(0, 1, t + 2);
        WAIT_L(8); P8_BAR(); WAIT_L(0); P8_MMA(0, 0, B0); P8_BAR(); P8_SCHED();
        P8_LDB(B1, 1, 1); P8_STAGE_B(1, 0, t + 3);
        P8_BAR(); WAIT_L(0); P8_MMA(0, 1, B1); P8_BAR();
        P8_LDA(At, 1, 1); P8_STAGE_A(1, 0, t + 3);
        P8_BAR(); WAIT_L(0); P8_MMA(1, 0, B0); P8_BAR(); P8_SCHED();
        P8_STAGE_B(1, 1, t + 3);
        WAIT_V(6); P8_BAR(); P8_MMA(1, 1, B1); P8_BAR();
    }
    {
        P8_LDB(B0, 0, 0); P8_LDA(At, 0, 0); P8_STAGE_A(1, 1, nk - 1);
        P8_BAR(); WAIT_L(0); P8_MMA(0, 0, B0); P8_BAR();
        P8_LDB(B1, 0, 1); P8_BAR(); WAIT_L(0); P8_MMA(0, 1, B1); P8_BAR();
        P8_LDA(At, 0, 1); WAIT_V(4); P8_BAR(); WAIT_L(0); P8_MMA(1, 0, B0); P8_MMA(1, 1, B1); P8_BAR();
    }
    {
        P8_LDB(B0, 1, 0); P8_LDA(At, 1, 0); WAIT_V(2); P8_BAR(); WAIT_L(0); P8_MMA(0, 0, B0); P8_BAR();
        P8_LDB(B1, 1, 1); WAIT_V(0); P8_BAR(); WAIT_L(0); P8_MMA(0, 1, B1); P8_BAR();
        P8_LDA(At, 1, 1); P8_BAR(); WAIT_L(0); P8_MMA(1, 0, B0); P8_MMA(1, 1, B1); P8_BAR();
    }
    if (wr == 0) P8_BAR();
    RAW_BARRIER();
    uchar* w = lds + wid * EPI_WAVE;
#pragma unroll
    for (int ai = 0; ai < 2; ++ai) {
#pragma unroll
        for (int bj = 0; bj < 2; ++bj)
#pragma unroll
            for (int m = 0; m < 4; ++m)
#pragma unroll
                for (int n = 0; n < 2; ++n) *(f32x4*)(w + (m * 16 + fr) * EPI_PITCH + (bj * 32 + n * 16 + fq * 4) * 4) = acc[ai][bj][m][n];
        epi(wr * 128 + ai * 64, wc, lane, w);
    }
}
DI void epi_unstage(const uchar* w, f32x16 (&t)[2][2], int l31, int hh) {
#pragma unroll
    for (int mb = 0; mb < 2; ++mb)
#pragma unroll
        for (int nb = 0; nb < 2; ++nb)
#pragma unroll
            for (int g = 0; g < 4; ++g) { const f32x4 v = *(const f32x4*)(w + (mb * 32 + l31) * EPI_PITCH + (nb * 32 + 8 * g + 4 * hh) * 4); t[nb][mb][4 * g] = v[0]; t[nb][mb][4 * g + 1] = v[1]; t[nb][mb][4 * g + 2] = v[2]; t[nb][mb][4 * g + 3] = v[3]; }
}

DI void rect_unit(int v, int MT, int NT, int& mt, int& nt) {
    if (gridDim.x != 256) { mt = v / NT; nt = v % NT; return; }
    const int r = v >> 8, b = v & 255, x = b & 7, y = b >> 3;
    const int q = r * 8 + x, nqn = NT >> 2, qm = q / nqn, qn = q - qm * nqn;
    mt = qm * 8 + (y & 7); nt = qn * 4 + (y >> 3);
}
DI void phase_inproj0(const Params& P, const Ctx& p, uchar* lds) {
    const int tid = tid_opaque();
    const u16* hb = (const u16*)(p.ws + WS_HB);
    const u16* w = (const u16*)(p.ws + WS_WIN0);
    u16* zc = (u16*)(p.ws + WS_REGA + RA_ZC);
    u16* qa = (u16*)(p.ws + WS_REGA + RA_Q);
    u16* ka = (u16*)(p.ws + WS_REGA + RA_K);
    u16* vt = (u16*)(p.ws + WS_REGA + RA_VT);
    const f32x2* rope = (const f32x2*)(p.ws + WS_ROPE);
    const int rs = tid >> 3;
    for (int u = blockIdx.x; u < 768 + 48; u += gridDim.x) {
        const bool big = u < 768;
        int mt, nt; if (big) rect_unit(u, 64, 12, mt, nt); else { mt = (u - 768) / 12; nt = (u - 768) % 12; }
        const int m0 = big ? mt * 256 : NL + mt * 128, n0 = nt * 256;
        auto epi =
            [&](f32x16 (&acc)[2][2], int roff, int wc, int lane, uchar* w) {
                const int l31 = lane & 31, hh = lane >> 5, nw = n0 + wc * 64;
                const int row0 = m0 + roff;
                int b, spos0; if (row0 < NL) { b = row0 >> 13; spos0 = row0 & 8191; } else { b = (row0 - NL) >> 8; spos0 = SEQ + ((row0 - NL) & 255); }
                if (nw < 1536) {
                    epi_stage(w, acc, l31, hh);
                    epi_rows8<64>(w, lane, [&](int row, int col, const f32x4& v0, const f32x4& v1) { *(u32x4*)(zc + (size_t)(row0 + row) * 1536 + nw + col) = pack8(v0, v1); });
                } else if (nw < 2560) {
                    const bool isq = nw < 2048;
                    const int cg = (nw - (isq ? 1536 : 2048)) >> 6, head = cg >> 1, map = cg & 1;
                    const float* gain = isq ? inp(p, I_QN) : inp(p, I_KN);
                    const float osc = isq ? QSCALE : 1.0f;
#pragma unroll
                    for (int mb = 0; mb < 2; ++mb) {
                        float ss = 0.f;
#pragma unroll
                        for (int nb = 0; nb < 2; ++nb)
#pragma unroll
                            for (int i = 0; i < 16; ++i) ss += acc[nb][mb][i] * acc[nb][mb][i];
                        ss = xor32_sum(ss);
                        const float rstd = rsqrtf(ss * (1.0f / 64.0f) + EPS);
                        const int spos = spos0 + mb * 32 + l31;
#pragma unroll
                        for (int g = 0; g < 4; ++g) {
                            const int d0 = 8 * g + 4 * hh;
                            const f32x4 g1v = *(const f32x4*)(gain + d0), g2v = *(const f32x4*)(gain + 32 + d0);
                            f32x4 csa = (f32x4){1.f, 0.f, 1.f, 0.f}, csb = csa;
                            if (row0 < NL) { csa = *(const f32x4*)((const float*)(rope + spos * 32 + d0)); csb = *(const f32x4*)((const float*)(rope + spos * 32 + d0 + 2)); }
                            float o1[4], o2[4];
#pragma unroll
                            for (int e = 0; e < 4; ++e) {
                                const float v1 = acc[0][mb][4 * g + e] * rstd * g1v[e], v2 = acc[1][mb][4 * g + e] * rstd * g2v[e];
                                const float cs = e < 2 ? csa[2 * e] : csb[2 * (e - 2)], sn = e < 2 ? csa[2 * e + 1] : csb[2 * (e - 2) + 1];
                                o1[e] = (v1 * cs - v2 * sn) * osc; o2[e] = (v2 * cs + v1 * sn) * osc;
                            }
                            epi_put4(w, mb * 32 + l31, d0, o1[0], o1[1], o1[2], o1[3]);
                            epi_put4(w, mb * 32 + l31, 32 + d0, o2[0], o2[1], o2[2], o2[3]);
                        }
                    }
                    u16* dst = (isq ? qa : ka) + ((size_t)(((b * 4 + head) * 2 + map)) * SK + spos0) * 64;
                    epi_rows8<64>(w, lane, [&](int row, int col, const f32x4& v0, const f32x4& v1) { *(u32x4*)(dst + (size_t)row * 64 + col) = pack8(v0, v1); });
                } else {
                    const int head = (nw - 2560) >> 7, vb0 = (nw - 2560) & 127;
#pragma unroll
                    for (int mb = 0; mb < 2; ++mb) {
                        const int tok = mb * 32 + l31, tp = (tok & ~12) | (((tok >> 3) & 1) << 2) | (((tok >> 2) & 1) << 3);
#pragma unroll
                        for (int nb = 0; nb < 2; ++nb)
#pragma unroll
                            for (int i = 0; i < 16; ++i) *(u16*)(w + (nb * 32 + crow(i, hh)) * 144 + tp * 2) = f2b(acc[nb][mb][i]);
                    }
                    u16* dst = vt + ((size_t)(b * 4 + head) * 128 + vb0) * SK + spos0;
#pragma unroll
                    for (int it = 0; it < 8; ++it) { const int v = it * 8 + (lane >> 3), c8 = lane & 7; *(u32x4*)(dst + (size_t)v * SK + c8 * 8) = *(const u32x4*)(w + v * 144 + c8 * 16); }
                }
            };
        if (big) {
            int r0, c; p8_rc(tid, r0, c);
            const unsigned ao = (unsigned)(r0 * 2048 + c * 2), bo = (unsigned)((((r0 >> 5) * 64 + (r0 & 31)) * 2048) + c * 2);
            gemm_tile8p(lds, (const uchar*)(hb + (size_t)m0 * 1024), ao, ao, ao, ao, 128 * 2048, 64 * 2048, 192 * 2048,
                        (const uchar*)(w + (size_t)n0 * 1024), bo, 128 * 2048, 32 * 2048, 160 * 2048, 16, 1 << 30, 0,
                        [&](int roff, int wc, int lane, uchar* w) {
                            const int nw = n0 + wc * 64;
                            if (nw < 1536) { const int row0 = m0 + roff; epi_rows8<64>(w, lane, [&](int row, int col, const f32x4& v0, const f32x4& v1) { *(u32x4*)(zc + (size_t)(row0 + row) * 1536 + nw + col) = pack8(v0, v1); }); }
                            else { f32x16 t[2][2]; epi_unstage(w, t, lane & 31, lane >> 5); epi(t, roff, wc, lane, w); } });
        } else {
            const u16* ab = hb + (size_t)(m0 + rs) * 1024;
            const u16* bb = w + (size_t)(n0 + rs) * 1024;
            gemm_tile(lds, ab, ab + 64 * 1024, bb, bb + 64 * 1024, bb + 128 * 1024, bb + 192 * 1024, 16, 1 << 30, 0, epi);
        }
    }
    tail_cvt_moe(P, lds, 768 + 48, 0, 0, MOE_CVT_TILES / 2);
    tail_cvt_dense(P, lds, 768 + 48, P.jobs[1].tile0, P.jobs[2].tile0);
}

constexpr int ATT_K = 64 * 128, ATT_V = 128 * 128;
constexpr int ATT_STAGE = 2 * ATT_K + ATT_V;
DI void attn_unit(const Ctx& p, uchar* lds, int bh, int q0, int key0, int ntile, int out_row0) {
    const int tid = tid_opaque();
    const int lane = tid & 63, wid = tid >> 6, l31 = lane & 31, hh = lane >> 5, m = wid >> 2, g = wid & 3;
    const u16* qa = (const u16*)(p.ws + WS_REGA + RA_Q);
    const u16* ka = (const u16*)(p.ws + WS_REGA + RA_K);
    const u16* vt = (const u16*)(p.ws + WS_REGA + RA_VT);
    uchar* qs = lds + 2 * ATT_STAGE + wid * 8192 + lane * 16;
    RAW_BARRIER();
    {
        const u16* qp = qa + ((size_t)(bh * 2 + m) * SK + q0 + g * 64 + l31) * 64 + hh * 8;
#pragma unroll
        for (int rg = 0; rg < 2; ++rg)
#pragma unroll
            for (int ks = 0; ks < 4; ++ks) *(bf16x8*)(qs + (rg * 4 + ks) * 1024) = *(const bf16x8*)(qp + rg * 32 * 64 + ks * 16);
    }
    const int lch = (lane & 7) ^ ((((wid & 1) << 3) + (lane >> 3)) >> 1);
    const u16* kp = ka + ((size_t)(bh * 2) * SK + key0 + wid * 8 + (lane >> 3)) * 64 + lch * 8;
    const u16* vp = vt + ((size_t)bh * 128 + wid * 8 + (lane >> 3)) * SK + key0 + lch * 8;
    const unsigned pw = (unsigned)__builtin_amdgcn_readfirstlane(wid) * 1024u;
    const int sw = (l31 >> 1) & 7;
    unsigned xo[4];
#pragma unroll
    for (int ks = 0; ks < 4; ++ks) xo[ks] = (unsigned)(((ks * 2 + hh) ^ sw) << 4);
    const unsigned kro = (unsigned)(m * ATT_K + l31 * 128), vro = (unsigned)(2 * ATT_K + l31 * 128);
    f32x16 O[2][4];
#pragma unroll
    for (int rg = 0; rg < 2; ++rg)
#pragma unroll
        for (int vb = 0; vb < 4; ++vb)
#pragma unroll
            for (int i = 0; i < 16; ++i) O[rg][vb][i] = 0.f;
    float lsum0 = 0.f, lsum1 = 0.f;
#define ATT_DMA(st_, t_) do { const int tq_ = (t_); uchar* s_ = lds + (st_) * ATT_STAGE + pw; \
        __builtin_amdgcn_global_load_lds((const unsigned*)(kp + (size_t)tq_ * 4096), (LAS unsigned*)(s_), 16, 0, 0); \
        __builtin_amdgcn_global_load_lds((const unsigned*)(kp + (size_t)SK * 64 + (size_t)tq_ * 4096), (LAS unsigned*)(s_ + ATT_K), 16, 0, 0); \
        __builtin_amdgcn_global_load_lds((const unsigned*)(vp + tq_ * 64), (LAS unsigned*)(s_ + 2 * ATT_K), 16, 0, 0); \
        __builtin_amdgcn_global_load_lds((const unsigned*)(vp + (size_t)64 * SK + tq_ * 64), (LAS unsigned*)(s_ + 2 * ATT_K + 8192), 16, 0, 0); } while (0)
    ATT_DMA(0, 0);
    WAIT_V(0);
    RAW_BARRIER();
#pragma unroll 1
    for (int t = 0; t < ntile; ++t) {
        if (t + 1 < ntile) ATT_DMA((t + 1) & 1, t + 1);
        const uchar* s = lds + (t & 1) * ATT_STAGE;
#pragma unroll 1
        for (int kb = 0; kb < 2; ++kb) {
            bf16x8 P[2][2];
#pragma unroll
            for (int rg = 0; rg < 2; ++rg) {
                f32x16 S;
#pragma unroll
                for (int i = 0; i < 16; ++i) S[i] = 0.f;
#pragma unroll
                for (int ks = 0; ks < 4; ++ks) { const bf16x8 kf = *(const bf16x8*)(s + kro + kb * 4096 + xo[ks]); const bf16x8 q = *(const bf16x8*)(qs + (rg * 4 + ks) * 1024); S = MFMA32(kf, q, S); }
                float ls = 0.f;
#pragma unroll
                for (int i = 0; i < 16; ++i) { S[i] = __builtin_amdgcn_exp2f(S[i]); ls += S[i]; }
                if (rg == 0) lsum0 += ls; else lsum1 += ls;
#pragma unroll
                for (int s2 = 0; s2 < 2; ++s2) {
                    u32x4 pw4; pw4.x = pk2(S[8 * s2], S[8 * s2 + 1]); pw4.y = pk2(S[8 * s2 + 2], S[8 * s2 + 3]); pw4.z = pk2(S[8 * s2 + 4], S[8 * s2 + 5]); pw4.w = pk2(S[8 * s2 + 6], S[8 * s2 + 7]);
                    P[rg][s2] = __builtin_bit_cast(bf16x8, pw4);
                }
            }
#pragma unroll
            for (int s2 = 0; s2 < 2; ++s2)
#pragma unroll
                for (int vb = 0; vb < 4; ++vb) {
                    const bf16x8 vf = *(const bf16x8*)(s + vro + vb * 4096 + (unsigned)(((4 * kb + 2 * s2 + hh) ^ sw) << 4));
                    O[0][vb] = MFMA32(vf, P[0][s2], O[0][vb]); O[1][vb] = MFMA32(vf, P[1][s2], O[1][vb]);
                }
        }
        WAIT_V(0);
        RAW_BARRIER();
    }
    lsum0 = xor32_sum(lsum0); lsum1 = xor32_sum(lsum1);
    const int tid2 = tid_opaque(), lane2 = tid2 & 63, wid2 = tid2 >> 6, e_l31 = lane2 & 31, e_hh = lane2 >> 5, e_m = wid2 >> 2, e_g = wid2 & 3;
    float lam;
    { float d1 = inp(p, I_LQ1)[lane2] * inp(p, I_LK1)[lane2], d2 = inp(p, I_LQ2)[lane2] * inp(p, I_LK2)[lane2]; d1 = wave_sum(d1); d2 = wave_sum(d2); lam = fexp(d1) - fexp(d2) + LAM_INIT0; }
    float* comb = (float*)lds + (size_t)e_g * 8192 + lane2;
    if (e_m == 1) {
#pragma unroll
        for (int rg = 0; rg < 2; ++rg) {
            const float sc = lam / (rg ? lsum1 : lsum0);
#pragma unroll
            for (int vb = 0; vb < 4; ++vb) {
#pragma unroll
                for (int i = 0; i < 16; ++i) comb[((rg * 4 + vb) * 16 + i) * 64] = O[rg][vb][i] * sc;
                __builtin_amdgcn_sched_barrier(0);
            }
        }
    }
    RAW_BARRIER();
    if (e_m == 0) {
        const float* snl = (const float*)(lds + 131072);
        const int h = bh & 3;
#pragma unroll
        for (int rg = 0; rg < 2; ++rg) {
            const float i0 = 1.0f / (rg ? lsum1 : lsum0);
            float ss = 0.f;
#pragma unroll
            for (int vb = 0; vb < 4; ++vb) {
#pragma unroll
                for (int i = 0; i < 16; ++i) { const float o = O[rg][vb][i] * i0 - comb[((rg * 4 + vb) * 16 + i) * 64]; O[rg][vb][i] = o; ss += o * o; }
                __builtin_amdgcn_sched_barrier(0);
            }
            ss = xor32_sum(ss);
            const float rstd = rsqrtf(ss * (1.0f / 128.0f) + EPS) * (1.0f - LAM_INIT0);
            u16* dst = (u16*)(p.ws + WS_HB) + (size_t)(out_row0 + e_g * 64 + rg * 32 + e_l31) * 1024 + 512 + h * 128;
#pragma unroll
            for (int vb = 0; vb < 4; ++vb)
#pragma unroll
                for (int gq = 0; gq < 4; ++gq) {
                    const int v0 = vb * 32 + 8 * gq + 4 * e_hh;
                    const f32x4 gn = *(const f32x4*)(snl + v0);
                    u32x2 w; w.x = pk2(O[rg][vb][4 * gq] * rstd * gn[0], O[rg][vb][4 * gq + 1] * rstd * gn[1]); w.y = pk2(O[rg][vb][4 * gq + 2] * rstd * gn[2], O[rg][vb][4 * gq + 3] * rstd * gn[3]);
                    *(u32x2*)(dst + v0) = w;
                }
        }
    }
}
DI void phase_attn(const Ctx& p, uchar* lds) {
    const int tid = tid_opaque();
    if (tid < 128) ((float*)(lds + 131072))[tid] = inp(p, I_SUBN)[tid];
    for (int u = blockIdx.x; u < 264; u += gridDim.x) {
        const bool lat = u < 256;
        const int bh = u & 7, qb = u >> 3;
        attn_unit(p, lds, bh, lat ? qb * 256 : SEQ, lat ? 0 : SEQ, lat ? 132 : 4, lat ? (bh >> 2) * SEQ + qb * 256 : NL + (bh >> 2) * CTXL);
    }
    {
        const u16* zc = (const u16*)(p.ws + WS_REGA + RA_ZC);
        u16* hb = (u16*)(p.ws + WS_HB);
        const int tid2 = tid_opaque(), lane = tid2 & 63, wid = tid2 >> 6, c8 = lane * 8;
        float w0[8], w1[8], w2[8], bias[8];
        {
            const float* cw = inp(p, I_EVCW) + c8; const float* cb = inp(p, I_EVCB) + c8;
#pragma unroll
            for (int h = 0; h < 2; ++h) {
                const f32x4 a = *(const f32x4*)(cw + 4 * h), b = *(const f32x4*)(cw + 512 + 4 * h), c = *(const f32x4*)(cw + 1024 + 4 * h), d = *(const f32x4*)(cb + 4 * h);
#pragma unroll
                for (int e = 0; e < 4; ++e) { w0[4 * h + e] = a[e]; w1[4 * h + e] = b[e]; w2[4 * h + e] = c[e]; bias[4 * h + e] = d[e]; }
            }
        }
        auto unpack8 = [](const u32x4& v, float (&f)[8]) { f[0] = blo(v.x); f[1] = bhi(v.x); f[2] = blo(v.y); f[3] = bhi(v.y); f[4] = blo(v.z); f[5] = bhi(v.z); f[6] = blo(v.w); f[7] = bhi(v.w); };
        for (int u = blockIdx.x; u < 256; u += gridDim.x) {
            const int rb = u * 66 + wid * 9, nr = wid < 7 ? 9 : 3;
            u32x4 cc[11], cx[11], cg[9];
#pragma unroll
            for (int j = 0; j < 11; ++j) {
                int row = rb - 1 + j; row = row < 0 ? 0 : (row >= R ? R - 1 : row);
                cc[j] = *(const u32x4*)(zc + (size_t)row * 1536 + 512 + c8); cx[j] = *(const u32x4*)(zc + (size_t)row * 1536 + 1024 + c8);
            }
#pragma unroll
            for (int i = 0; i < 9; ++i) { const int row = rb + i < R ? rb + i : R - 1; cg[i] = *(const u32x4*)(zc + (size_t)row * 1536 + c8); }
            float pm[8], pc[8], pn[8];
            { float a[8], b[8]; unpack8(cc[0], a); unpack8(cx[0], b);
#pragma unroll
              for (int e = 0; e < 8; ++e) pm[e] = a[e] * b[e];
              unpack8(cc[1], a); unpack8(cx[1], b);
#pragma unroll
              for (int e = 0; e < 8; ++e) pc[e] = a[e] * b[e]; }
#pragma unroll
            for (int i = 0; i < 9; ++i) {
                { float a[8], b[8]; unpack8(cc[i + 2], a); unpack8(cx[i + 2], b);
#pragma unroll
                  for (int e = 0; e < 8; ++e) pn[e] = a[e] * b[e]; }
                const int r = rb + i;
                const bool first = r < NL ? (r & 8191) == 0 : ((r - NL) & 255) == 0, last = r < NL ? (r & 8191) == 8191 : ((r - NL) & 255) == 255;
                if (i < nr) {
                    float g[8], o[8]; unpack8(cg[i], g);
#pragma unroll
                    for (int e = 0; e < 8; ++e) o[e] = g[e] * (bias[e] + w0[e] * (first ? 0.f : pm[e]) + w1[e] * pc[e] + w2[e] * (last ? 0.f : pn[e]));
                    u32x4 wv; wv.x = pk2(o[0], o[1]); wv.y = pk2(o[2], o[3]); wv.z = pk2(o[4], o[5]); wv.w = pk2(o[6], o[7]);
                    *(u32x4*)(hb + (size_t)r * 1024 + c8) = wv;
                }
#pragma unroll
                for (int e = 0; e < 8; ++e) { pm[e] = pc[e]; pc[e] = pn[e]; }
            }
        }
    }
}

DI void phase_outproj(const Params& P, const Ctx& p, uchar* lds, int layer) {
    const int tid = tid_opaque();
    const u16* hb = (const u16*)(p.ws + WS_HB);
    const u16* w = (const u16*)(p.ws + (layer == 0 ? WS_WOUT0 : WS_WOUT1));
    float* xs = (float*)(p.ws + WS_XS);
    const float* mod = (const float*)(p.ws + WS_MOD);
    const int nbig = 256, nunits = nbig + (layer == 0 ? 16 : 0);
    for (int u = blockIdx.x; u < nunits; u += gridDim.x) {
        const bool big = u < nbig;
        int mt, nt; if (big) rect_unit(u, 64, 4, mt, nt); else { mt = (u - nbig) >> 2; nt = u & 3; }
        const int m0 = big ? mt * 256 : NL + mt * 128, n0 = nt * 256;
        auto epi_body =
            [&](int roff, int wc, int lane, uchar* w) {
                const int row0 = m0 + roff, nw = n0 + wc * 64;
                const float* g1 = mod + (layer * 3 + mod_row(row0)) * 6144 + 2048 + nw;
                const float* src = row_src(p, layer, row0) + nw;
                f32x4 xi[16], gg = *(const f32x4*)(g1 + (lane & 15) * 4);
#pragma unroll
                for (int it = 0; it < 16; ++it) xi[it] = *(const f32x4*)(src + (size_t)(it * 4 + (lane >> 4)) * 1024 + (lane & 15) * 4);
#pragma unroll
                for (int it = 0; it < 16; ++it) {
                    const int row = it * 4 + (lane >> 4), col = (lane & 15) * 4;
                    const f32x4 v = *(const f32x4*)(w + row * EPI_PITCH + col * 4);
                    f32x4 o;
#pragma unroll
                    for (int e = 0; e < 4; ++e) o[e] = xi[it][e] + gg[e] * v[e];
                    *(f32x4*)(xs + (size_t)(row0 + row) * 1024 + nw + col) = o;
                }
            };
        auto epi = [&](f32x16 (&acc)[2][2], int roff, int wc, int lane, uchar* w) { epi_stage(w, acc, lane & 31, lane >> 5); epi_body(roff, wc, lane, w); };
        if (big) {
            int r0, c; p8_rc(tid, r0, c);
            const unsigned ao = (unsigned)(r0 * 2048 + c * 2), bo = (unsigned)((((r0 >> 5) * 64 + (r0 & 31)) * 2048) + c * 2);
            gemm_tile8p(lds, (const uchar*)(hb + (size_t)m0 * 1024), ao, ao, ao, ao, 128 * 2048, 64 * 2048, 192 * 2048,
                        (const uchar*)(w + (size_t)n0 * 1024), bo, 128 * 2048, 32 * 2048, 160 * 2048, 16, 1 << 30, 0, epi_body);
        } else {
            const int rs = tid >> 3;
            const u16* ab = hb + (size_t)(m0 + rs) * 1024;
            const u16* bb = w + (size_t)(n0 + rs) * 1024;
            gemm_tile(lds, ab, ab + 64 * 1024, bb, bb + 64 * 1024, bb + 128 * 1024, bb + 192 * 1024, 16, 1 << 30, 0, epi);
        }
    }
    if (layer == 0) tail_cvt_moe(P, lds, nunits, 0, MOE_CVT_TILES / 2, MOE_CVT_TILES);
}

struct TileInfo { int bucket, mt, cnt, ntiles; };
DI int moe_ntiles(const int* cnt) { int s = 0; for (int b = 0; b < 24; ++b) s += (cnt[b * 32] + 127) >> 7; return s; }
DI TileInfo moe_tile(const int* cnt, int t) {
    TileInfo ti; ti.bucket = 0; ti.mt = 0; ti.cnt = 0; ti.ntiles = 0;
    int base = 0;
    for (int b = 0; b < 24; ++b) { const int c = cnt[b * 32], n = (c + 127) >> 7; if (t >= base && t < base + n) { ti.bucket = b; ti.mt = t - base; ti.cnt = c; } base += n; }
    ti.ntiles = base; return ti;
}
DI void bucket_experts(int bucket, int& ea, int& eb) {
    const int g = bucket / 6, pi = bucket - g * 6;
    const int lo = pi < 3 ? 0 : (pi < 5 ? 1 : 2), hi = pi < 3 ? pi + 1 : (pi < 5 ? pi - 1 : 3);
    ea = g * 4 + lo; eb = g * 4 + hi;
}
struct MoeUnit { int bucket, t, mt, cnt, big, nt; };
typedef const volatile LAS int* lcnt_t;
DI int moe_units(lcnt_t cnt, int NT, int G, int& B, int& NBIG) {
    int b2 = 0, s1 = 0;
    for (int b = 0; b < 24; ++b) { const int n = (cnt[b] + 127) >> 7; b2 += n >> 1; s1 += n & 1; }
    B = b2;
    const int cand = b2 * NT;
    int best = 1 << 30; NBIG = 0;
    for (int k = 0; k <= (cand + G - 1) / G; ++k) {
        const int nb = k * G < cand ? k * G : cand, U = 2 * cand + s1 * NT - nb;
        const int rb = (nb + G - 1) / G, ru = (U + G - 1) / G, cost = rb * 7 + (ru - rb) * 5;
        if (cost < best) { best = cost; NBIG = nb; }
    }
    return 2 * cand + s1 * NT - NBIG;
}
DI MoeUnit moe_unit(lcnt_t cnt, int u, int NT, int B, int NBIG) {
    const int sh = NT == 8 ? 3 : 2;
    int kind, idx, half = 0, nt;
    if (u < NBIG) {
        kind = 0; idx = u >> sh; nt = u & (NT - 1);
        if (gridDim.x == 256 && u < (NBIG & ~255)) { const int r = u >> 8, b = u & 255, x = b & 7, y = b >> 3; idx = (r << (8 - sh)) + x * (32 >> sh) + (y >> sh); nt = y & (NT - 1); }
    }
    else {
        int v = u - NBIG; const int npl = B - (NBIG >> sh);
        if (v < npl * 2 * NT) { kind = 1; idx = (NBIG >> sh) + (v >> (sh + 1)); half = (v >> sh) & 1; nt = v & (NT - 1); }
        else { v -= npl * 2 * NT; kind = 2; idx = v >> sh; nt = v & (NT - 1); }
    }
    MoeUnit r; r.bucket = 0; r.t = 0; r.mt = 0; r.cnt = 0; r.big = kind == 0; r.nt = nt;
    int pb = 0, ps = 0, pt = 0;
    for (int b = 0; b < 24; ++b) {
        const int c = cnt[b], n = (c + 127) >> 7, np = n >> 1, sg = n & 1;
        if (kind != 2) { if (idx >= pb && idx < pb + np) { r.bucket = b; r.mt = 2 * (idx - pb) + half; r.t = pt + r.mt; r.cnt = c; } }
        else if (sg && idx == ps) { r.bucket = b; r.mt = n - 1; r.t = pt + n - 1; r.cnt = c; }
        pb += np; ps += sg; pt += n;
    }
    return r;
}
constexpr int MOE_TOK = 3 * GEMM_STAGE;
DI void phase_moe_up(const Params& P, const Ctx& p, uchar* lds, int layer) {
    const int tid = tid_opaque();
    const int* cnt = (const int*)(p.ws + WS_CTL + CTL_CNT) + layer * 1024;
    const int* list = (const int*)(p.ws + WS_LIST);
    const f32x2* route = (const f32x2*)(p.ws + WS_ROUTE);
    const u16* hb = (const u16*)(p.ws + WS_HB);
    const u16* wgu = (const u16*)(p.ws + WS_WGU) + (size_t)layer * 16 * 1024 * 1024;
    u16* act = (u16*)(p.ws + WS_REGA + RA_ACT);
    int* tok = (int*)(lds + MOE_TOK);
    const int rs = tid >> 3;
    lcnt_t lc = (lcnt_t)(smem + 640);
    __syncthreads();
    if (tid < 24) ((volatile LAS int*)(smem + 640))[tid] = cnt[tid * 32];
    __syncthreads();
    int B, NBIG;
    const int U = moe_units(lc, 8, gridDim.x, B, NBIG);
    for (int u = blockIdx.x; u < U; u += gridDim.x) {
        const MoeUnit mu = moe_unit(lc, u, 8, B, NBIG);
        const int nt = mu.nt;
        int ea, eb; bucket_experts(mu.bucket, ea, eb);
        __syncthreads();
        if (tid < (mu.big ? 256 : 128)) { const int pos = mu.mt * 128 + tid; tok[tid] = list[(size_t)mu.bucket * R + (pos < mu.cnt ? pos : 0)]; }
        __syncthreads();
        const int e = nt < 4 ? ea : eb;
        auto epi_body =
            [&](int roff, int wc, int lane, uchar* w) {
                u16* dst = act + ((size_t)mu.t * 128 + roff) * 1024 + (nt >= 4 ? 512 : 0) + (nt & 3) * 128 + wc * 32;
                const int col = (lane & 3) * 8;
                f32x2 rw[4];
#pragma unroll
                for (int it = 0; it < 4; ++it) rw[it] = route[tok[roff + it * 16 + (lane >> 2)]];
#pragma unroll
                for (int it = 0; it < 4; ++it) {
                    const int row = it * 16 + (lane >> 2);
                    const float wgt = nt < 4 ? rw[it].x : rw[it].y;
                    const uchar* wp = w + row * EPI_PITCH + col * 4;
                    const f32x4 g0 = *(const f32x4*)wp, g1 = *(const f32x4*)(wp + 16), u0 = *(const f32x4*)(wp + 128), u1 = *(const f32x4*)(wp + 144);
                    f32x4 o0, o1;
#pragma unroll
                    for (int e2 = 0; e2 < 4; ++e2) { o0[e2] = g0[e2] * sigmoidf_(g0[e2]) * u0[e2] * wgt; o1[e2] = g1[e2] * sigmoidf_(g1[e2]) * u1[e2] * wgt; }
                    *(u32x4*)(dst + (size_t)row * 1024 + col) = pack8(o0, o1);
                }
            };
        if (mu.big) {
            int r0, c; p8_rc(tid, r0, c);
            const unsigned bo = (unsigned)((((r0 >> 5) * 64 + (r0 & 31)) * 2048) + c * 2);
            const unsigned a00 = (unsigned)tok[r0] * 2048u + c * 2, a10 = (unsigned)tok[128 + r0] * 2048u + c * 2, a01 = (unsigned)tok[64 + r0] * 2048u + c * 2, a11 = (unsigned)tok[192 + r0] * 2048u + c * 2;
            gemm_tile8p(lds, (const uchar*)hb, a00, a10, a01, a11, 0, 0, 0,
                        (const uchar*)(wgu + ((size_t)e * 1024 + (nt & 3) * 256) * 1024), bo, 128 * 2048, 32 * 2048, 160 * 2048, 16, 1 << 30, 0, epi_body);
        } else {
            const u16* a0 = hb + (size_t)tok[rs] * 1024;
            const u16* a1 = hb + (size_t)tok[rs + 64] * 1024;
            const u16* bb = wgu + ((size_t)e * 1024 + (nt & 3) * 256 + rs) * 1024;
            gemm_tile(lds, a0, a1, bb, bb + 64 * 1024, bb + 128 * 1024, bb + 192 * 1024, 16, 1 << 30, 0,
                [&](f32x16 (&acc)[2][2], int roff, int wc, int lane, uchar* w) { epi_stage(w, acc, lane & 31, lane >> 5); epi_body(roff, wc, lane, w); });
        }
    }
    if (layer == 0) tail_cvt_dense(P, lds, U, P.jobs[2].tile0, P.jobs[6].tile0);
}
DI void phase_moe_down(const Params& P, const Ctx& p, uchar* lds, int layer) {
    const int tid = tid_opaque();
    const int* cnt = (const int*)(p.ws + WS_CTL + CTL_CNT) + layer * 1024;
    const int* list = (const int*)(p.ws + WS_LIST);
    const u16* wd = (const u16*)(p.ws + WS_WD) + (size_t)layer * 16 * 1024 * 512;
    const u16* act = (const u16*)(p.ws + WS_REGA + RA_ACT);
    float* xs = (float*)(p.ws + WS_XS);
    float* dsto = layer == 0 ? xs : p.out;
    const float* mod = (const float*)(p.ws + WS_MOD);
    int* tok = (int*)(lds + MOE_TOK);
    const int rs = tid >> 3;
    lcnt_t lc = (lcnt_t)(smem + 640);
    __syncthreads();
    if (tid < 24) ((volatile LAS int*)(smem + 640))[tid] = cnt[tid * 32];
    __syncthreads();
    int B, NBIG;
    const int U = moe_units(lc, 4, gridDim.x, B, NBIG);
    for (int u = blockIdx.x; u < U; u += gridDim.x) {
        const MoeUnit mu = moe_unit(lc, u, 4, B, NBIG);
        const int nt = mu.nt, n0 = nt * 256;
        int ea, eb; bucket_experts(mu.bucket, ea, eb);
        __syncthreads();
        if (tid < (mu.big ? 256 : 128)) { const int pos = mu.mt * 128 + tid; tok[tid] = pos < mu.cnt ? list[(size_t)mu.bucket * R + pos] : -1; }
        __syncthreads();
        const long bjump = (long)(eb - ea) * 1024 * 512 - 512;
        auto epi_body =
            [&](int roff, int wc, int lane, uchar* w) {
                const int nw = n0 + wc * 64 + (lane & 15) * 4;
                int tk[16]; f32x4 xi[16];
#pragma unroll
                for (int it = 0; it < 16; ++it) {
                    tk[it] = tok[roff + it * 4 + (lane >> 4)];
                    xi[it] = (f32x4){0.f, 0.f, 0.f, 0.f};
                    if (tk[it] >= 0) xi[it] = *(const f32x4*)(xs + (size_t)tk[it] * 1024 + nw);
                }
#pragma unroll
                for (int it = 0; it < 16; ++it) {
                    const int row = it * 4 + (lane >> 4);
                    if (tk[it] >= 0) {
                        const f32x4 gg = *(const f32x4*)(mod + (layer * 3 + mod_row(tk[it])) * 6144 + 5 * 1024 + nw);
                        const f32x4 v = *(const f32x4*)(w + row * EPI_PITCH + (lane & 15) * 16);
                        f32x4 o;
#pragma unroll
                        for (int e = 0; e < 4; ++e) o[e] = xi[it][e] + gg[e] * v[e];
                        *(f32x4*)(dsto + (size_t)tk[it] * 1024 + nw) = o;
                    }
                }
            };
        if (mu.big) {
            int r0, c; p8_rc(tid, r0, c);
            const unsigned ao = (unsigned)(r0 * 2048 + c * 2), bo = (unsigned)((((r0 >> 5) * 64 + (r0 & 31)) * 1024) + c * 2);
            gemm_tile8p(lds, (const uchar*)(act + (size_t)mu.t * 128 * 1024), ao, ao, ao, ao, 128 * 2048, 64 * 2048, 192 * 2048,
                        (const uchar*)(wd + ((size_t)ea * 1024 + n0) * 512), bo, 128 * 1024, 32 * 1024, 160 * 1024, 16, 8, bjump * 2, epi_body);
        } else {
            const u16* ab = act + ((size_t)mu.t * 128 + rs) * 1024;
            const u16* bb = wd + ((size_t)ea * 1024 + n0 + rs) * 512;
            gemm_tile(lds, ab, ab + 64 * 1024, bb, bb + 64 * 512, bb + 128 * 512, bb + 192 * 512, 16, 8, bjump,
                [&](f32x16 (&acc)[2][2], int roff, int wc, int lane, uchar* w) { epi_stage(w, acc, lane & 31, lane >> 5); epi_body(roff, wc, lane, w); });
        }
    }
    if (layer == 0) tail_cvt_moe(P, lds, U, 1, 0, MOE_CVT_TILES / 2);
}

DI void phase_inproj1(const Params& P, const Ctx& p, uchar* lds) {
    const int tid = tid_opaque();
    const u16* hb = (const u16*)(p.ws + WS_HB);
    const u16* w = (const u16*)(p.ws + WS_WIN1);
    u16* yb = (u16*)(p.ws + WS_REGA + RA_Y);
    u16* ub = (u16*)(p.ws + WS_REGA + RA_U);
    const int rs = tid >> 3;
    for (int u = blockIdx.x; u < 512 + 16; u += gridDim.x) {
        const bool big = u < 512;
        int mt, nt; if (big) rect_unit(u, 64, 8, mt, nt); else { mt = (u - 512) >> 2; nt = 4 + ((u - 512) & 3); }
        const int m0 = big ? mt * 256 : NL + mt * 128, n0 = nt * 256;
        auto epi_body =
            [&](int roff, int wc, int lane, uchar* w) {
                const int row0 = m0 + roff, nw = n0 + wc * 64;
                if (nt < 4) {
                    epi_rows8<64>(w, lane, [&](int row, int col, const f32x4& v0, const f32x4& v1) {
                        f32x4 a, b2;
#pragma unroll
                        for (int e = 0; e < 4; ++e) { const float x = v0[e], y = v1[e]; a[e] = x * sigmoidf_(1.5957691216057308f * (x + 0.044715f * x * x * x)); b2[e] = y * sigmoidf_(1.5957691216057308f * (y + 0.044715f * y * y * y)); }
                        *(u32x4*)(yb + (size_t)(row0 + row) * 1024 + nw + col) = pack8(a, b2); });
                } else {
                    epi_rows8<64>(w, lane, [&](int row, int col, const f32x4& v0, const f32x4& v1) { *(u32x4*)(ub + (size_t)(row0 + row) * 1024 + nw - 1024 + col) = pack8(v0, v1); });
                }
            };
        if (big) {
            int r0, c; p8_rc(tid, r0, c);
            const unsigned ao = (unsigned)(r0 * 2048 + c * 2), bo = (unsigned)((((r0 >> 5) * 64 + (r0 & 31)) * 2048) + c * 2);
            gemm_tile8p(lds, (const uchar*)(hb + (size_t)m0 * 1024), ao, ao, ao, ao, 128 * 2048, 64 * 2048, 192 * 2048,
                        (const uchar*)(w + (size_t)n0 * 1024), bo, 128 * 2048, 32 * 2048, 160 * 2048, 16, 1 << 30, 0, epi_body);
        } else {
            const u16* ab = hb + (size_t)(m0 + rs) * 1024;
            const u16* bb = w + (size_t)(n0 + rs) * 1024;
            gemm_tile(lds, ab, ab + 64 * 1024, bb, bb + 64 * 1024, bb + 128 * 1024, bb + 192 * 1024, 16, 1 << 30, 0,
                [&](f32x16 (&acc)[2][2], int roff, int wc, int lane, uchar* w) { epi_stage(w, acc, lane & 31, lane >> 5); epi_body(roff, wc, lane, w); });
        }
    }
    tail_cvt_moe(P, lds, 512 + 16, 1, MOE_CVT_TILES / 2, MOE_CVT_TILES);
}

constexpr int LRU_U = 0, LRU_UC = 36864, UROW = 272, UC_BLK = 64 * UROW  , UC_DIR = 2 * UC_BLK;
DI int lru_perm(int r) { return ((r >> 2) & 1) * 16 + (r >> 3) * 4 + (r & 3); }
DI unsigned* lru_bsave(const Ctx& p, int dir, int c, int cblk, int wid) {
    unsigned* base = (unsigned*)(p.ws + (dir == 0 ? WS_REGA + RA_BS0 : WS_WGU));
    return base + ((size_t)(c * 4 + cblk) * 8 + wid) * 1024;
}
DI u32x4* lru_osave(const Ctx& p, int dir, int c, int cblk, int wid, int q, int lane) {
    if (dir == 0) return (u32x4*)(p.ws + WS_HB + ((size_t)(c * 64 + (wid * 4 + q) * 2 + (lane >> 5)) * 2048 + cblk * 512 + (lane & 31) * 16));
    uchar* base = p.ws + (c < 128 ? WS_WD : WS_OM1B);
    return (u32x4*)(base + ((size_t)((c & 127) * 4 + cblk) * 32768 + ((wid * 4 + q) * 64 + lane) * 16));
}
struct LruW { bf16x8 fa[8], fx[8]; };
DI void lru_wload(const Ctx& p, int dir, int cblk, int wid, int lane, LruW& w, int which = 3) {
    const int l31 = lane & 31, hh = lane >> 5, bl = wid >> 2, jq = wid & 3, blkg = cblk * 2 + bl;
    const u16* wa = (const u16*)(p.ws + WS_WA) + ((size_t)(dir * 8 + blkg) * 128 + jq * 32 + l31) * 128 + hh * 8;
    const u16* wx = (const u16*)(p.ws + WS_WX) + ((size_t)(dir * 8 + blkg) * 128 + jq * 32 + l31) * 128 + hh * 8;
    if (which & 1) {
#pragma unroll
        for (int ks = 0; ks < 8; ++ks) w.fa[ks] = *(const bf16x8*)(wa + ks * 16);
    }
    if (which & 2) {
#pragma unroll
        for (int ks = 0; ks < 8; ++ks) w.fx[ks] = *(const bf16x8*)(wx + ks * 16);
    }
    __builtin_amdgcn_sched_barrier(0);
}
template <class Hook, class Hook2>
DI void lru_gates(const Ctx& p, const uchar* lds, int dir, int cblk, int wid, int lane, const LruW& w, float (&a)[2][16], float (&b)[2][16], unsigned* bsave, Hook&& hook, Hook2&& hook2) {
    const int l31 = lane & 31, hh = lane >> 5, bl = wid >> 2, jq = wid & 3;
    const int chl = bl * 128 + jq * 32 + l31;
    const int ch = cblk * 256 + chl;
    const uchar* uc = lds + LRU_UC + dir * UC_DIR + bl * UC_BLK;
    f32x16 dr[2], di[2];
#pragma unroll
    for (int rb = 0; rb < 2; ++rb)
#pragma unroll
        for (int i = 0; i < 16; ++i) { dr[rb][i] = 0.f; di[rb][i] = 0.f; }
    const int tk = lru_perm(l31);
#pragma unroll
    for (int ks = 0; ks < 8; ++ks) {
#pragma unroll
        for (int rb = 0; rb < 2; ++rb) dr[rb] = MFMA32(*(const bf16x8*)(uc + (rb * 32 + tk) * UROW + ks * 32 + hh * 16), w.fa[ks], dr[rb]);
    }
#pragma unroll
    for (int ks = 0; ks < 8; ++ks) {
#pragma unroll
        for (int rb = 0; rb < 2; ++rb) di[rb] = MFMA32(*(const bf16x8*)(uc + (rb * 32 + tk) * UROW + ks * 32 + hh * 16), w.fx[ks], di[rb]);
    }
    __builtin_amdgcn_sched_barrier(0);
    hook();
    const float nl2 = -1.4426950408889634f;
    const float kba = inp(p, I_ODBA)[dir * 1024 + ch] * nl2, kbx = inp(p, I_ODBX)[dir * 1024 + ch] * nl2;
    const float sp8 = 8.0f * log1pf(__expf(-inp(p, I_ODLAM)[dir * 1024 + ch]));
    const float c1 = sp8 * nl2;
    const int cofs = (jq * 32 + l31) * 2;
#pragma unroll
    for (int rb = 0; rb < 2; ++rb)
#pragma unroll
        for (int i = 0; i < 16; ++i) {
            const int token = rb * 32 + hh * 16 + i;
            const float r = frcp(1.0f + __builtin_amdgcn_exp2f(__builtin_fmaf(dr[rb][i], nl2, kba)));
            const float av = __builtin_amdgcn_exp2f(c1 * r);
            a[rb][i] = av;
            const float om = __builtin_fmaf(-av, av, 1.0f);
            const float ucv = b2f(*(const u16*)(uc + token * UROW + cofs));
            const float ig = frcp(1.0f + __builtin_amdgcn_exp2f(__builtin_fmaf(di[rb][i], nl2, kbx)));
            b[rb][i] = __builtin_amdgcn_sqrtf(om) * (ig * ucv);
        }
    __builtin_amdgcn_sched_barrier(0);
    hook2();
    if (bsave) {
#pragma unroll
        for (int q = 0; q < 4; ++q) {
            u32x4 v;
#pragma unroll
            for (int e = 0; e < 4; ++e) { const int j = q * 4 + e, rb = j >> 3, i = (j & 7) * 2; v[e] = pk2(b[rb][i], b[rb][i + 1]); }
            ((u32x4*)bsave)[q * 64 + lane] = v;
        }
    }
}
constexpr int LRU_U2 = 106496;
DI void lru_seq(int c, int& s0, int& s1) { if (c < 256) { s0 = (c >> 7) * SEQ; s1 = s0 + SEQ; } else { s0 = NL + ((c - 256) >> 2) * CTXL; s1 = s0 + CTXL; } }
DI void lru_dma(const Ctx& p, uchar* lds, int c, int cblk, int buf) {
    const int tid = tid_opaque(), lane = tid & 63, wid = tid >> 6;
    const u16* ub = (const u16*)(p.ws + WS_REGA + RA_U);
    int s0, s1; lru_seq(c, s0, s1);
    const int w0 = __builtin_amdgcn_readfirstlane(wid);
    uchar* dst = lds + (buf ? LRU_U2 : LRU_U);
#pragma unroll
    for (int k = 0; k < 5; ++k) {
        const int i = w0 + 8 * k;
        if (i < 35) {
            int row = c * 64 - 3 + 2 * i + (lane >> 5);
            row = row < s0 ? s0 : (row >= s1 ? s1 - 1 : row);
            __builtin_amdgcn_global_load_lds((const unsigned*)(ub + (size_t)row * 1024 + cblk * 256 + (lane & 31) * 8), (LAS unsigned*)(dst + i * 1024), 16, 0, 0);
        }
    }
}
DI void lru_conv(const Ctx& p, uchar* lds, int c, int cblk, int buf, bool counted = false) {
    const int tid = tid_opaque();
    const int row0 = c * 64;
    int s0, s1; lru_seq(c, s0, s1);
    const uchar* ut = lds + (buf ? LRU_U2 : LRU_U);
    if (counted) WAIT_V(8); else WAIT_V(0);
    __syncthreads();
    const int c8 = tid & 31, tq = tid >> 5, t0 = tq * 4;
    float uv[10][8];
#pragma unroll
    for (int rr = 0; rr < 10; ++rr) {
        u32x4 v = *(const u32x4*)(ut + (t0 + rr) * 512 + c8 * 16);
        const int row = row0 - 3 + t0 + rr;
        if (row < s0 || row >= s1) v = (u32x4){0u, 0u, 0u, 0u};
        uv[rr][0] = blo(v.x); uv[rr][1] = bhi(v.x); uv[rr][2] = blo(v.y); uv[rr][3] = bhi(v.y); uv[rr][4] = blo(v.z); uv[rr][5] = bhi(v.z); uv[rr][6] = blo(v.w); uv[rr][7] = bhi(v.w);
    }
#pragma unroll
    for (int dir = 0; dir < 2; ++dir) {
        const float* cw = inp(p, I_ODCW) + dir * 4096 + cblk * 256 + c8 * 8;
        const float* cb = inp(p, I_ODCB) + dir * 1024 + cblk * 256 + c8 * 8;
        float w[4][8], bs[8];
#pragma unroll
        for (int k = 0; k < 4; ++k) { const f32x4 x0 = *(const f32x4*)(cw + k * 1024), x1 = *(const f32x4*)(cw + k * 1024 + 4); w[k][0] = x0[0]; w[k][1] = x0[1]; w[k][2] = x0[2]; w[k][3] = x0[3]; w[k][4] = x1[0]; w[k][5] = x1[1]; w[k][6] = x1[2]; w[k][7] = x1[3]; }
        { const f32x4 x0 = *(const f32x4*)cb, x1 = *(const f32x4*)(cb + 4); bs[0] = x0[0]; bs[1] = x0[1]; bs[2] = x0[2]; bs[3] = x0[3]; bs[4] = x1[0]; bs[5] = x1[1]; bs[6] = x1[2]; bs[7] = x1[3]; }
#pragma unroll
        for (int tt = 0; tt < 4; ++tt) {
            float o[8];
#pragma unroll
            for (int e = 0; e < 8; ++e) {
                float s = bs[e];
#pragma unroll
                for (int k = 0; k < 4; ++k) s += w[k][e] * uv[tt + k + (dir ? 3 : 0)][e];
                o[e] = s;
            }
            const int t = t0 + tt;
            u32x4 wv; wv.x = pk2(o[0], o[1]); wv.y = pk2(o[2], o[3]); wv.z = pk2(o[4], o[5]); wv.w = pk2(o[6], o[7]);
            *(u32x4*)(lds + LRU_UC + dir * UC_DIR + (c8 >> 4) * UC_BLK + t * UROW + (c8 & 15) * 16) = wv;
        }
    }
    __syncthreads();
}
DI void lru_seg(const float (&a)[2][16], const float (&b)[2][16], int dir, int hh, float (&SA)[4], float (&SB)[4]) {
    float oa[2], ob[2];
#pragma unroll
    for (int rb = 0; rb < 2; ++rb) {
        float A = 1.f, B = 0.f;
#pragma unroll
        for (int ii = 0; ii < 16; ++ii) { const int i = dir ? 15 - ii : ii; B = a[rb][i] * B + b[rb][i]; A *= a[rb][i]; }
        oa[rb] = A; ob[rb] = B;
    }
    float pa[2], pb[2];
#pragma unroll
    for (int rb = 0; rb < 2; ++rb) { pa[rb] = __shfl_xor(oa[rb], 32); pb[rb] = __shfl_xor(ob[rb], 32); }
#pragma unroll
    for (int rb = 0; rb < 2; ++rb)
#pragma unroll
        for (int h = 0; h < 2; ++h) {
            const float A = (h == hh) ? oa[rb] : pa[rb], B = (h == hh) ? ob[rb] : pb[rb];
            const int s = dir ? 3 - (rb * 2 + h) : rb * 2 + h;
            SA[s] = A; SB[s] = B;
        }
}
DI void lru_summ_item(int j, int& c, int& cblk, int& role) {
    if (j < 1024) { c = j >> 2; cblk = j & 3; role = -1; } else { const int mini = j - 1024, cu = mini >> 3; c = 256 + (cu >> 2); cblk = cu & 3; role = mini & 7; }
}
template <class F>
DI void lru_summ_wave(const Ctx& p, uchar* lds, int c, int cblk, int role, LruW& w, F&& next_dma) {
    const int tid = tid_opaque(), lane = tid & 63, wid = role < 0 ? (tid >> 6) : role, hh = lane >> 5;
    f32x2* summ = (f32x2*)(p.ws + WS_SUMM);
    const int ch = cblk * 256 + (wid >> 2) * 128 + (wid & 3) * 32 + (lane & 31);
#pragma unroll
    for (int dir = 0; dir < 2; ++dir) {
        float a[2][16], b[2][16];
        unsigned* bs = c < 256 ? lru_bsave(p, dir, c, cblk, wid) : (unsigned*)nullptr;
        if (dir == 0) lru_gates(p, lds, 0, cblk, wid, lane, w, a, b, bs, [&]() { lru_wload(p, 1, cblk, wid, lane, w, 1); }, [&]() { lru_wload(p, 1, cblk, wid, lane, w, 2); });
        else          lru_gates(p, lds, 1, cblk, wid, lane, w, a, b, bs, [&]() { next_dma(); lru_wload(p, 0, cblk, wid, lane, w, 1); }, [&]() { lru_wload(p, 0, cblk, wid, lane, w, 2); });
        if (c < 256) {
#pragma unroll
            for (int q = 0; q < 4; ++q) {
                u32x4 v;
#pragma unroll
                for (int e = 0; e < 4; ++e) { const int j = q * 4 + e, rb = j >> 3, i = (j & 7) * 2; v[e] = pk2(1.0f - a[rb][i], 1.0f - a[rb][i + 1]); }
                *lru_osave(p, dir, c, cblk, wid, q, lane) = v;
            }
        }
        float SA[4], SB[4];
        lru_seg(a, b, dir, hh, SA, SB);
        float A = 1.f, B = 0.f;
#pragma unroll
        for (int s = 0; s < 4; ++s) { B = SA[s] * B + SB[s]; A *= SA[s]; }
        if (hh == 0) summ[((size_t)dir * 264 + c) * 1024 + ch] = (f32x2){A, B};
    }
}
DI void phase_lru_summ(const Ctx& p, uchar* lds) {
    const int tid = tid_opaque(), lane = tid & 63, wid = tid >> 6;
    constexpr int NITEM = 1024 + 32 * 8;
    int c, cblk, role;
    if ((int)blockIdx.x >= NITEM) return;
    lru_summ_item(blockIdx.x, c, cblk, role); lru_dma(p, lds, c, cblk, 0);
    LruW w;
    lru_wload(p, 0, cblk, role < 0 ? wid : role, lane, w);
    int buf = 0;
    bool counted = false;
    for (int j = blockIdx.x; j < NITEM; j += gridDim.x, buf ^= 1) {
        lru_summ_item(j, c, cblk, role);
        lru_conv(p, lds, c, cblk, buf, counted);
        counted = role < 0;
        int c2 = 0, cblk2 = 0, role2 = -1;
        const bool more = j + (int)gridDim.x < NITEM;
        if (more) lru_summ_item(j + gridDim.x, c2, cblk2, role2);
        auto next_dma = [&]() { if (more) lru_dma(p, lds, c2, cblk2, buf ^ 1); };
        if (role < 0) {
            lru_summ_wave(p, lds, c, cblk, -1, w, next_dma);
            if (more && role2 >= 0) lru_wload(p, 0, cblk2, role2, lane, w);
        } else {
            if (wid == 0) lru_summ_wave(p, lds, c, cblk, role, w, next_dma); else next_dma();
            if (more && (cblk2 != cblk || role2 != role)) lru_wload(p, 0, cblk2, role2, lane, w);
        }
    }
    WAIT_V(0);
}
DI void phase_lru_carry(const Ctx& p) {
    const int tid = tid_opaque();
    const f32x2* summ = (const f32x2*)(p.ws + WS_SUMM);
    float* carry = (float*)(p.ws + WS_CARRY);
    for (int g = blockIdx.x * 512 + tid; g < 4096; g += gridDim.x * 512) {
        const int ch = g & 1023, bt = (g >> 10) & 1, dir = g >> 11;
        const f32x2* sd = summ + (size_t)dir * 264 * 1024 + ch;
        float h = 0.f;
        f32x2 s[4];
#pragma unroll
        for (int q = 0; q < 4; ++q) s[q] = sd[(size_t)(256 + bt * 4 + (dir ? 3 - q : q)) * 1024];
#pragma unroll
        for (int q = 0; q < 4; ++q) h = s[q].x * h + s[q].y;
        f32x2 ta[16], tb[16];
#pragma unroll
        for (int q = 0; q < 16; ++q) { const int ci = dir ? 127 - q : q; ta[q] = sd[(size_t)(bt * 128 + ci) * 1024]; }
#pragma unroll 1
        for (int q0 = 0; q0 < 128; q0 += 32) {
#pragma unroll
            for (int q = 0; q < 16; ++q) { const int ci = dir ? 127 - (q0 + 16 + q) : q0 + 16 + q; tb[q] = sd[(size_t)(bt * 128 + ci) * 1024]; }
#pragma unroll
            for (int q = 0; q < 16; ++q) { const int ci = dir ? 127 - (q0 + q) : q0 + q; carry[((size_t)dir * 256 + bt * 128 + ci) * 1024 + ch] = h; h = ta[q].x * h + ta[q].y; }
            if (q0 + 32 < 128) {
#pragma unroll
                for (int q = 0; q < 16; ++q) { const int ci = dir ? 127 - (q0 + 32 + q) : q0 + 32 + q; ta[q] = sd[(size_t)(bt * 128 + ci) * 1024]; }
            }
#pragma unroll
            for (int q = 0; q < 16; ++q) { const int ci = dir ? 127 - (q0 + 16 + q) : q0 + 16 + q; carry[((size_t)dir * 256 + bt * 128 + ci) * 1024 + ch] = h; h = tb[q].x * h + tb[q].y; }
        }
    }
}
DI void phase_lru_scan(const Ctx& p, uchar* lds) {
    const int tid = tid_opaque(), lane = tid & 63, wid = tid >> 6, hh = lane >> 5;
    const u16* yb = (const u16*)(p.ws + WS_REGA + RA_Y);
    u16* hb = (u16*)(p.ws + WS_HB);
    for (int u = blockIdx.x; u < 256 * 4; u += gridDim.x) {
        const int c = u >> 2, cblk = u & 3;
        const int ch = cblk * 256 + (wid >> 2) * 128 + (wid & 3) * 32 + (lane & 31);
        float hsum[2][16];
        __syncthreads();
#pragma unroll
        for (int dir = 0; dir < 2; ++dir) {
            const float h0 = ((const float*)(p.ws + WS_CARRY))[((size_t)dir * 256 + c) * 1024 + ch];
            float a[2][16], b[2][16];
            {
                const unsigned* bs = lru_bsave(p, dir, c, cblk, wid);
                unsigned bw[16], ow[16];
#pragma unroll
                for (int q = 0; q < 4; ++q) {
                    const u32x4 vb = ((const u32x4*)bs)[q * 64 + lane], vo = *lru_osave(p, dir, c, cblk, wid, q, lane);
#pragma unroll
                    for (int e = 0; e < 4; ++e) { bw[q * 4 + e] = vb[e]; ow[q * 4 + e] = vo[e]; }
                }
#pragma unroll
                for (int rb = 0; rb < 2; ++rb)
#pragma unroll
                    for (int i = 0; i < 16; ++i) {
                        const unsigned wb = bw[rb * 8 + (i >> 1)], wo = ow[rb * 8 + (i >> 1)];
                        b[rb][i] = (i & 1) ? bhi(wb) : blo(wb);
                        a[rb][i] = 1.0f - ((i & 1) ? bhi(wo) : blo(wo));
                    }
            }
            float SA[4], SB[4];
            lru_seg(a, b, dir, hh, SA, SB);
            float st[4]; st[0] = h0;
#pragma unroll
            for (int s = 1; s < 4; ++s) st[s] = SA[s - 1] * st[s - 1] + SB[s - 1];
#pragma unroll
            for (int rb = 0; rb < 2; ++rb) {
                const int sidx = dir ? 3 - (rb * 2 + hh) : rb * 2 + hh;
                float h = sidx == 0 ? st[0] : (sidx == 1 ? st[1] : (sidx == 2 ? st[2] : st[3]));
#pragma unroll
                for (int ii = 0; ii < 16; ++ii) { const int i = dir ? 15 - ii : ii; h = a[rb][i] * h + b[rb][i]; if (dir == 0) hsum[rb][i] = h; else hsum[rb][i] += h; }
            }
        }
        __syncthreads();
        {
            const int chl = (wid >> 2) * 128 + (wid & 3) * 32 + (lane & 31);
#pragma unroll
            for (int rb = 0; rb < 2; ++rb)
#pragma unroll
                for (int i = 0; i < 16; ++i) *(float*)(lds + (rb * 32 + hh * 16 + i) * 1040 + chl * 4) = hsum[rb][i];
        }
        __syncthreads();
#pragma unroll
        for (int j = 0; j < 4; ++j) {
            const int pi = j * 512 + tid, tk = pi >> 5, c8 = pi & 31;
            const f32x4 h0 = *(const f32x4*)(lds + tk * 1040 + c8 * 32), h1 = *(const f32x4*)(lds + tk * 1040 + c8 * 32 + 16);
            const size_t o = (size_t)(c * 64 + tk) * 1024 + cblk * 256 + c8 * 8;
            const u32x4 yv = *(const u32x4*)(yb + o);
            u32x4 w;
            w.x = pk2(blo(yv.x) * h0[0], bhi(yv.x) * h0[1]); w.y = pk2(blo(yv.y) * h0[2], bhi(yv.y) * h0[3]);
            w.z = pk2(blo(yv.z) * h1[0], bhi(yv.z) * h1[1]); w.w = pk2(blo(yv.w) * h1[2], bhi(yv.w) * h1[3]);
            *(u32x4*)(hb + o) = w;
        }
    }
}

__global__ void __launch_bounds__(512) fwd_mega(const Params P) {
    uchar* lds = smem + LDS_USER;
    LAS unsigned long long* tab = (LAS unsigned long long*)(smem + 64);
    if (threadIdx.x < N_IN) tab[threadIdx.x] = (unsigned long long)P.in[threadIdx.x];
    if ((threadIdx.x & 63) == 0) ((volatile LAS int*)smem)[96 + hw_slot()] = threadIdx.x >> 6;
    const bool multi = (P.ph_hi - P.ph_lo) > 1;
    if (threadIdx.x == 0) { ((volatile LAS unsigned*)smem)[0] = 0u; ((volatile LAS unsigned*)smem)[1] = 0u; ((volatile LAS unsigned*)smem)[2] = 0u; ((volatile LAS unsigned*)smem)[3] = 0u; }
    __syncthreads();
    if (multi) (void)xcd_barrier_post((unsigned*)(P.ws + WS_CTL), (volatile LAS unsigned*)smem);
#define RUN_PHASE(k, call) if (P.ph_lo <= (k) && (k) < P.ph_hi) { { Ctx p; { unsigned long long wsi = (unsigned long long)P.ws; asm volatile("" : "+s"(wsi)); p.ws = (uchar*)(__attribute__((address_space(1))) uchar*)wsi; } p.out = P.out; p.tab = tab; call; } if ((PROBE_REPS >> (k)) & 1) { { XcdBarrier xb_; xb_.bar = (unsigned*)(P.ws + WS_CTL); xb_.x = xb_xcc_id(); xb_.st = (volatile LAS unsigned*)smem; xcd_barrier(xb_); } Ctx p; { unsigned long long wsi = (unsigned long long)P.ws; asm volatile("" : "+s"(wsi)); p.ws = (uchar*)(__attribute__((address_space(1))) uchar*)wsi; } p.out = P.out; p.tab = tab; call; } if (multi && (k) + 1 < P.ph_hi) { XcdBarrier xb_; xb_.bar = (unsigned*)(P.ws + WS_CTL); xb_.x = xb_xcc_id(); xb_.st = (volatile LAS unsigned*)smem; xcd_barrier(xb_); } }
    RUN_PHASE(0, phase_prep(P, p, lds))
    RUN_PHASE(1, phase_norm(p, 0))
    RUN_PHASE(2, phase_inproj0(P, p, lds))
    RUN_PHASE(3, phase_attn(p, lds))
    RUN_PHASE(4, phase_outproj(P, p, lds, 0))
    RUN_PHASE(5, phase_router(p, lds, 0))
#if PROBE_ROUTER2X
    if (P.ph_lo <= 5 && 5 < P.ph_hi) { Ctx p; { unsigned long long wsi = (unsigned long long)P.ws; asm volatile("" : "+s"(wsi)); p.ws = (uchar*)(__attribute__((address_space(1))) uchar*)wsi; } p.out = P.out; p.tab = tab; phase_router(p, lds, 0, 2); { XcdBarrier xb_; xb_.bar = (unsigned*)(P.ws + WS_CTL); xb_.x = xb_xcc_id(); xb_.st = (volatile LAS unsigned*)smem; xcd_barrier(xb_); } }
#endif
    RUN_PHASE(6, phase_moe_up(P, p, lds, 0))
    RUN_PHASE(7, phase_moe_down(P, p, lds, 0))
    RUN_PHASE(8, phase_norm(p, 1))
    RUN_PHASE(9, phase_inproj1(P, p, lds))
    RUN_PHASE(10, phase_lru_summ(p, lds))
    RUN_PHASE(11, phase_lru_carry(p))
    RUN_PHASE(12, phase_lru_scan(p, lds))
    RUN_PHASE(13, phase_outproj(P, p, lds, 1))
    RUN_PHASE(14, phase_router(p, lds, 1))
    RUN_PHASE(15, phase_moe_up(P, p, lds, 1))
    RUN_PHASE(16, phase_moe_down(P, p, lds, 1))
}

extern "C" void kernel_launch(void* const* d_in, const int* in_sizes, int n_in, void* d_out, int out_size, void* d_ws, size_t ws_size, hipStream_t stream) {
    static int grid = 0;
    if (grid == 0) {
        if (n_in != N_IN || out_size != NL * D || ws_size < WS_END) { fprintf(stderr, "kernel_launch: unexpected shapes (n_in %d, out %d, ws %zu, need %zu)\n", n_in, out_size, ws_size, (size_t)WS_END); grid = -1; return; }
        int dev = 0, cus = 0, per_cu = 0;
        if (hipGetDevice(&dev) != hipSuccess || hipDeviceGetAttribute(&cus, hipDeviceAttributeMultiprocessorCount, dev) != hipSuccess) { grid = -1; return; }
        if (hipFuncSetAttribute((const void*)fwd_mega, hipFuncAttributeMaxDynamicSharedMemorySize, LDS_BYTES) != hipSuccess) { fprintf(stderr, "kernel_launch: hipFuncSetAttribute failed\n"); grid = -1; return; }
        if (hipOccupancyMaxActiveBlocksPerMultiprocessor(&per_cu, (const void*)fwd_mega, 512, LDS_BYTES) != hipSuccess || per_cu < 1) { fprintf(stderr, "kernel_launch: occupancy query says %d\n", per_cu); (void)hipGetLastError(); grid = -1; return; }
        grid = cus;
    }
    if (grid < 0) return;
    if (hipMemsetAsync((char*)d_ws + WS_CTL, 0, CTL_BYTES, stream) != hipSuccess) return;
    Params p{};
    for (int i = 0; i < N_IN; ++i) p.in[i] = (const float*)d_in[i];
    p.out = (float*)d_out; p.ws = (uchar*)d_ws;
    uchar* ws = (uchar*)d_ws;
    int t0 = 0;
    auto job = [&](int j, const float* src, size_t dst_off, int nmat, int K, int N, int sstride, int dstride, int lddst, int mode, int half) {
        CvtJob& J = p.jobs[j]; J.src = src; J.dst = (u16*)(ws + dst_off); J.nmat = nmat; J.K = K; J.N = N; J.sstride = sstride; J.dstride = dstride; J.lddst = lddst; J.mode = mode; J.half = half; J.tile0 = t0; J.pad = 0;
        t0 += nmat * (K / 64) * (N / 64);
    };
    job(0, p.in[I_EVWIN], WS_WIN0, 1, 1024, 3072, 0, 0, 1024, 0, 0);
    job(1, p.in[I_EVWOUT], WS_WOUT0, 1, 1024, 1024, 0, 0, 1024, 0, 0);
    job(2, p.in[I_ODWIN], WS_WIN1, 1, 1024, 2048, 0, 0, 1024, 0, 0);
    job(3, p.in[I_ODWOUT], WS_WOUT1, 1, 1024, 1024, 0, 0, 1024, 0, 0);
    job(4, p.in[I_ODWA], WS_WA, 16, 128, 128, 16384, 16384, 128, 0, 0);
    job(5, p.in[I_ODWX], WS_WX, 16, 128, 128, 16384, 16384, 128, 0, 0);
    job(6, p.in[I_MGATE], WS_WGU, 32, 1024, 512, 524288, 1048576, 1024, 1, 0);
    job(7, p.in[I_MUP], WS_WGU, 32, 1024, 512, 524288, 1048576, 1024, 1, 1);
    job(8, p.in[I_MDOWN], WS_WD, 32, 512, 1024, 524288, 524288, 512, 0, 0);
    p.ncvt = t0;
    const int nl = N_LAUNCHES;
    for (int li = 0; li < nl; ++li) {
        p.ph_lo = li * NPH / nl; p.ph_hi = (li + 1) * NPH / nl;
        hipLaunchKernelGGL(fwd_mega, dim3(grid), dim3(512), LDS_BYTES, stream, p);
    }
}
```

```cpp
#include <hip/hip_runtime.h>
#include <stdint.h>
#include <stdio.h>

#define DI __device__ __forceinline__
#define LAS __attribute__((address_space(3)))
typedef unsigned short u16;
typedef unsigned char uchar;
typedef short bf16x8 __attribute__((ext_vector_type(8)));
typedef float f32x16 __attribute__((ext_vector_type(16)));
typedef float f32x4 __attribute__((ext_vector_type(4)));
typedef float f32x2 __attribute__((ext_vector_type(2)));
typedef __bf16 bf2_t __attribute__((ext_vector_type(2)));
typedef unsigned u32x2 __attribute__((ext_vector_type(2)));
typedef unsigned u32x4 __attribute__((ext_vector_type(4)));

#ifndef N_LAUNCHES
#define N_LAUNCHES 1
#endif
#ifndef PROBE_GEMM2X
#define PROBE_GEMM2X 0
#endif
#ifndef PROBE_ROUTER2X
#define PROBE_ROUTER2X 0
#endif
#ifndef PROBE_REPS
#define PROBE_REPS 0x0000
#endif

DI unsigned pk2(float a, float b) { f32x2 v = {a, b}; bf2_t r = __builtin_convertvector(v, bf2_t); return __builtin_bit_cast(unsigned, r); }
DI u16 f2b(float a) { __bf16 r = (__bf16)a; return __builtin_bit_cast(u16, r); }
DI float b2f(u16 v) { return __uint_as_float(((unsigned)v) << 16); }
DI float blo(unsigned v) { return __uint_as_float(v << 16); }
DI float bhi(unsigned v) { return __uint_as_float(v & 0xffff0000u); }
#define MFMA32(a, b, c) __builtin_amdgcn_mfma_f32_32x32x16_bf16((a), (b), (c), 0, 0, 0)

constexpr int D = 1024, NL = 16384, NC = 512, R = 16896, SEQ = 8192, CTXL = 256, SK = 8448;
constexpr int NPH = 17;
constexpr float EPS = 1e-6f;
constexpr float LAM_INIT0 = 0.2f;
constexpr float QSCALE = 0.125f * 1.4426950408889634f;

enum { I_X = 0, I_C, I_CTX, I_CCTX, I_ADAW, I_ADAB, I_NMIX, I_NFFN, I_EVWIN, I_EVCW, I_EVCB, I_QN, I_KN, I_LQ1, I_LK1, I_LQ2, I_LK2, I_SUBN, I_EVWOUT,
       I_ODWIN, I_ODCW, I_ODCB, I_ODWA, I_ODBA, I_ODWX, I_ODBX, I_ODLAM, I_ODWOUT, I_MWGRP, I_MBGRP, I_MWRT, I_MBRT, I_MGATE, I_MUP, I_MDOWN, N_IN };

constexpr size_t al256(size_t x) { return (x + 255) & ~(size_t)255; }
constexpr size_t WS_CTL   = 0;
constexpr size_t CTL_BYTES = 65536;
constexpr size_t CTL_CNT  = 16384;
constexpr size_t WS_MOD   = WS_CTL + CTL_BYTES;
constexpr size_t WS_ROPE  = WS_MOD + al256(2 * 3 * 6144 * 4);
constexpr size_t WS_ROUTE = WS_ROPE + (size_t)SEQ * 32 * 8;
constexpr size_t WS_LIST  = WS_ROUTE + al256((size_t)R * 8);
constexpr size_t WS_SUMM  = WS_LIST + al256((size_t)24 * R * 4);
constexpr size_t WS_CARRY = WS_SUMM + (size_t)2 * 264 * 1024 * 8;
constexpr size_t WS_WIN0  = WS_CARRY + (size_t)2 * 256 * 1024 * 4;
constexpr size_t WS_WOUT0 = WS_WIN0 + (size_t)3072 * 1024 * 2;
constexpr size_t WS_WIN1  = WS_WOUT0 + (size_t)1024 * 1024 * 2;
constexpr size_t WS_WOUT1 = WS_WIN1 + (size_t)2048 * 1024 * 2;
constexpr size_t WS_WA    = WS_WOUT1 + (size_t)1024 * 1024 * 2;
constexpr size_t WS_WX    = WS_WA + (size_t)2 * 8 * 128 * 128 * 2;
constexpr size_t WS_WGU   = WS_WX + (size_t)2 * 8 * 128 * 128 * 2;
constexpr size_t WS_WD    = WS_WGU + (size_t)2 * 16 * 1024 * 1024 * 2;
constexpr size_t WS_XS    = WS_WD + (size_t)2 * 16 * 1024 * 512 * 2;
constexpr size_t WS_HB    = WS_XS + (size_t)R * 1024 * 4;
constexpr size_t WS_REGA  = WS_HB + (size_t)R * 1024 * 2;
constexpr size_t RA_ZC    = 0;
constexpr size_t RA_Q     = RA_ZC + (size_t)R * 1536 * 2;
constexpr size_t RA_K     = RA_Q + (size_t)16 * SK * 64 * 2;
constexpr size_t RA_VT    = RA_K + (size_t)16 * SK * 64 * 2;
constexpr size_t RA_END0  = RA_VT + (size_t)8 * 128 * SK * 2;
constexpr size_t RA_ACT   = 0;
constexpr size_t RA_Y     = 0;
constexpr size_t RA_U     = RA_Y + (size_t)NL * 1024 * 2;
constexpr size_t RA_BS0   = RA_U + (size_t)R * 1024 * 2;
constexpr size_t WS_OM1B  = WS_REGA + RA_END0;
constexpr size_t WS_END   = WS_OM1B + (size_t)128 * 4 * 32768;
static_assert(RA_BS0 + (size_t)256 * 4 * 8 * 1024 * 4 <= RA_END0 && (size_t)20480 * 1024 * 2 <= RA_END0, "region A overlays");
static_assert((size_t)256 * 4 * 8 * 1024 * 4 <= (size_t)16 * 1024 * 1024 * 2, "b of direction 1 fits layer 0's gate/up weights");
static_assert(WS_END <= 352000000ull, "workspace budget");

constexpr int LDS_BYTES = 147456 + 1024 + 1024;
constexpr int LDS_USER = 1024;

struct CvtJob { const float* src; u16* dst; int nmat, K, N, sstride, dstride, lddst, mode, half, tile0, pad; };
struct Params {
    const float* in[N_IN];
    float* out;
    uchar* ws;
    CvtJob jobs[9];
    int ncvt, ph_lo, ph_hi, pad;
};
struct Ctx { uchar* ws; float* out; const LAS unsigned long long* tab; };
typedef const __attribute__((address_space(1))) float* gcf_t;
DI const float* inp(const Ctx& c, int i) { return (const float*)(gcf_t)c.tab[i]; }

extern __shared__ __attribute__((aligned(16))) uchar smem[];
DI int hw_slot() { return (int)(__builtin_amdgcn_s_getreg(((6 - 1) << 11) | 4) & 63u); }
DI int tid_opaque() {
    const int lane = (int)__builtin_amdgcn_mbcnt_hi(~0u, __builtin_amdgcn_mbcnt_lo(~0u, 0u));
    int w = ((volatile LAS int*)smem)[96 + hw_slot()];
    w = __builtin_amdgcn_readfirstlane(w);
    int t = w * 64 + lane; asm volatile("" : "+v"(t)); return t;
}
#define XB_TMO      128
#define XB_XCNT(j)  (256  + 64 * (j))
#define XB_XSUB(j)  (1280 + 64 * (j))
#define XB_XGEN(j)  (2304 + 64 * (j))
#define XB_TOP      3328
#define XB_TOPGEN   3392
#define XCD_BAR_WORDS 3456
#define XB_SPIN_CAP (1u << 20)
DI unsigned xb_ld(unsigned* p)              { return __hip_atomic_load(p, __ATOMIC_RELAXED, __HIP_MEMORY_SCOPE_AGENT); }
DI unsigned xb_add(unsigned* p, unsigned v) { return __hip_atomic_fetch_add(p, v, __ATOMIC_RELAXED, __HIP_MEMORY_SCOPE_AGENT); }
DI unsigned xb_xcc_id() { return (unsigned)__builtin_amdgcn_s_getreg((3 << 11) | 20) & 0xFu; }
#define XB_SPIN(cond, bar) do { unsigned _sp = 0; while (cond) { __builtin_amdgcn_s_sleep(1); \
    if ((++_sp & 255u) == 0u) { if (xb_ld(&(bar)[XB_TMO])) break; if (_sp > XB_SPIN_CAP) { atomicAdd(&(bar)[XB_TMO], 1u); break; } } } } while (0)
struct XcdBarrier { unsigned* bar; unsigned x; volatile LAS unsigned* st; };
DI XcdBarrier xcd_barrier_post(unsigned* bar, volatile LAS unsigned* st) {
    XcdBarrier b; b.bar = bar; b.x = xb_xcc_id(); b.st = st;
    if (tid_opaque() == 0) (void)xb_add(&bar[XB_XCNT(b.x)], 1u);
    return b;
}
DI void xcd_barrier_complete(unsigned* bar, unsigned x, unsigned& nloc, unsigned& nx) {
    const unsigned G = gridDim.x * gridDim.y * gridDim.z;
    unsigned sum, cnt, mine, sp = 0u;
    for (;;) {
        sum = 0u; cnt = 0u; mine = 0u;
#pragma unroll
        for (unsigned j = 0; j < 16; ++j) { const unsigned c = xb_ld(&bar[XB_XCNT(j)]); sum += c; cnt += (c > 0u) ? 1u : 0u; mine = (j == x) ? c : mine; }
        if (sum == G) break;
        __builtin_amdgcn_s_sleep(1);
        if ((++sp & 255u) == 0u) { if (xb_ld(&bar[XB_TMO])) break; if (sp > XB_SPIN_CAP) { atomicAdd(&bar[XB_TMO], 1u); break; } }
    }
    nloc = mine > 0u ? mine : 1u; nx = cnt > 0u ? cnt : 1u;
}
DI void xcd_barrier(const XcdBarrier& b) {
    asm volatile("s_waitcnt vmcnt(0)" ::: "memory");
    __syncthreads();
    if (tid_opaque() == 0) {
        unsigned* bar = b.bar;
        __builtin_amdgcn_s_waitcnt(0);
        unsigned nloc = b.st[0], nx = b.st[1];
        if (nloc == 0u) { xcd_barrier_complete(bar, b.x, nloc, nx); b.st[0] = nloc; b.st[1] = nx; }
        const unsigned old = xb_add(&bar[XB_XSUB(b.x)], 1u);
        const unsigned gen = old / nloc;
        if (old + 1u == (gen + 1u) * nloc) {
            __builtin_amdgcn_fence(__ATOMIC_RELEASE, "agent");
            asm volatile("s_waitcnt vmcnt(0)" ::: "memory");
            const unsigned og = xb_add(&bar[XB_TOP], 1u);
            const unsigned tg = og / nx;
            if (og + 1u == (tg + 1u) * nx) xb_add(&bar[XB_TOPGEN], 1u);
            else XB_SPIN(xb_ld(&bar[XB_TOPGEN]) == tg, bar);
            __builtin_amdgcn_fence(__ATOMIC_ACQUIRE, "agent");
            xb_add(&bar[XB_XGEN(b.x)], 1u);
            asm volatile("s_waitcnt vmcnt(0)" ::: "memory");
        } else {
            XB_SPIN(xb_ld(&bar[XB_XGEN(b.x)]) == gen, bar);
            __builtin_amdgcn_fence(__ATOMIC_ACQUIRE, "agent");
            asm volatile("s_waitcnt vmcnt(0)" ::: "memory");
        }
    }
    __syncthreads();
}

DI float xor32_sum(float x) {
    const unsigned u = __float_as_uint(x);
    const auto r = __builtin_amdgcn_permlane32_swap(u, u, false, false);
    return __uint_as_float(r[0]) + __uint_as_float(r[1]);
}
#define DPP_ADD(v, ctrl) ((v) + __uint_as_float((unsigned)__builtin_amdgcn_update_dpp(0, (int)__float_as_uint(v), (ctrl), 0xf, 0xf, true)))
DI float wave_sum(float v) {
    v = DPP_ADD(v, 0xB1);
    v = DPP_ADD(v, 0x4E);
    v = DPP_ADD(v, 0x141);
    v = DPP_ADD(v, 0x140);
    const unsigned u = __float_as_uint(v);
    return (__uint_as_float(__builtin_amdgcn_readlane(u, 0)) + __uint_as_float(__builtin_amdgcn_readlane(u, 16))) +
           (__uint_as_float(__builtin_amdgcn_readlane(u, 32)) + __uint_as_float(__builtin_amdgcn_readlane(u, 48)));
}
DI int crow(int i, int hh) { return (i & 3) + 8 * (i >> 2) + 4 * hh; }
DI int mod_row(int r) { return r < NL ? (r >> 13) : 2; }
DI float frcp(float x) { return __builtin_amdgcn_rcpf(x); }
DI float fexp(float x) { return __builtin_amdgcn_exp2f(x * 1.4426950408889634f); }
DI float sigmoidf_(float x) { return frcp(1.0f + fexp(-x)); }
DI float one_minus_exp(float x) {
    const float s = -x * (1.0f + x * 0.5f * (1.0f + x * (1.0f / 3.0f) * (1.0f + x * 0.25f * (1.0f + x * 0.2f * (1.0f + x * (1.0f / 6.0f))))));
    const float d = 1.0f - fexp(x);
    return x > -0.125f ? s : d;
}

template <class F>
DI void cvt_list(const Params& P, uchar* lds, int i0, int step, int n, F&& job_of) {
    const int tid = tid_opaque();
    float* tl = (float*)lds;
    f32x4 rv[2];
    auto tile_src = [&](int idx, int& j, int& mat, int& kt, int& nt) -> const float* {
        int t; job_of(idx, j, t);
        const int N = P.jobs[j].N, tn = N >> 6, per = (P.jobs[j].K >> 6) * tn; mat = t / per; t -= mat * per; kt = t / tn; nt = t - kt * tn;
        return P.jobs[j].src + (size_t)mat * P.jobs[j].sstride + (size_t)(kt * 64) * N + nt * 64;
    };
    int u = i0, j = 0, mat = 0, kt = 0, nt = 0;
    __syncthreads();
    if (u < n) { const float* src = tile_src(u, j, mat, kt, nt); const int N = P.jobs[j].N;
#pragma unroll
        for (int i = 0; i < 2; ++i) rv[i] = *(const f32x4*)(src + (size_t)((tid >> 4) + 32 * i) * N + (tid & 15) * 4); }
    for (; u < n; u += step) {
#pragma unroll
        for (int i = 0; i < 2; ++i) { float* q = tl + ((tid >> 4) + 32 * i) * 65 + (tid & 15) * 4; q[0] = rv[i][0]; q[1] = rv[i][1]; q[2] = rv[i][2]; q[3] = rv[i][3]; }
        const CvtJob J = P.jobs[j];
        const int cmat = mat, ckt = kt, cnt_ = nt;
        const int un = u + step;
        if (un < n) { const float* src = tile_src(un, j, mat, kt, nt); const int N = P.jobs[j].N;
#pragma unroll
            for (int i = 0; i < 2; ++i) rv[i] = *(const f32x4*)(src + (size_t)((tid >> 4) + 32 * i) * N + (tid & 15) * 4); }
        __syncthreads();
        const int n_ = tid >> 3, kc = tid & 7;
        float v[8];
#pragma unroll
        for (int e = 0; e < 8; ++e) v[e] = tl[(kc * 8 + e) * 65 + n_];
        const int ng = cnt_ * 64 + n_;
        const int drow = J.mode ? ((ng >> 5) * 64 + J.half * 32 + (ng & 31)) : ng;
        u16* d = J.dst + (size_t)cmat * J.dstride + (size_t)drow * J.lddst + ckt * 64 + kc * 8;
        u32x4 w; w.x = pk2(v[0], v[1]); w.y = pk2(v[2], v[3]); w.z = pk2(v[4], v[5]); w.w = pk2(v[6], v[7]);
        *(u32x4*)d = w;
        __syncthreads();
    }
}
constexpr int MOE_CVT_TILES = 6144;
DI void tail_cvt_dense(const Params& P, uchar* lds, int nunits, int lo, int hi) {
    const int G = gridDim.x, rem = nunits % G;
    int rank = blockIdx.x, nidle = G;
    if (rem != 0) { if ((int)blockIdx.x < rem) return; rank = blockIdx.x - rem; nidle = G - rem; }
    cvt_list(P, lds, lo + rank, nidle, hi, [&](int idx, int& j, int& t) {
        j = 0;
#pragma unroll
        for (int q = 1; q < 6; ++q) if (idx >= P.jobs[q].tile0) j = q;
        t = idx - P.jobs[j].tile0; });
}
DI void tail_cvt_moe(const Params& P, uchar* lds, int nunits, int layer, int lo, int hi) {
    const int G = gridDim.x, rem = nunits % G;
    int rank = blockIdx.x, nidle = G;
    if (rem != 0) { if ((int)blockIdx.x < rem) return; rank = blockIdx.x - rem; nidle = G - rem; }
    cvt_list(P, lds, lo + rank, nidle, hi, [&](int idx, int& j, int& t) { j = 6 + (idx >> 11); t = layer * 2048 + (idx & 2047); });
}

DI void phase_prep(const Params& P, const Ctx& p, uchar* lds) {
    const int tid = tid_opaque();
    float* tl = (float*)lds;
    {
        float* sc = tl;
        float* red = tl + 3072;
        for (int u = blockIdx.x; u < 192; u += gridDim.x) {
            __syncthreads();
            for (int i = tid; i < 3072; i += 512) { const int mr = i >> 10, d = i & 1023; const float c = mr < 2 ? inp(p, I_C)[mr * 1024 + d] : inp(p, I_CCTX)[d]; sc[i] = c * sigmoidf_(c); }
            __syncthreads();
            const int l = u / 96, nc = u % 96, c4 = tid & 15, dg = tid >> 4;
            const float* w = inp(p, I_ADAW) + (size_t)l * 1024 * 6144 + nc * 64 + c4 * 4;
            f32x4 a0 = (f32x4){0.f, 0.f, 0.f, 0.f}, a1 = a0, a2 = a0;
#pragma unroll 16
            for (int dd = 0; dd < 32; ++dd) {
                const int d = dg * 32 + dd; const f32x4 wv = *(const f32x4*)(w + (size_t)d * 6144);
                const float s0 = sc[d], s1 = sc[1024 + d], s2 = sc[2048 + d];
#pragma unroll
                for (int e = 0; e < 4; ++e) { a0[e] += s0 * wv[e]; a1[e] += s1 * wv[e]; a2[e] += s2 * wv[e]; }
            }
            *(f32x4*)(red + (dg * 3 + 0) * 64 + c4 * 4) = a0; *(f32x4*)(red + (dg * 3 + 1) * 64 + c4 * 4) = a1; *(f32x4*)(red + (dg * 3 + 2) * 64 + c4 * 4) = a2;
            __syncthreads();
            if (tid < 192) {
                const int mr = tid >> 6, nn = tid & 63; float s = 0.f;
#pragma unroll
                for (int g = 0; g < 32; ++g) s += red[(g * 3 + mr) * 64 + nn];
                const int ncol = nc * 64 + nn;
                ((float*)(p.ws + WS_MOD))[(l * 3 + mr) * 6144 + ncol] = s + inp(p, I_ADAB)[l * 6144 + ncol];
            }
        }
        __syncthreads();
    }
    const int ntile0 = P.jobs[1].tile0;
    const bool split = gridDim.x == 256 && ntile0 == 768;
    const bool has_unit = (int)blockIdx.x < 192;
    int ci0 = blockIdx.x, cstep = gridDim.x, cn = ntile0;
    if (split) { if (has_unit) { cstep = 192; cn = 384; } else { ci0 = 384 + ((int)blockIdx.x - 192); cstep = 64; } }
    cvt_list(P, lds, ci0, cstep, cn, [&](int idx, int& j, int& t) {
        j = 0;
#pragma unroll
        for (int q = 1; q < 6; ++q) if (idx >= P.jobs[q].tile0) j = q;
        t = idx - P.jobs[j].tile0; });
    if (!split || !has_unit) {
        const int rb0 = split ? (int)blockIdx.x - 192 : (int)blockIdx.x, rbn = split ? 64 : (int)gridDim.x;
        for (int i = rb0 * 512 + tid; i < SEQ * 32; i += rbn * 512) {
            const int t = i >> 5, j = i & 31;
            const float pos = (float)(j < 16 ? (t >> 6) : (t & 63));
            const float inv = exp2f(-(float)(j & 15) * (13.287712379549449f / 16.0f));
            float sn, cs; sincosf(pos * inv, &sn, &cs);
            ((f32x2*)(p.ws + WS_ROPE))[i] = (f32x2){cs, sn};
        }
    }
}

DI void load_row16(const float* src, int lane, float (&v)[16]) {
#pragma unroll
    for (int j = 0; j < 4; ++j) { const f32x4 x = *(const f32x4*)(src + j * 256 + lane * 4); v[j * 4 + 0] = x[0]; v[j * 4 + 1] = x[1]; v[j * 4 + 2] = x[2]; v[j * 4 + 3] = x[3]; }
}
DI void norm_mod16(float (&v)[16], const float* g, const float* sh, const float* sc, int lane) {
    float ss = 0.f;
#pragma unroll
    for (int i = 0; i < 16; ++i) ss += v[i] * v[i];
    ss = wave_sum(ss);
    const float rstd = rsqrtf(ss * (1.0f / 1024.0f) + EPS);
#pragma unroll
    for (int j = 0; j < 4; ++j) {
        const int c = j * 256 + lane * 4;
        const f32x4 gg = *(const f32x4*)(g + c), s1 = *(const f32x4*)(sc + c), s0 = *(const f32x4*)(sh + c);
#pragma unroll
        for (int e = 0; e < 4; ++e) v[j * 4 + e] = (v[j * 4 + e] * rstd * gg[e]) * (1.0f + s1[e]) + s0[e];
    }
}
DI void store_row16_bf16(u16* dst, int lane, const float (&v)[16]) {
#pragma unroll
    for (int j = 0; j < 4; ++j) { u32x2 w; w.x = pk2(v[j * 4 + 0], v[j * 4 + 1]); w.y = pk2(v[j * 4 + 2], v[j * 4 + 3]); *(u32x2*)(dst + j * 256 + lane * 4) = w; }
}
DI const float* row_src(const Ctx& p, int layer, int r) {
    if (layer == 0) return r < NL ? inp(p, I_X) + (size_t)r * 1024 : inp(p, I_CTX) + (size_t)(r - NL) * 1024;
    return (const float*)(p.ws + WS_XS) + (size_t)r * 1024;
}
DI void phase_norm(const Ctx& p, int layer) {
    const int tid = tid_opaque(), lane = tid & 63, wv = blockIdx.x * 8 + (tid >> 6), nwv = gridDim.x * 8;
    const float* mod = (const float*)(p.ws + WS_MOD);
    u16* hb = (u16*)(p.ws + WS_HB);
    for (int r = wv; r < R; r += nwv) {
        float v[16];
        load_row16(row_src(p, layer, r), lane, v);
        const float* m = mod + (layer * 3 + mod_row(r)) * 6144;
        norm_mod16(v, inp(p, I_NMIX) + layer * 1024, m, m + 1024, lane);
        store_row16_bf16(hb + (size_t)r * 1024, lane, v);
    }
}
DI void phase_router(const Ctx& p, uchar* lds, int layer, int cnt_slot = -1) {
    const int tid = tid_opaque(), lane = tid & 63, wid = tid >> 6, wv = blockIdx.x * 8 + wid, nwv = gridDim.x * 8;
    const float* mod = (const float*)(p.ws + WS_MOD);
    u16* hb = (u16*)(p.ws + WS_HB);
    const float* xs = (const float*)(p.ws + WS_XS);
    const int nrows = layer == 0 ? R : NL;
    const float* wg = inp(p, I_MWGRP) + layer * 1024 * 4;
    const float* wr = inp(p, I_MWRT) + layer * 1024 * 16;
    const float* gnorm = inp(p, I_NFFN) + layer * 1024;
    int* cnt = (int*)(p.ws + WS_CTL + CTL_CNT) + (cnt_slot >= 0 ? cnt_slot : layer) * 1024;
    int* list = (int*)(p.ws + WS_LIST);
    f32x2* route = (f32x2*)(p.ws + WS_ROUTE);
    float* wrl = (float*)lds;
    float* wgl = wrl + 16384;
    float* hs = (float*)(lds + 81920 + wid * 8192);
    __syncthreads();
#pragma unroll
    for (int i = 0; i < 8; ++i) *(f32x4*)(wrl + (i * 512 + tid) * 4) = *(const f32x4*)(wr + (i * 512 + tid) * 4);
#pragma unroll
    for (int i = 0; i < 2; ++i) *(f32x4*)(wgl + (i * 512 + tid) * 4) = *(const f32x4*)(wg + (i * 512 + tid) * 4);
    __syncthreads();
    float bg[4], br[4];
#pragma unroll
    for (int o = 0; o < 4; ++o) { bg[o] = inp(p, I_MBGRP)[layer * 4 + o]; br[o] = inp(p, I_MBRT)[layer * 16 + (lane & 3) * 4 + o]; }
    for (int r0 = wv * 2; r0 < nrows; r0 += nwv * 2) {
        const float* m = mod + (layer * 3 + mod_row(r0)) * 6144;
        float v0[16], v1[16];
        load_row16(xs + (size_t)r0 * 1024, lane, v0);
        load_row16(xs + (size_t)(r0 + 1) * 1024, lane, v1);
        norm_mod16(v0, gnorm, m + 3 * 1024, m + 4 * 1024, lane);
        norm_mod16(v1, gnorm, m + 3 * 1024, m + 4 * 1024, lane);
        store_row16_bf16(hb + (size_t)r0 * 1024, lane, v0);
        store_row16_bf16(hb + (size_t)(r0 + 1) * 1024, lane, v1);
#pragma unroll
        for (int j = 0; j < 4; ++j) {
            *(f32x4*)(hs + (j * 256 + lane * 4) * 2) = (f32x4){v0[j * 4], v1[j * 4], v0[j * 4 + 1], v1[j * 4 + 1]};
            *(f32x4*)(hs + (j * 256 + lane * 4) * 2 + 4) = (f32x4){v0[j * 4 + 2], v1[j * 4 + 2], v0[j * 4 + 3], v1[j * 4 + 3]};
        }
        float ar[2][4], ag[2][4];
#pragma unroll
        for (int q = 0; q < 2; ++q)
#pragma unroll
            for (int o = 0; o < 4; ++o) { ar[q][o] = 0.f; ag[q][o] = 0.f; }
#pragma unroll 8
        for (int it = 0; it < 64; ++it) {
            const f32x4 w4 = *(const f32x4*)(wrl + (it * 64 + lane) * 4);
            const f32x2 x2 = *(const f32x2*)(hs + (it * 16 + (lane >> 2)) * 2);
#pragma unroll
            for (int o = 0; o < 4; ++o) { ar[0][o] += x2.x * w4[o]; ar[1][o] += x2.y * w4[o]; }
        }
#pragma unroll 8
        for (int it = 0; it < 16; ++it) {
            const f32x4 w4 = *(const f32x4*)(wgl + (it * 64 + lane) * 4);
            const f32x2 x2 = *(const f32x2*)(hs + (it * 64 + lane) * 2);
#pragma unroll
            for (int o = 0; o < 4; ++o) { ag[0][o] += x2.x * w4[o]; ag[1][o] += x2.y * w4[o]; }
        }
#pragma unroll
        for (int q = 0; q < 2; ++q)
#pragma unroll
            for (int o = 0; o < 4; ++o) {
                ag[q][o] = wave_sum(ag[q][o]);
                float v = ar[q][o]; v += __shfl_xor(v, 4); v += __shfl_xor(v, 8); v += __shfl_xor(v, 16); v = xor32_sum(v); ar[q][o] = v;
            }
#pragma unroll
        for (int q = 0; q < 2; ++q) {
            float gl[4];
#pragma unroll
            for (int o = 0; o < 4; ++o) gl[o] = ag[q][o] + bg[o];
            int gi = 0; float gm = gl[0];
#pragma unroll
            for (int o = 1; o < 4; ++o) if (gl[o] > gm) { gm = gl[o]; gi = o; }
            float gs = 0.f;
#pragma unroll
            for (int o = 0; o < 4; ++o) gs += __expf(gl[o] - gm);
            const float psel = 1.0f / gs;
            float el[4];
#pragma unroll
            for (int o = 0; o < 4; ++o) el[o] = __shfl(ar[q][o] + br[o], gi);
            int i1 = 0; float m1 = el[0];
#pragma unroll
            for (int o = 1; o < 4; ++o) if (el[o] > m1) { m1 = el[o]; i1 = o; }
            int i2 = -1; float m2 = -3.0e38f;
#pragma unroll
            for (int o = 0; o < 4; ++o) if (o != i1 && el[o] > m2) { m2 = el[o]; i2 = o; }
            if (lane == 0) {
                const int r = r0 + q;
                const float e2 = __expf(m2 - m1);
                const float w1 = psel / (1.0f + e2), w2 = psel * e2 / (1.0f + e2);
                const int lo = i1 < i2 ? i1 : i2, hi = i1 < i2 ? i2 : i1;
                const float wlo = i1 < i2 ? w1 : w2, whi = i1 < i2 ? w2 : w1;
                const int pi = lo == 0 ? (hi - 1) : (lo == 1 ? (hi + 1) : 5);
                const int bucket = gi * 6 + pi;
                const int pos = atomicAdd(cnt + bucket * 32, 1);
                list[(size_t)bucket * R + pos] = r;
                route[r] = (f32x2){wlo, whi};
            }
        }
    }
}

constexpr int LROW = 144;
constexpr int GEMM_A = 128 * 128, GEMM_B = 256 * 128, GEMM_STAGE = GEMM_A + GEMM_B;
constexpr int EPI_PITCH = 272, EPI_WAVE = 64 * EPI_PITCH;
static_assert(8 * EPI_WAVE <= 3 * GEMM_STAGE, "epilogue strips overlay the GEMM stages");
#define WAIT_V(n) asm volatile("s_waitcnt vmcnt(%0)" ::"n"(n) : "memory")
#define WAIT_L(n) asm volatile("s_waitcnt lgkmcnt(%0)" ::"n"(n) : "memory")
#define RAW_BARRIER() do { WAIT_L(0); __builtin_amdgcn_s_barrier(); } while (0)

template <class Epi>
DI void gemm_tile(uchar* lds, const u16* a0, const u16* a1, const u16* b0, const u16* b1, const u16* b2, const u16* b3, int nk, int ksplit, long bjump, Epi&& epi) {
    const int tid = tid_opaque(), lane = tid & 63, wid = tid >> 6, wr = wid >> 2, wc = wid & 3, l31 = lane & 31, hh = lane >> 5;
    const int lch = (lane & 7) ^ ((((wid & 1) << 3) + (lane >> 3)) >> 1);
    a0 += lch * 8; a1 += lch * 8; b0 += lch * 8; b1 += lch * 8; b2 += lch * 8; b3 += lch * 8;
    const unsigned pw = (unsigned)__builtin_amdgcn_readfirstlane(wid) * 1024u;
    const int sw = (l31 >> 1) & 7;
    unsigned xo[4];
#pragma unroll
    for (int ks = 0; ks < 4; ++ks) xo[ks] = (unsigned)(((ks * 2 + hh) ^ sw) << 4);
    const unsigned aro = (unsigned)((wr * 64 + l31) * 128), bro = (unsigned)(GEMM_A + (wc * 64 + l31) * 128);
    f32x16 acc[2][2];
#pragma unroll
    for (int a = 0; a < 2; ++a)
#pragma unroll
        for (int b = 0; b < 2; ++b)
#pragma unroll
            for (int i = 0; i < 16; ++i) acc[a][b][i] = 0.f;
#define GEMM_DMA(st_, kt_) do { const int kq_ = (kt_); const long bo_ = (long)kq_ * 64 + (kq_ >= ksplit ? bjump : 0); uchar* s_ = lds + (st_) * GEMM_STAGE + pw; \
        __builtin_amdgcn_global_load_lds((const unsigned*)(a0 + kq_ * 64), (LAS unsigned*)(s_), 16, 0, 0); \
        __builtin_amdgcn_global_load_lds((const unsigned*)(a1 + kq_ * 64), (LAS unsigned*)(s_ + 8192), 16, 0, 0); \
        __builtin_amdgcn_global_load_lds((const unsigned*)(b0 + bo_), (LAS unsigned*)(s_ + GEMM_A), 16, 0, 0); \
        __builtin_amdgcn_global_load_lds((const unsigned*)(b1 + bo_), (LAS unsigned*)(s_ + GEMM_A + 8192), 16, 0, 0); \
        __builtin_amdgcn_global_load_lds((const unsigned*)(b2 + bo_), (LAS unsigned*)(s_ + GEMM_A + 16384), 16, 0, 0); \
        __builtin_amdgcn_global_load_lds((const unsigned*)(b3 + bo_), (LAS unsigned*)(s_ + GEMM_A + 24576), 16, 0, 0); } while (0)
    RAW_BARRIER();
    GEMM_DMA(0, 0); GEMM_DMA(1, 1);
    WAIT_V(6);
    RAW_BARRIER();
    int cur = 0;
#pragma unroll 1
    for (int kt = 0; kt < nk; ++kt) {
        const int nxt = cur == 0 ? 2 : cur - 1;
        if (kt + 2 < nk) GEMM_DMA(nxt, kt + 2);
        const uchar* s = lds + cur * GEMM_STAGE;
#pragma unroll
        for (int ks = 0; ks < 4; ++ks) {
            const bf16x8 fa0 = *(const bf16x8*)(s + aro + xo[ks]), fa1 = *(const bf16x8*)(s + aro + 4096 + xo[ks]);
            const bf16x8 fb0 = *(const bf16x8*)(s + bro + xo[ks]), fb1 = *(const bf16x8*)(s + bro + 4096 + xo[ks]);
            acc[0][0] = MFMA32(fb0, fa0, acc[0][0]); acc[0][1] = MFMA32(fb0, fa1, acc[0][1]);
            acc[1][0] = MFMA32(fb1, fa0, acc[1][0]); acc[1][1] = MFMA32(fb1, fa1, acc[1][1]);
        }
        if (kt + 2 < nk) WAIT_V(6); else WAIT_V(0);
        RAW_BARRIER();
        cur = cur == 2 ? 0 : cur + 1;
    }
#if PROBE_GEMM2X == 1
    {
        f32x16 d[2][2];
        for (int a = 0; a < 2; ++a) for (int b = 0; b < 2; ++b) for (int i = 0; i < 16; ++i) d[a][b][i] = 0.f;
        RAW_BARRIER(); GEMM_DMA(0, 0); GEMM_DMA(1, 1); WAIT_V(6); RAW_BARRIER();
        int cur2 = 0;
#pragma unroll 1
        for (int kt = 0; kt < nk; ++kt) {
            const int nxt = cur2 == 0 ? 2 : cur2 - 1;
            if (kt + 2 < nk) GEMM_DMA(nxt, kt + 2);
            const uchar* s = lds + cur2 * GEMM_STAGE;
#pragma unroll
            for (int ks = 0; ks < 4; ++ks) {
                const bf16x8 fa0 = *(const bf16x8*)(s + aro + xo[ks]), fa1 = *(const bf16x8*)(s + aro + 4096 + xo[ks]);
                const bf16x8 fb0 = *(const bf16x8*)(s + bro + xo[ks]), fb1 = *(const bf16x8*)(s + bro + 4096 + xo[ks]);
                d[0][0] = MFMA32(fb0, fa0, d[0][0]); d[0][1] = MFMA32(fb0, fa1, d[0][1]);
                d[1][0] = MFMA32(fb1, fa0, d[1][0]); d[1][1] = MFMA32(fb1, fa1, d[1][1]);
            }
            if (kt + 2 < nk) WAIT_V(6); else WAIT_V(0);
            RAW_BARRIER();
            cur2 = cur2 == 2 ? 0 : cur2 + 1;
        }
        asm volatile("" :: "v"(d[0][0]), "v"(d[0][1]), "v"(d[1][0]), "v"(d[1][1]));
    }
#elif PROBE_GEMM2X == 2
    {
        f32x4 d[4][4];
        for (int a = 0; a < 4; ++a) for (int b = 0; b < 4; ++b) d[a][b] = (f32x4){0.f, 0.f, 0.f, 0.f};
        RAW_BARRIER(); GEMM_DMA(0, 0); GEMM_DMA(1, 1); WAIT_V(6); RAW_BARRIER();
        int cur2 = 0;
#pragma unroll 1
        for (int kt = 0; kt < nk; ++kt) {
            const int nxt = cur2 == 0 ? 2 : cur2 - 1;
            if (kt + 2 < nk) GEMM_DMA(nxt, kt + 2);
            const uchar* s = lds + cur2 * GEMM_STAGE;
#pragma unroll
            for (int kp = 0; kp < 2; ++kp) {
                bf16x8 fa[4], fb[4];
                fa[0] = *(const bf16x8*)(s + aro + xo[2 * kp]); fa[1] = *(const bf16x8*)(s + aro + 4096 + xo[2 * kp]); fa[2] = *(const bf16x8*)(s + aro + xo[2 * kp + 1]); fa[3] = *(const bf16x8*)(s + aro + 4096 + xo[2 * kp + 1]);
                fb[0] = *(const bf16x8*)(s + bro + xo[2 * kp]); fb[1] = *(const bf16x8*)(s + bro + 4096 + xo[2 * kp]); fb[2] = *(const bf16x8*)(s + bro + xo[2 * kp + 1]); fb[3] = *(const bf16x8*)(s + bro + 4096 + xo[2 * kp + 1]);
#pragma unroll
                for (int a = 0; a < 4; ++a)
#pragma unroll
                    for (int b = 0; b < 4; ++b) d[a][b] = __builtin_amdgcn_mfma_f32_16x16x32_bf16(fb[b], fa[a], d[a][b], 0, 0, 0);
            }
            if (kt + 2 < nk) WAIT_V(6); else WAIT_V(0);
            RAW_BARRIER();
            cur2 = cur2 == 2 ? 0 : cur2 + 1;
        }
        asm volatile("" :: "v"(d[0][0]), "v"(d[0][1]), "v"(d[0][2]), "v"(d[0][3]), "v"(d[1][0]), "v"(d[1][1]), "v"(d[1][2]), "v"(d[1][3]));
        asm volatile("" :: "v"(d[2][0]), "v"(d[2][1]), "v"(d[2][2]), "v"(d[2][3]), "v"(d[3][0]), "v"(d[3][1]), "v"(d[3][2]), "v"(d[3][3]));
    }
#endif
    epi(acc, wr * 64, wc, lane, lds + wid * EPI_WAVE);
}

constexpr int G2_A = 256 * 64, G2_STAGE = 2 * G2_A;
template <class Epi>
DI void gemm_tile256(uchar* lds, const u16* a0, const u16* a1, const u16* b0, const u16* b1, int nk, int ksplit, long bjump, Epi&& epi) {
    const int tid = tid_opaque(), lane = tid & 63, wid = tid >> 6, wr = wid >> 2, wc = wid & 3, l31 = lane & 31, hh = lane >> 5;
    const int lch = (lane & 3) ^ ((lane >> 4) & 3);
    a0 += lch * 8; a1 += lch * 8; b0 += lch * 8; b1 += lch * 8;
    const unsigned pw = (unsigned)__builtin_amdgcn_readfirstlane(wid) * 1024u;
    const int sw = (l31 >> 2) & 3;
    const unsigned xo0 = (unsigned)(((0 + hh) ^ sw) << 4), xo1 = (unsigned)(((2 + hh) ^ sw) << 4);
    const unsigned aro = (unsigned)((wr * 128 + l31) * 64), bro = (unsigned)(G2_A + (wc * 64 + l31) * 64);
    f32x16 acc[2][4];
#pragma unroll
    for (int a = 0; a < 2; ++a)
#pragma unroll
        for (int b = 0; b < 4; ++b)
#pragma unroll
            for (int i = 0; i < 16; ++i) acc[a][b][i] = 0.f;
#define G2_DMA(st_, kt_) do { const int kq_ = (kt_); const long bo_ = (long)kq_ * 32 + (kq_ >= ksplit ? bjump : 0); uchar* s_ = lds + (st_) * G2_STAGE + pw; \
        __builtin_amdgcn_global_load_lds((const unsigned*)(a0 + kq_ * 32), (LAS unsigned*)(s_), 16, 0, 0); \
        __builtin_amdgcn_global_load_lds((const unsigned*)(a1 + kq_ * 32), (LAS unsigned*)(s_ + 8192), 16, 0, 0); \
        __builtin_amdgcn_global_load_lds((const unsigned*)(b0 + bo_), (LAS unsigned*)(s_ + G2_A), 16, 0, 0); \
        __builtin_amdgcn_global_load_lds((const unsigned*)(b1 + bo_), (LAS unsigned*)(s_ + G2_A + 8192), 16, 0, 0); } while (0)
    RAW_BARRIER();
    G2_DMA(0, 0); G2_DMA(1, 1); G2_DMA(2, 2);
    WAIT_V(8);
    RAW_BARRIER();
#pragma unroll 1
    for (int kt = 0; kt < nk; ++kt) {
        if (kt + 3 < nk) G2_DMA((kt + 3) & 3, kt + 3);
        const uchar* s = lds + (kt & 3) * G2_STAGE;
#pragma unroll
        for (int ks = 0; ks < 2; ++ks) {
            const unsigned xo = ks ? xo1 : xo0;
            bf16x8 fa[4], fb[2];
#pragma unroll
            for (int mb = 0; mb < 4; ++mb) fa[mb] = *(const bf16x8*)(s + aro + mb * 2048 + xo);
#pragma unroll
            for (int nb = 0; nb < 2; ++nb) fb[nb] = *(const bf16x8*)(s + bro + nb * 2048 + xo);
#pragma unroll
            for (int nb = 0; nb < 2; ++nb)
#pragma unroll
                for (int mb = 0; mb < 4; ++mb) acc[nb][mb] = MFMA32(fb[nb], fa[mb], acc[nb][mb]);
        }
        if (kt + 3 < nk) WAIT_V(8); else if (kt + 2 < nk) WAIT_V(4); else WAIT_V(0);
        RAW_BARRIER();
    }
#pragma unroll
    for (int half = 0; half < 2; ++half) {
        f32x16 t[2][2];
#pragma unroll
        for (int nb = 0; nb < 2; ++nb)
#pragma unroll
            for (int mb = 0; mb < 2; ++mb) t[nb][mb] = acc[nb][2 * half + mb];
        epi(t, wr * 128 + half * 64, wc, lane, lds + wid * EPI_WAVE);
    }
}

DI void epi_put4(uchar* w, int row, int col, float a, float b, float c, float d) { *(f32x4*)(w + row * EPI_PITCH + col * 4) = (f32x4){a, b, c, d}; }
DI void epi_stage(uchar* w, const f32x16 (&acc)[2][2], int l31, int hh) {
#pragma unroll
    for (int mb = 0; mb < 2; ++mb)
#pragma unroll
        for (int nb = 0; nb < 2; ++nb)
#pragma unroll
            for (int g = 0; g < 4; ++g) epi_put4(w, mb * 32 + l31, nb * 32 + 8 * g + 4 * hh, acc[nb][mb][4 * g], acc[nb][mb][4 * g + 1], acc[nb][mb][4 * g + 2], acc[nb][mb][4 * g + 3]);
}
template <class F> DI void epi_rows4(const uchar* w, int lane, F&& f) {
#pragma unroll
    for (int it = 0; it < 16; ++it) { const int row = it * 4 + (lane >> 4), col = (lane & 15) * 4; f(row, col, *(const f32x4*)(w + row * EPI_PITCH + col * 4)); }
}
template <int NC, class F> DI void epi_rows8(const uchar* w, int lane, F&& f) {
    constexpr int LPR = NC / 8, RPI = 64 / LPR;
#pragma unroll
    for (int it = 0; it < 64 / RPI; ++it) { const int row = it * RPI + lane / LPR, col = (lane % LPR) * 8; f(row, col, *(const f32x4*)(w + row * EPI_PITCH + col * 4), *(const f32x4*)(w + row * EPI_PITCH + col * 4 + 16)); }
}
DI u32x4 pack8(const f32x4& a, const f32x4& b) { u32x4 r; r.x = pk2(a[0], a[1]); r.y = pk2(a[2], a[3]); r.z = pk2(b[0], b[1]); r.w = pk2(b[2], b[3]); return r; }

#define MFMA16(a, b, c) __builtin_amdgcn_mfma_f32_16x16x32_bf16((a), (b), (c), 0, 0, 0)
constexpr int P8_HT = 16384;
DI void p8_rc(int tid, int& r0, int& c) { const int wid = tid >> 6, lane = tid & 63; r0 = (wid >> 1) * 16 + (lane >> 2); c = (wid & 1) * 32 + (((lane & 3) ^ ((lane >> 5) << 1)) << 3); }
DI void glds16(const uchar* g, uchar* s) { __builtin_amdgcn_global_load_lds((const unsigned*)g, (LAS unsigned*)s, 16, 0, 0); }
template <class Epi>
DI void gemm_tile8p(uchar* lds, const uchar* abase, unsigned a0_0, unsigned a1_0, unsigned a0_1, unsigned a1_1, int ac1_0, int ac0_1, int ac1_1,
                    const uchar* bbase, unsigned bo, int bc1_0, int bc0_1, int bc1_1, int nk, int ksplit, long bjump, Epi&& epi) {
    constexpr int ac0_0 = 0, bc0_0 = 0;
    const int tid = tid_opaque(), lane = tid & 63, wid = tid >> 6, wr = wid >> 2, wc = wid & 3, fr = lane & 15, fq = lane >> 4;
    const unsigned pw = (unsigned)__builtin_amdgcn_readfirstlane(wid) * 1024u;
    const unsigned lp = (unsigned)((fr * 64 + fq * 16) ^ ((fr >> 3) << 5));
    const unsigned la = (unsigned)wr * 8192u + lp, lb = (unsigned)wc * 4096u + lp;
    f32x4 acc[2][2][4][2];
#pragma unroll
    for (int a = 0; a < 2; ++a)
#pragma unroll
        for (int b = 0; b < 2; ++b)
#pragma unroll
            for (int m = 0; m < 4; ++m)
#pragma unroll
                for (int n = 0; n < 2; ++n) acc[a][b][m][n] = (f32x4){0.f, 0.f, 0.f, 0.f};
    bf16x8 At[4][2], B0[2][2], B1[2][2];
#define P8_SA(b, h) (((b) * 2 + (h)) * P8_HT)
#define P8_SB(b, h) ((4 + (b) * 2 + (h)) * P8_HT)
#define P8_STAGE_A(b, h, kt) do { const uchar* g_ = abase + (size_t)(kt) * 128; uchar* s_ = lds + P8_SA(b, h) + pw; glds16(g_ + ac0_##h + a0_##h, s_); glds16(g_ + ac1_##h + a1_##h, s_ + 8192); } while (0)
#define P8_STAGE_B(b, h, kt) do { const int kq_ = (kt); const uchar* g_ = bbase + (size_t)kq_ * 128 + (kq_ >= ksplit ? bjump : 0); uchar* s_ = lds + P8_SB(b, h) + pw; glds16(g_ + bc0_##h + bo, s_); glds16(g_ + bc1_##h + bo, s_ + 8192); } while (0)
#define P8_LDA(dst, b, h) do { _Pragma("unroll") for (int m = 0; m < 4; ++m) { _Pragma("unroll") for (int k = 0; k < 2; ++k) dst[m][k] = *(const bf16x8*)(lds + P8_SA(b, h) + la + (m * 2 + k) * 1024); } } while (0)
#define P8_LDB(dst, b, h) do { _Pragma("unroll") for (int n = 0; n < 2; ++n) { _Pragma("unroll") for (int k = 0; k < 2; ++k) dst[n][k] = *(const bf16x8*)(lds + P8_SB(b, h) + lb + (n * 2 + k) * 1024); } } while (0)
#define P8_MMA(ai, bj, Bx) do { __builtin_amdgcn_s_setprio(1); \
        _Pragma("unroll") for (int m = 0; m < 4; ++m) { _Pragma("unroll") for (int n = 0; n < 2; ++n) { _Pragma("unroll") for (int k = 0; k < 2; ++k) acc[ai][bj][m][n] = MFMA16(Bx[n][k], At[m][k], acc[ai][bj][m][n]); } } \
        __builtin_amdgcn_s_setprio(0); } while (0)
#define P8_BAR() __builtin_amdgcn_s_barrier()
#define P8_SCHED() __builtin_amdgcn_sched_barrier(0)
    RAW_BARRIER();
    P8_STAGE_B(0, 0, 0); P8_STAGE_A(0, 0, 0); P8_STAGE_B(0, 1, 0); P8_STAGE_A(0, 1, 0);
    if (wr == 1) P8_BAR();
    WAIT_V(4); P8_BAR();
    P8_STAGE_B(1, 0, 1); P8_STAGE_A(1, 0, 1); P8_STAGE_B(1, 1, 1);
    WAIT_V(6); P8_BAR();
#pragma unroll 1
    for (int t = 0; t < nk - 2; t += 2) {
        P8_LDB(B0, 0, 0); P8_SCHED(); P8_LDA(At, 0, 0); P8_STAGE_A(1, 1, t + 1);
        WAIT_L(8); P8_BAR(); WAIT_L(0); P8_MMA(0, 0, B0); P8_BAR(); P8_SCHED();
        P8_LDB(B1, 0, 1); P8_STAGE_B(0, 0, t + 2);
        P8_BAR(); WAIT_L(0); P8_MMA(0, 1, B1); P8_BAR();
        P8_LDA(At, 0, 1); P8_STAGE_A(0, 0, t + 2);
        P8_BAR(); WAIT_L(0); P8_MMA(1, 0, B0); P8_BAR(); P8_SCHED();
        P8_STAGE_B(0, 1, t + 2);
        WAIT_V(6); P8_BAR(); P8_MMA(1, 1, B1); P8_BAR();
        P8_LDB(B0, 1, 0); P8_SCHED(); P8_LDA(At, 1, 0); P8_STAGE_A(0, 1, t + 2);
        WAIT_L(8); P8_BAR(); WAIT_L(0); P8_MMA(0, 0, B0); P8_BAR(); P8_SCHED();
        P8_LDB(B1, 1, 1); P8_STAGE_B(1, 0, t + 3);
        P8_BAR(); WAIT_L(0); P8_MMA(0, 1, B1); P8_BAR();
        P8_LDA(At, 1, 1); P8_STAGE_A(1, 0, t + 3);
        P8_BAR(); WAIT_L(0); P8_MMA(1, 0, B0); P8_BAR(); P8_SCHED();
        P8_STAGE_B(1, 1, t + 3);
        WAIT_V(6); P8_BAR(); P8_MMA(1, 1, B1); P8_BAR();
    }
    {
        P8_LDB(B0, 0, 0); P8_LDA(At, 0, 0); P8_STAGE_A(1, 1, nk - 1);
        P8_BAR(); WAIT_L(0); P8_MMA(0, 0, B0); P8_BAR();
        P8_LDB(B1, 0, 1); P8_BAR(); WAIT_L(0); P8_MMA(0, 1, B1); P8_BAR();
        P8_LDA(At, 0, 1); WAIT_V(4); P8_BAR(); WAIT_L(0); P8_MMA(1, 0, B0); P8_MMA(1, 1, B1); P8_BAR();
    }
    {
        P8_LDB(B0, 1, 0); P8_LDA(At, 1, 0); WAIT_V(2); P8_BAR(); WAIT_L(0); P8_MMA(0, 0, B0); P8_BAR();
        P8_LDB(B1, 1, 1); WAIT_V(0); P8_BAR(); WAIT_L(0); P8_MMA(0, 1, B1); P8_BAR();
        P8_LDA(At, 1, 1); P8_BAR(); WAIT_L(0); P8_MMA(1, 0, B0); P8_MMA(1, 1, B1); P8_BAR();
    }
    if (wr == 0) P8_BAR();
    RAW_BARRIER();
    uchar* w = lds + wid * EPI_WAVE;
#pragma unroll
    for (int ai = 0; ai < 2; ++ai) {
#pragma unroll
        for (int bj = 0; bj < 2; ++bj)
#pragma unroll
            for (int m = 0; m < 4; ++m)
#pragma unroll
                for (int n = 0; n < 2; ++n) *(f32x4*)(w + (m * 16 + fr) * EPI_PITCH + (bj * 32 + n * 16 + fq * 4) * 4) = acc[ai][bj][m][n];
        epi(wr * 128 + ai * 64, wc, lane, w);
    }
}
DI void epi_unstage(const uchar* w, f32x16 (&t)[2][2], int l31, int hh) {
#pragma unroll
    for (int mb = 0; mb < 2; ++mb)
#pragma unroll
        for (int nb = 0; nb < 2; ++nb)
#pragma unroll
            for (int g = 0; g < 4; ++g) { const f32x4 v = *(const f32x4*)(w + (mb * 32 + l31) * EPI_PITCH + (nb * 32 + 8 * g + 4 * hh) * 4); t[nb][mb][4 * g] = v[0]; t[nb][mb][4 * g + 1] = v[1]; t[nb][mb][4 * g + 2] = v[2]; t[nb][mb][4 * g + 3] = v[3]; }
}

DI void rect_unit(int v, int MT, int NT, int& mt, int& nt) {
    if (gridDim.x != 256) { mt = v / NT; nt = v % NT; return; }
    const int r = v >> 8, b = v & 255, x = b & 7, y = b >> 3;
    const int q = r * 8 + x, nqn = NT >> 2, qm = q / nqn, qn = q - qm * nqn;
    mt = qm * 8 + (y & 7); nt = qn * 4 + (y >> 3);
}
DI void phase_inproj0(const Params& P, const Ctx& p, uchar* lds) {
    const int tid = tid_opaque();
    const u16* hb = (const u16*)(p.ws + WS_HB);
    const u16* w = (const u16*)(p.ws + WS_WIN0);
    u16* zc = (u16*)(p.ws + WS_REGA + RA_ZC);
    u16* qa = (u16*)(p.ws + WS_REGA + RA_Q);
    u16* ka = (u16*)(p.ws + WS_REGA + RA_K);
    u16* vt = (u16*)(p.ws + WS_REGA + RA_VT);
    const f32x2* rope = (const f32x2*)(p.ws + WS_ROPE);
    const int rs = tid >> 3;
    for (int u = blockIdx.x; u < 768 + 48; u += gridDim.x) {
        const bool big = u < 768;
        int mt, nt; if (big) rect_unit(u, 64, 12, mt, nt); else { mt = (u - 768) / 12; nt = (u - 768) % 12; }
        const int m0 = big ? mt * 256 : NL + mt * 128, n0 = nt * 256;
        auto epi =
            [&](f32x16 (&acc)[2][2], int roff, int wc, int lane, uchar* w) {
                const int l31 = lane & 31, hh = lane >> 5, nw = n0 + wc * 64;
                const int row0 = m0 + roff;
                int b, spos0; if (row0 < NL) { b = row0 >> 13; spos0 = row0 & 8191; } else { b = (row0 - NL) >> 8; spos0 = SEQ + ((row0 - NL) & 255); }
                if (nw < 1536) {
                    epi_stage(w, acc, l31, hh);
                    epi_rows8<64>(w, lane, [&](int row, int col, const f32x4& v0, const f32x4& v1) { *(u32x4*)(zc + (size_t)(row0 + row) * 1536 + nw + col) = pack8(v0, v1); });
                } else if (nw < 2560) {
                    const bool isq = nw < 2048;
                    const int cg = (nw - (isq ? 1536 : 2048)) >> 6, head = cg >> 1, map = cg & 1;
                    const float* gain = isq ? inp(p, I_QN) : inp(p, I_KN);
                    const float osc = isq ? QSCALE : 1.0f;
#pragma unroll
                    for (int mb = 0; mb < 2; ++mb) {
                        float ss = 0.f;
#pragma unroll
                        for (int nb = 0; nb < 2; ++nb)
#pragma unroll
                            for (int i = 0; i < 16; ++i) ss += acc[nb][mb][i] * acc[nb][mb][i];
                        ss = xor32_sum(ss);
                        const float rstd = rsqrtf(ss * (1.0f / 64.0f) + EPS);
                        const int spos = spos0 + mb * 32 + l31;
#pragma unroll
                        for (int g = 0; g < 4; ++g) {
                            const int d0 = 8 * g + 4 * hh;
                            const f32x4 g1v = *(const f32x4*)(gain + d0), g2v = *(const f32x4*)(gain + 32 + d0);
                            f32x4 csa = (f32x4){1.f, 0.f, 1.f, 0.f}, csb = csa;
                            if (row0 < NL) { csa = *(const f32x4*)((const float*)(rope + spos * 32 + d0)); csb = *(const f32x4*)((const float*)(rope + spos * 32 + d0 + 2)); }
                            float o1[4], o2[4];
#pragma unroll
                            for (int e = 0; e < 4; ++e) {
                                const float v1 = acc[0][mb][4 * g + e] * rstd * g1v[e], v2 = acc[1][mb][4 * g + e] * rstd * g2v[e];
                                const float cs = e < 2 ? csa[2 * e] : csb[2 * (e - 2)], sn = e < 2 ? csa[2 * e + 1] : csb[2 * (e - 2) + 1];
                                o1[e] = (v1 * cs - v2 * sn) * osc; o2[e] = (v2 * cs + v1 * sn) * osc;
                            }
                            epi_put4(w, mb * 32 + l31, d0, o1[0], o1[1], o1[2], o1[3]);
                            epi_put4(w, mb * 32 + l31, 32 + d0, o2[0], o2[1], o2[2], o2[3]);
                        }
                    }
                    u16* dst = (isq ? qa : ka) + ((size_t)(((b * 4 + head) * 2 + map)) * SK + spos0) * 64;
                    epi_rows8<64>(w, lane, [&](int row, int col, const f32x4& v0, const f32x4& v1) { *(u32x4*)(dst + (size_t)row * 64 + col) = pack8(v0, v1); });
                } else {
                    const int head = (nw - 2560) >> 7, vb0 = (nw - 2560) & 127;
#pragma unroll
                    for (int mb = 0; mb < 2; ++mb) {
                        const int tok = mb * 32 + l31, tp = (tok & ~12) | (((tok >> 3) & 1) << 2) | (((tok >> 2) & 1) << 3);
#pragma unroll
                        for (int nb = 0; nb < 2; ++nb)
#pragma unroll
                            for (int i = 0; i < 16; ++i) *(u16*)(w + (nb * 32 + crow(i, hh)) * 144 + tp * 2) = f2b(acc[nb][mb][i]);
                    }
                    u16* dst = vt + ((size_t)(b * 4 + head) * 128 + vb0) * SK + spos0;
#pragma unroll
                    for (int it = 0; it < 8; ++it) { const int v = it * 8 + (lane >> 3), c8 = lane & 7; *(u32x4*)(dst + (size_t)v * SK + c8 * 8) = *(const u32x4*)(w + v * 144 + c8 * 16); }
                }
            };
        if (big) {
            int r0, c; p8_rc(tid, r0, c);
            const unsigned ao = (unsigned)(r0 * 2048 + c * 2), bo = (unsigned)((((r0 >> 5) * 64 + (r0 & 31)) * 2048) + c * 2);
            gemm_tile8p(lds, (const uchar*)(hb + (size_t)m0 * 1024), ao, ao, ao, ao, 128 * 2048, 64 * 2048, 192 * 2048,
                        (const uchar*)(w + (size_t)n0 * 1024), bo, 128 * 2048, 32 * 2048, 160 * 2048, 16, 1 << 30, 0,
                        [&](int roff, int wc, int lane, uchar* w) {
                            const int nw = n0 + wc * 64;
                            if (nw < 1536) { const int row0 = m0 + roff; epi_rows8<64>(w, lane, [&](int row, int col, const f32x4& v0, const f32x4& v1) { *(u32x4*)(zc + (size_t)(row0 + row) * 1536 + nw + col) = pack8(v0, v1); }); }
                            else { f32x16 t[2][2]; epi_unstage(w, t, lane & 31, lane >> 5); epi(t, roff, wc, lane, w); } });
        } else {
            const u16* ab = hb + (size_t)(m0 + rs) * 1024;
            const u16* bb = w + (size_t)(n0 + rs) * 1024;
            gemm_tile(lds, ab, ab + 64 * 1024, bb, bb + 64 * 1024, bb + 128 * 1024, bb + 192 * 1024, 16, 1 << 30, 0, epi);
        }
    }
    tail_cvt_moe(P, lds, 768 + 48, 0, 0, MOE_CVT_TILES / 2);
    tail_cvt_dense(P, lds, 768 + 48, P.jobs[1].tile0, P.jobs[2].tile0);
}

constexpr int ATT_K = 64 * 128, ATT_V = 128 * 128;
constexpr int ATT_STAGE = 2 * ATT_K + ATT_V;
DI void attn_unit(const Ctx& p, uchar* lds, int bh, int q0, int key0, int ntile, int out_row0) {
    const int tid = tid_opaque();
    const int lane = tid & 63, wid = tid >> 6, l31 = lane & 31, hh = lane >> 5, m = wid >> 2, g = wid & 3;
    const u16* qa = (const u16*)(p.ws + WS_REGA + RA_Q);
    const u16* ka = (const u16*)(p.ws + WS_REGA + RA_K);
    const u16* vt = (const u16*)(p.ws + WS_REGA + RA_VT);
    uchar* qs = lds + 2 * ATT_STAGE + wid * 8192 + lane * 16;
    RAW_BARRIER();
    {
        const u16* qp = qa + ((size_t)(bh * 2 + m) * SK + q0 + g * 64 + l31) * 64 + hh * 8;
#pragma unroll
        for (int rg = 0; rg < 2; ++rg)
#pragma unroll
            for (int ks = 0; ks < 4; ++ks) *(bf16x8*)(qs + (rg * 4 + ks) * 1024) = *(const bf16x8*)(qp + rg * 32 * 64 + ks * 16);
    }
    const int lch = (lane & 7) ^ ((((wid & 1) << 3) + (lane >> 3)) >> 1);
    const u16* kp = ka + ((size_t)(bh * 2) * SK + key0 + wid * 8 + (lane >> 3)) * 64 + lch * 8;
    const u16* vp = vt + ((size_t)bh * 128 + wid * 8 + (lane >> 3)) * SK + key0 + lch * 8;
    const unsigned pw = (unsigned)__builtin_amdgcn_readfirstlane(wid) * 1024u;
    const int sw = (l31 >> 1) & 7;
    unsigned xo[4];
#pragma unroll
    for (int ks = 0; ks < 4; ++ks) xo[ks] = (unsigned)(((ks * 2 + hh) ^ sw) << 4);
    const unsigned kro = (unsigned)(m * ATT_K + l31 * 128), vro = (unsigned)(2 * ATT_K + l31 * 128);
    f32x16 O[2][4];
#pragma unroll
    for (int rg = 0; rg < 2; ++rg)
#pragma unroll
        for (int vb = 0; vb < 4; ++vb)
#pragma unroll
            for (int i = 0; i < 16; ++i) O[rg][vb][i] = 0.f;
    float lsum0 = 0.f, lsum1 = 0.f;
#define ATT_DMA(st_, t_) do { const int tq_ = (t_); uchar* s_ = lds + (st_) * ATT_STAGE + pw; \
        __builtin_amdgcn_global_load_lds((const unsigned*)(kp + (size_t)tq_ * 4096), (LAS unsigned*)(s_), 16, 0, 0); \
        __builtin_amdgcn_global_load_lds((const unsigned*)(kp + (size_t)SK * 64 + (size_t)tq_ * 4096), (LAS unsigned*)(s_ + ATT_K), 16, 0, 0); \
        __builtin_amdgcn_global_load_lds((const unsigned*)(vp + tq_ * 64), (LAS unsigned*)(s_ + 2 * ATT_K), 16, 0, 0); \
        __builtin_amdgcn_global_load_lds((const unsigned*)(vp + (size_t)64 * SK + tq_ * 64), (LAS unsigned*)(s_ + 2 * ATT_K + 8192), 16, 0, 0); } while (0)
    ATT_DMA(0, 0);
    WAIT_V(0);
    RAW_BARRIER();
#pragma unroll 1
    for (int t = 0; t < ntile; ++t) {
        if (t + 1 < ntile) ATT_DMA((t + 1) & 1, t + 1);
        const uchar* s = lds + (t & 1) * ATT_STAGE;
#pragma unroll 1
        for (int kb = 0; kb < 2; ++kb) {
            bf16x8 P[2][2];
#pragma unroll
            for (int rg = 0; rg < 2; ++rg) {
                f32x16 S;
#pragma unroll
                for (int i = 0; i < 16; ++i) S[i] = 0.f;
#pragma unroll
                for (int ks = 0; ks < 4; ++ks) { const bf16x8 kf = *(const bf16x8*)(s + kro + kb * 4096 + xo[ks]); const bf16x8 q = *(const bf16x8*)(qs + (rg * 4 + ks) * 1024); S = MFMA32(kf, q, S); }
                float ls = 0.f;
#pragma unroll
                for (int i = 0; i < 16; ++i) { S[i] = __builtin_amdgcn_exp2f(S[i]); ls += S[i]; }
                if (rg == 0) lsum0 += ls; else lsum1 += ls;
#pragma unroll
                for (int s2 = 0; s2 < 2; ++s2) {
                    u32x4 pw4; pw4.x = pk2(S[8 * s2], S[8 * s2 + 1]); pw4.y = pk2(S[8 * s2 + 2], S[8 * s2 + 3]); pw4.z = pk2(S[8 * s2 + 4], S[8 * s2 + 5]); pw4.w = pk2(S[8 * s2 + 6], S[8 * s2 + 7]);
                    P[rg][s2] = __builtin_bit_cast(bf16x8, pw4);
                }
            }
#pragma unroll
            for (int s2 = 0; s2 < 2; ++s2)
#pragma unroll
                for (int vb = 0; vb < 4; ++vb) {
                    const bf16x8 vf = *(const bf16x8*)(s + vro + vb * 4096 + (unsigned)(((4 * kb + 2 * s2 + hh) ^ sw) << 4));
                    O[0][vb] = MFMA32(vf, P[0][s2], O[0][vb]); O[1][vb] = MFMA32(vf, P[1][s2], O[1][vb]);
                }
        }
        WAIT_V(0);
        RAW_BARRIER();
    }
    lsum0 = xor32_sum(lsum0); lsum1 = xor32_sum(lsum1);
    const int tid2 = tid_opaque(), lane2 = tid2 & 63, wid2 = tid2 >> 6, e_l31 = lane2 & 31, e_hh = lane2 >> 5, e_m = wid2 >> 2, e_g = wid2 & 3;
    float lam;
    { float d1 = inp(p, I_LQ1)[lane2] * inp(p, I_LK1)[lane2], d2 = inp(p, I_LQ2)[lane2] * inp(p, I_LK2)[lane2]; d1 = wave_sum(d1); d2 = wave_sum(d2); lam = fexp(d1) - fexp(d2) + LAM_INIT0; }
    float* comb = (float*)lds + (size_t)e_g * 8192 + lane2;
    if (e_m == 1) {
#pragma unroll
        for (int rg = 0; rg < 2; ++rg) {
            const float sc = lam / (rg ? lsum1 : lsum0);
#pragma unroll
            for (int vb = 0; vb < 4; ++vb) {
#pragma unroll
                for (int i = 0; i < 16; ++i) comb[((rg * 4 + vb) * 16 + i) * 64] = O[rg][vb][i] * sc;
                __builtin_amdgcn_sched_barrier(0);
            }
        }
    }
    RAW_BARRIER();
    if (e_m == 0) {
        const float* snl = (const float*)(lds + 131072);
        const int h = bh & 3;
#pragma unroll
        for (int rg = 0; rg < 2; ++rg) {
            const float i0 = 1.0f / (rg ? lsum1 : lsum0);
            float ss = 0.f;
#pragma unroll
            for (int vb = 0; vb < 4; ++vb) {
#pragma unroll
                for (int i = 0; i < 16; ++i) { const float o = O[rg][vb][i] * i0 - comb[((rg * 4 + vb) * 16 + i) * 64]; O[rg][vb][i] = o; ss += o * o; }
                __builtin_amdgcn_sched_barrier(0);
            }
            ss = xor32_sum(ss);
            const float rstd = rsqrtf(ss * (1.0f / 128.0f) + EPS) * (1.0f - LAM_INIT0);
            u16* dst = (u16*)(p.ws + WS_HB) + (size_t)(out_row0 + e_g * 64 + rg * 32 + e_l31) * 1024 + 512 + h * 128;
#pragma unroll
            for (int vb = 0; vb < 4; ++vb)
#pragma unroll
                for (int gq = 0; gq < 4; ++gq) {
                    const int v0 = vb * 32 + 8 * gq + 4 * e_hh;
                    const f32x4 gn = *(const f32x4*)(snl + v0);
                    u32x2 w; w.x = pk2(O[rg][vb][4 * gq] * rstd * gn[0], O[rg][vb][4 * gq + 1] * rstd * gn[1]); w.y = pk2(O[rg][vb][4 * gq + 2] * rstd * gn[2], O[rg][vb][4 * gq + 3] * rstd * gn[3]);
                    *(u32x2*)(dst + v0) = w;
                }
        }
    }
}
DI void phase_attn(const Ctx& p, uchar* lds) {
    const int tid = tid_opaque();
    if (tid < 128) ((float*)(lds + 131072))[tid] = inp(p, I_SUBN)[tid];
    for (int u = blockIdx.x; u < 264; u += gridDim.x) {
        const bool lat = u < 256;
        const int bh = u & 7, qb = u >> 3;
        attn_unit(p, lds, bh, lat ? qb * 256 : SEQ, lat ? 0 : SEQ, lat ? 132 : 4, lat ? (bh >> 2) * SEQ + qb * 256 : NL + (bh >> 2) * CTXL);
    }
    {
        const u16* zc = (const u16*)(p.ws + WS_REGA + RA_ZC);
        u16* hb = (u16*)(p.ws + WS_HB);
        const int tid2 = tid_opaque(), lane = tid2 & 63, wid = tid2 >> 6, c8 = lane * 8;
        float w0[8], w1[8], w2[8], bias[8];
        {
            const float* cw = inp(p, I_EVCW) + c8; const float* cb = inp(p, I_EVCB) + c8;
#pragma unroll
            for (int h = 0; h < 2; ++h) {
                const f32x4 a = *(const f32x4*)(cw + 4 * h), b = *(const f32x4*)(cw + 512 + 4 * h), c = *(const f32x4*)(cw + 1024 + 4 * h), d = *(const f32x4*)(cb + 4 * h);
#pragma unroll
                for (int e = 0; e < 4; ++e) { w0[4 * h + e] = a[e]; w1[4 * h + e] = b[e]; w2[4 * h + e] = c[e]; bias[4 * h + e] = d[e]; }
            }
        }
        auto unpack8 = [](const u32x4& v, float (&f)[8]) { f[0] = blo(v.x); f[1] = bhi(v.x); f[2] = blo(v.y); f[3] = bhi(v.y); f[4] = blo(v.z); f[5] = bhi(v.z); f[6] = blo(v.w); f[7] = bhi(v.w); };
        for (int u = blockIdx.x; u < 256; u += gridDim.x) {
            const int rb = u * 66 + wid * 9, nr = wid < 7 ? 9 : 3;
            u32x4 cc[11], cx[11], cg[9];
#pragma unroll
            for (int j = 0; j < 11; ++j) {
                int row = rb - 1 + j; row = row < 0 ? 0 : (row >= R ? R - 1 : row);
                cc[j] = *(const u32x4*)(zc + (size_t)row * 1536 + 512 + c8); cx[j] = *(const u32x4*)(zc + (size_t)row * 1536 + 1024 + c8);
            }
#pragma unroll
            for (int i = 0; i < 9; ++i) { const int row = rb + i < R ? rb + i : R - 1; cg[i] = *(const u32x4*)(zc + (size_t)row * 1536 + c8); }
            float pm[8], pc[8], pn[8];
            { float a[8], b[8]; unpack8(cc[0], a); unpack8(cx[0], b);
#pragma unroll
              for (int e = 0; e < 8; ++e) pm[e] = a[e] * b[e];
              unpack8(cc[1], a); unpack8(cx[1], b);
#pragma unroll
              for (int e = 0; e < 8; ++e) pc[e] = a[e] * b[e]; }
#pragma unroll
            for (int i = 0; i < 9; ++i) {
                { float a[8], b[8]; unpack8(cc[i + 2], a); unpack8(cx[i + 2], b);
#pragma unroll
                  for (int e = 0; e < 8; ++e) pn[e] = a[e] * b[e]; }
                const int r = rb + i;
                const bool first = r < NL ? (r & 8191) == 0 : ((r - NL) & 255) == 0, last = r < NL ? (r & 8191) == 8191 : ((r - NL) & 255) == 255;
                if (i < nr) {
                    float g[8], o[8]; unpack8(cg[i], g);
#pragma unroll
                    for (int e = 0; e < 8; ++e) o[e] = g[e] * (bias[e] + w0[e] * (first ? 0.f : pm[e]) + w1[e] * pc[e] + w2[e] * (last ? 0.f : pn[e]));
                    u32x4 wv; wv.x = pk2(o[0], o[1]); wv.y = pk2(o[2], o[3]); wv.z = pk2(o[4], o[5]); wv.w = pk2(o[6], o[7]);
                    *(u32x4*)(hb + (size_t)r * 1024 + c8) = wv;
                }
#pragma unroll
                for (int e = 0; e < 8; ++e) { pm[e] = pc[e]; pc[e] = pn[e]; }
            }
        }
    }
}

DI void phase_outproj(const Params& P, const Ctx& p, uchar* lds, int layer) {
    const int tid = tid_opaque();
    const u16* hb = (const u16*)(p.ws + WS_HB);
    const u16* w = (const u16*)(p.ws + (layer == 0 ? WS_WOUT0 : WS_WOUT1));
    float* xs = (float*)(p.ws + WS_XS);
    const float* mod = (const float*)(p.ws + WS_MOD);
    const int nbig = 256, nunits = nbig + (layer == 0 ? 16 : 0);
    for (int u = blockIdx.x; u < nunits; u += gridDim.x) {
        const bool big = u < nbig;
        int mt, nt; if (big) rect_unit(u, 64, 4, mt, nt); else { mt = (u - nbig) >> 2; nt = u & 3; }
        const int m0 = big ? mt * 256 : NL + mt * 128, n0 = nt * 256;
        auto epi_body =
            [&](int roff, int wc, int lane, uchar* w) {
                const int row0 = m0 + roff, nw = n0 + wc * 64;
                const float* g1 = mod + (layer * 3 + mod_row(row0)) * 6144 + 2048 + nw;
                const float* src = row_src(p, layer, row0) + nw;
                f32x4 xi[16], gg = *(const f32x4*)(g1 + (lane & 15) * 4);
#pragma unroll
                for (int it = 0; it < 16; ++it) xi[it] = *(const f32x4*)(src + (size_t)(it * 4 + (lane >> 4)) * 1024 + (lane & 15) * 4);
#pragma unroll
                for (int it = 0; it < 16; ++it) {
                    const int row = it * 4 + (lane >> 4), col = (lane & 15) * 4;
                    const f32x4 v = *(const f32x4*)(w + row * EPI_PITCH + col * 4);
                    f32x4 o;
#pragma unroll
                    for (int e = 0; e < 4; ++e) o[e] = xi[it][e] + gg[e] * v[e];
                    *(f32x4*)(xs + (size_t)(row0 + row) * 1024 + nw + col) = o;
                }
            };
        auto epi = [&](f32x16 (&acc)[2][2], int roff, int wc, int lane, uchar* w) { epi_stage(w, acc, lane & 31, lane >> 5); epi_body(roff, wc, lane, w); };
        if (big) {
            int r0, c; p8_rc(tid, r0, c);
            const unsigned ao = (unsigned)(r0 * 2048 + c * 2), bo = (unsigned)((((r0 >> 5) * 64 + (r0 & 31)) * 2048) + c * 2);
            gemm_tile8p(lds, (const uchar*)(hb + (size_t)m0 * 1024), ao, ao, ao, ao, 128 * 2048, 64 * 2048, 192 * 2048,
                        (const uchar*)(w + (size_t)n0 * 1024), bo, 128 * 2048, 32 * 2048, 160 * 2048, 16, 1 << 30, 0, epi_body);
        } else {
            const int rs = tid >> 3;
            const u16* ab = hb + (size_t)(m0 + rs) * 1024;
            const u16* bb = w + (size_t)(n0 + rs) * 1024;
            gemm_tile(lds, ab, ab + 64 * 1024, bb, bb + 64 * 1024, bb + 128 * 1024, bb + 192 * 1024, 16, 1 << 30, 0, epi);
        }
    }
    if (layer == 0) tail_cvt_moe(P, lds, nunits, 0, MOE_CVT_TILES / 2, MOE_CVT_TILES);
}

struct TileInfo { int bucket, mt, cnt, ntiles; };
DI int moe_ntiles(const int* cnt) { int s = 0; for (int b = 0; b < 24; ++b) s += (cnt[b * 32] + 127) >> 7; return s; }
DI TileInfo moe_tile(const int* cnt, int t) {
    TileInfo ti; ti.bucket = 0; ti.mt = 0; ti.cnt = 0; ti.ntiles = 0;
    int base = 0;
    for (int b = 0; b < 24; ++b) { const int c = cnt[b * 32], n = (c + 127) >> 7; if (t >= base && t < base + n) { ti.bucket = b; ti.mt = t - base; ti.cnt = c; } base += n; }
    ti.ntiles = base; return ti;
}
DI void bucket_experts(int bucket, int& ea, int& eb) {
    const int g = bucket / 6, pi = bucket - g * 6;
    const int lo = pi < 3 ? 0 : (pi < 5 ? 1 : 2), hi = pi < 3 ? pi + 1 : (pi < 5 ? pi - 1 : 3);
    ea = g * 4 + lo; eb = g * 4 + hi;
}
struct MoeUnit { int bucket, t, mt, cnt, big, nt; };
typedef const volatile LAS int* lcnt_t;
DI int moe_units(lcnt_t cnt, int NT, int G, int& B, int& NBIG) {
    int b2 = 0, s1 = 0;
    for (int b = 0; b < 24; ++b) { const int n = (cnt[b] + 127) >> 7; b2 += n >> 1; s1 += n & 1; }
    B = b2;
    const int cand = b2 * NT;
    int best = 1 << 30; NBIG = 0;
    for (int k = 0; k <= (cand + G - 1) / G; ++k) {
        const int nb = k * G < cand ? k * G : cand, U = 2 * cand + s1 * NT - nb;
        const int rb = (nb + G - 1) / G, ru = (U + G - 1) / G, cost = rb * 7 + (ru - rb) * 5;
        if (cost < best) { best = cost; NBIG = nb; }
    }
    return 2 * cand + s1 * NT - NBIG;
}
DI MoeUnit moe_unit(lcnt_t cnt, int u, int NT, int B, int NBIG) {
    const int sh = NT == 8 ? 3 : 2;
    int kind, idx, half = 0, nt;
    if (u < NBIG) {
        kind = 0; idx = u >> sh; nt = u & (NT - 1);
        if (gridDim.x == 256 && u < (NBIG & ~255)) { const int r = u >> 8, b = u & 255, x = b & 7, y = b >> 3; idx = (r << (8 - sh)) + x * (32 >> sh) + (y >> sh); nt = y & (NT - 1); }
    }
    else {
        int v = u - NBIG; const int npl = B - (NBIG >> sh);
        if (v < npl * 2 * NT) { kind = 1; idx = (NBIG >> sh) + (v >> (sh + 1)); half = (v >> sh) & 1; nt = v & (NT - 1); }
        else { v -= npl * 2 * NT; kind = 2; idx = v >> sh; nt = v & (NT - 1); }
    }
    MoeUnit r; r.bucket = 0; r.t = 0; r.mt = 0; r.cnt = 0; r.big = kind == 0; r.nt = nt;
    int pb = 0, ps = 0, pt = 0;
    for (int b = 0; b < 24; ++b) {
        const int c = cnt[b], n = (c + 127) >> 7, np = n >> 1, sg = n & 1;
        if (kind != 2) { if (idx >= pb && idx < pb + np) { r.bucket = b; r.mt = 2 * (idx - pb) + half; r.t = pt + r.mt; r.cnt = c; } }
        else if (sg && idx == ps) { r.bucket = b; r.mt = n - 1; r.t = pt + n - 1; r.cnt = c; }
        pb += np; ps += sg; pt += n;
    }
    return r;
}
constexpr int MOE_TOK = 3 * GEMM_STAGE;
DI void phase_moe_up(const Params& P, const Ctx& p, uchar* lds, int layer) {
    const int tid = tid_opaque();
    const int* cnt = (const int*)(p.ws + WS_CTL + CTL_CNT) + layer * 1024;
    const int* list = (const int*)(p.ws + WS_LIST);
    const f32x2* route = (const f32x2*)(p.ws + WS_ROUTE);
    const u16* hb = (const u16*)(p.ws + WS_HB);
    const u16* wgu = (const u16*)(p.ws + WS_WGU) + (size_t)layer * 16 * 1024 * 1024;
    u16* act = (u16*)(p.ws + WS_REGA + RA_ACT);
    int* tok = (int*)(lds + MOE_TOK);
    const int rs = tid >> 3;
    lcnt_t lc = (lcnt_t)(smem + 640);
    __syncthreads();
    if (tid < 24) ((volatile LAS int*)(smem + 640))[tid] = cnt[tid * 32];
    __syncthreads();
    int B, NBIG;
    const int U = moe_units(lc, 8, gridDim.x, B, NBIG);
    for (int u = blockIdx.x; u < U; u += gridDim.x) {
        const MoeUnit mu = moe_unit(lc, u, 8, B, NBIG);
        const int nt = mu.nt;
        int ea, eb; bucket_experts(mu.bucket, ea, eb);
        __syncthreads();
        if (tid < (mu.big ? 256 : 128)) { const int pos = mu.mt * 128 + tid; tok[tid] = list[(size_t)mu.bucket * R + (pos < mu.cnt ? pos : 0)]; }
        __syncthreads();
        const int e = nt < 4 ? ea : eb;
        auto epi_body =
            [&](int roff, int wc, int lane, uchar* w) {
                u16* dst = act + ((size_t)mu.t * 128 + roff) * 1024 + (nt >= 4 ? 512 : 0) + (nt & 3) * 128 + wc * 32;
                const int col = (lane & 3) * 8;
                f32x2 rw[4];
#pragma unroll
                for (int it = 0; it < 4; ++it) rw[it] = route[tok[roff + it * 16 + (lane >> 2)]];
#pragma unroll
                for (int it = 0; it < 4; ++it) {
                    const int row = it * 16 + (lane >> 2);
                    const float wgt = nt < 4 ? rw[it].x : rw[it].y;
                    const uchar* wp = w + row * EPI_PITCH + col * 4;
                    const f32x4 g0 = *(const f32x4*)wp, g1 = *(const f32x4*)(wp + 16), u0 = *(const f32x4*)(wp + 128), u1 = *(const f32x4*)(wp + 144);
                    f32x4 o0, o1;
#pragma unroll
                    for (int e2 = 0; e2 < 4; ++e2) { o0[e2] = g0[e2] * sigmoidf_(g0[e2]) * u0[e2] * wgt; o1[e2] = g1[e2] * sigmoidf_(g1[e2]) * u1[e2] * wgt; }
                    *(u32x4*)(dst + (size_t)row * 1024 + col) = pack8(o0, o1);
                }
            };
        if (mu.big) {
            int r0, c; p8_rc(tid, r0, c);
            const unsigned bo = (unsigned)((((r0 >> 5) * 64 + (r0 & 31)) * 2048) + c * 2);
            const unsigned a00 = (unsigned)tok[r0] * 2048u + c * 2, a10 = (unsigned)tok[128 + r0] * 2048u + c * 2, a01 = (unsigned)tok[64 + r0] * 2048u + c * 2, a11 = (unsigned)tok[192 + r0] * 2048u + c * 2;
            gemm_tile8p(lds, (const uchar*)hb, a00, a10, a01, a11, 0, 0, 0,
                        (const uchar*)(wgu + ((size_t)e * 1024 + (nt & 3) * 256) * 1024), bo, 128 * 2048, 32 * 2048, 160 * 2048, 16, 1 << 30, 0, epi_body);
        } else {
            const u16* a0 = hb + (size_t)tok[rs] * 1024;
            const u16* a1 = hb + (size_t)tok[rs + 64] * 1024;
            const u16* bb = wgu + ((size_t)e * 1024 + (nt & 3) * 256 + rs) * 1024;
            gemm_tile(lds, a0, a1, bb, bb + 64 * 1024, bb + 128 * 1024, bb + 192 * 1024, 16, 1 << 30, 0,
                [&](f32x16 (&acc)[2][2], int roff, int wc, int lane, uchar* w) { epi_stage(w, acc, lane & 31, lane >> 5); epi_body(roff, wc, lane, w); });
        }
    }
    if (layer == 0) tail_cvt_dense(P, lds, U, P.jobs[2].tile0, P.jobs[6].tile0);
}
DI void phase_moe_down(const Params& P, const Ctx& p, uchar* lds, int layer) {
    const int tid = tid_opaque();
    const int* cnt = (const int*)(p.ws + WS_CTL + CTL_CNT) + layer * 1024;
    const int* list = (const int*)(p.ws + WS_LIST);
    const u16* wd = (const u16*)(p.ws + WS_WD) + (size_t)layer * 16 * 1024 * 512;
    const u16* act = (const u16*)(p.ws + WS_REGA + RA_ACT);
    float* xs = (float*)(p.ws + WS_XS);
    float* dsto = layer == 0 ? xs : p.out;
    const float* mod = (const float*)(p.ws + WS_MOD);
    int* tok = (int*)(lds + MOE_TOK);
    const int rs = tid >> 3;
    lcnt_t lc = (lcnt_t)(smem + 640);
    __syncthreads();
    if (tid < 24) ((volatile LAS int*)(smem + 640))[tid] = cnt[tid * 32];
    __syncthreads();
    int B, NBIG;
    const int U = moe_units(lc, 4, gridDim.x, B, NBIG);
    for (int u = blockIdx.x; u < U; u += gridDim.x) {
        const MoeUnit mu = moe_unit(lc, u, 4, B, NBIG);
        const int nt = mu.nt, n0 = nt * 256;
        int ea, eb; bucket_experts(mu.bucket, ea, eb);
        __syncthreads();
        if (tid < (mu.big ? 256 : 128)) { const int pos = mu.mt * 128 + tid; tok[tid] = pos < mu.cnt ? list[(size_t)mu.bucket * R + pos] : -1; }
        __syncthreads();
        const long bjump = (long)(eb - ea) * 1024 * 512 - 512;
        auto epi_body =
            [&](int roff, int wc, int lane, uchar* w) {
                const int nw = n0 + wc * 64 + (lane & 15) * 4;
                int tk[16]; f32x4 xi[16], g3[3];
#pragma unroll
                for (int q = 0; q < 3; ++q) g3[q] = *(const f32x4*)(mod + (layer * 3 + q) * 6144 + 5 * 1024 + nw);
#pragma unroll
                for (int it = 0; it < 16; ++it) {
                    tk[it] = tok[roff + it * 4 + (lane >> 4)];
                    xi[it] = (f32x4){0.f, 0.f, 0.f, 0.f};
                    if (tk[it] >= 0) xi[it] = *(const f32x4*)(xs + (size_t)tk[it] * 1024 + nw);
                }
#pragma unroll
                for (int it = 0; it < 16; ++it) {
                    const int row = it * 4 + (lane >> 4);
                    if (tk[it] >= 0) {
                        const int mr = mod_row(tk[it]);
                        const f32x4 gg = mr == 0 ? g3[0] : (mr == 1 ? g3[1] : g3[2]);
                        const f32x4 v = *(const f32x4*)(w + row * EPI_PITCH + (lane & 15) * 16);
                        f32x4 o;
#pragma unroll
                        for (int e = 0; e < 4; ++e) o[e] = xi[it][e] + gg[e] * v[e];
                        *(f32x4*)(dsto + (size_t)tk[it] * 1024 + nw) = o;
                    }
                }
            };
        if (mu.big) {
            int r0, c; p8_rc(tid, r0, c);
            const unsigned ao = (unsigned)(r0 * 2048 + c * 2), bo = (unsigned)((((r0 >> 5) * 64 + (r0 & 31)) * 1024) + c * 2);
            gemm_tile8p(lds, (const uchar*)(act + (size_t)mu.t * 128 * 1024), ao, ao, ao, ao, 128 * 2048, 64 * 2048, 192 * 2048,
                        (const uchar*)(wd + ((size_t)ea * 1024 + n0) * 512), bo, 128 * 1024, 32 * 1024, 160 * 1024, 16, 8, bjump * 2, epi_body);
        } else {
            const u16* ab = act + ((size_t)mu.t * 128 + rs) * 1024;
            const u16* bb = wd + ((size_t)ea * 1024 + n0 + rs) * 512;
            gemm_tile(lds, ab, ab + 64 * 1024, bb, bb + 64 * 512, bb + 128 * 512, bb + 192 * 512, 16, 8, bjump,
                [&](f32x16 (&acc)[2][2], int roff, int wc, int lane, uchar* w) { epi_stage(w, acc, lane & 31, lane >> 5); epi_body(roff, wc, lane, w); });
        }
    }
    if (layer == 0) tail_cvt_moe(P, lds, U, 1, 0, MOE_CVT_TILES / 2);
}

DI void phase_inproj1(const Params& P, const Ctx& p, uchar* lds) {
    const int tid = tid_opaque();
    const u16* hb = (const u16*)(p.ws + WS_HB);
    const u16* w = (const u16*)(p.ws + WS_WIN1);
    u16* yb = (u16*)(p.ws + WS_REGA + RA_Y);
    u16* ub = (u16*)(p.ws + WS_REGA + RA_U);
    const int rs = tid >> 3;
    for (int u = blockIdx.x; u < 512 + 16; u += gridDim.x) {
        const bool big = u < 512;
        int mt, nt; if (big) rect_unit(u, 64, 8, mt, nt); else { mt = (u - 512) >> 2; nt = 4 + ((u - 512) & 3); }
        const int m0 = big ? mt * 256 : NL + mt * 128, n0 = nt * 256;
        auto epi_body =
            [&](int roff, int wc, int lane, uchar* w) {
                const int row0 = m0 + roff, nw = n0 + wc * 64;
                if (nt < 4) {
                    epi_rows8<64>(w, lane, [&](int row, int col, const f32x4& v0, const f32x4& v1) {
                        f32x4 a, b2;
#pragma unroll
                        for (int e = 0; e < 4; ++e) { const float x = v0[e], y = v1[e]; a[e] = x * sigmoidf_(1.5957691216057308f * (x + 0.044715f * x * x * x)); b2[e] = y * sigmoidf_(1.5957691216057308f * (y + 0.044715f * y * y * y)); }
                        *(u32x4*)(yb + (size_t)(row0 + row) * 1024 + nw + col) = pack8(a, b2); });
                } else {
                    epi_rows8<64>(w, lane, [&](int row, int col, const f32x4& v0, const f32x4& v1) { *(u32x4*)(ub + (size_t)(row0 + row) * 1024 + nw - 1024 + col) = pack8(v0, v1); });
                }
            };
        if (big) {
            int r0, c; p8_rc(tid, r0, c);
            const unsigned ao = (unsigned)(r0 * 2048 + c * 2), bo = (unsigned)((((r0 >> 5) * 64 + (r0 & 31)) * 2048) + c * 2);
            gemm_tile8p(lds, (const uchar*)(hb + (size_t)m0 * 1024), ao, ao, ao, ao, 128 * 2048, 64 * 2048, 192 * 2048,
                        (const uchar*)(w + (size_t)n0 * 1024), bo, 128 * 2048, 32 * 2048, 160 * 2048, 16, 1 << 30, 0, epi_body);
        } else {
            const u16* ab = hb + (size_t)(m0 + rs) * 1024;
            const u16* bb = w + (size_t)(n0 + rs) * 1024;
            gemm_tile(lds, ab, ab + 64 * 1024, bb, bb + 64 * 1024, bb + 128 * 1024, bb + 192 * 1024, 16, 1 << 30, 0,
                [&](f32x16 (&acc)[2][2], int roff, int wc, int lane, uchar* w) { epi_stage(w, acc, lane & 31, lane >> 5); epi_body(roff, wc, lane, w); });
        }
    }
    tail_cvt_moe(P, lds, 512 + 16, 1, MOE_CVT_TILES / 2, MOE_CVT_TILES);
}

constexpr int LRU_U = 0, LRU_UC = 36864, UROW = 272, UC_BLK = 64 * UROW  , UC_DIR = 2 * UC_BLK;
DI int lru_perm(int r) { return ((r >> 2) & 1) * 16 + (r >> 3) * 4 + (r & 3); }
DI unsigned* lru_bsave(const Ctx& p, int dir, int c, int cblk, int wid) {
    unsigned* base = (unsigned*)(p.ws + (dir == 0 ? WS_REGA + RA_BS0 : WS_WGU));
    return base + ((size_t)(c * 4 + cblk) * 8 + wid) * 1024;
}
DI u32x4* lru_osave(const Ctx& p, int dir, int c, int cblk, int wid, int q, int lane) {
    if (dir == 0) return (u32x4*)(p.ws + WS_HB + ((size_t)(c * 64 + (wid * 4 + q) * 2 + (lane >> 5)) * 2048 + cblk * 512 + (lane & 31) * 16));
    uchar* base = p.ws + (c < 128 ? WS_WD : WS_OM1B);
    return (u32x4*)(base + ((size_t)((c & 127) * 4 + cblk) * 32768 + ((wid * 4 + q) * 64 + lane) * 16));
}
struct LruW { bf16x8 fa[8], fx[8]; };
DI void lru_wload(const Ctx& p, int dir, int cblk, int wid, int lane, LruW& w, int which = 3) {
    const int l31 = lane & 31, hh = lane >> 5, bl = wid >> 2, jq = wid & 3, blkg = cblk * 2 + bl;
    const u16* wa = (const u16*)(p.ws + WS_WA) + ((size_t)(dir * 8 + blkg) * 128 + jq * 32 + l31) * 128 + hh * 8;
    const u16* wx = (const u16*)(p.ws + WS_WX) + ((size_t)(dir * 8 + blkg) * 128 + jq * 32 + l31) * 128 + hh * 8;
    if (which & 1) {
#pragma unroll
        for (int ks = 0; ks < 8; ++ks) w.fa[ks] = *(const bf16x8*)(wa + ks * 16);
    }
    if (which & 2) {
#pragma unroll
        for (int ks = 0; ks < 8; ++ks) w.fx[ks] = *(const bf16x8*)(wx + ks * 16);
    }
    __builtin_amdgcn_sched_barrier(0);
}
template <class Hook, class Hook2>
DI void lru_gates(const Ctx& p, const uchar* lds, int dir, int cblk, int wid, int lane, const LruW& w, float (&a)[2][16], float (&b)[2][16], unsigned* bsave, Hook&& hook, Hook2&& hook2) {
    const int l31 = lane & 31, hh = lane >> 5, bl = wid >> 2, jq = wid & 3;
    const int chl = bl * 128 + jq * 32 + l31;
    const int ch = cblk * 256 + chl;
    const uchar* uc = lds + LRU_UC + dir * UC_DIR + bl * UC_BLK;
    f32x16 dr[2], di[2];
#pragma unroll
    for (int rb = 0; rb < 2; ++rb)
#pragma unroll
        for (int i = 0; i < 16; ++i) { dr[rb][i] = 0.f; di[rb][i] = 0.f; }
    const int tk = lru_perm(l31);
#pragma unroll
    for (int ks = 0; ks < 8; ++ks) {
#pragma unroll
        for (int rb = 0; rb < 2; ++rb) dr[rb] = MFMA32(*(const bf16x8*)(uc + (rb * 32 + tk) * UROW + ks * 32 + hh * 16), w.fa[ks], dr[rb]);
    }
#pragma unroll
    for (int ks = 0; ks < 8; ++ks) {
#pragma unroll
        for (int rb = 0; rb < 2; ++rb) di[rb] = MFMA32(*(const bf16x8*)(uc + (rb * 32 + tk) * UROW + ks * 32 + hh * 16), w.fx[ks], di[rb]);
    }
    __builtin_amdgcn_sched_barrier(0);
    hook();
    const float nl2 = -1.4426950408889634f;
    const float kba = inp(p, I_ODBA)[dir * 1024 + ch] * nl2, kbx = inp(p, I_ODBX)[dir * 1024 + ch] * nl2;
    const float sp8 = 8.0f * log1pf(__expf(-inp(p, I_ODLAM)[dir * 1024 + ch]));
    const float c1 = sp8 * nl2;
    const int cofs = (jq * 32 + l31) * 2;
#pragma unroll
    for (int rb = 0; rb < 2; ++rb)
#pragma unroll
        for (int i = 0; i < 16; ++i) {
            const int token = rb * 32 + hh * 16 + i;
            const float r = frcp(1.0f + __builtin_amdgcn_exp2f(__builtin_fmaf(dr[rb][i], nl2, kba)));
            const float av = __builtin_amdgcn_exp2f(c1 * r);
            a[rb][i] = av;
            const float om = __builtin_fmaf(-av, av, 1.0f);
            const float ucv = b2f(*(const u16*)(uc + token * UROW + cofs));
            const float ig = frcp(1.0f + __builtin_amdgcn_exp2f(__builtin_fmaf(di[rb][i], nl2, kbx)));
            b[rb][i] = __builtin_amdgcn_sqrtf(om) * (ig * ucv);
        }
    __builtin_amdgcn_sched_barrier(0);
    hook2();
    if (bsave) {
#pragma unroll
        for (int q = 0; q < 4; ++q) {
            u32x4 v;
#pragma unroll
            for (int e = 0; e < 4; ++e) { const int j = q * 4 + e, rb = j >> 3, i = (j & 7) * 2; v[e] = pk2(b[rb][i], b[rb][i + 1]); }
            ((u32x4*)bsave)[q * 64 + lane] = v;
        }
    }
}
constexpr int LRU_U2 = 106496;
DI void lru_seq(int c, int& s0, int& s1) { if (c < 256) { s0 = (c >> 7) * SEQ; s1 = s0 + SEQ; } else { s0 = NL + ((c - 256) >> 2) * CTXL; s1 = s0 + CTXL; } }
DI void lru_dma(const Ctx& p, uchar* lds, int c, int cblk, int buf) {
    const int tid = tid_opaque(), lane = tid & 63, wid = tid >> 6;
    const u16* ub = (const u16*)(p.ws + WS_REGA + RA_U);
    int s0, s1; lru_seq(c, s0, s1);
    const int w0 = __builtin_amdgcn_readfirstlane(wid);
    uchar* dst = lds + (buf ? LRU_U2 : LRU_U);
#pragma unroll
    for (int k = 0; k < 5; ++k) {
        const int i = w0 + 8 * k;
        if (i < 35) {
            int row = c * 64 - 3 + 2 * i + (lane >> 5);
            row = row < s0 ? s0 : (row >= s1 ? s1 - 1 : row);
            __builtin_amdgcn_global_load_lds((const unsigned*)(ub + (size_t)row * 1024 + cblk * 256 + (lane & 31) * 8), (LAS unsigned*)(dst + i * 1024), 16, 0, 0);
        }
    }
}
DI void lru_conv(const Ctx& p, uchar* lds, int c, int cblk, int buf, bool counted = false) {
    const int tid = tid_opaque();
    const int row0 = c * 64;
    int s0, s1; lru_seq(c, s0, s1);
    const uchar* ut = lds + (buf ? LRU_U2 : LRU_U);
    if (counted) WAIT_V(8); else WAIT_V(0);
    __syncthreads();
    const int c8 = tid & 31, tq = tid >> 5, t0 = tq * 4;
    float uv[10][8];
#pragma unroll
    for (int rr = 0; rr < 10; ++rr) {
        u32x4 v = *(const u32x4*)(ut + (t0 + rr) * 512 + c8 * 16);
        const int row = row0 - 3 + t0 + rr;
        if (row < s0 || row >= s1) v = (u32x4){0u, 0u, 0u, 0u};
        uv[rr][0] = blo(v.x); uv[rr][1] = bhi(v.x); uv[rr][2] = blo(v.y); uv[rr][3] = bhi(v.y); uv[rr][4] = blo(v.z); uv[rr][5] = bhi(v.z); uv[rr][6] = blo(v.w); uv[rr][7] = bhi(v.w);
    }
#pragma unroll
    for (int dir = 0; dir < 2; ++dir) {
        const float* cw = inp(p, I_ODCW) + dir * 4096 + cblk * 256 + c8 * 8;
        const float* cb = inp(p, I_ODCB) + dir * 1024 + cblk * 256 + c8 * 8;
        float w[4][8], bs[8];
#pragma unroll
        for (int k = 0; k < 4; ++k) { const f32x4 x0 = *(const f32x4*)(cw + k * 1024), x1 = *(const f32x4*)(cw + k * 1024 + 4); w[k][0] = x0[0]; w[k][1] = x0[1]; w[k][2] = x0[2]; w[k][3] = x0[3]; w[k][4] = x1[0]; w[k][5] = x1[1]; w[k][6] = x1[2]; w[k][7] = x1[3]; }
        { const f32x4 x0 = *(const f32x4*)cb, x1 = *(const f32x4*)(cb + 4); bs[0] = x0[0]; bs[1] = x0[1]; bs[2] = x0[2]; bs[3] = x0[3]; bs[4] = x1[0]; bs[5] = x1[1]; bs[6] = x1[2]; bs[7] = x1[3]; }
#pragma unroll
        for (int tt = 0; tt < 4; ++tt) {
            float o[8];
#pragma unroll
            for (int e = 0; e < 8; ++e) {
                float s = bs[e];
#pragma unroll
                for (int k = 0; k < 4; ++k) s += w[k][e] * uv[tt + k + (dir ? 3 : 0)][e];
                o[e] = s;
            }
            const int t = t0 + tt;
            u32x4 wv; wv.x = pk2(o[0], o[1]); wv.y = pk2(o[2], o[3]); wv.z = pk2(o[4], o[5]); wv.w = pk2(o[6], o[7]);
            *(u32x4*)(lds + LRU_UC + dir * UC_DIR + (c8 >> 4) * UC_BLK + t * UROW + (c8 & 15) * 16) = wv;
        }
    }
    __syncthreads();
}
DI void lru_seg(const float (&a)[2][16], const float (&b)[2][16], int dir, int hh, float (&SA)[4], float (&SB)[4]) {
    float oa[2], ob[2];
#pragma unroll
    for (int rb = 0; rb < 2; ++rb) {
        float A = 1.f, B = 0.f;
#pragma unroll
        for (int ii = 0; ii < 16; ++ii) { const int i = dir ? 15 - ii : ii; B = a[rb][i] * B + b[rb][i]; A *= a[rb][i]; }
        oa[rb] = A; ob[rb] = B;
    }
    float pa[2], pb[2];
#pragma unroll
    for (int rb = 0; rb < 2; ++rb) { pa[rb] = __shfl_xor(oa[rb], 32); pb[rb] = __shfl_xor(ob[rb], 32); }
#pragma unroll
    for (int rb = 0; rb < 2; ++rb)
#pragma unroll
        for (int h = 0; h < 2; ++h) {
            const float A = (h == hh) ? oa[rb] : pa[rb], B = (h == hh) ? ob[rb] : pb[rb];
            const int s = dir ? 3 - (rb * 2 + h) : rb * 2 + h;
            SA[s] = A; SB[s] = B;
        }
}
DI void lru_summ_item(int j, int& c, int& cblk, int& role) {
    if (j < 1024) { c = j >> 2; cblk = j & 3; role = -1; } else { const int mini = j - 1024, cu = mini >> 3; c = 256 + (cu >> 2); cblk = cu & 3; role = mini & 7; }
}
template <class F>
DI void lru_summ_wave(const Ctx& p, uchar* lds, int c, int cblk, int role, LruW& w, F&& next_dma) {
    const int tid = tid_opaque(), lane = tid & 63, wid = role < 0 ? (tid >> 6) : role, hh = lane >> 5;
    f32x2* summ = (f32x2*)(p.ws + WS_SUMM);
    const int ch = cblk * 256 + (wid >> 2) * 128 + (wid & 3) * 32 + (lane & 31);
#pragma unroll
    for (int dir = 0; dir < 2; ++dir) {
        float a[2][16], b[2][16];
        unsigned* bs = c < 256 ? lru_bsave(p, dir, c, cblk, wid) : (unsigned*)nullptr;
        if (dir == 0) lru_gates(p, lds, 0, cblk, wid, lane, w, a, b, bs, [&]() { lru_wload(p, 1, cblk, wid, lane, w, 1); }, [&]() { lru_wload(p, 1, cblk, wid, lane, w, 2); });
        else          lru_gates(p, lds, 1, cblk, wid, lane, w, a, b, bs, [&]() { next_dma(); lru_wload(p, 0, cblk, wid, lane, w, 1); }, [&]() { lru_wload(p, 0, cblk, wid, lane, w, 2); });
        if (c < 256) {
#pragma unroll
            for (int q = 0; q < 4; ++q) {
                u32x4 v;
#pragma unroll
                for (int e = 0; e < 4; ++e) { const int j = q * 4 + e, rb = j >> 3, i = (j & 7) * 2; v[e] = pk2(1.0f - a[rb][i], 1.0f - a[rb][i + 1]); }
                *lru_osave(p, dir, c, cblk, wid, q, lane) = v;
            }
        }
        float SA[4], SB[4];
        lru_seg(a, b, dir, hh, SA, SB);
        float A = 1.f, B = 0.f;
#pragma unroll
        for (int s = 0; s < 4; ++s) { B = SA[s] * B + SB[s]; A *= SA[s]; }
        if (hh == 0) summ[((size_t)dir * 264 + c) * 1024 + ch] = (f32x2){A, B};
    }
}
DI void phase_lru_summ(const Ctx& p, uchar* lds) {
    const int tid = tid_opaque(), lane = tid & 63, wid = tid >> 6;
    constexpr int NITEM = 1024 + 32 * 8;
    int c, cblk, role;
    if ((int)blockIdx.x >= NITEM) return;
    lru_summ_item(blockIdx.x, c, cblk, role); lru_dma(p, lds, c, cblk, 0);
    LruW w;
    lru_wload(p, 0, cblk, role < 0 ? wid : role, lane, w);
    int buf = 0;
    bool counted = false;
    for (int j = blockIdx.x; j < NITEM; j += gridDim.x, buf ^= 1) {
        lru_summ_item(j, c, cblk, role);
        lru_conv(p, lds, c, cblk, buf, counted);
        counted = role < 0;
        int c2 = 0, cblk2 = 0, role2 = -1;
        const bool more = j + (int)gridDim.x < NITEM;
        if (more) lru_summ_item(j + gridDim.x, c2, cblk2, role2);
        auto next_dma = [&]() { if (more) lru_dma(p, lds, c2, cblk2, buf ^ 1); };
        if (role < 0) {
            lru_summ_wave(p, lds, c, cblk, -1, w, next_dma);
            if (more && role2 >= 0) lru_wload(p, 0, cblk2, role2, lane, w);
        } else {
            if (wid == 0) lru_summ_wave(p, lds, c, cblk, role, w, next_dma); else next_dma();
            if (more && (cblk2 != cblk || role2 != role)) lru_wload(p, 0, cblk2, role2, lane, w);
        }
    }
    WAIT_V(0);
}
DI void phase_lru_carry(const Ctx& p) {
    const int tid = tid_opaque();
    const f32x2* summ = (const f32x2*)(p.ws + WS_SUMM);
    float* carry = (float*)(p.ws + WS_CARRY);
    for (int g = blockIdx.x * 512 + tid; g < 4096; g += gridDim.x * 512) {
        const int ch = g & 1023, bt = (g >> 10) & 1, dir = g >> 11;
        const f32x2* sd = summ + (size_t)dir * 264 * 1024 + ch;
        float h = 0.f;
        f32x2 s[4];
#pragma unroll
        for (int q = 0; q < 4; ++q) s[q] = sd[(size_t)(256 + bt * 4 + (dir ? 3 - q : q)) * 1024];
#pragma unroll
        for (int q = 0; q < 4; ++q) h = s[q].x * h + s[q].y;
        f32x2 ta[16], tb[16];
#pragma unroll
        for (int q = 0; q < 16; ++q) { const int ci = dir ? 127 - q : q; ta[q] = sd[(size_t)(bt * 128 + ci) * 1024]; }
#pragma unroll 1
        for (int q0 = 0; q0 < 128; q0 += 32) {
#pragma unroll
            for (int q = 0; q < 16; ++q) { const int ci = dir ? 127 - (q0 + 16 + q) : q0 + 16 + q; tb[q] = sd[(size_t)(bt * 128 + ci) * 1024]; }
#pragma unroll
            for (int q = 0; q < 16; ++q) { const int ci = dir ? 127 - (q0 + q) : q0 + q; carry[((size_t)dir * 256 + bt * 128 + ci) * 1024 + ch] = h; h = ta[q].x * h + ta[q].y; }
            if (q0 + 32 < 128) {
#pragma unroll
                for (int q = 0; q < 16; ++q) { const int ci = dir ? 127 - (q0 + 32 + q) : q0 + 32 + q; ta[q] = sd[(size_t)(bt * 128 + ci) * 1024]; }
            }
#pragma unroll
            for (int q = 0; q < 16; ++q) { const int ci = dir ? 127 - (q0 + 16 + q) : q0 + 16 + q; carry[((size_t)dir * 256 + bt * 128 + ci) * 1024 + ch] = h; h = tb[q].x * h + tb[q].y; }
        }
    }
}
DI void phase_lru_scan(const Ctx& p, uchar* lds) {
    const int tid = tid_opaque(), lane = tid & 63, wid = tid >> 6, hh = lane >> 5;
    const u16* yb = (const u16*)(p.ws + WS_REGA + RA_Y);
    u16* hb = (u16*)(p.ws + WS_HB);
    for (int u = blockIdx.x; u < 256 * 4; u += gridDim.x) {
        const int c = u >> 2, cblk = u & 3;
        const int ch = cblk * 256 + (wid >> 2) * 128 + (wid & 3) * 32 + (lane & 31);
        float hsum[2][16];
        __syncthreads();
#pragma unroll
        for (int dir = 0; dir < 2; ++dir) {
            const float h0 = ((const float*)(p.ws + WS_CARRY))[((size_t)dir * 256 + c) * 1024 + ch];
            float a[2][16], b[2][16];
            {
                const unsigned* bs = lru_bsave(p, dir, c, cblk, wid);
                unsigned bw[16], ow[16];
#pragma unroll
                for (int q = 0; q < 4; ++q) {
                    const u32x4 vb = ((const u32x4*)bs)[q * 64 + lane], vo = *lru_osave(p, dir, c, cblk, wid, q, lane);
#pragma unroll
                    for (int e = 0; e < 4; ++e) { bw[q * 4 + e] = vb[e]; ow[q * 4 + e] = vo[e]; }
                }
#pragma unroll
                for (int rb = 0; rb < 2; ++rb)
#pragma unroll
                    for (int i = 0; i < 16; ++i) {
                        const unsigned wb = bw[rb * 8 + (i >> 1)], wo = ow[rb * 8 + (i >> 1)];
                        b[rb][i] = (i & 1) ? bhi(wb) : blo(wb);
                        a[rb][i] = 1.0f - ((i & 1) ? bhi(wo) : blo(wo));
                    }
            }
            float SA[4], SB[4];
            lru_seg(a, b, dir, hh, SA, SB);
            float st[4]; st[0] = h0;
#pragma unroll
            for (int s = 1; s < 4; ++s) st[s] = SA[s - 1] * st[s - 1] + SB[s - 1];
#pragma unroll
            for (int rb = 0; rb < 2; ++rb) {
                const int sidx = dir ? 3 - (rb * 2 + hh) : rb * 2 + hh;
                float h = sidx == 0 ? st[0] : (sidx == 1 ? st[1] : (sidx == 2 ? st[2] : st[3]));
#pragma unroll
                for (int ii = 0; ii < 16; ++ii) { const int i = dir ? 15 - ii : ii; h = a[rb][i] * h + b[rb][i]; if (dir == 0) hsum[rb][i] = h; else hsum[rb][i] += h; }
            }
        }
        __syncthreads();
        {
            const int chl = (wid >> 2) * 128 + (wid & 3) * 32 + (lane & 31);
#pragma unroll
            for (int rb = 0; rb < 2; ++rb)
#pragma unroll
                for (int i = 0; i < 16; ++i) *(float*)(lds + (rb * 32 + hh * 16 + i) * 1040 + chl * 4) = hsum[rb][i];
        }
        __syncthreads();
        u32x4 yv[4];
#pragma unroll
        for (int j = 0; j < 4; ++j) { const int pi = j * 512 + tid, tk = pi >> 5, c8 = pi & 31; yv[j] = *(const u32x4*)(yb + (size_t)(c * 64 + tk) * 1024 + cblk * 256 + c8 * 8); }
#pragma unroll
        for (int j = 0; j < 4; ++j) {
            const int pi = j * 512 + tid, tk = pi >> 5, c8 = pi & 31;
            const f32x4 h0 = *(const f32x4*)(lds + tk * 1040 + c8 * 32), h1 = *(const f32x4*)(lds + tk * 1040 + c8 * 32 + 16);
            const size_t o = (size_t)(c * 64 + tk) * 1024 + cblk * 256 + c8 * 8;
            u32x4 w;
            w.x = pk2(blo(yv[j].x) * h0[0], bhi(yv[j].x) * h0[1]); w.y = pk2(blo(yv[j].y) * h0[2], bhi(yv[j].y) * h0[3]);
            w.z = pk2(blo(yv[j].z) * h1[0], bhi(yv[j].z) * h1[1]); w.w = pk2(blo(yv[j].w) * h1[2], bhi(yv[j].w) * h1[3]);
            *(u32x4*)(hb + o) = w;
        }
    }
}

__global__ void __launch_bounds__(512) fwd_mega(const Params P) {
    uchar* lds = smem + LDS_USER;
    LAS unsigned long long* tab = (LAS unsigned long long*)(smem + 64);
    if (threadIdx.x < N_IN) tab[threadIdx.x] = (unsigned long long)P.in[threadIdx.x];
    if ((threadIdx.x & 63) == 0) ((volatile LAS int*)smem)[96 + hw_slot()] = threadIdx.x >> 6;
    const bool multi = (P.ph_hi - P.ph_lo) > 1;
    if (threadIdx.x == 0) { ((volatile LAS unsigned*)smem)[0] = 0u; ((volatile LAS unsigned*)smem)[1] = 0u; ((volatile LAS unsigned*)smem)[2] = 0u; ((volatile LAS unsigned*)smem)[3] = 0u; }
    __syncthreads();
    if (multi) (void)xcd_barrier_post((unsigned*)(P.ws + WS_CTL), (volatile LAS unsigned*)smem);
#define RUN_PHASE(k, call) if (P.ph_lo <= (k) && (k) < P.ph_hi) { { Ctx p; { unsigned long long wsi = (unsigned long long)P.ws; asm volatile("" : "+s"(wsi)); p.ws = (uchar*)(__attribute__((address_space(1))) uchar*)wsi; } p.out = P.out; p.tab = tab; call; } if ((PROBE_REPS >> (k)) & 1) { { XcdBarrier xb_; xb_.bar = (unsigned*)(P.ws + WS_CTL); xb_.x = xb_xcc_id(); xb_.st = (volatile LAS unsigned*)smem; xcd_barrier(xb_); } Ctx p; { unsigned long long wsi = (unsigned long long)P.ws; asm volatile("" : "+s"(wsi)); p.ws = (uchar*)(__attribute__((address_space(1))) uchar*)wsi; } p.out = P.out; p.tab = tab; call; } if (multi && (k) + 1 < P.ph_hi) { XcdBarrier xb_; xb_.bar = (unsigned*)(P.ws + WS_CTL); xb_.x = xb_xcc_id(); xb_.st = (volatile LAS unsigned*)smem; xcd_barrier(xb_); } }
    RUN_PHASE(0, phase_prep(P, p, lds))
    RUN_PHASE(1, phase_norm(p, 0))
    RUN_PHASE(2, phase_inproj0(P, p, lds))
    RUN_PHASE(3, phase_attn(p, lds))
    RUN_PHASE(4, phase_outproj(P, p, lds, 0))
    RUN_PHASE(5, phase_router(p, lds, 0))
#if PROBE_ROUTER2X
    if (P.ph_lo <= 5 && 5 < P.ph_hi) { Ctx p; { unsigned long long wsi = (unsigned long long)P.ws; asm volatile("" : "+s"(wsi)); p.ws = (uchar*)(__attribute__((address_space(1))) uchar*)wsi; } p.out = P.out; p.tab = tab; phase_router(p, lds, 0, 2); { XcdBarrier xb_; xb_.bar = (unsigned*)(P.ws + WS_CTL); xb_.x = xb_xcc_id(); xb_.st = (volatile LAS unsigned*)smem; xcd_barrier(xb_); } }
#endif
    RUN_PHASE(6, phase_moe_up(P, p, lds, 0))
    RUN_PHASE(7, phase_moe_down(P, p, lds, 0))
    RUN_PHASE(8, phase_norm(p, 1))
    RUN_PHASE(9, phase_inproj1(P, p, lds))
    RUN_PHASE(10, phase_lru_summ(p, lds))
    RUN_PHASE(11, phase_lru_carry(p))
    RUN_PHASE(12, phase_lru_scan(p, lds))
    RUN_PHASE(13, phase_outproj(P, p, lds, 1))
    RUN_PHASE(14, phase_router(p, lds, 1))
    RUN_PHASE(15, phase_moe_up(P, p, lds, 1))
    RUN_PHASE(16, phase_moe_down(P, p, lds, 1))
}

extern "C" void kernel_launch(void* const* d_in, const int* in_sizes, int n_in, void* d_out, int out_size, void* d_ws, size_t ws_size, hipStream_t stream) {
    static int grid = 0;
    if (grid == 0) {
        if (n_in != N_IN || out_size != NL * D || ws_size < WS_END) { fprintf(stderr, "kernel_launch: unexpected shapes (n_in %d, out %d, ws %zu, need %zu)\n", n_in, out_size, ws_size, (size_t)WS_END); grid = -1; return; }
        int dev = 0, cus = 0, per_cu = 0;
        if (hipGetDevice(&dev) != hipSuccess || hipDeviceGetAttribute(&cus, hipDeviceAttributeMultiprocessorCount, dev) != hipSuccess) { grid = -1; return; }
        if (hipFuncSetAttribute((const void*)fwd_mega, hipFuncAttributeMaxDynamicSharedMemorySize, LDS_BYTES) != hipSuccess) { fprintf(stderr, "kernel_launch: hipFuncSetAttribute failed\n"); grid = -1; return; }
        if (hipOccupancyMaxActiveBlocksPerMultiprocessor(&per_cu, (const void*)fwd_mega, 512, LDS_BYTES) != hipSuccess || per_cu < 1) { fprintf(stderr, "kernel_launch: occupancy query says %d\n", per_cu); (void)hipGetLastError(); grid = -1; return; }
        grid = cus;
    }
    if (grid < 0) return;
    if (hipMemsetAsync((char*)d_ws + WS_CTL, 0, CTL_BYTES, stream) != hipSuccess) return;
    Params p{};
    for (int i = 0; i < N_IN; ++i) p.in[i] = (const float*)d_in[i];
    p.out = (float*)d_out; p.ws = (uchar*)d_ws;
    uchar* ws = (uchar*)d_ws;
    int t0 = 0;
    auto job = [&](int j, const float* src, size_t dst_off, int nmat, int K, int N, int sstride, int dstride, int lddst, int mode, int half) {
        CvtJob& J = p.jobs[j]; J.src = src; J.dst = (u16*)(ws + dst_off); J.nmat = nmat; J.K = K; J.N = N; J.sstride = sstride; J.dstride = dstride; J.lddst = lddst; J.mode = mode; J.half = half; J.tile0 = t0; J.pad = 0;
        t0 += nmat * (K / 64) * (N / 64);
    };
    job(0, p.in[I_EVWIN], WS_WIN0, 1, 1024, 3072, 0, 0, 1024, 0, 0);
    job(1, p.in[I_EVWOUT], WS_WOUT0, 1, 1024, 1024, 0, 0, 1024, 0, 0);
    job(2, p.in[I_ODWIN], WS_WIN1, 1, 1024, 2048, 0, 0, 1024, 0, 0);
    job(3, p.in[I_ODWOUT], WS_WOUT1, 1, 1024, 1024, 0, 0, 1024, 0, 0);
    job(4, p.in[I_ODWA], WS_WA, 16, 128, 128, 16384, 16384, 128, 0, 0);
    job(5, p.in[I_ODWX], WS_WX, 16, 128, 128, 16384, 16384, 128, 0, 0);
    job(6, p.in[I_MGATE], WS_WGU, 32, 1024, 512, 524288, 1048576, 1024, 1, 0);
    job(7, p.in[I_MUP], WS_WGU, 32, 1024, 512, 524288, 1048576, 1024, 1, 1);
    job(8, p.in[I_MDOWN], WS_WD, 32, 512, 1024, 524288, 524288, 512, 0, 0);
    p.ncvt = t0;
    const int nl = N_LAUNCHES;
    for (int li = 0; li < nl; ++li) {
        p.ph_lo = li * NPH / nl; p.ph_hi = (li + 1) * NPH / nl;
        hipLaunchKernelGGL(fwd_mega, dim3(grid), dim3(512), LDS_BYTES, stream, p);
    }
}
```

```cpp
#include <hip/hip_runtime.h>
#include <stdint.h>
#include <stdio.h>

#define DI __device__ __forceinline__
#define LAS __attribute__((address_space(3)))
typedef unsigned short u16;
typedef unsigned char uchar;
typedef short bf16x8 __attribute__((ext_vector_type(8)));
typedef float f32x16 __attribute__((ext_vector_type(16)));
typedef float f32x4 __attribute__((ext_vector_type(4)));
typedef float f32x2 __attribute__((ext_vector_type(2)));
typedef __bf16 bf2_t __attribute__((ext_vector_type(2)));
typedef unsigned u32x2 __attribute__((ext_vector_type(2)));
typedef unsigned u32x4 __attribute__((ext_vector_type(4)));

#ifndef N_LAUNCHES
#define N_LAUNCHES 1
#endif
#ifndef PROBE_GEMM2X
#define PROBE_GEMM2X 0
#endif
#ifndef PROBE_ROUTER2X
#define PROBE_ROUTER2X 0
#endif
#ifndef PROBE_REPS
#define PROBE_REPS 0x0000
#endif

DI unsigned pk2(float a, float b) { f32x2 v = {a, b}; bf2_t r = __builtin_convertvector(v, bf2_t); return __builtin_bit_cast(unsigned, r); }
DI u16 f2b(float a) { __bf16 r = (__bf16)a; return __builtin_bit_cast(u16, r); }
DI float b2f(u16 v) { return __uint_as_float(((unsigned)v) << 16); }
DI float blo(unsigned v) { return __uint_as_float(v << 16); }
DI float bhi(unsigned v) { return __uint_as_float(v & 0xffff0000u); }
#define MFMA32(a, b, c) __builtin_amdgcn_mfma_f32_32x32x16_bf16((a), (b), (c), 0, 0, 0)

constexpr int D = 1024, NL = 16384, NC = 512, R = 16896, SEQ = 8192, CTXL = 256, SK = 8448;
constexpr int NPH = 17;
constexpr float EPS = 1e-6f;
constexpr float LAM_INIT0 = 0.2f;
constexpr float QSCALE = 0.125f * 1.4426950408889634f;

enum { I_X = 0, I_C, I_CTX, I_CCTX, I_ADAW, I_ADAB, I_NMIX, I_NFFN, I_EVWIN, I_EVCW, I_EVCB, I_QN, I_KN, I_LQ1, I_LK1, I_LQ2, I_LK2, I_SUBN, I_EVWOUT,
       I_ODWIN, I_ODCW, I_ODCB, I_ODWA, I_ODBA, I_ODWX, I_ODBX, I_ODLAM, I_ODWOUT, I_MWGRP, I_MBGRP, I_MWRT, I_MBRT, I_MGATE, I_MUP, I_MDOWN, N_IN };

constexpr size_t al256(size_t x) { return (x + 255) & ~(size_t)255; }
constexpr size_t WS_CTL   = 0;
constexpr size_t CTL_BYTES = 65536;
constexpr size_t CTL_CTXF = 32768;
constexpr size_t CTL_CNT  = 16384;
constexpr size_t WS_MOD   = WS_CTL + CTL_BYTES;
constexpr size_t WS_ROPE  = WS_MOD + al256(2 * 3 * 6144 * 4);
constexpr size_t WS_ROUTE = WS_ROPE + (size_t)SEQ * 32 * 8;
constexpr size_t WS_LIST  = WS_ROUTE + al256((size_t)R * 8);
constexpr size_t WS_SUMM  = WS_LIST + al256((size_t)24 * R * 4);
constexpr size_t WS_CARRY = WS_SUMM + (size_t)2 * 264 * 1024 * 8;
constexpr size_t WS_WIN0  = WS_CARRY + (size_t)2 * 256 * 1024 * 4;
constexpr size_t WS_WOUT0 = WS_WIN0 + (size_t)3072 * 1024 * 2;
constexpr size_t WS_WIN1  = WS_WOUT0 + (size_t)1024 * 1024 * 2;
constexpr size_t WS_WOUT1 = WS_WIN1 + (size_t)2048 * 1024 * 2;
constexpr size_t WS_WA    = WS_WOUT1 + (size_t)1024 * 1024 * 2;
constexpr size_t WS_WX    = WS_WA + (size_t)2 * 8 * 128 * 128 * 2;
constexpr size_t WS_WGU   = WS_WX + (size_t)2 * 8 * 128 * 128 * 2;
constexpr size_t WS_WD    = WS_WGU + (size_t)2 * 16 * 1024 * 1024 * 2;
constexpr size_t WS_XS    = WS_WD + (size_t)2 * 16 * 1024 * 512 * 2;
constexpr size_t WS_HB    = WS_XS + (size_t)R * 1024 * 4;
constexpr size_t WS_REGA  = WS_HB + (size_t)R * 1024 * 2;
constexpr size_t RA_ZC    = 0;
constexpr size_t RA_Q     = RA_ZC + (size_t)R * 1536 * 2;
constexpr size_t RA_K     = RA_Q + (size_t)16 * SK * 64 * 2;
constexpr size_t RA_VT    = RA_K + (size_t)16 * SK * 64 * 2;
constexpr size_t RA_END0  = RA_VT + (size_t)8 * 128 * SK * 2;
constexpr size_t RA_ACT   = 0;
constexpr size_t RA_Y     = 0;
constexpr size_t RA_U     = RA_Y + (size_t)NL * 1024 * 2;
constexpr size_t RA_BS0   = RA_U + (size_t)R * 1024 * 2;
constexpr size_t WS_OM1B  = WS_REGA + RA_END0;
constexpr size_t WS_END   = WS_OM1B + (size_t)128 * 4 * 32768;
static_assert(RA_BS0 + (size_t)256 * 4 * 8 * 1024 * 4 <= RA_END0 && (size_t)20480 * 1024 * 2 <= RA_END0, "region A overlays");
static_assert((size_t)256 * 4 * 8 * 1024 * 4 <= (size_t)16 * 1024 * 1024 * 2, "b of direction 1 fits layer 0's gate/up weights");
static_assert(WS_END <= 352000000ull, "workspace budget");

constexpr int LDS_BYTES = 147456 + 1024 + 1024;
constexpr int LDS_USER = 1024;

struct CvtJob { const float* src; u16* dst; int nmat, K, N, sstride, dstride, lddst, mode, half, tile0, pad; };
struct Params {
    const float* in[N_IN];
    float* out;
    uchar* ws;
    CvtJob jobs[9];
    int ncvt, ph_lo, ph_hi, pad;
};
struct Ctx { uchar* ws; float* out; const LAS unsigned long long* tab; };
typedef const __attribute__((address_space(1))) float* gcf_t;
DI const float* inp(const Ctx& c, int i) { return (const float*)(gcf_t)c.tab[i]; }

extern __shared__ __attribute__((aligned(16))) uchar smem[];
DI int hw_slot() { return (int)(__builtin_amdgcn_s_getreg(((6 - 1) << 11) | 4) & 63u); }
DI int tid_opaque() {
    const int lane = (int)__builtin_amdgcn_mbcnt_hi(~0u, __builtin_amdgcn_mbcnt_lo(~0u, 0u));
    int w = ((volatile LAS int*)smem)[96 + hw_slot()];
    w = __builtin_amdgcn_readfirstlane(w);
    int t = w * 64 + lane; asm volatile("" : "+v"(t)); return t;
}
#define XB_TMO      128
#define XB_XCNT(j)  (256  + 64 * (j))
#define XB_XSUB(j)  (1280 + 64 * (j))
#define XB_XGEN(j)  (2304 + 64 * (j))
#define XB_TOP      3328
#define XB_TOPGEN   3392
#define XCD_BAR_WORDS 3456
#define XB_SPIN_CAP (1u << 20)
DI unsigned xb_ld(unsigned* p)              { return __hip_atomic_load(p, __ATOMIC_RELAXED, __HIP_MEMORY_SCOPE_AGENT); }
DI unsigned xb_add(unsigned* p, unsigned v) { return __hip_atomic_fetch_add(p, v, __ATOMIC_RELAXED, __HIP_MEMORY_SCOPE_AGENT); }
DI unsigned xb_xcc_id() { return (unsigned)__builtin_amdgcn_s_getreg((3 << 11) | 20) & 0xFu; }
#define XB_SPIN(cond, bar) do { unsigned _sp = 0; while (cond) { __builtin_amdgcn_s_sleep(1); \
    if ((++_sp & 255u) == 0u) { if (xb_ld(&(bar)[XB_TMO])) break; if (_sp > XB_SPIN_CAP) { atomicAdd(&(bar)[XB_TMO], 1u); break; } } } } while (0)
struct XcdBarrier { unsigned* bar; unsigned x; volatile LAS unsigned* st; };
DI XcdBarrier xcd_barrier_post(unsigned* bar, volatile LAS unsigned* st) {
    XcdBarrier b; b.bar = bar; b.x = xb_xcc_id(); b.st = st;
    if (tid_opaque() == 0) (void)xb_add(&bar[XB_XCNT(b.x)], 1u);
    return b;
}
DI void xcd_barrier_complete(unsigned* bar, unsigned x, unsigned& nloc, unsigned& nx) {
    const unsigned G = gridDim.x * gridDim.y * gridDim.z;
    unsigned sum, cnt, mine, sp = 0u;
    for (;;) {
        sum = 0u; cnt = 0u; mine = 0u;
#pragma unroll
        for (unsigned j = 0; j < 16; ++j) { const unsigned c = xb_ld(&bar[XB_XCNT(j)]); sum += c; cnt += (c > 0u) ? 1u : 0u; mine = (j == x) ? c : mine; }
        if (sum == G) break;
        __builtin_amdgcn_s_sleep(1);
        if ((++sp & 255u) == 0u) { if (xb_ld(&bar[XB_TMO])) break; if (sp > XB_SPIN_CAP) { atomicAdd(&bar[XB_TMO], 1u); break; } }
    }
    nloc = mine > 0u ? mine : 1u; nx = cnt > 0u ? cnt : 1u;
}
DI void xcd_barrier(const XcdBarrier& b) {
    asm volatile("s_waitcnt vmcnt(0)" ::: "memory");
    __syncthreads();
    if (tid_opaque() == 0) {
        unsigned* bar = b.bar;
        __builtin_amdgcn_s_waitcnt(0);
        unsigned nloc = b.st[0], nx = b.st[1];
        if (nloc == 0u) { xcd_barrier_complete(bar, b.x, nloc, nx); b.st[0] = nloc; b.st[1] = nx; }
        const unsigned old = xb_add(&bar[XB_XSUB(b.x)], 1u);
        const unsigned gen = old / nloc;
        if (old + 1u == (gen + 1u) * nloc) {
            __builtin_amdgcn_fence(__ATOMIC_RELEASE, "agent");
            asm volatile("s_waitcnt vmcnt(0)" ::: "memory");
            const unsigned og = xb_add(&bar[XB_TOP], 1u);
            const unsigned tg = og / nx;
            if (og + 1u == (tg + 1u) * nx) xb_add(&bar[XB_TOPGEN], 1u);
            else XB_SPIN(xb_ld(&bar[XB_TOPGEN]) == tg, bar);
            __builtin_amdgcn_fence(__ATOMIC_ACQUIRE, "agent");
            xb_add(&bar[XB_XGEN(b.x)], 1u);
            asm volatile("s_waitcnt vmcnt(0)" ::: "memory");
        } else {
            XB_SPIN(xb_ld(&bar[XB_XGEN(b.x)]) == gen, bar);
            __builtin_amdgcn_fence(__ATOMIC_ACQUIRE, "agent");
            asm volatile("s_waitcnt vmcnt(0)" ::: "memory");
        }
    }
    __syncthreads();
}

DI float xor32_sum(float x) {
    const unsigned u = __float_as_uint(x);
    const auto r = __builtin_amdgcn_permlane32_swap(u, u, false, false);
    return __uint_as_float(r[0]) + __uint_as_float(r[1]);
}
#define DPP_ADD(v, ctrl) ((v) + __uint_as_float((unsigned)__builtin_amdgcn_update_dpp(0, (int)__float_as_uint(v), (ctrl), 0xf, 0xf, true)))
DI float wave_sum(float v) {
    v = DPP_ADD(v, 0xB1);
    v = DPP_ADD(v, 0x4E);
    v = DPP_ADD(v, 0x141);
    v = DPP_ADD(v, 0x140);
    const unsigned u = __float_as_uint(v);
    return (__uint_as_float(__builtin_amdgcn_readlane(u, 0)) + __uint_as_float(__builtin_amdgcn_readlane(u, 16))) +
           (__uint_as_float(__builtin_amdgcn_readlane(u, 32)) + __uint_as_float(__builtin_amdgcn_readlane(u, 48)));
}
DI int crow(int i, int hh) { return (i & 3) + 8 * (i >> 2) + 4 * hh; }
DI int mod_row(int r) { return r < NL ? (r >> 13) : 2; }
DI float frcp(float x) { return __builtin_amdgcn_rcpf(x); }
DI float fexp(float x) { return __builtin_amdgcn_exp2f(x * 1.4426950408889634f); }
DI float sigmoidf_(float x) { return frcp(1.0f + fexp(-x)); }
DI float one_minus_exp(float x) {
    const float s = -x * (1.0f + x * 0.5f * (1.0f + x * (1.0f / 3.0f) * (1.0f + x * 0.25f * (1.0f + x * 0.2f * (1.0f + x * (1.0f / 6.0f))))));
    const float d = 1.0f - fexp(x);
    return x > -0.125f ? s : d;
}

template <class F>
DI void cvt_list(const Params& P, uchar* lds, int i0, int step, int n, F&& job_of) {
    const int tid = tid_opaque();
    float* tl = (float*)lds;
    f32x4 rv[2];
    auto tile_src = [&](int idx, int& j, int& mat, int& kt, int& nt) -> const float* {
        int t; job_of(idx, j, t);
        const int N = P.jobs[j].N, tn = N >> 6, per = (P.jobs[j].K >> 6) * tn; mat = t / per; t -= mat * per; kt = t / tn; nt = t - kt * tn;
        return P.jobs[j].src + (size_t)mat * P.jobs[j].sstride + (size_t)(kt * 64) * N + nt * 64;
    };
    int u = i0, j = 0, mat = 0, kt = 0, nt = 0;
    __syncthreads();
    if (u < n) { const float* src = tile_src(u, j, mat, kt, nt); const int N = P.jobs[j].N;
#pragma unroll
        for (int i = 0; i < 2; ++i) rv[i] = *(const f32x4*)(src + (size_t)((tid >> 4) + 32 * i) * N + (tid & 15) * 4); }
    for (; u < n; u += step) {
#pragma unroll
        for (int i = 0; i < 2; ++i) { float* q = tl + ((tid >> 4) + 32 * i) * 65 + (tid & 15) * 4; q[0] = rv[i][0]; q[1] = rv[i][1]; q[2] = rv[i][2]; q[3] = rv[i][3]; }
        const CvtJob J = P.jobs[j];
        const int cmat = mat, ckt = kt, cnt_ = nt;
        const int un = u + step;
        if (un < n) { const float* src = tile_src(un, j, mat, kt, nt); const int N = P.jobs[j].N;
#pragma unroll
            for (int i = 0; i < 2; ++i) rv[i] = *(const f32x4*)(src + (size_t)((tid >> 4) + 32 * i) * N + (tid & 15) * 4); }
        __syncthreads();
        const int n_ = tid >> 3, kc = tid & 7;
        float v[8];
#pragma unroll
        for (int e = 0; e < 8; ++e) v[e] = tl[(kc * 8 + e) * 65 + n_];
        const int ng = cnt_ * 64 + n_;
        const int drow = J.mode ? ((ng >> 5) * 64 + J.half * 32 + (ng & 31)) : ng;
        u16* d = J.dst + (size_t)cmat * J.dstride + (size_t)drow * J.lddst + ckt * 64 + kc * 8;
        u32x4 w; w.x = pk2(v[0], v[1]); w.y = pk2(v[2], v[3]); w.z = pk2(v[4], v[5]); w.w = pk2(v[6], v[7]);
        *(u32x4*)d = w;
        __syncthreads();
    }
}
constexpr int MOE_CVT_TILES = 6144;
DI void tail_cvt_dense(const Params& P, uchar* lds, int nunits, int lo, int hi) {
    const int G = gridDim.x, rem = nunits % G;
    int rank = blockIdx.x, nidle = G;
    if (rem != 0) { if ((int)blockIdx.x < rem) return; rank = blockIdx.x - rem; nidle = G - rem; }
    cvt_list(P, lds, lo + rank, nidle, hi, [&](int idx, int& j, int& t) {
        j = 0;
#pragma unroll
        for (int q = 1; q < 6; ++q) if (idx >= P.jobs[q].tile0) j = q;
        t = idx - P.jobs[j].tile0; });
}
DI void tail_cvt_moe(const Params& P, uchar* lds, int nunits, int layer, int lo, int hi) {
    const int G = gridDim.x, rem = nunits % G;
    int rank = blockIdx.x, nidle = G;
    if (rem != 0) { if ((int)blockIdx.x < rem) return; rank = blockIdx.x - rem; nidle = G - rem; }
    cvt_list(P, lds, lo + rank, nidle, hi, [&](int idx, int& j, int& t) { j = 6 + (idx >> 11); t = layer * 2048 + (idx & 2047); });
}

DI void phase_prep(const Params& P, const Ctx& p, uchar* lds) {
    const int tid = tid_opaque();
    float* tl = (float*)lds;
    {
        float* sc = tl;
        float* red = tl + 3072;
        for (int u = blockIdx.x; u < 192; u += gridDim.x) {
            __syncthreads();
            for (int i = tid; i < 3072; i += 512) { const int mr = i >> 10, d = i & 1023; const float c = mr < 2 ? inp(p, I_C)[mr * 1024 + d] : inp(p, I_CCTX)[d]; sc[i] = c * sigmoidf_(c); }
            __syncthreads();
            const int l = u / 96, nc = u % 96, c4 = tid & 15, dg = tid >> 4;
            const float* w = inp(p, I_ADAW) + (size_t)l * 1024 * 6144 + nc * 64 + c4 * 4;
            f32x4 a0 = (f32x4){0.f, 0.f, 0.f, 0.f}, a1 = a0, a2 = a0;
#pragma unroll 16
            for (int dd = 0; dd < 32; ++dd) {
                const int d = dg * 32 + dd; const f32x4 wv = *(const f32x4*)(w + (size_t)d * 6144);
                const float s0 = sc[d], s1 = sc[1024 + d], s2 = sc[2048 + d];
#pragma unroll
                for (int e = 0; e < 4; ++e) { a0[e] += s0 * wv[e]; a1[e] += s1 * wv[e]; a2[e] += s2 * wv[e]; }
            }
            *(f32x4*)(red + (dg * 3 + 0) * 64 + c4 * 4) = a0; *(f32x4*)(red + (dg * 3 + 1) * 64 + c4 * 4) = a1; *(f32x4*)(red + (dg * 3 + 2) * 64 + c4 * 4) = a2;
            __syncthreads();
            if (tid < 192) {
                const int mr = tid >> 6, nn = tid & 63; float s = 0.f;
#pragma unroll
                for (int g = 0; g < 32; ++g) s += red[(g * 3 + mr) * 64 + nn];
                const int ncol = nc * 64 + nn;
                ((float*)(p.ws + WS_MOD))[(l * 3 + mr) * 6144 + ncol] = s + inp(p, I_ADAB)[l * 6144 + ncol];
            }
        }
        __syncthreads();
    }
    const int ntile0 = P.jobs[1].tile0;
    const bool split = gridDim.x == 256 && ntile0 == 768;
    const bool has_unit = (int)blockIdx.x < 192;
    int ci0 = blockIdx.x, cstep = gridDim.x, cn = ntile0;
    if (split) { if (has_unit) { cstep = 192; cn = 384; } else { ci0 = 384 + ((int)blockIdx.x - 192); cstep = 64; } }
    cvt_list(P, lds, ci0, cstep, cn, [&](int idx, int& j, int& t) {
        j = 0;
#pragma unroll
        for (int q = 1; q < 6; ++q) if (idx >= P.jobs[q].tile0) j = q;
        t = idx - P.jobs[j].tile0; });
    if (!split || !has_unit) {
        const int rb0 = split ? (int)blockIdx.x - 192 : (int)blockIdx.x, rbn = split ? 64 : (int)gridDim.x;
        for (int i = rb0 * 512 + tid; i < SEQ * 32; i += rbn * 512) {
            const int t = i >> 5, j = i & 31;
            const float pos = (float)(j < 16 ? (t >> 6) : (t & 63));
            const float inv = exp2f(-(float)(j & 15) * (13.287712379549449f / 16.0f));
            float sn, cs; sincosf(pos * inv, &sn, &cs);
            ((f32x2*)(p.ws + WS_ROPE))[i] = (f32x2){cs, sn};
        }
    }
}

DI void load_row16(const float* src, int lane, float (&v)[16]) {
#pragma unroll
    for (int j = 0; j < 4; ++j) { const f32x4 x = *(const f32x4*)(src + j * 256 + lane * 4); v[j * 4 + 0] = x[0]; v[j * 4 + 1] = x[1]; v[j * 4 + 2] = x[2]; v[j * 4 + 3] = x[3]; }
}
DI void norm_mod16(float (&v)[16], const float* g, const float* sh, const float* sc, int lane) {
    float ss = 0.f;
#pragma unroll
    for (int i = 0; i < 16; ++i) ss += v[i] * v[i];
    ss = wave_sum(ss);
    const float rstd = rsqrtf(ss * (1.0f / 1024.0f) + EPS);
#pragma unroll
    for (int j = 0; j < 4; ++j) {
        const int c = j * 256 + lane * 4;
        const f32x4 gg = *(const f32x4*)(g + c), s1 = *(const f32x4*)(sc + c), s0 = *(const f32x4*)(sh + c);
#pragma unroll
        for (int e = 0; e < 4; ++e) v[j * 4 + e] = (v[j * 4 + e] * rstd * gg[e]) * (1.0f + s1[e]) + s0[e];
    }
}
DI void store_row16_bf16(u16* dst, int lane, const float (&v)[16]) {
#pragma unroll
    for (int j = 0; j < 4; ++j) { u32x2 w; w.x = pk2(v[j * 4 + 0], v[j * 4 + 1]); w.y = pk2(v[j * 4 + 2], v[j * 4 + 3]); *(u32x2*)(dst + j * 256 + lane * 4) = w; }
}
DI const float* row_src(const Ctx& p, int layer, int r) {
    if (layer == 0) return r < NL ? inp(p, I_X) + (size_t)r * 1024 : inp(p, I_CTX) + (size_t)(r - NL) * 1024;
    return (const float*)(p.ws + WS_XS) + (size_t)r * 1024;
}
DI void phase_norm(const Ctx& p, int layer) {
    const int tid = tid_opaque(), lane = tid & 63, wv = blockIdx.x * 8 + (tid >> 6), nwv = gridDim.x * 8;
    const float* mod = (const float*)(p.ws + WS_MOD);
    u16* hb = (u16*)(p.ws + WS_HB);
    for (int r = wv; r < R; r += nwv) {
        float v[16];
        load_row16(row_src(p, layer, r), lane, v);
        const float* m = mod + (layer * 3 + mod_row(r)) * 6144;
        norm_mod16(v, inp(p, I_NMIX) + layer * 1024, m, m + 1024, lane);
        store_row16_bf16(hb + (size_t)r * 1024, lane, v);
    }
}
DI void phase_router(const Ctx& p, uchar* lds, int layer, int cnt_slot = -1) {
    const int tid = tid_opaque(), lane = tid & 63, wid = tid >> 6, wv = blockIdx.x * 8 + wid, nwv = gridDim.x * 8;
    const float* mod = (const float*)(p.ws + WS_MOD);
    u16* hb = (u16*)(p.ws + WS_HB);
    const float* xs = (const float*)(p.ws + WS_XS);
    const int nrows = layer == 0 ? R : NL;
    const float* wg = inp(p, I_MWGRP) + layer * 1024 * 4;
    const float* wr = inp(p, I_MWRT) + layer * 1024 * 16;
    const float* gnorm = inp(p, I_NFFN) + layer * 1024;
    int* cnt = (int*)(p.ws + WS_CTL + CTL_CNT) + (cnt_slot >= 0 ? cnt_slot : layer) * 1024;
    int* list = (int*)(p.ws + WS_LIST);
    f32x2* route = (f32x2*)(p.ws + WS_ROUTE);
    float* wrl = (float*)lds;
    float* wgl = wrl + 16384;
    float* hs = (float*)(lds + 81920 + wid * 8192);
    __syncthreads();
#pragma unroll
    for (int i = 0; i < 8; ++i) *(f32x4*)(wrl + (i * 512 + tid) * 4) = *(const f32x4*)(wr + (i * 512 + tid) * 4);
#pragma unroll
    for (int i = 0; i < 2; ++i) *(f32x4*)(wgl + (i * 512 + tid) * 4) = *(const f32x4*)(wg + (i * 512 + tid) * 4);
    __syncthreads();
    float bg[4], br[4];
#pragma unroll
    for (int o = 0; o < 4; ++o) { bg[o] = inp(p, I_MBGRP)[layer * 4 + o]; br[o] = inp(p, I_MBRT)[layer * 16 + (lane & 3) * 4 + o]; }
    for (int r0 = wv * 2; r0 < nrows; r0 += nwv * 2) {
        const float* m = mod + (layer * 3 + mod_row(r0)) * 6144;
        float v0[16], v1[16];
        load_row16(xs + (size_t)r0 * 1024, lane, v0);
        load_row16(xs + (size_t)(r0 + 1) * 1024, lane, v1);
        norm_mod16(v0, gnorm, m + 3 * 1024, m + 4 * 1024, lane);
        norm_mod16(v1, gnorm, m + 3 * 1024, m + 4 * 1024, lane);
        store_row16_bf16(hb + (size_t)r0 * 1024, lane, v0);
        store_row16_bf16(hb + (size_t)(r0 + 1) * 1024, lane, v1);
#pragma unroll
        for (int j = 0; j < 4; ++j) {
            *(f32x4*)(hs + (j * 256 + lane * 4) * 2) = (f32x4){v0[j * 4], v1[j * 4], v0[j * 4 + 1], v1[j * 4 + 1]};
            *(f32x4*)(hs + (j * 256 + lane * 4) * 2 + 4) = (f32x4){v0[j * 4 + 2], v1[j * 4 + 2], v0[j * 4 + 3], v1[j * 4 + 3]};
        }
        float ar[2][4], ag[2][4];
#pragma unroll
        for (int q = 0; q < 2; ++q)
#pragma unroll
            for (int o = 0; o < 4; ++o) { ar[q][o] = 0.f; ag[q][o] = 0.f; }
#pragma unroll 8
        for (int it = 0; it < 64; ++it) {
            const f32x4 w4 = *(const f32x4*)(wrl + (it * 64 + lane) * 4);
            const f32x2 x2 = *(const f32x2*)(hs + (it * 16 + (lane >> 2)) * 2);
#pragma unroll
            for (int o = 0; o < 4; ++o) { ar[0][o] += x2.x * w4[o]; ar[1][o] += x2.y * w4[o]; }
        }
#pragma unroll 8
        for (int it = 0; it < 16; ++it) {
            const f32x4 w4 = *(const f32x4*)(wgl + (it * 64 + lane) * 4);
            const f32x2 x2 = *(const f32x2*)(hs + (it * 64 + lane) * 2);
#pragma unroll
            for (int o = 0; o < 4; ++o) { ag[0][o] += x2.x * w4[o]; ag[1][o] += x2.y * w4[o]; }
        }
#pragma unroll
        for (int q = 0; q < 2; ++q)
#pragma unroll
            for (int o = 0; o < 4; ++o) {
                ag[q][o] = wave_sum(ag[q][o]);
                float v = ar[q][o]; v += __shfl_xor(v, 4); v += __shfl_xor(v, 8); v += __shfl_xor(v, 16); v = xor32_sum(v); ar[q][o] = v;
            }
#pragma unroll
        for (int q = 0; q < 2; ++q) {
            float gl[4];
#pragma unroll
            for (int o = 0; o < 4; ++o) gl[o] = ag[q][o] + bg[o];
            int gi = 0; float gm = gl[0];
#pragma unroll
            for (int o = 1; o < 4; ++o) if (gl[o] > gm) { gm = gl[o]; gi = o; }
            float gs = 0.f;
#pragma unroll
            for (int o = 0; o < 4; ++o) gs += __expf(gl[o] - gm);
            const float psel = 1.0f / gs;
            float el[4];
#pragma unroll
            for (int o = 0; o < 4; ++o) el[o] = __shfl(ar[q][o] + br[o], gi);
            int i1 = 0; float m1 = el[0];
#pragma unroll
            for (int o = 1; o < 4; ++o) if (el[o] > m1) { m1 = el[o]; i1 = o; }
            int i2 = -1; float m2 = -3.0e38f;
#pragma unroll
            for (int o = 0; o < 4; ++o) if (o != i1 && el[o] > m2) { m2 = el[o]; i2 = o; }
            if (lane == 0) {
                const int r = r0 + q;
                const float e2 = __expf(m2 - m1);
                const float w1 = psel / (1.0f + e2), w2 = psel * e2 / (1.0f + e2);
                const int lo = i1 < i2 ? i1 : i2, hi = i1 < i2 ? i2 : i1;
                const float wlo = i1 < i2 ? w1 : w2, whi = i1 < i2 ? w2 : w1;
                const int pi = lo == 0 ? (hi - 1) : (lo == 1 ? (hi + 1) : 5);
                const int bucket = gi * 6 + pi;
                const int pos = atomicAdd(cnt + bucket * 32, 1);
                list[(size_t)bucket * R + pos] = r;
                route[r] = (f32x2){wlo, whi};
            }
        }
    }
}

constexpr int LROW = 144;
constexpr int GEMM_A = 128 * 128, GEMM_B = 256 * 128, GEMM_STAGE = GEMM_A + GEMM_B;
constexpr int EPI_PITCH = 272, EPI_WAVE = 64 * EPI_PITCH;
static_assert(8 * EPI_WAVE <= 3 * GEMM_STAGE, "epilogue strips overlay the GEMM stages");
#define WAIT_V(n) asm volatile("s_waitcnt vmcnt(%0)" ::"n"(n) : "memory")
#define WAIT_L(n) asm volatile("s_waitcnt lgkmcnt(%0)" ::"n"(n) : "memory")
#define RAW_BARRIER() do { WAIT_L(0); __builtin_amdgcn_s_barrier(); } while (0)

template <class Epi>
DI void gemm_tile(uchar* lds, const u16* a0, const u16* a1, const u16* b0, const u16* b1, const u16* b2, const u16* b3, int nk, int ksplit, long bjump, Epi&& epi) {
    const int tid = tid_opaque(), lane = tid & 63, wid = tid >> 6, wr = wid >> 2, wc = wid & 3, l31 = lane & 31, hh = lane >> 5;
    const int lch = (lane & 7) ^ ((((wid & 1) << 3) + (lane >> 3)) >> 1);
    a0 += lch * 8; a1 += lch * 8; b0 += lch * 8; b1 += lch * 8; b2 += lch * 8; b3 += lch * 8;
    const unsigned pw = (unsigned)__builtin_amdgcn_readfirstlane(wid) * 1024u;
    const int sw = (l31 >> 1) & 7;
    unsigned xo[4];
#pragma unroll
    for (int ks = 0; ks < 4; ++ks) xo[ks] = (unsigned)(((ks * 2 + hh) ^ sw) << 4);
    const unsigned aro = (unsigned)((wr * 64 + l31) * 128), bro = (unsigned)(GEMM_A + (wc * 64 + l31) * 128);
    f32x16 acc[2][2];
#pragma unroll
    for (int a = 0; a < 2; ++a)
#pragma unroll
        for (int b = 0; b < 2; ++b)
#pragma unroll
            for (int i = 0; i < 16; ++i) acc[a][b][i] = 0.f;
#define GEMM_DMA(st_, kt_) do { const int kq_ = (kt_); const long bo_ = (long)kq_ * 64 + (kq_ >= ksplit ? bjump : 0); uchar* s_ = lds + (st_) * GEMM_STAGE + pw; \
        __builtin_amdgcn_global_load_lds((const unsigned*)(a0 + kq_ * 64), (LAS unsigned*)(s_), 16, 0, 0); \
        __builtin_amdgcn_global_load_lds((const unsigned*)(a1 + kq_ * 64), (LAS unsigned*)(s_ + 8192), 16, 0, 0); \
        __builtin_amdgcn_global_load_lds((const unsigned*)(b0 + bo_), (LAS unsigned*)(s_ + GEMM_A), 16, 0, 0); \
        __builtin_amdgcn_global_load_lds((const unsigned*)(b1 + bo_), (LAS unsigned*)(s_ + GEMM_A + 8192), 16, 0, 0); \
        __builtin_amdgcn_global_load_lds((const unsigned*)(b2 + bo_), (LAS unsigned*)(s_ + GEMM_A + 16384), 16, 0, 0); \
        __builtin_amdgcn_global_load_lds((const unsigned*)(b3 + bo_), (LAS unsigned*)(s_ + GEMM_A + 24576), 16, 0, 0); } while (0)
    RAW_BARRIER();
    GEMM_DMA(0, 0); GEMM_DMA(1, 1);
    WAIT_V(6);
    RAW_BARRIER();
    int cur = 0;
#pragma unroll 1
    for (int kt = 0; kt < nk; ++kt) {
        const int nxt = cur == 0 ? 2 : cur - 1;
        if (kt + 2 < nk) GEMM_DMA(nxt, kt + 2);
        const uchar* s = lds + cur * GEMM_STAGE;
#pragma unroll
        for (int ks = 0; ks < 4; ++ks) {
            const bf16x8 fa0 = *(const bf16x8*)(s + aro + xo[ks]), fa1 = *(const bf16x8*)(s + aro + 4096 + xo[ks]);
            const bf16x8 fb0 = *(const bf16x8*)(s + bro + xo[ks]), fb1 = *(const bf16x8*)(s + bro + 4096 + xo[ks]);
            acc[0][0] = MFMA32(fb0, fa0, acc[0][0]); acc[0][1] = MFMA32(fb0, fa1, acc[0][1]);
            acc[1][0] = MFMA32(fb1, fa0, acc[1][0]); acc[1][1] = MFMA32(fb1, fa1, acc[1][1]);
        }
        if (kt + 2 < nk) WAIT_V(6); else WAIT_V(0);
        RAW_BARRIER();
        cur = cur == 2 ? 0 : cur + 1;
    }
#if PROBE_GEMM2X == 1
    {
        f32x16 d[2][2];
        for (int a = 0; a < 2; ++a) for (int b = 0; b < 2; ++b) for (int i = 0; i < 16; ++i) d[a][b][i] = 0.f;
        RAW_BARRIER(); GEMM_DMA(0, 0); GEMM_DMA(1, 1); WAIT_V(6); RAW_BARRIER();
        int cur2 = 0;
#pragma unroll 1
        for (int kt = 0; kt < nk; ++kt) {
            const int nxt = cur2 == 0 ? 2 : cur2 - 1;
            if (kt + 2 < nk) GEMM_DMA(nxt, kt + 2);
            const uchar* s = lds + cur2 * GEMM_STAGE;
#pragma unroll
            for (int ks = 0; ks < 4; ++ks) {
                const bf16x8 fa0 = *(const bf16x8*)(s + aro + xo[ks]), fa1 = *(const bf16x8*)(s + aro + 4096 + xo[ks]);
                const bf16x8 fb0 = *(const bf16x8*)(s + bro + xo[ks]), fb1 = *(const bf16x8*)(s + bro + 4096 + xo[ks]);
                d[0][0] = MFMA32(fb0, fa0, d[0][0]); d[0][1] = MFMA32(fb0, fa1, d[0][1]);
                d[1][0] = MFMA32(fb1, fa0, d[1][0]); d[1][1] = MFMA32(fb1, fa1, d[1][1]);
            }
            if (kt + 2 < nk) WAIT_V(6); else WAIT_V(0);
            RAW_BARRIER();
            cur2 = cur2 == 2 ? 0 : cur2 + 1;
        }
        asm volatile("" :: "v"(d[0][0]), "v"(d[0][1]), "v"(d[1][0]), "v"(d[1][1]));
    }
#elif PROBE_GEMM2X == 2
    {
        f32x4 d[4][4];
        for (int a = 0; a < 4; ++a) for (int b = 0; b < 4; ++b) d[a][b] = (f32x4){0.f, 0.f, 0.f, 0.f};
        RAW_BARRIER(); GEMM_DMA(0, 0); GEMM_DMA(1, 1); WAIT_V(6); RAW_BARRIER();
        int cur2 = 0;
#pragma unroll 1
        for (int kt = 0; kt < nk; ++kt) {
            const int nxt = cur2 == 0 ? 2 : cur2 - 1;
            if (kt + 2 < nk) GEMM_DMA(nxt, kt + 2);
            const uchar* s = lds + cur2 * GEMM_STAGE;
#pragma unroll
            for (int kp = 0; kp < 2; ++kp) {
                bf16x8 fa[4], fb[4];
                fa[0] = *(const bf16x8*)(s + aro + xo[2 * kp]); fa[1] = *(const bf16x8*)(s + aro + 4096 + xo[2 * kp]); fa[2] = *(const bf16x8*)(s + aro + xo[2 * kp + 1]); fa[3] = *(const bf16x8*)(s + aro + 4096 + xo[2 * kp + 1]);
                fb[0] = *(const bf16x8*)(s + bro + xo[2 * kp]); fb[1] = *(const bf16x8*)(s + bro + 4096 + xo[2 * kp]); fb[2] = *(const bf16x8*)(s + bro + xo[2 * kp + 1]); fb[3] = *(const bf16x8*)(s + bro + 4096 + xo[2 * kp + 1]);
#pragma unroll
                for (int a = 0; a < 4; ++a)
#pragma unroll
                    for (int b = 0; b < 4; ++b) d[a][b] = __builtin_amdgcn_mfma_f32_16x16x32_bf16(fb[b], fa[a], d[a][b], 0, 0, 0);
            }
            if (kt + 2 < nk) WAIT_V(6); else WAIT_V(0);
            RAW_BARRIER();
            cur2 = cur2 == 2 ? 0 : cur2 + 1;
        }
        asm volatile("" :: "v"(d[0][0]), "v"(d[0][1]), "v"(d[0][2]), "v"(d[0][3]), "v"(d[1][0]), "v"(d[1][1]), "v"(d[1][2]), "v"(d[1][3]));
        asm volatile("" :: "v"(d[2][0]), "v"(d[2][1]), "v"(d[2][2]), "v"(d[2][3]), "v"(d[3][0]), "v"(d[3][1]), "v"(d[3][2]), "v"(d[3][3]));
    }
#endif
    epi(acc, wr * 64, wc, lane, lds + wid * EPI_WAVE);
}

constexpr int G2_A = 256 * 64, G2_STAGE = 2 * G2_A;
template <class Epi>
DI void gemm_tile256(uchar* lds, const u16* a0, const u16* a1, const u16* b0, const u16* b1, int nk, int ksplit, long bjump, Epi&& epi) {
    const int tid = tid_opaque(), lane = tid & 63, wid = tid >> 6, wr = wid >> 2, wc = wid & 3, l31 = lane & 31, hh = lane >> 5;
    const int lch = (lane & 3) ^ ((lane >> 4) & 3);
    a0 += lch * 8; a1 += lch * 8; b0 += lch * 8; b1 += lch * 8;
    const unsigned pw = (unsigned)__builtin_amdgcn_readfirstlane(wid) * 1024u;
    const int sw = (l31 >> 2) & 3;
    const unsigned xo0 = (unsigned)(((0 + hh) ^ sw) << 4), xo1 = (unsigned)(((2 + hh) ^ sw) << 4);
    const unsigned aro = (unsigned)((wr * 128 + l31) * 64), bro = (unsigned)(G2_A + (wc * 64 + l31) * 64);
    f32x16 acc[2][4];
#pragma unroll
    for (int a = 0; a < 2; ++a)
#pragma unroll
        for (int b = 0; b < 4; ++b)
#pragma unroll
            for (int i = 0; i < 16; ++i) acc[a][b][i] = 0.f;
#define G2_DMA(st_, kt_) do { const int kq_ = (kt_); const long bo_ = (long)kq_ * 32 + (kq_ >= ksplit ? bjump : 0); uchar* s_ = lds + (st_) * G2_STAGE + pw; \
        __builtin_amdgcn_global_load_lds((const unsigned*)(a0 + kq_ * 32), (LAS unsigned*)(s_), 16, 0, 0); \
        __builtin_amdgcn_global_load_lds((const unsigned*)(a1 + kq_ * 32), (LAS unsigned*)(s_ + 8192), 16, 0, 0); \
        __builtin_amdgcn_global_load_lds((const unsigned*)(b0 + bo_), (LAS unsigned*)(s_ + G2_A), 16, 0, 0); \
        __builtin_amdgcn_global_load_lds((const unsigned*)(b1 + bo_), (LAS unsigned*)(s_ + G2_A + 8192), 16, 0, 0); } while (0)
    RAW_BARRIER();
    G2_DMA(0, 0); G2_DMA(1, 1); G2_DMA(2, 2);
    WAIT_V(8);
    RAW_BARRIER();
#pragma unroll 1
    for (int kt = 0; kt < nk; ++kt) {
        if (kt + 3 < nk) G2_DMA((kt + 3) & 3, kt + 3);
        const uchar* s = lds + (kt & 3) * G2_STAGE;
#pragma unroll
        for (int ks = 0; ks < 2; ++ks) {
            const unsigned xo = ks ? xo1 : xo0;
            bf16x8 fa[4], fb[2];
#pragma unroll
            for (int mb = 0; mb < 4; ++mb) fa[mb] = *(const bf16x8*)(s + aro + mb * 2048 + xo);
#pragma unroll
            for (int nb = 0; nb < 2; ++nb) fb[nb] = *(const bf16x8*)(s + bro + nb * 2048 + xo);
#pragma unroll
            for (int nb = 0; nb < 2; ++nb)
#pragma unroll
                for (int mb = 0; mb < 4; ++mb) acc[nb][mb] = MFMA32(fb[nb], fa[mb], acc[nb][mb]);
        }
        if (kt + 3 < nk) WAIT_V(8); else if (kt + 2 < nk) WAIT_V(4); else WAIT_V(0);
        RAW_BARRIER();
    }
#pragma unroll
    for (int half = 0; half < 2; ++half) {
        f32x16 t[2][2];
#pragma unroll
        for (int nb = 0; nb < 2; ++nb)
#pragma unroll
            for (int mb = 0; mb < 2; ++mb) t[nb][mb] = acc[nb][2 * half + mb];
        epi(t, wr * 128 + half * 64, wc, lane, lds + wid * EPI_WAVE);
    }
}

DI void epi_put4(uchar* w, int row, int col, float a, float b, float c, float d) { *(f32x4*)(w + row * EPI_PITCH + col * 4) = (f32x4){a, b, c, d}; }
DI void epi_stage(uchar* w, const f32x16 (&acc)[2][2], int l31, int hh) {
#pragma unroll
    for (int mb = 0; mb < 2; ++mb)
#pragma unroll
        for (int nb = 0; nb < 2; ++nb)
#pragma unroll
            for (int g = 0; g < 4; ++g) epi_put4(w, mb * 32 + l31, nb * 32 + 8 * g + 4 * hh, acc[nb][mb][4 * g], acc[nb][mb][4 * g + 1], acc[nb][mb][4 * g + 2], acc[nb][mb][4 * g + 3]);
}
template <class F> DI void epi_rows4(const uchar* w, int lane, F&& f) {
#pragma unroll
    for (int it = 0; it < 16; ++it) { const int row = it * 4 + (lane >> 4), col = (lane & 15) * 4; f(row, col, *(const f32x4*)(w + row * EPI_PITCH + col * 4)); }
}
template <int NC, class F> DI void epi_rows8(const uchar* w, int lane, F&& f) {
    constexpr int LPR = NC / 8, RPI = 64 / LPR;
#pragma unroll
    for (int it = 0; it < 64 / RPI; ++it) { const int row = it * RPI + lane / LPR, col = (lane % LPR) * 8; f(row, col, *(const f32x4*)(w + row * EPI_PITCH + col * 4), *(const f32x4*)(w + row * EPI_PITCH + col * 4 + 16)); }
}
DI u32x4 pack8(const f32x4& a, const f32x4& b) { u32x4 r; r.x = pk2(a[0], a[1]); r.y = pk2(a[2], a[3]); r.z = pk2(b[0], b[1]); r.w = pk2(b[2], b[3]); return r; }

#define MFMA16(a, b, c) __builtin_amdgcn_mfma_f32_16x16x32_bf16((a), (b), (c), 0, 0, 0)
constexpr int P8_HT = 16384;
DI void p8_rc(int tid, int& r0, int& c) { const int wid = tid >> 6, lane = tid & 63; r0 = (wid >> 1) * 16 + (lane >> 2); c = (wid & 1) * 32 + (((lane & 3) ^ ((lane >> 5) << 1)) << 3); }
DI void glds16(const uchar* g, uchar* s) { __builtin_amdgcn_global_load_lds((const unsigned*)g, (LAS unsigned*)s, 16, 0, 0); }
template <class Epi>
DI void gemm_tile8p(uchar* lds, const uchar* abase, unsigned a0_0, unsigned a1_0, unsigned a0_1, unsigned a1_1, int ac1_0, int ac0_1, int ac1_1,
                    const uchar* bbase, unsigned bo, int bc1_0, int bc0_1, int bc1_1, int nk, int ksplit, long bjump, Epi&& epi) {
    constexpr int ac0_0 = 0, bc0_0 = 0;
    const int tid = tid_opaque(), lane = tid & 63, wid = tid >> 6, wr = wid >> 2, wc = wid & 3, fr = lane & 15, fq = lane >> 4;
    const unsigned pw = (unsigned)__builtin_amdgcn_readfirstlane(wid) * 1024u;
    const unsigned lp = (unsigned)((fr * 64 + fq * 16) ^ ((fr >> 3) << 5));
    const unsigned la = (unsigned)wr * 8192u + lp, lb = (unsigned)wc * 4096u + lp;
    f32x4 acc[2][2][4][2];
#pragma unroll
    for (int a = 0; a < 2; ++a)
#pragma unroll
        for (int b = 0; b < 2; ++b)
#pragma unroll
            for (int m = 0; m < 4; ++m)
#pragma unroll
                for (int n = 0; n < 2; ++n) acc[a][b][m][n] = (f32x4){0.f, 0.f, 0.f, 0.f};
    bf16x8 At[4][2], B0[2][2], B1[2][2];
#define P8_SA(b, h) (((b) * 2 + (h)) * P8_HT)
#define P8_SB(b, h) ((4 + (b) * 2 + (h)) * P8_HT)
#define P8_STAGE_A(b, h, kt) do { const uchar* g_ = abase + (size_t)(kt) * 128; uchar* s_ = lds + P8_SA(b, h) + pw; glds16(g_ + ac0_##h + a0_##h, s_); glds16(g_ + ac1_##h + a1_##h, s_ + 8192); } while (0)
#define P8_STAGE_B(b, h, kt) do { const int kq_ = (kt); const uchar* g_ = bbase + (size_t)kq_ * 128 + (kq_ >= ksplit ? bjump : 0); uchar* s_ = lds + P8_SB(b, h) + pw; glds16(g_ + bc0_##h + bo, s_); glds16(g_ + bc1_##h + bo, s_ + 8192); } while (0)
#define P8_LDA(dst, b, h) do { _Pragma("unroll") for (int m = 0; m < 4; ++m) { _Pragma("unroll") for (int k = 0; k < 2; ++k) dst[m][k] = *(const bf16x8*)(lds + P8_SA(b, h) + la + (m * 2 + k) * 1024); } } while (0)
#define P8_LDB(dst, b, h) do { _Pragma("unroll") for (int n = 0; n < 2; ++n) { _Pragma("unroll") for (int k = 0; k < 2; ++k) dst[n][k] = *(const bf16x8*)(lds + P8_SB(b, h) + lb + (n * 2 + k) * 1024); } } while (0)
#define P8_MMA(ai, bj, Bx) do { __builtin_amdgcn_s_setprio(1); \
        _Pragma("unroll") for (int m = 0; m < 4; ++m) { _Pragma("unroll") for (int n = 0; n < 2; ++n) { _Pragma("unroll") for (int k = 0; k < 2; ++k) acc[ai][bj][m][n] = MFMA16(Bx[n][k], At[m][k], acc[ai][bj][m][n]); } } \
        __builtin_amdgcn_s_setprio(0); } while (0)
#define P8_BAR() __builtin_amdgcn_s_barrier()
#define P8_SCHED() __builtin_amdgcn_sched_barrier(0)
    RAW_BARRIER();
    P8_STAGE_B(0, 0, 0); P8_STAGE_A(0, 0, 0); P8_STAGE_B(0, 1, 0); P8_STAGE_A(0, 1, 0);
    if (wr == 1) P8_BAR();
    WAIT_V(4); P8_BAR();
    P8_STAGE_B(1, 0, 1); P8_STAGE_A(1, 0, 1); P8_STAGE_B(1, 1, 1);
    WAIT_V(6); P8_BAR();
#pragma unroll 1
    for (int t = 0; t < nk - 2; t += 2) {
        P8_LDB(B0, 0, 0); P8_SCHED(); P8_LDA(At, 0, 0); P8_STAGE_A(1, 1, t + 1);
        WAIT_L(8); P8_BAR(); WAIT_L(0); P8_MMA(0, 0, B0); P8_BAR(); P8_SCHED();
        P8_LDB(B1, 0, 1); P8_STAGE_B(0, 0, t + 2);
        P8_BAR(); WAIT_L(0); P8_MMA(0, 1, B1); P8_BAR();
        P8_LDA(At, 0, 1); P8_STAGE_A(0, 0, t + 2);
        P8_BAR(); WAIT_L(0); P8_MMA(1, 0, B0); P8_BAR(); P8_SCHED();
        P8_STAGE_B(0, 1, t + 2);
        WAIT_V(6); P8_BAR(); P8_MMA(1, 1, B1); P8_BAR();
        P8_LDB(B0, 1, 0); P8_SCHED(); P8_LDA(At, 1, 0); P8_STAGE_A(0, 1, t + 2);
        WAIT_L(8); P8_BAR(); WAIT_L(0); P8_MMA(0, 0, B0); P8_BAR(); P8_SCHED();
        P8_LDB(B1, 1, 1); P8_STAGE_B(1, 0, t + 3);
        P8_BAR(); WAIT_L(0); P8_MMA(0, 1, B1); P8_BAR();
        P8_LDA(At, 1, 1); P8_STAGE_A(1, 0, t + 3);
        P8_BAR(); WAIT_L(0); P8_MMA(1, 0, B0); P8_BAR(); P8_SCHED();
        P8_STAGE_B(1, 1, t + 3);
        WAIT_V(6); P8_BAR(); P8_MMA(1, 1, B1); P8_BAR();
    }
    {
        P8_LDB(B0, 0, 0); P8_LDA(At, 0, 0); P8_STAGE_A(1, 1, nk - 1);
        P8_BAR(); WAIT_L(0); P8_MMA(0, 0, B0); P8_BAR();
        P8_LDB(B1, 0, 1); P8_BAR(); WAIT_L(0); P8_MMA(0, 1, B1); P8_BAR();
        P8_LDA(At, 0, 1); WAIT_V(4); P8_BAR(); WAIT_L(0); P8_MMA(1, 0, B0); P8_MMA(1, 1, B1); P8_BAR();
    }
    {
        P8_LDB(B0, 1, 0); P8_LDA(At, 1, 0); WAIT_V(2); P8_BAR(); WAIT_L(0); P8_MMA(0, 0, B0); P8_BAR();
        P8_LDB(B1, 1, 1); WAIT_V(0); P8_BAR(); WAIT_L(0); P8_MMA(0, 1, B1); P8_BAR();
        P8_LDA(At, 1, 1); P8_BAR(); WAIT_L(0); P8_MMA(1, 0, B0); P8_MMA(1, 1, B1); P8_BAR();
    }
    if (wr == 0) P8_BAR();
    RAW_BARRIER();
    uchar* w = lds + wid * EPI_WAVE;
#pragma unroll
    for (int ai = 0; ai < 2; ++ai) {
#pragma unroll
        for (int bj = 0; bj < 2; ++bj)
#pragma unroll
            for (int m = 0; m < 4; ++m)
#pragma unroll
                for (int n = 0; n < 2; ++n) *(f32x4*)(w + (m * 16 + fr) * EPI_PITCH + (bj * 32 + n * 16 + fq * 4) * 4) = acc[ai][bj][m][n];
        epi(wr * 128 + ai * 64, wc, lane, w);
    }
}
DI void epi_unstage(const uchar* w, f32x16 (&t)[2][2], int l31, int hh) {
#pragma unroll
    for (int mb = 0; mb < 2; ++mb)
#pragma unroll
        for (int nb = 0; nb < 2; ++nb)
#pragma unroll
            for (int g = 0; g < 4; ++g) { const f32x4 v = *(const f32x4*)(w + (mb * 32 + l31) * EPI_PITCH + (nb * 32 + 8 * g + 4 * hh) * 4); t[nb][mb][4 * g] = v[0]; t[nb][mb][4 * g + 1] = v[1]; t[nb][mb][4 * g + 2] = v[2]; t[nb][mb][4 * g + 3] = v[3]; }
}

DI void rect_unit(int v, int MT, int NT, int& mt, int& nt) {
    if (gridDim.x != 256) { mt = v / NT; nt = v % NT; return; }
    const int r = v >> 8, b = v & 255, x = b & 7, y = b >> 3;
    const int q = r * 8 + x, nqn = NT >> 2, qm = q / nqn, qn = q - qm * nqn;
    mt = qm * 8 + (y & 7); nt = qn * 4 + (y >> 3);
}
DI void phase_inproj0(const Params& P, const Ctx& p, uchar* lds) {
    const int tid = tid_opaque();
    const u16* hb = (const u16*)(p.ws + WS_HB);
    const u16* w = (const u16*)(p.ws + WS_WIN0);
    u16* zc = (u16*)(p.ws + WS_REGA + RA_ZC);
    u16* qa = (u16*)(p.ws + WS_REGA + RA_Q);
    u16* ka = (u16*)(p.ws + WS_REGA + RA_K);
    u16* vt = (u16*)(p.ws + WS_REGA + RA_VT);
    const f32x2* rope = (const f32x2*)(p.ws + WS_ROPE);
    const int rs = tid >> 3;
    for (int u = blockIdx.x; u < 768 + 48; u += gridDim.x) {
        const bool big = u < 768;
        int mt, nt; if (big) rect_unit(u, 64, 12, mt, nt); else { mt = (u - 768) / 12; nt = (u - 768) % 12; }
        const int m0 = big ? mt * 256 : NL + mt * 128, n0 = nt * 256;
        auto epi =
            [&](f32x16 (&acc)[2][2], int roff, int wc, int lane, uchar* w) {
                const int l31 = lane & 31, hh = lane >> 5, nw = n0 + wc * 64;
                const int row0 = m0 + roff;
                int b, spos0; if (row0 < NL) { b = row0 >> 13; spos0 = row0 & 8191; } else { b = (row0 - NL) >> 8; spos0 = SEQ + ((row0 - NL) & 255); }
                if (nw < 1536) {
                    epi_stage(w, acc, l31, hh);
                    epi_rows8<64>(w, lane, [&](int row, int col, const f32x4& v0, const f32x4& v1) { *(u32x4*)(zc + (size_t)(row0 + row) * 1536 + nw + col) = pack8(v0, v1); });
                } else if (nw < 2560) {
                    const bool isq = nw < 2048;
                    const int cg = (nw - (isq ? 1536 : 2048)) >> 6, head = cg >> 1, map = cg & 1;
                    const float* gain = isq ? inp(p, I_QN) : inp(p, I_KN);
                    const float osc = isq ? QSCALE : 1.0f;
#pragma unroll
                    for (int mb = 0; mb < 2; ++mb) {
                        float ss = 0.f;
#pragma unroll
                        for (int nb = 0; nb < 2; ++nb)
#pragma unroll
                            for (int i = 0; i < 16; ++i) ss += acc[nb][mb][i] * acc[nb][mb][i];
                        ss = xor32_sum(ss);
                        const float rstd = rsqrtf(ss * (1.0f / 64.0f) + EPS);
                        const int spos = spos0 + mb * 32 + l31;
#pragma unroll
                        for (int g = 0; g < 4; ++g) {
                            const int d0 = 8 * g + 4 * hh;
                            const f32x4 g1v = *(const f32x4*)(gain + d0), g2v = *(const f32x4*)(gain + 32 + d0);
                            f32x4 csa = (f32x4){1.f, 0.f, 1.f, 0.f}, csb = csa;
                            if (row0 < NL) { csa = *(const f32x4*)((const float*)(rope + spos * 32 + d0)); csb = *(const f32x4*)((const float*)(rope + spos * 32 + d0 + 2)); }
                            float o1[4], o2[4];
#pragma unroll
                            for (int e = 0; e < 4; ++e) {
                                const float v1 = acc[0][mb][4 * g + e] * rstd * g1v[e], v2 = acc[1][mb][4 * g + e] * rstd * g2v[e];
                                const float cs = e < 2 ? csa[2 * e] : csb[2 * (e - 2)], sn = e < 2 ? csa[2 * e + 1] : csb[2 * (e - 2) + 1];
                                o1[e] = (v1 * cs - v2 * sn) * osc; o2[e] = (v2 * cs + v1 * sn) * osc;
                            }
                            epi_put4(w, mb * 32 + l31, d0, o1[0], o1[1], o1[2], o1[3]);
                            epi_put4(w, mb * 32 + l31, 32 + d0, o2[0], o2[1], o2[2], o2[3]);
                        }
                    }
                    u16* dst = (isq ? qa : ka) + ((size_t)(((b * 4 + head) * 2 + map)) * SK + spos0) * 64;
                    epi_rows8<64>(w, lane, [&](int row, int col, const f32x4& v0, const f32x4& v1) { *(u32x4*)(dst + (size_t)row * 64 + col) = pack8(v0, v1); });
                } else {
                    const int head = (nw - 2560) >> 7, vb0 = (nw - 2560) & 127;
#pragma unroll
                    for (int mb = 0; mb < 2; ++mb) {
                        const int tok = mb * 32 + l31, tp = (tok & ~12) | (((tok >> 3) & 1) << 2) | (((tok >> 2) & 1) << 3);
#pragma unroll
                        for (int nb = 0; nb < 2; ++nb)
#pragma unroll
                            for (int i = 0; i < 16; ++i) *(u16*)(w + (nb * 32 + crow(i, hh)) * 144 + tp * 2) = f2b(acc[nb][mb][i]);
                    }
                    u16* dst = vt + ((size_t)(b * 4 + head) * 128 + vb0) * SK + spos0;
#pragma unroll
                    for (int it = 0; it < 8; ++it) { const int v = it * 8 + (lane >> 3), c8 = lane & 7; *(u32x4*)(dst + (size_t)v * SK + c8 * 8) = *(const u32x4*)(w + v * 144 + c8 * 16); }
                }
            };
        if (big) {
            int r0, c; p8_rc(tid, r0, c);
            const unsigned ao = (unsigned)(r0 * 2048 + c * 2), bo = (unsigned)((((r0 >> 5) * 64 + (r0 & 31)) * 2048) + c * 2);
            gemm_tile8p(lds, (const uchar*)(hb + (size_t)m0 * 1024), ao, ao, ao, ao, 128 * 2048, 64 * 2048, 192 * 2048,
                        (const uchar*)(w + (size_t)n0 * 1024), bo, 128 * 2048, 32 * 2048, 160 * 2048, 16, 1 << 30, 0,
                        [&](int roff, int wc, int lane, uchar* w) {
                            const int nw = n0 + wc * 64;
                            if (nw < 1536) { const int row0 = m0 + roff; epi_rows8<64>(w, lane, [&](int row, int col, const f32x4& v0, const f32x4& v1) { *(u32x4*)(zc + (size_t)(row0 + row) * 1536 + nw + col) = pack8(v0, v1); }); }
                            else { f32x16 t[2][2]; epi_unstage(w, t, lane & 31, lane >> 5); epi(t, roff, wc, lane, w); } });
        } else {
            const u16* ab = hb + (size_t)(m0 + rs) * 1024;
            const u16* bb = w + (size_t)(n0 + rs) * 1024;
            gemm_tile(lds, ab, ab + 64 * 1024, bb, bb + 64 * 1024, bb + 128 * 1024, bb + 192 * 1024, 16, 1 << 30, 0, epi);
        }
    }
    tail_cvt_moe(P, lds, 768 + 48, 0, 0, MOE_CVT_TILES / 2);
    tail_cvt_dense(P, lds, 768 + 48, P.jobs[1].tile0, P.jobs[2].tile0);
}

constexpr int ATT_K = 64 * 128, ATT_V = 128 * 128;
constexpr int ATT_STAGE = 2 * ATT_K + ATT_V;
DI void attn_unit(const Ctx& p, uchar* lds, int bh, int q0, int key0, int ntile, int out_row0) {
    const int tid = tid_opaque();
    const int lane = tid & 63, wid = tid >> 6, l31 = lane & 31, hh = lane >> 5, m = wid >> 2, g = wid & 3;
    const u16* qa = (const u16*)(p.ws + WS_REGA + RA_Q);
    const u16* ka = (const u16*)(p.ws + WS_REGA + RA_K);
    const u16* vt = (const u16*)(p.ws + WS_REGA + RA_VT);
    uchar* qs = lds + 2 * ATT_STAGE + wid * 8192 + lane * 16;
    RAW_BARRIER();
    {
        const u16* qp = qa + ((size_t)(bh * 2 + m) * SK + q0 + g * 64 + l31) * 64 + hh * 8;
#pragma unroll
        for (int rg = 0; rg < 2; ++rg)
#pragma unroll
            for (int ks = 0; ks < 4; ++ks) *(bf16x8*)(qs + (rg * 4 + ks) * 1024) = *(const bf16x8*)(qp + rg * 32 * 64 + ks * 16);
    }
    const int lch = (lane & 7) ^ ((((wid & 1) << 3) + (lane >> 3)) >> 1);
    const u16* kp = ka + ((size_t)(bh * 2) * SK + key0 + wid * 8 + (lane >> 3)) * 64 + lch * 8;
    const u16* vp = vt + ((size_t)bh * 128 + wid * 8 + (lane >> 3)) * SK + key0 + lch * 8;
    const unsigned pw = (unsigned)__builtin_amdgcn_readfirstlane(wid) * 1024u;
    const int sw = (l31 >> 1) & 7;
    unsigned xo[4];
#pragma unroll
    for (int ks = 0; ks < 4; ++ks) xo[ks] = (unsigned)(((ks * 2 + hh) ^ sw) << 4);
    const unsigned kro = (unsigned)(m * ATT_K + l31 * 128), vro = (unsigned)(2 * ATT_K + l31 * 128);
    f32x16 O[2][4];
#pragma unroll
    for (int rg = 0; rg < 2; ++rg)
#pragma unroll
        for (int vb = 0; vb < 4; ++vb)
#pragma unroll
            for (int i = 0; i < 16; ++i) O[rg][vb][i] = 0.f;
    float lsum0 = 0.f, lsum1 = 0.f;
#define ATT_DMA(st_, t_) do { const int tq_ = (t_); uchar* s_ = lds + (st_) * ATT_STAGE + pw; \
        __builtin_amdgcn_global_load_lds((const unsigned*)(kp + (size_t)tq_ * 4096), (LAS unsigned*)(s_), 16, 0, 0); \
        __builtin_amdgcn_global_load_lds((const unsigned*)(kp + (size_t)SK * 64 + (size_t)tq_ * 4096), (LAS unsigned*)(s_ + ATT_K), 16, 0, 0); \
        __builtin_amdgcn_global_load_lds((const unsigned*)(vp + tq_ * 64), (LAS unsigned*)(s_ + 2 * ATT_K), 16, 0, 0); \
        __builtin_amdgcn_global_load_lds((const unsigned*)(vp + (size_t)64 * SK + tq_ * 64), (LAS unsigned*)(s_ + 2 * ATT_K + 8192), 16, 0, 0); } while (0)
    ATT_DMA(0, 0);
    WAIT_V(0);
    RAW_BARRIER();
#pragma unroll 1
    for (int t = 0; t < ntile; ++t) {
        if (t + 1 < ntile) ATT_DMA((t + 1) & 1, t + 1);
        const uchar* s = lds + (t & 1) * ATT_STAGE;
#pragma unroll 1
        for (int kb = 0; kb < 2; ++kb) {
            bf16x8 P[2][2];
#pragma unroll
            for (int rg = 0; rg < 2; ++rg) {
                f32x16 S;
#pragma unroll
                for (int i = 0; i < 16; ++i) S[i] = 0.f;
#pragma unroll
                for (int ks = 0; ks < 4; ++ks) { const bf16x8 kf = *(const bf16x8*)(s + kro + kb * 4096 + xo[ks]); const bf16x8 q = *(const bf16x8*)(qs + (rg * 4 + ks) * 1024); S = MFMA32(kf, q, S); }
                float ls = 0.f;
#pragma unroll
                for (int i = 0; i < 16; ++i) { S[i] = __builtin_amdgcn_exp2f(S[i]); ls += S[i]; }
                if (rg == 0) lsum0 += ls; else lsum1 += ls;
#pragma unroll
                for (int s2 = 0; s2 < 2; ++s2) {
                    u32x4 pw4; pw4.x = pk2(S[8 * s2], S[8 * s2 + 1]); pw4.y = pk2(S[8 * s2 + 2], S[8 * s2 + 3]); pw4.z = pk2(S[8 * s2 + 4], S[8 * s2 + 5]); pw4.w = pk2(S[8 * s2 + 6], S[8 * s2 + 7]);
                    P[rg][s2] = __builtin_bit_cast(bf16x8, pw4);
                }
            }
#pragma unroll
            for (int s2 = 0; s2 < 2; ++s2)
#pragma unroll
                for (int vb = 0; vb < 4; ++vb) {
                    const bf16x8 vf = *(const bf16x8*)(s + vro + vb * 4096 + (unsigned)(((4 * kb + 2 * s2 + hh) ^ sw) << 4));
                    O[0][vb] = MFMA32(vf, P[0][s2], O[0][vb]); O[1][vb] = MFMA32(vf, P[1][s2], O[1][vb]);
                }
        }
        WAIT_V(0);
        RAW_BARRIER();
    }
    lsum0 = xor32_sum(lsum0); lsum1 = xor32_sum(lsum1);
    const int tid2 = tid_opaque(), lane2 = tid2 & 63, wid2 = tid2 >> 6, e_l31 = lane2 & 31, e_hh = lane2 >> 5, e_m = wid2 >> 2, e_g = wid2 & 3;
    float lam;
    { float d1 = inp(p, I_LQ1)[lane2] * inp(p, I_LK1)[lane2], d2 = inp(p, I_LQ2)[lane2] * inp(p, I_LK2)[lane2]; d1 = wave_sum(d1); d2 = wave_sum(d2); lam = fexp(d1) - fexp(d2) + LAM_INIT0; }
    float* comb = (float*)lds + (size_t)e_g * 8192 + lane2;
    if (e_m == 1) {
#pragma unroll
        for (int rg = 0; rg < 2; ++rg) {
            const float sc = lam / (rg ? lsum1 : lsum0);
#pragma unroll
            for (int vb = 0; vb < 4; ++vb) {
#pragma unroll
                for (int i = 0; i < 16; ++i) comb[((rg * 4 + vb) * 16 + i) * 64] = O[rg][vb][i] * sc;
                __builtin_amdgcn_sched_barrier(0);
            }
        }
    }
    RAW_BARRIER();
    if (e_m == 0) {
        const float* snl = (const float*)(lds + 131072);
        const int h = bh & 3;
#pragma unroll
        for (int rg = 0; rg < 2; ++rg) {
            const float i0 = 1.0f / (rg ? lsum1 : lsum0);
            float ss = 0.f;
#pragma unroll
            for (int vb = 0; vb < 4; ++vb) {
#pragma unroll
                for (int i = 0; i < 16; ++i) { const float o = O[rg][vb][i] * i0 - comb[((rg * 4 + vb) * 16 + i) * 64]; O[rg][vb][i] = o; ss += o * o; }
                __builtin_amdgcn_sched_barrier(0);
            }
            ss = xor32_sum(ss);
            const float rstd = rsqrtf(ss * (1.0f / 128.0f) + EPS) * (1.0f - LAM_INIT0);
            u16* dst = (u16*)(p.ws + WS_HB) + (size_t)(out_row0 + e_g * 64 + rg * 32 + e_l31) * 1024 + 512 + h * 128;
#pragma unroll
            for (int vb = 0; vb < 4; ++vb)
#pragma unroll
                for (int gq = 0; gq < 4; ++gq) {
                    const int v0 = vb * 32 + 8 * gq + 4 * e_hh;
                    const f32x4 gn = *(const f32x4*)(snl + v0);
                    u32x2 w; w.x = pk2(O[rg][vb][4 * gq] * rstd * gn[0], O[rg][vb][4 * gq + 1] * rstd * gn[1]); w.y = pk2(O[rg][vb][4 * gq + 2] * rstd * gn[2], O[rg][vb][4 * gq + 3] * rstd * gn[3]);
                    *(u32x2*)(dst + v0) = w;
                }
        }
    }
}
DI void phase_attn(const Ctx& p, uchar* lds) {
    const int tid = tid_opaque();
    if (tid < 128) ((float*)(lds + 131072))[tid] = inp(p, I_SUBN)[tid];
    for (int u = blockIdx.x; u < (gridDim.x == 256 ? 256 : 264); u += gridDim.x) {
        const bool lat = u < 256;
        const int bh = u & 7, qb = u >> 3;
        attn_unit(p, lds, bh, lat ? qb * 256 : SEQ, lat ? 0 : SEQ, lat ? 132 : 4, lat ? (bh >> 2) * SEQ + qb * 256 : NL + (bh >> 2) * CTXL);
    }
    {
        const u16* zc = (const u16*)(p.ws + WS_REGA + RA_ZC);
        u16* hb = (u16*)(p.ws + WS_HB);
        const int tid2 = tid_opaque(), lane = tid2 & 63, wid = tid2 >> 6, c8 = lane * 8;
        float w0[8], w1[8], w2[8], bias[8];
        {
            const float* cw = inp(p, I_EVCW) + c8; const float* cb = inp(p, I_EVCB) + c8;
#pragma unroll
            for (int h = 0; h < 2; ++h) {
                const f32x4 a = *(const f32x4*)(cw + 4 * h), b = *(const f32x4*)(cw + 512 + 4 * h), c = *(const f32x4*)(cw + 1024 + 4 * h), d = *(const f32x4*)(cb + 4 * h);
#pragma unroll
                for (int e = 0; e < 4; ++e) { w0[4 * h + e] = a[e]; w1[4 * h + e] = b[e]; w2[4 * h + e] = c[e]; bias[4 * h + e] = d[e]; }
            }
        }
        auto unpack8 = [](const u32x4& v, float (&f)[8]) { f[0] = blo(v.x); f[1] = bhi(v.x); f[2] = blo(v.y); f[3] = bhi(v.y); f[4] = blo(v.z); f[5] = bhi(v.z); f[6] = blo(v.w); f[7] = bhi(v.w); };
        for (int u = blockIdx.x; u < 256; u += gridDim.x) {
            const int rb = u * 66 + wid * 9, nr = wid < 7 ? 9 : 3;
            u32x4 cc[11], cx[11], cg[9];
#pragma unroll
            for (int j = 0; j < 11; ++j) {
                int row = rb - 1 + j; row = row < 0 ? 0 : (row >= R ? R - 1 : row);
                cc[j] = *(const u32x4*)(zc + (size_t)row * 1536 + 512 + c8); cx[j] = *(const u32x4*)(zc + (size_t)row * 1536 + 1024 + c8);
            }
#pragma unroll
            for (int i = 0; i < 9; ++i) { const int row = rb + i < R ? rb + i : R - 1; cg[i] = *(const u32x4*)(zc + (size_t)row * 1536 + c8); }
            float pm[8], pc[8], pn[8];
            { float a[8], b[8]; unpack8(cc[0], a); unpack8(cx[0], b);
#pragma unroll
              for (int e = 0; e < 8; ++e) pm[e] = a[e] * b[e];
              unpack8(cc[1], a); unpack8(cx[1], b);
#pragma unroll
              for (int e = 0; e < 8; ++e) pc[e] = a[e] * b[e]; }
#pragma unroll
            for (int i = 0; i < 9; ++i) {
                { float a[8], b[8]; unpack8(cc[i + 2], a); unpack8(cx[i + 2], b);
#pragma unroll
                  for (int e = 0; e < 8; ++e) pn[e] = a[e] * b[e]; }
                const int r = rb + i;
                const bool first = r < NL ? (r & 8191) == 0 : ((r - NL) & 255) == 0, last = r < NL ? (r & 8191) == 8191 : ((r - NL) & 255) == 255;
                if (i < nr) {
                    float g[8], o[8]; unpack8(cg[i], g);
#pragma unroll
                    for (int e = 0; e < 8; ++e) o[e] = g[e] * (bias[e] + w0[e] * (first ? 0.f : pm[e]) + w1[e] * pc[e] + w2[e] * (last ? 0.f : pn[e]));
                    u32x4 wv; wv.x = pk2(o[0], o[1]); wv.y = pk2(o[2], o[3]); wv.z = pk2(o[4], o[5]); wv.w = pk2(o[6], o[7]);
                    *(u32x4*)(hb + (size_t)r * 1024 + c8) = wv;
                }
#pragma unroll
                for (int e = 0; e < 8; ++e) { pm[e] = pc[e]; pc[e] = pn[e]; }
            }
        }
    }
}

DI void phase_outproj(const Params& P, const Ctx& p, uchar* lds, int layer) {
    const int tid = tid_opaque();
    const u16* hb = (const u16*)(p.ws + WS_HB);
    const u16* w = (const u16*)(p.ws + (layer == 0 ? WS_WOUT0 : WS_WOUT1));
    float* xs = (float*)(p.ws + WS_XS);
    const float* mod = (const float*)(p.ws + WS_MOD);
    const int nbig = 256, nunits = nbig + (layer == 0 ? 16 : 0);
    const bool ctx_split = layer == 0 && gridDim.x == 256;
    unsigned* ctxf = (unsigned*)(p.ws + WS_CTL + CTL_CTXF);
    if (ctx_split && blockIdx.x >= 248) {
        if (tid < 128) ((float*)(lds + 131072))[tid] = inp(p, I_SUBN)[tid];
        const int bh = blockIdx.x - 248;
        attn_unit(p, lds, bh, SEQ, SEQ, 4, NL + (bh >> 2) * CTXL);
        asm volatile("s_waitcnt vmcnt(0)" ::: "memory");
        __syncthreads();
        if (tid_opaque() == 0) { __builtin_amdgcn_fence(__ATOMIC_RELEASE, "agent"); asm volatile("s_waitcnt vmcnt(0)" ::: "memory"); (void)xb_add(ctxf, 1u); }
    }
    bool ctx_ready = !ctx_split;
    for (int u = blockIdx.x; u < nunits; u += gridDim.x) {
        const bool big = u < nbig;
        if (!big && !ctx_ready) {
            if (tid_opaque() == 0) { unsigned sp = 0; while (xb_ld(ctxf) < 8u && ++sp < (1u << 22)) __builtin_amdgcn_s_sleep(2); __builtin_amdgcn_fence(__ATOMIC_ACQUIRE, "agent"); asm volatile("s_waitcnt vmcnt(0)" ::: "memory"); }
            __syncthreads();
            ctx_ready = true;
        }
        int mt, nt; if (big) rect_unit(u, 64, 4, mt, nt); else { mt = (u - nbig) >> 2; nt = u & 3; }
        const int m0 = big ? mt * 256 : NL + mt * 128, n0 = nt * 256;
        auto epi_body =
            [&](int roff, int wc, int lane, uchar* w) {
                const int row0 = m0 + roff, nw = n0 + wc * 64;
                const float* g1 = mod + (layer * 3 + mod_row(row0)) * 6144 + 2048 + nw;
                const float* src = row_src(p, layer, row0) + nw;
                f32x4 xi[16], gg = *(const f32x4*)(g1 + (lane & 15) * 4);
#pragma unroll
                for (int it = 0; it < 16; ++it) xi[it] = *(const f32x4*)(src + (size_t)(it * 4 + (lane >> 4)) * 1024 + (lane & 15) * 4);
#pragma unroll
                for (int it = 0; it < 16; ++it) {
                    const int row = it * 4 + (lane >> 4), col = (lane & 15) * 4;
                    const f32x4 v = *(const f32x4*)(w + row * EPI_PITCH + col * 4);
                    f32x4 o;
#pragma unroll
                    for (int e = 0; e < 4; ++e) o[e] = xi[it][e] + gg[e] * v[e];
                    *(f32x4*)(xs + (size_t)(row0 + row) * 1024 + nw + col) = o;
                }
            };
        auto epi = [&](f32x16 (&acc)[2][2], int roff, int wc, int lane, uchar* w) { epi_stage(w, acc, lane & 31, lane >> 5); epi_body(roff, wc, lane, w); };
        if (big) {
            int r0, c; p8_rc(tid, r0, c);
            const unsigned ao = (unsigned)(r0 * 2048 + c * 2), bo = (unsigned)((((r0 >> 5) * 64 + (r0 & 31)) * 2048) + c * 2);
            gemm_tile8p(lds, (const uchar*)(hb + (size_t)m0 * 1024), ao, ao, ao, ao, 128 * 2048, 64 * 2048, 192 * 2048,
                        (const uchar*)(w + (size_t)n0 * 1024), bo, 128 * 2048, 32 * 2048, 160 * 2048, 16, 1 << 30, 0, epi_body);
        } else {
            const int rs = tid >> 3;
            const u16* ab = hb + (size_t)(m0 + rs) * 1024;
            const u16* bb = w + (size_t)(n0 + rs) * 1024;
            gemm_tile(lds, ab, ab + 64 * 1024, bb, bb + 64 * 1024, bb + 128 * 1024, bb + 192 * 1024, 16, 1 << 30, 0, epi);
        }
    }
    if (layer == 0) {
        if (ctx_split) { if (blockIdx.x >= 16 && blockIdx.x < 248) cvt_list(P, lds, MOE_CVT_TILES / 2 + ((int)blockIdx.x - 16), 232, MOE_CVT_TILES, [&](int idx, int& j, int& t) { j = 6 + (idx >> 11); t = (idx & 2047); }); }
        else tail_cvt_moe(P, lds, nunits, 0, MOE_CVT_TILES / 2, MOE_CVT_TILES);
    }
}

struct TileInfo { int bucket, mt, cnt, ntiles; };
DI int moe_ntiles(const int* cnt) { int s = 0; for (int b = 0; b < 24; ++b) s += (cnt[b * 32] + 127) >> 7; return s; }
DI TileInfo moe_tile(const int* cnt, int t) {
    TileInfo ti; ti.bucket = 0; ti.mt = 0; ti.cnt = 0; ti.ntiles = 0;
    int base = 0;
    for (int b = 0; b < 24; ++b) { const int c = cnt[b * 32], n = (c + 127) >> 7; if (t >= base && t < base + n) { ti.bucket = b; ti.mt = t - base; ti.cnt = c; } base += n; }
    ti.ntiles = base; return ti;
}
DI void bucket_experts(int bucket, int& ea, int& eb) {
    const int g = bucket / 6, pi = bucket - g * 6;
    const int lo = pi < 3 ? 0 : (pi < 5 ? 1 : 2), hi = pi < 3 ? pi + 1 : (pi < 5 ? pi - 1 : 3);
    ea = g * 4 + lo; eb = g * 4 + hi;
}
struct MoeUnit { int bucket, t, mt, cnt, big, nt; };
typedef const volatile LAS int* lcnt_t;
DI int moe_units(lcnt_t cnt, int NT, int G, int& B, int& NBIG) {
    int b2 = 0, s1 = 0;
    for (int b = 0; b < 24; ++b) { const int n = (cnt[b] + 127) >> 7; b2 += n >> 1; s1 += n & 1; }
    B = b2;
    const int cand = b2 * NT;
    int best = 1 << 30; NBIG = 0;
    for (int k = 0; k <= (cand + G - 1) / G; ++k) {
        const int nb = k * G < cand ? k * G : cand, U = 2 * cand + s1 * NT - nb;
        const int rb = (nb + G - 1) / G, ru = (U + G - 1) / G, cost = rb * 7 + (ru - rb) * 5;
        if (cost < best) { best = cost; NBIG = nb; }
    }
    return 2 * cand + s1 * NT - NBIG;
}
DI MoeUnit moe_unit(lcnt_t cnt, int u, int NT, int B, int NBIG) {
    const int sh = NT == 8 ? 3 : 2;
    int kind, idx, half = 0, nt;
    if (u < NBIG) {
        kind = 0; idx = u >> sh; nt = u & (NT - 1);
        if (gridDim.x == 256 && u < (NBIG & ~255)) { const int r = u >> 8, b = u & 255, x = b & 7, y = b >> 3; idx = (r << (8 - sh)) + x * (32 >> sh) + (y >> sh); nt = y & (NT - 1); }
    }
    else {
        int v = u - NBIG; const int npl = B - (NBIG >> sh);
        if (v < npl * 2 * NT) { kind = 1; idx = (NBIG >> sh) + (v >> (sh + 1)); half = (v >> sh) & 1; nt = v & (NT - 1); }
        else { v -= npl * 2 * NT; kind = 2; idx = v >> sh; nt = v & (NT - 1); }
    }
    MoeUnit r; r.bucket = 0; r.t = 0; r.mt = 0; r.cnt = 0; r.big = kind == 0; r.nt = nt;
    int pb = 0, ps = 0, pt = 0;
    for (int b = 0; b < 24; ++b) {
        const int c = cnt[b], n = (c + 127) >> 7, np = n >> 1, sg = n & 1;
        if (kind != 2) { if (idx >= pb && idx < pb + np) { r.bucket = b; r.mt = 2 * (idx - pb) + half; r.t = pt + r.mt; r.cnt = c; } }
        else if (sg && idx == ps) { r.bucket = b; r.mt = n - 1; r.t = pt + n - 1; r.cnt = c; }
        pb += np; ps += sg; pt += n;
    }
    return r;
}
constexpr int MOE_TOK = 3 * GEMM_STAGE;
DI void phase_moe_up(const Params& P, const Ctx& p, uchar* lds, int layer) {
    const int tid = tid_opaque();
    const int* cnt = (const int*)(p.ws + WS_CTL + CTL_CNT) + layer * 1024;
    const int* list = (const int*)(p.ws + WS_LIST);
    const f32x2* route = (const f32x2*)(p.ws + WS_ROUTE);
    const u16* hb = (const u16*)(p.ws + WS_HB);
    const u16* wgu = (const u16*)(p.ws + WS_WGU) + (size_t)layer * 16 * 1024 * 1024;
    u16* act = (u16*)(p.ws + WS_REGA + RA_ACT);
    int* tok = (int*)(lds + MOE_TOK);
    const int rs = tid >> 3;
    lcnt_t lc = (lcnt_t)(smem + 640);
    __syncthreads();
    if (tid < 24) ((volatile LAS int*)(smem + 640))[tid] = cnt[tid * 32];
    __syncthreads();
    int B, NBIG;
    const int U = moe_units(lc, 8, gridDim.x, B, NBIG);
    for (int u = blockIdx.x; u < U; u += gridDim.x) {
        const MoeUnit mu = moe_unit(lc, u, 8, B, NBIG);
        const int nt = mu.nt;
        int ea, eb; bucket_experts(mu.bucket, ea, eb);
        __syncthreads();
        if (tid < (mu.big ? 256 : 128)) { const int pos = mu.mt * 128 + tid; tok[tid] = list[(size_t)mu.bucket * R + (pos < mu.cnt ? pos : 0)]; }
        __syncthreads();
        const int e = nt < 4 ? ea : eb;
        auto epi_body =
            [&](int roff, int wc, int lane, uchar* w) {
                u16* dst = act + ((size_t)mu.t * 128 + roff) * 1024 + (nt >= 4 ? 512 : 0) + (nt & 3) * 128 + wc * 32;
                const int col = (lane & 3) * 8;
                f32x2 rw[4];
#pragma unroll
                for (int it = 0; it < 4; ++it) rw[it] = route[tok[roff + it * 16 + (lane >> 2)]];
#pragma unroll
                for (int it = 0; it < 4; ++it) {
                    const int row = it * 16 + (lane >> 2);
                    const float wgt = nt < 4 ? rw[it].x : rw[it].y;
                    const uchar* wp = w + row * EPI_PITCH + col * 4;
                    const f32x4 g0 = *(const f32x4*)wp, g1 = *(const f32x4*)(wp + 16), u0 = *(const f32x4*)(wp + 128), u1 = *(const f32x4*)(wp + 144);
                    f32x4 o0, o1;
#pragma unroll
                    for (int e2 = 0; e2 < 4; ++e2) { o0[e2] = g0[e2] * sigmoidf_(g0[e2]) * u0[e2] * wgt; o1[e2] = g1[e2] * sigmoidf_(g1[e2]) * u1[e2] * wgt; }
                    *(u32x4*)(dst + (size_t)row * 1024 + col) = pack8(o0, o1);
                }
            };
        if (mu.big) {
            int r0, c; p8_rc(tid, r0, c);
            const unsigned bo = (unsigned)((((r0 >> 5) * 64 + (r0 & 31)) * 2048) + c * 2);
            const unsigned a00 = (unsigned)tok[r0] * 2048u + c * 2, a10 = (unsigned)tok[128 + r0] * 2048u + c * 2, a01 = (unsigned)tok[64 + r0] * 2048u + c * 2, a11 = (unsigned)tok[192 + r0] * 2048u + c * 2;
            gemm_tile8p(lds, (const uchar*)hb, a00, a10, a01, a11, 0, 0, 0,
                        (const uchar*)(wgu + ((size_t)e * 1024 + (nt & 3) * 256) * 1024), bo, 128 * 2048, 32 * 2048, 160 * 2048, 16, 1 << 30, 0, epi_body);
        } else {
            const u16* a0 = hb + (size_t)tok[rs] * 1024;
            const u16* a1 = hb + (size_t)tok[rs + 64] * 1024;
            const u16* bb = wgu + ((size_t)e * 1024 + (nt & 3) * 256 + rs) * 1024;
            gemm_tile(lds, a0, a1, bb, bb + 64 * 1024, bb + 128 * 1024, bb + 192 * 1024, 16, 1 << 30, 0,
                [&](f32x16 (&acc)[2][2], int roff, int wc, int lane, uchar* w) { epi_stage(w, acc, lane & 31, lane >> 5); epi_body(roff, wc, lane, w); });
        }
    }
    if (layer == 0) tail_cvt_dense(P, lds, U, P.jobs[2].tile0, P.jobs[6].tile0);
}
DI void phase_moe_down(const Params& P, const Ctx& p, uchar* lds, int layer) {
    const int tid = tid_opaque();
    const int* cnt = (const int*)(p.ws + WS_CTL + CTL_CNT) + layer * 1024;
    const int* list = (const int*)(p.ws + WS_LIST);
    const u16* wd = (const u16*)(p.ws + WS_WD) + (size_t)layer * 16 * 1024 * 512;
    const u16* act = (const u16*)(p.ws + WS_REGA + RA_ACT);
    float* xs = (float*)(p.ws + WS_XS);
    float* dsto = layer == 0 ? xs : p.out;
    const float* mod = (const float*)(p.ws + WS_MOD);
    int* tok = (int*)(lds + MOE_TOK);
    const int rs = tid >> 3;
    lcnt_t lc = (lcnt_t)(smem + 640);
    __syncthreads();
    if (tid < 24) ((volatile LAS int*)(smem + 640))[tid] = cnt[tid * 32];
    __syncthreads();
    int B, NBIG;
    const int U = moe_units(lc, 4, gridDim.x, B, NBIG);
    for (int u = blockIdx.x; u < U; u += gridDim.x) {
        const MoeUnit mu = moe_unit(lc, u, 4, B, NBIG);
        const int nt = mu.nt, n0 = nt * 256;
        int ea, eb; bucket_experts(mu.bucket, ea, eb);
        __syncthreads();
        if (tid < (mu.big ? 256 : 128)) { const int pos = mu.mt * 128 + tid; tok[tid] = pos < mu.cnt ? list[(size_t)mu.bucket * R + pos] : -1; }
        __syncthreads();
        const long bjump = (long)(eb - ea) * 1024 * 512 - 512;
        auto epi_body =
            [&](int roff, int wc, int lane, uchar* w) {
                const int nw = n0 + wc * 64 + (lane & 15) * 4;
                int tk[16]; f32x4 xi[16], g3[3];
#pragma unroll
                for (int q = 0; q < 3; ++q) g3[q] = *(const f32x4*)(mod + (layer * 3 + q) * 6144 + 5 * 1024 + nw);
#pragma unroll
                for (int it = 0; it < 16; ++it) {
                    tk[it] = tok[roff + it * 4 + (lane >> 4)];
                    xi[it] = (f32x4){0.f, 0.f, 0.f, 0.f};
                    if (tk[it] >= 0) xi[it] = *(const f32x4*)(xs + (size_t)tk[it] * 1024 + nw);
                }
#pragma unroll
                for (int it = 0; it < 16; ++it) {
                    const int row = it * 4 + (lane >> 4);
                    if (tk[it] >= 0) {
                        const int mr = mod_row(tk[it]);
                        const f32x4 gg = mr == 0 ? g3[0] : (mr == 1 ? g3[1] : g3[2]);
                        const f32x4 v = *(const f32x4*)(w + row * EPI_PITCH + (lane & 15) * 16);
                        f32x4 o;
#pragma unroll
                        for (int e = 0; e < 4; ++e) o[e] = xi[it][e] + gg[e] * v[e];
                        *(f32x4*)(dsto + (size_t)tk[it] * 1024 + nw) = o;
                    }
                }
            };
        if (mu.big) {
            int r0, c; p8_rc(tid, r0, c);
            const unsigned ao = (unsigned)(r0 * 2048 + c * 2), bo = (unsigned)((((r0 >> 5) * 64 + (r0 & 31)) * 1024) + c * 2);
            gemm_tile8p(lds, (const uchar*)(act + (size_t)mu.t * 128 * 1024), ao, ao, ao, ao, 128 * 2048, 64 * 2048, 192 * 2048,
                        (const uchar*)(wd + ((size_t)ea * 1024 + n0) * 512), bo, 128 * 1024, 32 * 1024, 160 * 1024, 16, 8, bjump * 2, epi_body);
        } else {
            const u16* ab = act + ((size_t)mu.t * 128 + rs) * 1024;
            const u16* bb = wd + ((size_t)ea * 1024 + n0 + rs) * 512;
            gemm_tile(lds, ab, ab + 64 * 1024, bb, bb + 64 * 512, bb + 128 * 512, bb + 192 * 512, 16, 8, bjump,
                [&](f32x16 (&acc)[2][2], int roff, int wc, int lane, uchar* w) { epi_stage(w, acc, lane & 31, lane >> 5); epi_body(roff, wc, lane, w); });
        }
    }
    if (layer == 0) tail_cvt_moe(P, lds, U, 1, 0, MOE_CVT_TILES / 2);
}

DI void phase_inproj1(const Params& P, const Ctx& p, uchar* lds) {
    const int tid = tid_opaque();
    const u16* hb = (const u16*)(p.ws + WS_HB);
    const u16* w = (const u16*)(p.ws + WS_WIN1);
    u16* yb = (u16*)(p.ws + WS_REGA + RA_Y);
    u16* ub = (u16*)(p.ws + WS_REGA + RA_U);
    const int rs = tid >> 3;
    for (int u = blockIdx.x; u < 512 + 16; u += gridDim.x) {
        const bool big = u < 512;
        int mt, nt; if (big) rect_unit(u, 64, 8, mt, nt); else { mt = (u - 512) >> 2; nt = 4 + ((u - 512) & 3); }
        const int m0 = big ? mt * 256 : NL + mt * 128, n0 = nt * 256;
        auto epi_body =
            [&](int roff, int wc, int lane, uchar* w) {
                const int row0 = m0 + roff, nw = n0 + wc * 64;
                if (nt < 4) {
                    epi_rows8<64>(w, lane, [&](int row, int col, const f32x4& v0, const f32x4& v1) {
                        f32x4 a, b2;
#pragma unroll
                        for (int e = 0; e < 4; ++e) { const float x = v0[e], y = v1[e]; a[e] = x * sigmoidf_(1.5957691216057308f * (x + 0.044715f * x * x * x)); b2[e] = y * sigmoidf_(1.5957691216057308f * (y + 0.044715f * y * y * y)); }
                        *(u32x4*)(yb + (size_t)(row0 + row) * 1024 + nw + col) = pack8(a, b2); });
                } else {
                    epi_rows8<64>(w, lane, [&](int row, int col, const f32x4& v0, const f32x4& v1) { *(u32x4*)(ub + (size_t)(row0 + row) * 1024 + nw - 1024 + col) = pack8(v0, v1); });
                }
            };
        if (big) {
            int r0, c; p8_rc(tid, r0, c);
            const unsigned ao = (unsigned)(r0 * 2048 + c * 2), bo = (unsigned)((((r0 >> 5) * 64 + (r0 & 31)) * 2048) + c * 2);
            gemm_tile8p(lds, (const uchar*)(hb + (size_t)m0 * 1024), ao, ao, ao, ao, 128 * 2048, 64 * 2048, 192 * 2048,
                        (const uchar*)(w + (size_t)n0 * 1024), bo, 128 * 2048, 32 * 2048, 160 * 2048, 16, 1 << 30, 0, epi_body);
        } else {
            const u16* ab = hb + (size_t)(m0 + rs) * 1024;
            const u16* bb = w + (size_t)(n0 + rs) * 1024;
            gemm_tile(lds, ab, ab + 64 * 1024, bb, bb + 64 * 1024, bb + 128 * 1024, bb + 192 * 1024, 16, 1 << 30, 0,
                [&](f32x16 (&acc)[2][2], int roff, int wc, int lane, uchar* w) { epi_stage(w, acc, lane & 31, lane >> 5); epi_body(roff, wc, lane, w); });
        }
    }
    tail_cvt_moe(P, lds, 512 + 16, 1, MOE_CVT_TILES / 2, MOE_CVT_TILES);
}

constexpr int LRU_U = 0, LRU_UC = 36864, UROW = 272, UC_BLK = 64 * UROW  , UC_DIR = 2 * UC_BLK;
DI int lru_perm(int r) { return ((r >> 2) & 1) * 16 + (r >> 3) * 4 + (r & 3); }
DI unsigned* lru_bsave(const Ctx& p, int dir, int c, int cblk, int wid) {
    unsigned* base = (unsigned*)(p.ws + (dir == 0 ? WS_REGA + RA_BS0 : WS_WGU));
    return base + ((size_t)(c * 4 + cblk) * 8 + wid) * 1024;
}
DI u32x4* lru_osave(const Ctx& p, int dir, int c, int cblk, int wid, int q, int lane) {
    if (dir == 0) return (u32x4*)(p.ws + WS_HB + ((size_t)(c * 64 + (wid * 4 + q) * 2 + (lane >> 5)) * 2048 + cblk * 512 + (lane & 31) * 16));
    uchar* base = p.ws + (c < 128 ? WS_WD : WS_OM1B);
    return (u32x4*)(base + ((size_t)((c & 127) * 4 + cblk) * 32768 + ((wid * 4 + q) * 64 + lane) * 16));
}
struct LruW { bf16x8 fa[8], fx[8]; };
DI void lru_wload(const Ctx& p, int dir, int cblk, int wid, int lane, LruW& w, int which = 3) {
    const int l31 = lane & 31, hh = lane >> 5, bl = wid >> 2, jq = wid & 3, blkg = cblk * 2 + bl;
    const u16* wa = (const u16*)(p.ws + WS_WA) + ((size_t)(dir * 8 + blkg) * 128 + jq * 32 + l31) * 128 + hh * 8;
    const u16* wx = (const u16*)(p.ws + WS_WX) + ((size_t)(dir * 8 + blkg) * 128 + jq * 32 + l31) * 128 + hh * 8;
    if (which & 1) {
#pragma unroll
        for (int ks = 0; ks < 8; ++ks) w.fa[ks] = *(const bf16x8*)(wa + ks * 16);
    }
    if (which & 2) {
#pragma unroll
        for (int ks = 0; ks < 8; ++ks) w.fx[ks] = *(const bf16x8*)(wx + ks * 16);
    }
    __builtin_amdgcn_sched_barrier(0);
}
template <class Hook, class Hook2>
DI void lru_gates(const Ctx& p, const uchar* lds, int dir, int cblk, int wid, int lane, const LruW& w, float (&a)[2][16], float (&b)[2][16], unsigned* bsave, Hook&& hook, Hook2&& hook2) {
    const int l31 = lane & 31, hh = lane >> 5, bl = wid >> 2, jq = wid & 3;
    const int chl = bl * 128 + jq * 32 + l31;
    const int ch = cblk * 256 + chl;
    const uchar* uc = lds + LRU_UC + dir * UC_DIR + bl * UC_BLK;
    f32x16 dr[2], di[2];
#pragma unroll
    for (int rb = 0; rb < 2; ++rb)
#pragma unroll
        for (int i = 0; i < 16; ++i) { dr[rb][i] = 0.f; di[rb][i] = 0.f; }
    const int tk = lru_perm(l31);
#pragma unroll
    for (int ks = 0; ks < 8; ++ks) {
#pragma unroll
        for (int rb = 0; rb < 2; ++rb) dr[rb] = MFMA32(*(const bf16x8*)(uc + (rb * 32 + tk) * UROW + ks * 32 + hh * 16), w.fa[ks], dr[rb]);
    }
#pragma unroll
    for (int ks = 0; ks < 8; ++ks) {
#pragma unroll
        for (int rb = 0; rb < 2; ++rb) di[rb] = MFMA32(*(const bf16x8*)(uc + (rb * 32 + tk) * UROW + ks * 32 + hh * 16), w.fx[ks], di[rb]);
    }
    __builtin_amdgcn_sched_barrier(0);
    hook();
    const float nl2 = -1.4426950408889634f;
    const float kba = inp(p, I_ODBA)[dir * 1024 + ch] * nl2, kbx = inp(p, I_ODBX)[dir * 1024 + ch] * nl2;
    const float sp8 = 8.0f * log1pf(__expf(-inp(p, I_ODLAM)[dir * 1024 + ch]));
    const float c1 = sp8 * nl2;
    const int cofs = (jq * 32 + l31) * 2;
#pragma unroll
    for (int rb = 0; rb < 2; ++rb)
#pragma unroll
        for (int i = 0; i < 16; ++i) {
            const int token = rb * 32 + hh * 16 + i;
            const float r = frcp(1.0f + __builtin_amdgcn_exp2f(__builtin_fmaf(dr[rb][i], nl2, kba)));
            const float av = __builtin_amdgcn_exp2f(c1 * r);
            a[rb][i] = av;
            const float om = __builtin_fmaf(-av, av, 1.0f);
            const float ucv = b2f(*(const u16*)(uc + token * UROW + cofs));
            const float ig = frcp(1.0f + __builtin_amdgcn_exp2f(__builtin_fmaf(di[rb][i], nl2, kbx)));
            b[rb][i] = __builtin_amdgcn_sqrtf(om) * (ig * ucv);
        }
    __builtin_amdgcn_sched_barrier(0);
    hook2();
    if (bsave) {
#pragma unroll
        for (int q = 0; q < 4; ++q) {
            u32x4 v;
#pragma unroll
            for (int e = 0; e < 4; ++e) { const int j = q * 4 + e, rb = j >> 3, i = (j & 7) * 2; v[e] = pk2(b[rb][i], b[rb][i + 1]); }
            ((u32x4*)bsave)[q * 64 + lane] = v;
        }
    }
}
constexpr int LRU_U2 = 106496;
DI void lru_seq(int c, int& s0, int& s1) { if (c < 256) { s0 = (c >> 7) * SEQ; s1 = s0 + SEQ; } else { s0 = NL + ((c - 256) >> 2) * CTXL; s1 = s0 + CTXL; } }
DI void lru_dma(const Ctx& p, uchar* lds, int c, int cblk, int buf) {
    const int tid = tid_opaque(), lane = tid & 63, wid = tid >> 6;
    const u16* ub = (const u16*)(p.ws + WS_REGA + RA_U);
    int s0, s1; lru_seq(c, s0, s1);
    const int w0 = __builtin_amdgcn_readfirstlane(wid);
    uchar* dst = lds + (buf ? LRU_U2 : LRU_U);
#pragma unroll
    for (int k = 0; k < 5; ++k) {
        const int i = w0 + 8 * k;
        if (i < 35) {
            int row = c * 64 - 3 + 2 * i + (lane >> 5);
            row = row < s0 ? s0 : (row >= s1 ? s1 - 1 : row);
            __builtin_amdgcn_global_load_lds((const unsigned*)(ub + (size_t)row * 1024 + cblk * 256 + (lane & 31) * 8), (LAS unsigned*)(dst + i * 1024), 16, 0, 0);
        }
    }
}
DI void lru_conv(const Ctx& p, uchar* lds, int c, int cblk, int buf, bool counted = false) {
    const int tid = tid_opaque();
    const int row0 = c * 64;
    int s0, s1; lru_seq(c, s0, s1);
    const uchar* ut = lds + (buf ? LRU_U2 : LRU_U);
    if (counted) WAIT_V(8); else WAIT_V(0);
    __syncthreads();
    const int c8 = tid & 31, tq = tid >> 5, t0 = tq * 4;
    float uv[10][8];
#pragma unroll
    for (int rr = 0; rr < 10; ++rr) {
        u32x4 v = *(const u32x4*)(ut + (t0 + rr) * 512 + c8 * 16);
        const int row = row0 - 3 + t0 + rr;
        if (row < s0 || row >= s1) v = (u32x4){0u, 0u, 0u, 0u};
        uv[rr][0] = blo(v.x); uv[rr][1] = bhi(v.x); uv[rr][2] = blo(v.y); uv[rr][3] = bhi(v.y); uv[rr][4] = blo(v.z); uv[rr][5] = bhi(v.z); uv[rr][6] = blo(v.w); uv[rr][7] = bhi(v.w);
    }
#pragma unroll
    for (int dir = 0; dir < 2; ++dir) {
        const float* cw = inp(p, I_ODCW) + dir * 4096 + cblk * 256 + c8 * 8;
        const float* cb = inp(p, I_ODCB) + dir * 1024 + cblk * 256 + c8 * 8;
        float w[4][8], bs[8];
#pragma unroll
        for (int k = 0; k < 4; ++k) { const f32x4 x0 = *(const f32x4*)(cw + k * 1024), x1 = *(const f32x4*)(cw + k * 1024 + 4); w[k][0] = x0[0]; w[k][1] = x0[1]; w[k][2] = x0[2]; w[k][3] = x0[3]; w[k][4] = x1[0]; w[k][5] = x1[1]; w[k][6] = x1[2]; w[k][7] = x1[3]; }
        { const f32x4 x0 = *(const f32x4*)cb, x1 = *(const f32x4*)(cb + 4); bs[0] = x0[0]; bs[1] = x0[1]; bs[2] = x0[2]; bs[3] = x0[3]; bs[4] = x1[0]; bs[5] = x1[1]; bs[6] = x1[2]; bs[7] = x1[3]; }
#pragma unroll
        for (int tt = 0; tt < 4; ++tt) {
            float o[8];
#pragma unroll
            for (int e = 0; e < 8; ++e) {
                float s = bs[e];
#pragma unroll
                for (int k = 0; k < 4; ++k) s += w[k][e] * uv[tt + k + (dir ? 3 : 0)][e];
                o[e] = s;
            }
            const int t = t0 + tt;
            u32x4 wv; wv.x = pk2(o[0], o[1]); wv.y = pk2(o[2], o[3]); wv.z = pk2(o[4], o[5]); wv.w = pk2(o[6], o[7]);
            *(u32x4*)(lds + LRU_UC + dir * UC_DIR + (c8 >> 4) * UC_BLK + t * UROW + (c8 & 15) * 16) = wv;
        }
    }
    __syncthreads();
}
DI void lru_seg(const float (&a)[2][16], const float (&b)[2][16], int dir, int hh, float (&SA)[4], float (&SB)[4]) {
    float oa[2], ob[2];
#pragma unroll
    for (int rb = 0; rb < 2; ++rb) {
        float A = 1.f, B = 0.f;
#pragma unroll
        for (int ii = 0; ii < 16; ++ii) { const int i = dir ? 15 - ii : ii; B = a[rb][i] * B + b[rb][i]; A *= a[rb][i]; }
        oa[rb] = A; ob[rb] = B;
    }
    float pa[2], pb[2];
#pragma unroll
    for (int rb = 0; rb < 2; ++rb) { pa[rb] = __shfl_xor(oa[rb], 32); pb[rb] = __shfl_xor(ob[rb], 32); }
#pragma unroll
    for (int rb = 0; rb < 2; ++rb)
#pragma unroll
        for (int h = 0; h < 2; ++h) {
            const float A = (h == hh) ? oa[rb] : pa[rb], B = (h == hh) ? ob[rb] : pb[rb];
            const int s = dir ? 3 - (rb * 2 + h) : rb * 2 + h;
            SA[s] = A; SB[s] = B;
        }
}
DI void lru_summ_item(int j, int& c, int& cblk, int& role) {
    if (j < 1024) { c = j >> 2; cblk = j & 3; role = -1; } else { const int mini = j - 1024, cu = mini >> 3; c = 256 + (cu >> 2); cblk = cu & 3; role = mini & 7; }
}
template <class F>
DI void lru_summ_wave(const Ctx& p, uchar* lds, int c, int cblk, int role, LruW& w, F&& next_dma) {
    const int tid = tid_opaque(), lane = tid & 63, wid = role < 0 ? (tid >> 6) : role, hh = lane >> 5;
    f32x2* summ = (f32x2*)(p.ws + WS_SUMM);
    const int ch = cblk * 256 + (wid >> 2) * 128 + (wid & 3) * 32 + (lane & 31);
#pragma unroll
    for (int dir = 0; dir < 2; ++dir) {
        float a[2][16], b[2][16];
        unsigned* bs = c < 256 ? lru_bsave(p, dir, c, cblk, wid) : (unsigned*)nullptr;
        if (dir == 0) lru_gates(p, lds, 0, cblk, wid, lane, w, a, b, bs, [&]() { lru_wload(p, 1, cblk, wid, lane, w, 1); }, [&]() { lru_wload(p, 1, cblk, wid, lane, w, 2); });
        else          lru_gates(p, lds, 1, cblk, wid, lane, w, a, b, bs, [&]() { next_dma(); lru_wload(p, 0, cblk, wid, lane, w, 1); }, [&]() { lru_wload(p, 0, cblk, wid, lane, w, 2); });
        if (c < 256) {
#pragma unroll
            for (int q = 0; q < 4; ++q) {
                u32x4 v;
#pragma unroll
                for (int e = 0; e < 4; ++e) { const int j = q * 4 + e, rb = j >> 3, i = (j & 7) * 2; v[e] = pk2(1.0f - a[rb][i], 1.0f - a[rb][i + 1]); }
                *lru_osave(p, dir, c, cblk, wid, q, lane) = v;
            }
        }
        float SA[4], SB[4];
        lru_seg(a, b, dir, hh, SA, SB);
        float A = 1.f, B = 0.f;
#pragma unroll
        for (int s = 0; s < 4; ++s) { B = SA[s] * B + SB[s]; A *= SA[s]; }
        if (hh == 0) summ[((size_t)dir * 264 + c) * 1024 + ch] = (f32x2){A, B};
    }
}
DI void phase_lru_summ(const Ctx& p, uchar* lds) {
    const int tid = tid_opaque(), lane = tid & 63, wid = tid >> 6;
    constexpr int NITEM = 1024 + 32 * 8;
    int c, cblk, role;
    if ((int)blockIdx.x >= NITEM) return;
    lru_summ_item(blockIdx.x, c, cblk, role); lru_dma(p, lds, c, cblk, 0);
    LruW w;
    lru_wload(p, 0, cblk, role < 0 ? wid : role, lane, w);
    int buf = 0;
    bool counted = false;
    for (int j = blockIdx.x; j < NITEM; j += gridDim.x, buf ^= 1) {
        lru_summ_item(j, c, cblk, role);
        lru_conv(p, lds, c, cblk, buf, counted);
        counted = role < 0;
        int c2 = 0, cblk2 = 0, role2 = -1;
        const bool more = j + (int)gridDim.x < NITEM;
        if (more) lru_summ_item(j + gridDim.x, c2, cblk2, role2);
        auto next_dma = [&]() { if (more) lru_dma(p, lds, c2, cblk2, buf ^ 1); };
        if (role < 0) {
            lru_summ_wave(p, lds, c, cblk, -1, w, next_dma);
            if (more && role2 >= 0) lru_wload(p, 0, cblk2, role2, lane, w);
        } else {
            if (wid == 0) lru_summ_wave(p, lds, c, cblk, role, w, next_dma); else next_dma();
            if (more && (cblk2 != cblk || role2 != role)) lru_wload(p, 0, cblk2, role2, lane, w);
        }
    }
    WAIT_V(0);
}
DI void phase_lru_carry(const Ctx& p) {
    const int tid = tid_opaque();
    const f32x2* summ = (const f32x2*)(p.ws + WS_SUMM);
    float* carry = (float*)(p.ws + WS_CARRY);
    for (int g = blockIdx.x * 512 + tid; g < 4096; g += gridDim.x * 512) {
        const int ch = g & 1023, bt = (g >> 10) & 1, dir = g >> 11;
        const f32x2* sd = summ + (size_t)dir * 264 * 1024 + ch;
        float h = 0.f;
        f32x2 s[4];
#pragma unroll
        for (int q = 0; q < 4; ++q) s[q] = sd[(size_t)(256 + bt * 4 + (dir ? 3 - q : q)) * 1024];
#pragma unroll
        for (int q = 0; q < 4; ++q) h = s[q].x * h + s[q].y;
        f32x2 ta[16], tb[16];
#pragma unroll
        for (int q = 0; q < 16; ++q) { const int ci = dir ? 127 - q : q; ta[q] = sd[(size_t)(bt * 128 + ci) * 1024]; }
#pragma unroll 1
        for (int q0 = 0; q0 < 128; q0 += 32) {
#pragma unroll
            for (int q = 0; q < 16; ++q) { const int ci = dir ? 127 - (q0 + 16 + q) : q0 + 16 + q; tb[q] = sd[(size_t)(bt * 128 + ci) * 1024]; }
#pragma unroll
            for (int q = 0; q < 16; ++q) { const int ci = dir ? 127 - (q0 + q) : q0 + q; carry[((size_t)dir * 256 + bt * 128 + ci) * 1024 + ch] = h; h = ta[q].x * h + ta[q].y; }
            if (q0 + 32 < 128) {
#pragma unroll
                for (int q = 0; q < 16; ++q) { const int ci = dir ? 127 - (q0 + 32 + q) : q0 + 32 + q; ta[q] = sd[(size_t)(bt * 128 + ci) * 1024]; }
            }
#pragma unroll
            for (int q = 0; q < 16; ++q) { const int ci = dir ? 127 - (q0 + 16 + q) : q0 + 16 + q; carry[((size_t)dir * 256 + bt * 128 + ci) * 1024 + ch] = h; h = tb[q].x * h + tb[q].y; }
        }
    }
}
DI void phase_lru_scan(const Ctx& p, uchar* lds) {
    const int tid = tid_opaque(), lane = tid & 63, wid = tid >> 6, hh = lane >> 5;
    const u16* yb = (const u16*)(p.ws + WS_REGA + RA_Y);
    u16* hb = (u16*)(p.ws + WS_HB);
    for (int u = blockIdx.x; u < 256 * 4; u += gridDim.x) {
        const int c = u >> 2, cblk = u & 3;
        const int ch = cblk * 256 + (wid >> 2) * 128 + (wid & 3) * 32 + (lane & 31);
        float hsum[2][16];
        __syncthreads();
#pragma unroll
        for (int dir = 0; dir < 2; ++dir) {
            const float h0 = ((const float*)(p.ws + WS_CARRY))[((size_t)dir * 256 + c) * 1024 + ch];
            float a[2][16], b[2][16];
            {
                const unsigned* bs = lru_bsave(p, dir, c, cblk, wid);
                unsigned bw[16], ow[16];
#pragma unroll
                for (int q = 0; q < 4; ++q) {
                    const u32x4 vb = ((const u32x4*)bs)[q * 64 + lane], vo = *lru_osave(p, dir, c, cblk, wid, q, lane);
#pragma unroll
                    for (int e = 0; e < 4; ++e) { bw[q * 4 + e] = vb[e]; ow[q * 4 + e] = vo[e]; }
                }
#pragma unroll
                for (int rb = 0; rb < 2; ++rb)
#pragma unroll
                    for (int i = 0; i < 16; ++i) {
                        const unsigned wb = bw[rb * 8 + (i >> 1)], wo = ow[rb * 8 + (i >> 1)];
                        b[rb][i] = (i & 1) ? bhi(wb) : blo(wb);
                        a[rb][i] = 1.0f - ((i & 1) ? bhi(wo) : blo(wo));
                    }
            }
            float SA[4], SB[4];
            lru_seg(a, b, dir, hh, SA, SB);
            float st[4]; st[0] = h0;
#pragma unroll
            for (int s = 1; s < 4; ++s) st[s] = SA[s - 1] * st[s - 1] + SB[s - 1];
#pragma unroll
            for (int rb = 0; rb < 2; ++rb) {
                const int sidx = dir ? 3 - (rb * 2 + hh) : rb * 2 + hh;
                float h = sidx == 0 ? st[0] : (sidx == 1 ? st[1] : (sidx == 2 ? st[2] : st[3]));
#pragma unroll
                for (int ii = 0; ii < 16; ++ii) { const int i = dir ? 15 - ii : ii; h = a[rb][i] * h + b[rb][i]; if (dir == 0) hsum[rb][i] = h; else hsum[rb][i] += h; }
            }
        }
        __syncthreads();
        {
            const int chl = (wid >> 2) * 128 + (wid & 3) * 32 + (lane & 31);
#pragma unroll
            for (int rb = 0; rb < 2; ++rb)
#pragma unroll
                for (int i = 0; i < 16; ++i) *(float*)(lds + (rb * 32 + hh * 16 + i) * 1040 + chl * 4) = hsum[rb][i];
        }
        __syncthreads();
        u32x4 yv[4];
#pragma unroll
        for (int j = 0; j < 4; ++j) { const int pi = j * 512 + tid, tk = pi >> 5, c8 = pi & 31; yv[j] = *(const u32x4*)(yb + (size_t)(c * 64 + tk) * 1024 + cblk * 256 + c8 * 8); }
#pragma unroll
        for (int j = 0; j < 4; ++j) {
            const int pi = j * 512 + tid, tk = pi >> 5, c8 = pi & 31;
            const f32x4 h0 = *(const f32x4*)(lds + tk * 1040 + c8 * 32), h1 = *(const f32x4*)(lds + tk * 1040 + c8 * 32 + 16);
            const size_t o = (size_t)(c * 64 + tk) * 1024 + cblk * 256 + c8 * 8;
            u32x4 w;
            w.x = pk2(blo(yv[j].x) * h0[0], bhi(yv[j].x) * h0[1]); w.y = pk2(blo(yv[j].y) * h0[2], bhi(yv[j].y) * h0[3]);
            w.z = pk2(blo(yv[j].z) * h1[0], bhi(yv[j].z) * h1[1]); w.w = pk2(blo(yv[j].w) * h1[2], bhi(yv[j].w) * h1[3]);
            *(u32x4*)(hb + o) = w;
        }
    }
}

__global__ void __launch_bounds__(512) fwd_mega(const Params P) {
    uchar* lds = smem + LDS_USER;
    LAS unsigned long long* tab = (LAS unsigned long long*)(smem + 64);
    if (threadIdx.x < N_IN) tab[threadIdx.x] = (unsigned long long)P.in[threadIdx.x];
    if ((threadIdx.x & 63) == 0) ((volatile LAS int*)smem)[96 + hw_slot()] = threadIdx.x >> 6;
    const bool multi = (P.ph_hi - P.ph_lo) > 1;
    if (threadIdx.x == 0) { ((volatile LAS unsigned*)smem)[0] = 0u; ((volatile LAS unsigned*)smem)[1] = 0u; ((volatile LAS unsigned*)smem)[2] = 0u; ((volatile LAS unsigned*)smem)[3] = 0u; }
    __syncthreads();
    if (multi) (void)xcd_barrier_post((unsigned*)(P.ws + WS_CTL), (volatile LAS unsigned*)smem);
#define RUN_PHASE(k, call) if (P.ph_lo <= (k) && (k) < P.ph_hi) { { Ctx p; { unsigned long long wsi = (unsigned long long)P.ws; asm volatile("" : "+s"(wsi)); p.ws = (uchar*)(__attribute__((address_space(1))) uchar*)wsi; } p.out = P.out; p.tab = tab; call; } if ((PROBE_REPS >> (k)) & 1) { { XcdBarrier xb_; xb_.bar = (unsigned*)(P.ws + WS_CTL); xb_.x = xb_xcc_id(); xb_.st = (volatile LAS unsigned*)smem; xcd_barrier(xb_); } Ctx p; { unsigned long long wsi = (unsigned long long)P.ws; asm volatile("" : "+s"(wsi)); p.ws = (uchar*)(__attribute__((address_space(1))) uchar*)wsi; } p.out = P.out; p.tab = tab; call; } if (multi && (k) + 1 < P.ph_hi) { XcdBarrier xb_; xb_.bar = (unsigned*)(P.ws + WS_CTL); xb_.x = xb_xcc_id(); xb_.st = (volatile LAS unsigned*)smem; xcd_barrier(xb_); } }
    RUN_PHASE(0, phase_prep(P, p, lds))
    RUN_PHASE(1, phase_norm(p, 0))
    RUN_PHASE(2, phase_inproj0(P, p, lds))
    RUN_PHASE(3, phase_attn(p, lds))
    RUN_PHASE(4, phase_outproj(P, p, lds, 0))
    RUN_PHASE(5, phase_router(p, lds, 0))
#if PROBE_ROUTER2X
    if (P.ph_lo <= 5 && 5 < P.ph_hi) { Ctx p; { unsigned long long wsi = (unsigned long long)P.ws; asm volatile("" : "+s"(wsi)); p.ws = (uchar*)(__attribute__((address_space(1))) uchar*)wsi; } p.out = P.out; p.tab = tab; phase_router(p, lds, 0, 2); { XcdBarrier xb_; xb_.bar = (unsigned*)(P.ws + WS_CTL); xb_.x = xb_xcc_id(); xb_.st = (volatile LAS unsigned*)smem; xcd_barrier(xb_); } }
#endif
    RUN_PHASE(6, phase_moe_up(P, p, lds, 0))
    RUN_PHASE(7, phase_moe_down(P, p, lds, 0))
    RUN_PHASE(8, phase_norm(p, 1))
    RUN_PHASE(9, phase_inproj1(P, p, lds))
    RUN_PHASE(10, phase_lru_summ(p, lds))
    RUN_PHASE(11, phase_lru_carry(p))
    RUN_PHASE(12, phase_lru_scan(p, lds))
    RUN_PHASE(13, phase_outproj(P, p, lds, 1))
    RUN_PHASE(14, phase_router(p, lds, 1))
    RUN_PHASE(15, phase_moe_up(P, p, lds, 1))
    RUN_PHASE(16, phase_moe_down(P, p, lds, 1))
}

extern "C" void kernel_launch(void* const* d_in, const int* in_sizes, int n_in, void* d_out, int out_size, void* d_ws, size_t ws_size, hipStream_t stream) {
    static int grid = 0;
    if (grid == 0) {
        if (n_in != N_IN || out_size != NL * D || ws_size < WS_END) { fprintf(stderr, "kernel_launch: unexpected shapes (n_in %d, out %d, ws %zu, need %zu)\n", n_in, out_size, ws_size, (size_t)WS_END); grid = -1; return; }
        int dev = 0, cus = 0, per_cu = 0;
        if (hipGetDevice(&dev) != hipSuccess || hipDeviceGetAttribute(&cus, hipDeviceAttributeMultiprocessorCount, dev) != hipSuccess) { grid = -1; return; }
        if (hipFuncSetAttribute((const void*)fwd_mega, hipFuncAttributeMaxDynamicSharedMemorySize, LDS_BYTES) != hipSuccess) { fprintf(stderr, "kernel_launch: hipFuncSetAttribute failed\n"); grid = -1; return; }
        if (hipOccupancyMaxActiveBlocksPerMultiprocessor(&per_cu, (const void*)fwd_mega, 512, LDS_BYTES) != hipSuccess || per_cu < 1) { fprintf(stderr, "kernel_launch: occupancy query says %d\n", per_cu); (void)hipGetLastError(); grid = -1; return; }
        grid = cus;
    }
    if (grid < 0) return;
    if (hipMemsetAsync((char*)d_ws + WS_CTL, 0, CTL_BYTES, stream) != hipSuccess) return;
    Params p{};
    for (int i = 0; i < N_IN; ++i) p.in[i] = (const float*)d_in[i];
    p.out = (float*)d_out; p.ws = (uchar*)d_ws;
    uchar* ws = (uchar*)d_ws;
    int t0 = 0;
    auto job = [&](int j, const float* src, size_t dst_off, int nmat, int K, int N, int sstride, int dstride, int lddst, int mode, int half) {
        CvtJob& J = p.jobs[j]; J.src = src; J.dst = (u16*)(ws + dst_off); J.nmat = nmat; J.K = K; J.N = N; J.sstride = sstride; J.dstride = dstride; J.lddst = lddst; J.mode = mode; J.half = half; J.tile0 = t0; J.pad = 0;
        t0 += nmat * (K / 64) * (N / 64);
    };
    job(0, p.in[I_EVWIN], WS_WIN0, 1, 1024, 3072, 0, 0, 1024, 0, 0);
    job(1, p.in[I_EVWOUT], WS_WOUT0, 1, 1024, 1024, 0, 0, 1024, 0, 0);
    job(2, p.in[I_ODWIN], WS_WIN1, 1, 1024, 2048, 0, 0, 1024, 0, 0);
    job(3, p.in[I_ODWOUT], WS_WOUT1, 1, 1024, 1024, 0, 0, 1024, 0, 0);
    job(4, p.in[I_ODWA], WS_WA, 16, 128, 128, 16384, 16384, 128, 0, 0);
    job(5, p.in[I_ODWX], WS_WX, 16, 128, 128, 16384, 16384, 128, 0, 0);
    job(6, p.in[I_MGATE], WS_WGU, 32, 1024, 512, 524288, 1048576, 1024, 1, 0);
    job(7, p.in[I_MUP], WS_WGU, 32, 1024, 512, 524288, 1048576, 1024, 1, 1);
    job(8, p.in[I_MDOWN], WS_WD, 32, 512, 1024, 524288, 524288, 512, 0, 0);
    p.ncvt = t0;
    const int nl = N_LAUNCHES;
    for (int li = 0; li < nl; ++li) {
        p.ph_lo = li * NPH / nl; p.ph_hi = (li + 1) * NPH / nl;
        hipLaunchKernelGGL(fwd_mega, dim3(grid), dim3(512), LDS_BYTES, stream, p);
    }
}
```

```cpp
#include <hip/hip_runtime.h>
#include <stdint.h>
#include <stdio.h>

#define DI __device__ __forceinline__
#define LAS __attribute__((address_space(3)))
typedef unsigned short u16;
typedef unsigned char uchar;
typedef short bf16x8 __attribute__((ext_vector_type(8)));
typedef float f32x16 __attribute__((ext_vector_type(16)));
typedef float f32x4 __attribute__((ext_vector_type(4)));
typedef float f32x2 __attribute__((ext_vector_type(2)));
typedef __bf16 bf2_t __attribute__((ext_vector_type(2)));
typedef unsigned u32x2 __attribute__((ext_vector_type(2)));
typedef unsigned u32x4 __attribute__((ext_vector_type(4)));

#ifndef N_LAUNCHES
#define N_LAUNCHES 1
#endif
#ifndef PROBE_GEMM2X
#define PROBE_GEMM2X 0
#endif
#ifndef PROBE_ROUTER2X
#define PROBE_ROUTER2X 0
#endif
#ifndef PROBE_REPS
#define PROBE_REPS 0x0000
#endif

DI unsigned pk2(float a, float b) { f32x2 v = {a, b}; bf2_t r = __builtin_convertvector(v, bf2_t); return __builtin_bit_cast(unsigned, r); }
DI u16 f2b(float a) { __bf16 r = (__bf16)a; return __builtin_bit_cast(u16, r); }
DI float b2f(u16 v) { return __uint_as_float(((unsigned)v) << 16); }
DI float blo(unsigned v) { return __uint_as_float(v << 16); }
DI float bhi(unsigned v) { return __uint_as_float(v & 0xffff0000u); }
#define MFMA32(a, b, c) __builtin_amdgcn_mfma_f32_32x32x16_bf16((a), (b), (c), 0, 0, 0)

constexpr int D = 1024, NL = 16384, NC = 512, R = 16896, SEQ = 8192, CTXL = 256, SK = 8448;
constexpr int NPH = 17;
constexpr float EPS = 1e-6f;
constexpr float LAM_INIT0 = 0.2f;
constexpr float QSCALE = 0.125f * 1.4426950408889634f;

enum { I_X = 0, I_C, I_CTX, I_CCTX, I_ADAW, I_ADAB, I_NMIX, I_NFFN, I_EVWIN, I_EVCW, I_EVCB, I_QN, I_KN, I_LQ1, I_LK1, I_LQ2, I_LK2, I_SUBN, I_EVWOUT,
       I_ODWIN, I_ODCW, I_ODCB, I_ODWA, I_ODBA, I_ODWX, I_ODBX, I_ODLAM, I_ODWOUT, I_MWGRP, I_MBGRP, I_MWRT, I_MBRT, I_MGATE, I_MUP, I_MDOWN, N_IN };

constexpr size_t al256(size_t x) { return (x + 255) & ~(size_t)255; }
constexpr size_t WS_CTL   = 0;
constexpr size_t CTL_BYTES = 65536;
constexpr size_t CTL_CTXF = 32768;
constexpr size_t CTL_CNT  = 16384;
constexpr size_t WS_MOD   = WS_CTL + CTL_BYTES;
constexpr size_t WS_ROPE  = WS_MOD + al256(2 * 3 * 6144 * 4);
constexpr size_t WS_ROUTE = WS_ROPE + (size_t)SEQ * 32 * 8;
constexpr size_t WS_LIST  = WS_ROUTE + al256((size_t)R * 8);
constexpr size_t WS_SUMM  = WS_LIST + al256((size_t)24 * R * 4);
constexpr size_t WS_CARRY = WS_SUMM + (size_t)2 * 264 * 1024 * 8;
constexpr size_t WS_WIN0  = WS_CARRY + (size_t)2 * 256 * 1024 * 4;
constexpr size_t WS_WOUT0 = WS_WIN0 + (size_t)3072 * 1024 * 2;
constexpr size_t WS_WIN1  = WS_WOUT0 + (size_t)1024 * 1024 * 2;
constexpr size_t WS_WOUT1 = WS_WIN1 + (size_t)2048 * 1024 * 2;
constexpr size_t WS_WA    = WS_WOUT1 + (size_t)1024 * 1024 * 2;
constexpr size_t WS_WX    = WS_WA + (size_t)2 * 8 * 128 * 128 * 2;
constexpr size_t WS_WGU   = WS_WX + (size_t)2 * 8 * 128 * 128 * 2;
constexpr size_t WS_WD    = WS_WGU + (size_t)2 * 16 * 1024 * 1024 * 2;
constexpr size_t WS_XS    = WS_WD + (size_t)2 * 16 * 1024 * 512 * 2;
constexpr size_t WS_HB    = WS_XS + (size_t)R * 1024 * 4;
constexpr size_t WS_REGA  = WS_HB + (size_t)R * 1024 * 2;
constexpr size_t RA_ZC    = 0;
constexpr size_t RA_Q     = RA_ZC + (size_t)R * 1536 * 2;
constexpr size_t RA_K     = RA_Q + (size_t)16 * SK * 64 * 2;
constexpr size_t RA_VT    = RA_K + (size_t)16 * SK * 64 * 2;
constexpr size_t RA_END0  = RA_VT + (size_t)8 * 128 * SK * 2;
constexpr size_t RA_ACT   = 0;
constexpr size_t RA_Y     = 0;
constexpr size_t RA_U     = RA_Y + (size_t)NL * 1024 * 2;
constexpr size_t RA_BS0   = RA_U + (size_t)R * 1024 * 2;
constexpr size_t WS_OM1B  = WS_REGA + RA_END0;
constexpr size_t WS_END   = WS_OM1B + (size_t)128 * 4 * 32768;
static_assert(RA_BS0 + (size_t)256 * 4 * 8 * 1024 * 4 <= RA_END0 && (size_t)20480 * 1024 * 2 <= RA_END0, "region A overlays");
static_assert((size_t)256 * 4 * 8 * 1024 * 4 <= (size_t)16 * 1024 * 1024 * 2, "b of direction 1 fits layer 0's gate/up weights");
static_assert(WS_END <= 352000000ull, "workspace budget");

constexpr int LDS_BYTES = 147456 + 1024 + 1024;
constexpr int LDS_USER = 1024;

struct CvtJob { const float* src; u16* dst; int nmat, K, N, sstride, dstride, lddst, mode, half, tile0, pad; };
struct Params {
    const float* in[N_IN];
    float* out;
    uchar* ws;
    CvtJob jobs[9];
    int ncvt, ph_lo, ph_hi, pad;
};
struct Ctx { uchar* ws; float* out; const LAS unsigned long long* tab; };
typedef const __attribute__((address_space(1))) float* gcf_t;
DI const float* inp(const Ctx& c, int i) { return (const float*)(gcf_t)c.tab[i]; }

extern __shared__ __attribute__((aligned(16))) uchar smem[];
DI int hw_slot() { return (int)(__builtin_amdgcn_s_getreg(((6 - 1) << 11) | 4) & 63u); }
DI int tid_opaque() {
    const int lane = (int)__builtin_amdgcn_mbcnt_hi(~0u, __builtin_amdgcn_mbcnt_lo(~0u, 0u));
    int w = ((volatile LAS int*)smem)[96 + hw_slot()];
    w = __builtin_amdgcn_readfirstlane(w);
    int t = w * 64 + lane; asm volatile("" : "+v"(t)); return t;
}
#define XB_TMO      128
#define XB_XCNT(j)  (256  + 64 * (j))
#define XB_XSUB(j)  (1280 + 64 * (j))
#define XB_XGEN(j)  (2304 + 64 * (j))
#define XB_TOP      3328
#define XB_TOPGEN   3392
#define XCD_BAR_WORDS 3456
#define XB_SPIN_CAP (1u << 20)
DI unsigned xb_ld(unsigned* p)              { return __hip_atomic_load(p, __ATOMIC_RELAXED, __HIP_MEMORY_SCOPE_AGENT); }
DI unsigned xb_add(unsigned* p, unsigned v) { return __hip_atomic_fetch_add(p, v, __ATOMIC_RELAXED, __HIP_MEMORY_SCOPE_AGENT); }
DI unsigned xb_xcc_id() { return (unsigned)__builtin_amdgcn_s_getreg((3 << 11) | 20) & 0xFu; }
#define XB_SPIN(cond, bar) do { unsigned _sp = 0; while (cond) { __builtin_amdgcn_s_sleep(1); \
    if ((++_sp & 255u) == 0u) { if (xb_ld(&(bar)[XB_TMO])) break; if (_sp > XB_SPIN_CAP) { atomicAdd(&(bar)[XB_TMO], 1u); break; } } } } while (0)
struct XcdBarrier { unsigned* bar; unsigned x; volatile LAS unsigned* st; };
DI XcdBarrier xcd_barrier_post(unsigned* bar, volatile LAS unsigned* st) {
    XcdBarrier b; b.bar = bar; b.x = xb_xcc_id(); b.st = st;
    if (tid_opaque() == 0) (void)xb_add(&bar[XB_XCNT(b.x)], 1u);
    return b;
}
DI void xcd_barrier_complete(unsigned* bar, unsigned x, unsigned& nloc, unsigned& nx) {
    const unsigned G = gridDim.x * gridDim.y * gridDim.z;
    unsigned sum, cnt, mine, sp = 0u;
    for (;;) {
        sum = 0u; cnt = 0u; mine = 0u;
#pragma unroll
        for (unsigned j = 0; j < 16; ++j) { const unsigned c = xb_ld(&bar[XB_XCNT(j)]); sum += c; cnt += (c > 0u) ? 1u : 0u; mine = (j == x) ? c : mine; }
        if (sum == G) break;
        __builtin_amdgcn_s_sleep(1);
        if ((++sp & 255u) == 0u) { if (xb_ld(&bar[XB_TMO])) break; if (sp > XB_SPIN_CAP) { atomicAdd(&bar[XB_TMO], 1u); break; } }
    }
    nloc = mine > 0u ? mine : 1u; nx = cnt > 0u ? cnt : 1u;
}
DI void xcd_barrier(const XcdBarrier& b) {
    asm volatile("s_waitcnt vmcnt(0)" ::: "memory");
    __syncthreads();
    if (tid_opaque() == 0) {
        unsigned* bar = b.bar;
        __builtin_amdgcn_s_waitcnt(0);
        unsigned nloc = b.st[0], nx = b.st[1];
        if (nloc == 0u) { xcd_barrier_complete(bar, b.x, nloc, nx); b.st[0] = nloc; b.st[1] = nx; }
        const unsigned old = xb_add(&bar[XB_XSUB(b.x)], 1u);
        const unsigned gen = old / nloc;
        if (old + 1u == (gen + 1u) * nloc) {
            __builtin_amdgcn_fence(__ATOMIC_RELEASE, "agent");
            asm volatile("s_waitcnt vmcnt(0)" ::: "memory");
            __builtin_amdgcn_fence(__ATOMIC_ACQUIRE, "agent");
            const unsigned og = xb_add(&bar[XB_TOP], 1u);
            const unsigned tg = og / nx;
            if (og + 1u == (tg + 1u) * nx) xb_add(&bar[XB_TOPGEN], 1u);
            else XB_SPIN(xb_ld(&bar[XB_TOPGEN]) == tg, bar);
            xb_add(&bar[XB_XGEN(b.x)], 1u);
            asm volatile("s_waitcnt vmcnt(0)" ::: "memory");
        } else {
            __builtin_amdgcn_fence(__ATOMIC_ACQUIRE, "agent");
            XB_SPIN(xb_ld(&bar[XB_XGEN(b.x)]) == gen, bar);
            asm volatile("s_waitcnt vmcnt(0)" ::: "memory");
        }
    }
    __syncthreads();
}

DI float xor32_sum(float x) {
    const unsigned u = __float_as_uint(x);
    const auto r = __builtin_amdgcn_permlane32_swap(u, u, false, false);
    return __uint_as_float(r[0]) + __uint_as_float(r[1]);
}
#define DPP_ADD(v, ctrl) ((v) + __uint_as_float((unsigned)__builtin_amdgcn_update_dpp(0, (int)__float_as_uint(v), (ctrl), 0xf, 0xf, true)))
DI float wave_sum(float v) {
    v = DPP_ADD(v, 0xB1);
    v = DPP_ADD(v, 0x4E);
    v = DPP_ADD(v, 0x141);
    v = DPP_ADD(v, 0x140);
    const unsigned u = __float_as_uint(v);
    return (__uint_as_float(__builtin_amdgcn_readlane(u, 0)) + __uint_as_float(__builtin_amdgcn_readlane(u, 16))) +
           (__uint_as_float(__builtin_amdgcn_readlane(u, 32)) + __uint_as_float(__builtin_amdgcn_readlane(u, 48)));
}
DI int crow(int i, int hh) { return (i & 3) + 8 * (i >> 2) + 4 * hh; }
DI int mod_row(int r) { return r < NL ? (r >> 13) : 2; }
DI float frcp(float x) { return __builtin_amdgcn_rcpf(x); }
DI float fexp(float x) { return __builtin_amdgcn_exp2f(x * 1.4426950408889634f); }
DI float sigmoidf_(float x) { return frcp(1.0f + fexp(-x)); }
DI float one_minus_exp(float x) {
    const float s = -x * (1.0f + x * 0.5f * (1.0f + x * (1.0f / 3.0f) * (1.0f + x * 0.25f * (1.0f + x * 0.2f * (1.0f + x * (1.0f / 6.0f))))));
    const float d = 1.0f - fexp(x);
    return x > -0.125f ? s : d;
}

template <class F>
DI void cvt_list(const Params& P, uchar* lds, int i0, int step, int n, F&& job_of) {
    const int tid = tid_opaque();
    float* tl = (float*)lds;
    f32x4 rv[2];
    auto tile_src = [&](int idx, int& j, int& mat, int& kt, int& nt) -> const float* {
        int t; job_of(idx, j, t);
        const int N = P.jobs[j].N, tn = N >> 6, per = (P.jobs[j].K >> 6) * tn; mat = t / per; t -= mat * per; kt = t / tn; nt = t - kt * tn;
        return P.jobs[j].src + (size_t)mat * P.jobs[j].sstride + (size_t)(kt * 64) * N + nt * 64;
    };
    int u = i0, j = 0, mat = 0, kt = 0, nt = 0;
    __syncthreads();
    if (u < n) { const float* src = tile_src(u, j, mat, kt, nt); const int N = P.jobs[j].N;
#pragma unroll
        for (int i = 0; i < 2; ++i) rv[i] = __builtin_nontemporal_load((const f32x4*)(src + (size_t)((tid >> 4) + 32 * i) * N + (tid & 15) * 4)); }
    for (; u < n; u += step) {
#pragma unroll
        for (int i = 0; i < 2; ++i) { float* q = tl + ((tid >> 4) + 32 * i) * 65 + (tid & 15) * 4; q[0] = rv[i][0]; q[1] = rv[i][1]; q[2] = rv[i][2]; q[3] = rv[i][3]; }
        const CvtJob J = P.jobs[j];
        const int cmat = mat, ckt = kt, cnt_ = nt;
        const int un = u + step;
        if (un < n) { const float* src = tile_src(un, j, mat, kt, nt); const int N = P.jobs[j].N;
#pragma unroll
            for (int i = 0; i < 2; ++i) rv[i] = __builtin_nontemporal_load((const f32x4*)(src + (size_t)((tid >> 4) + 32 * i) * N + (tid & 15) * 4)); }
        __syncthreads();
        const int n_ = tid >> 3, kc = tid & 7;
        float v[8];
#pragma unroll
        for (int e = 0; e < 8; ++e) v[e] = tl[(kc * 8 + e) * 65 + n_];
        const int ng = cnt_ * 64 + n_;
        const int drow = J.mode ? ((ng >> 5) * 64 + J.half * 32 + (ng & 31)) : ng;
        u16* d = J.dst + (size_t)cmat * J.dstride + (size_t)drow * J.lddst + ckt * 64 + kc * 8;
        u32x4 w; w.x = pk2(v[0], v[1]); w.y = pk2(v[2], v[3]); w.z = pk2(v[4], v[5]); w.w = pk2(v[6], v[7]);
        *(u32x4*)d = w;
        __syncthreads();
    }
}
constexpr int MOE_CVT_TILES = 6144;
DI void tail_cvt_dense(const Params& P, uchar* lds, int nunits, int lo, int hi) {
    const int G = gridDim.x, rem = nunits % G;
    int rank = blockIdx.x, nidle = G;
    if (rem != 0) { if ((int)blockIdx.x < rem) return; rank = blockIdx.x - rem; nidle = G - rem; }
    cvt_list(P, lds, lo + rank, nidle, hi, [&](int idx, int& j, int& t) {
        j = 0;
#pragma unroll
        for (int q = 1; q < 6; ++q) if (idx >= P.jobs[q].tile0) j = q;
        t = idx - P.jobs[j].tile0; });
}
DI void tail_cvt_moe(const Params& P, uchar* lds, int nunits, int layer, int lo, int hi) {
    const int G = gridDim.x, rem = nunits % G;
    int rank = blockIdx.x, nidle = G;
    if (rem != 0) { if ((int)blockIdx.x < rem) return; rank = blockIdx.x - rem; nidle = G - rem; }
    cvt_list(P, lds, lo + rank, nidle, hi, [&](int idx, int& j, int& t) { j = 6 + (idx >> 11); t = layer * 2048 + (idx & 2047); });
}

DI void phase_prep(const Params& P, const Ctx& p, uchar* lds) {
    const int tid = tid_opaque();
    float* tl = (float*)lds;
    {
        float* sc = tl;
        float* red = tl + 3072;
        for (int u = blockIdx.x; u < 192; u += gridDim.x) {
            __syncthreads();
            for (int i = tid; i < 3072; i += 512) { const int mr = i >> 10, d = i & 1023; const float c = mr < 2 ? inp(p, I_C)[mr * 1024 + d] : inp(p, I_CCTX)[d]; sc[i] = c * sigmoidf_(c); }
            __syncthreads();
            const int l = u / 96, nc = u % 96, c4 = tid & 15, dg = tid >> 4;
            const float* w = inp(p, I_ADAW) + (size_t)l * 1024 * 6144 + nc * 64 + c4 * 4;
            f32x4 a0 = (f32x4){0.f, 0.f, 0.f, 0.f}, a1 = a0, a2 = a0;
#pragma unroll 16
            for (int dd = 0; dd < 32; ++dd) {
                const int d = dg * 32 + dd; const f32x4 wv = __builtin_nontemporal_load((const f32x4*)(w + (size_t)d * 6144));
                const float s0 = sc[d], s1 = sc[1024 + d], s2 = sc[2048 + d];
#pragma unroll
                for (int e = 0; e < 4; ++e) { a0[e] += s0 * wv[e]; a1[e] += s1 * wv[e]; a2[e] += s2 * wv[e]; }
            }
            *(f32x4*)(red + (dg * 3 + 0) * 64 + c4 * 4) = a0; *(f32x4*)(red + (dg * 3 + 1) * 64 + c4 * 4) = a1; *(f32x4*)(red + (dg * 3 + 2) * 64 + c4 * 4) = a2;
            __syncthreads();
            if (tid < 192) {
                const int mr = tid >> 6, nn = tid & 63; float s = 0.f;
#pragma unroll
                for (int g = 0; g < 32; ++g) s += red[(g * 3 + mr) * 64 + nn];
                const int ncol = nc * 64 + nn;
                ((float*)(p.ws + WS_MOD))[(l * 3 + mr) * 6144 + ncol] = s + inp(p, I_ADAB)[l * 6144 + ncol];
            }
        }
        __syncthreads();
    }
    const int ntile0 = P.jobs[1].tile0;
    const bool split = gridDim.x == 256 && ntile0 == 768;
    const bool has_unit = (int)blockIdx.x < 192;
    int ci0 = blockIdx.x, cstep = gridDim.x, cn = ntile0;
    if (split) { if (has_unit) { cstep = 192; cn = 384; } else { ci0 = 384 + ((int)blockIdx.x - 192); cstep = 64; } }
    cvt_list(P, lds, ci0, cstep, cn, [&](int idx, int& j, int& t) {
        j = 0;
#pragma unroll
        for (int q = 1; q < 6; ++q) if (idx >= P.jobs[q].tile0) j = q;
        t = idx - P.jobs[j].tile0; });
    if (!split || !has_unit) {
        const int rb0 = split ? (int)blockIdx.x - 192 : (int)blockIdx.x, rbn = split ? 64 : (int)gridDim.x;
        for (int i = rb0 * 512 + tid; i < SEQ * 32; i += rbn * 512) {
            const int t = i >> 5, j = i & 31;
            const float pos = (float)(j < 16 ? (t >> 6) : (t & 63));
            const float inv = exp2f(-(float)(j & 15) * (13.287712379549449f / 16.0f));
            float sn, cs; sincosf(pos * inv, &sn, &cs);
            ((f32x2*)(p.ws + WS_ROPE))[i] = (f32x2){cs, sn};
        }
    }
}

DI void load_row16(const float* src, int lane, float (&v)[16]) {
#pragma unroll
    for (int j = 0; j < 4; ++j) { const f32x4 x = *(const f32x4*)(src + j * 256 + lane * 4); v[j * 4 + 0] = x[0]; v[j * 4 + 1] = x[1]; v[j * 4 + 2] = x[2]; v[j * 4 + 3] = x[3]; }
}
DI void norm_mod16(float (&v)[16], const float* g, const float* sh, const float* sc, int lane) {
    float ss = 0.f;
#pragma unroll
    for (int i = 0; i < 16; ++i) ss += v[i] * v[i];
    ss = wave_sum(ss);
    const float rstd = rsqrtf(ss * (1.0f / 1024.0f) + EPS);
#pragma unroll
    for (int j = 0; j < 4; ++j) {
        const int c = j * 256 + lane * 4;
        const f32x4 gg = *(const f32x4*)(g + c), s1 = *(const f32x4*)(sc + c), s0 = *(const f32x4*)(sh + c);
#pragma unroll
        for (int e = 0; e < 4; ++e) v[j * 4 + e] = (v[j * 4 + e] * rstd * gg[e]) * (1.0f + s1[e]) + s0[e];
    }
}
DI void store_row16_bf16(u16* dst, int lane, const float (&v)[16]) {
#pragma unroll
    for (int j = 0; j < 4; ++j) { u32x2 w; w.x = pk2(v[j * 4 + 0], v[j * 4 + 1]); w.y = pk2(v[j * 4 + 2], v[j * 4 + 3]); *(u32x2*)(dst + j * 256 + lane * 4) = w; }
}
DI const float* row_src(const Ctx& p, int layer, int r) {
    if (layer == 0) return r < NL ? inp(p, I_X) + (size_t)r * 1024 : inp(p, I_CTX) + (size_t)(r - NL) * 1024;
    return (const float*)(p.ws + WS_XS) + (size_t)r * 1024;
}
DI void phase_norm(const Ctx& p, int layer) {
    const int tid = tid_opaque(), lane = tid & 63, wv = blockIdx.x * 8 + (tid >> 6), nwv = gridDim.x * 8;
    const float* mod = (const float*)(p.ws + WS_MOD);
    u16* hb = (u16*)(p.ws + WS_HB);
    for (int r = wv; r < R; r += nwv) {
        float v[16];
        load_row16(row_src(p, layer, r), lane, v);
        const float* m = mod + (layer * 3 + mod_row(r)) * 6144;
        norm_mod16(v, inp(p, I_NMIX) + layer * 1024, m, m + 1024, lane);
        store_row16_bf16(hb + (size_t)r * 1024, lane, v);
    }
}
DI void phase_router(const Ctx& p, uchar* lds, int layer, int cnt_slot = -1) {
    const int tid = tid_opaque(), lane = tid & 63, wid = tid >> 6, wv = blockIdx.x * 8 + wid, nwv = gridDim.x * 8;
    const float* mod = (const float*)(p.ws + WS_MOD);
    u16* hb = (u16*)(p.ws + WS_HB);
    const float* xs = (const float*)(p.ws + WS_XS);
    const int nrows = layer == 0 ? R : NL;
    const float* wg = inp(p, I_MWGRP) + layer * 1024 * 4;
    const float* wr = inp(p, I_MWRT) + layer * 1024 * 16;
    const float* gnorm = inp(p, I_NFFN) + layer * 1024;
    int* cnt = (int*)(p.ws + WS_CTL + CTL_CNT) + (cnt_slot >= 0 ? cnt_slot : layer) * 1024;
    int* list = (int*)(p.ws + WS_LIST);
    f32x2* route = (f32x2*)(p.ws + WS_ROUTE);
    float* wrl = (float*)lds;
    float* wgl = wrl + 16384;
    float* hs = (float*)(lds + 81920 + wid * 8192);
    __syncthreads();
#pragma unroll
    for (int i = 0; i < 8; ++i) { const int q4 = i * 512 + tid; *(f32x4*)(wrl + ((q4 & 3) * 1024 + (q4 >> 2)) * 4) = *(const f32x4*)(wr + q4 * 4); }
    if (tid < 16) ((float*)(lds + 147456 + 768))[tid] = inp(p, I_MBRT)[layer * 16 + tid];
#pragma unroll
    for (int i = 0; i < 2; ++i) *(f32x4*)(wgl + (i * 512 + tid) * 4) = *(const f32x4*)(wg + (i * 512 + tid) * 4);
    __syncthreads();
    float bg[4], br[4];
#pragma unroll
    for (int o = 0; o < 4; ++o) { bg[o] = inp(p, I_MBGRP)[layer * 4 + o]; br[o] = inp(p, I_MBRT)[layer * 16 + (lane & 3) * 4 + o]; }
    for (int r0 = wv * 2; r0 < nrows; r0 += nwv * 2) {
        const float* m = mod + (layer * 3 + mod_row(r0)) * 6144;
        float v0[16], v1[16];
        load_row16(xs + (size_t)r0 * 1024, lane, v0);
        load_row16(xs + (size_t)(r0 + 1) * 1024, lane, v1);
        norm_mod16(v0, gnorm, m + 3 * 1024, m + 4 * 1024, lane);
        norm_mod16(v1, gnorm, m + 3 * 1024, m + 4 * 1024, lane);
        store_row16_bf16(hb + (size_t)r0 * 1024, lane, v0);
        store_row16_bf16(hb + (size_t)(r0 + 1) * 1024, lane, v1);
#pragma unroll
        for (int j = 0; j < 4; ++j) {
            *(f32x4*)(hs + (j * 256 + lane * 4) * 2) = (f32x4){v0[j * 4], v1[j * 4], v0[j * 4 + 1], v1[j * 4 + 1]};
            *(f32x4*)(hs + (j * 256 + lane * 4) * 2 + 4) = (f32x4){v0[j * 4 + 2], v1[j * 4 + 2], v0[j * 4 + 3], v1[j * 4 + 3]};
        }
        float ag[2][4];
#pragma unroll
        for (int q = 0; q < 2; ++q)
#pragma unroll
            for (int o = 0; o < 4; ++o) ag[q][o] = 0.f;
#pragma unroll 8
        for (int it = 0; it < 16; ++it) {
            const f32x4 w4 = *(const f32x4*)(wgl + (it * 64 + lane) * 4);
            const f32x2 x2 = *(const f32x2*)(hs + (it * 64 + lane) * 2);
#pragma unroll
            for (int o = 0; o < 4; ++o) { ag[0][o] += x2.x * w4[o]; ag[1][o] += x2.y * w4[o]; }
        }
        int gi2[2]; float psel2[2];
#pragma unroll
        for (int q = 0; q < 2; ++q) {
            float gl[4];
#pragma unroll
            for (int o = 0; o < 4; ++o) gl[o] = wave_sum(ag[q][o]) + bg[o];
            int gi = 0; float gm = gl[0];
#pragma unroll
            for (int o = 1; o < 4; ++o) if (gl[o] > gm) { gm = gl[o]; gi = o; }
            float gs = 0.f;
#pragma unroll
            for (int o = 0; o < 4; ++o) gs += __expf(gl[o] - gm);
            gi2[q] = gi; psel2[q] = 1.0f / gs;
        }
        float ar[2][4];
#pragma unroll
        for (int q = 0; q < 2; ++q)
#pragma unroll
            for (int o = 0; o < 4; ++o) ar[q][o] = 0.f;
        const float* we0 = wrl + gi2[0] * 4096, * we1 = wrl + gi2[1] * 4096;
#pragma unroll 8
        for (int it = 0; it < 16; ++it) {
            const f32x4 w0 = *(const f32x4*)(we0 + (it * 64 + lane) * 4), w1 = *(const f32x4*)(we1 + (it * 64 + lane) * 4);
            const f32x2 x2 = *(const f32x2*)(hs + (it * 64 + lane) * 2);
#pragma unroll
            for (int o = 0; o < 4; ++o) { ar[0][o] += x2.x * w0[o]; ar[1][o] += x2.y * w1[o]; }
        }
#pragma unroll
        for (int q = 0; q < 2; ++q) {
            const int gi = gi2[q]; const float psel = psel2[q];
            const f32x4 bre = *(const f32x4*)((const float*)(lds + 147456 + 768) + gi * 4);
            float el[4];
#pragma unroll
            for (int o = 0; o < 4; ++o) el[o] = wave_sum(ar[q][o]) + bre[o];
            int i1 = 0; float m1 = el[0];
#pragma unroll
            for (int o = 1; o < 4; ++o) if (el[o] > m1) { m1 = el[o]; i1 = o; }
            int i2 = -1; float m2 = -3.0e38f;
#pragma unroll
            for (int o = 0; o < 4; ++o) if (o != i1 && el[o] > m2) { m2 = el[o]; i2 = o; }
            if (lane == 0) {
                const int r = r0 + q;
                const float e2 = __expf(m2 - m1);
                const float w1 = psel / (1.0f + e2), w2 = psel * e2 / (1.0f + e2);
                const int lo = i1 < i2 ? i1 : i2, hi = i1 < i2 ? i2 : i1;
                const float wlo = i1 < i2 ? w1 : w2, whi = i1 < i2 ? w2 : w1;
                const int pi = lo == 0 ? (hi - 1) : (lo == 1 ? (hi + 1) : 5);
                const int bucket = gi * 6 + pi;
                const int pos = atomicAdd(cnt + bucket * 32, 1);
                list[(size_t)bucket * R + pos] = r;
                route[r] = (f32x2){wlo, whi};
            }
        }
    }
}

constexpr int LROW = 144;
constexpr int GEMM_A = 128 * 128, GEMM_B = 256 * 128, GEMM_STAGE = GEMM_A + GEMM_B;
constexpr int EPI_PITCH = 272, EPI_WAVE = 64 * EPI_PITCH;
static_assert(8 * EPI_WAVE <= 3 * GEMM_STAGE, "epilogue strips overlay the GEMM stages");
#define WAIT_V(n) asm volatile("s_waitcnt vmcnt(%0)" ::"n"(n) : "memory")
#define WAIT_L(n) asm volatile("s_waitcnt lgkmcnt(%0)" ::"n"(n) : "memory")
#define RAW_BARRIER() do { WAIT_L(0); __builtin_amdgcn_s_barrier(); } while (0)

template <class Epi>
DI void gemm_tile(uchar* lds, const u16* a0, const u16* a1, const u16* b0, const u16* b1, const u16* b2, const u16* b3, int nk, int ksplit, long bjump, Epi&& epi) {
    const int tid = tid_opaque(), lane = tid & 63, wid = tid >> 6, wr = wid >> 2, wc = wid & 3, l31 = lane & 31, hh = lane >> 5;
    const int lch = (lane & 7) ^ ((((wid & 1) << 3) + (lane >> 3)) >> 1);
    a0 += lch * 8; a1 += lch * 8; b0 += lch * 8; b1 += lch * 8; b2 += lch * 8; b3 += lch * 8;
    const unsigned pw = (unsigned)__builtin_amdgcn_readfirstlane(wid) * 1024u;
    const int sw = (l31 >> 1) & 7;
    unsigned xo[4];
#pragma unroll
    for (int ks = 0; ks < 4; ++ks) xo[ks] = (unsigned)(((ks * 2 + hh) ^ sw) << 4);
    const unsigned aro = (unsigned)((wr * 64 + l31) * 128), bro = (unsigned)(GEMM_A + (wc * 64 + l31) * 128);
    f32x16 acc[2][2];
#pragma unroll
    for (int a = 0; a < 2; ++a)
#pragma unroll
        for (int b = 0; b < 2; ++b)
#pragma unroll
            for (int i = 0; i < 16; ++i) acc[a][b][i] = 0.f;
#define GEMM_DMA(st_, kt_) do { const int kq_ = (kt_); const long bo_ = (long)kq_ * 64 + (kq_ >= ksplit ? bjump : 0); uchar* s_ = lds + (st_) * GEMM_STAGE + pw; \
        __builtin_amdgcn_global_load_lds((const unsigned*)(a0 + kq_ * 64), (LAS unsigned*)(s_), 16, 0, 0); \
        __builtin_amdgcn_global_load_lds((const unsigned*)(a1 + kq_ * 64), (LAS unsigned*)(s_ + 8192), 16, 0, 0); \
        __builtin_amdgcn_global_load_lds((const unsigned*)(b0 + bo_), (LAS unsigned*)(s_ + GEMM_A), 16, 0, 0); \
        __builtin_amdgcn_global_load_lds((const unsigned*)(b1 + bo_), (LAS unsigned*)(s_ + GEMM_A + 8192), 16, 0, 0); \
        __builtin_amdgcn_global_load_lds((const unsigned*)(b2 + bo_), (LAS unsigned*)(s_ + GEMM_A + 16384), 16, 0, 0); \
        __builtin_amdgcn_global_load_lds((const unsigned*)(b3 + bo_), (LAS unsigned*)(s_ + GEMM_A + 24576), 16, 0, 0); } while (0)
    RAW_BARRIER();
    GEMM_DMA(0, 0); GEMM_DMA(1, 1);
    WAIT_V(6);
    RAW_BARRIER();
    int cur = 0;
#pragma unroll 1
    for (int kt = 0; kt < nk; ++kt) {
        const int nxt = cur == 0 ? 2 : cur - 1;
        if (kt + 2 < nk) GEMM_DMA(nxt, kt + 2);
        const uchar* s = lds + cur * GEMM_STAGE;
#pragma unroll
        for (int ks = 0; ks < 4; ++ks) {
            const bf16x8 fa0 = *(const bf16x8*)(s + aro + xo[ks]), fa1 = *(const bf16x8*)(s + aro + 4096 + xo[ks]);
            const bf16x8 fb0 = *(const bf16x8*)(s + bro + xo[ks]), fb1 = *(const bf16x8*)(s + bro + 4096 + xo[ks]);
            acc[0][0] = MFMA32(fb0, fa0, acc[0][0]); acc[0][1] = MFMA32(fb0, fa1, acc[0][1]);
            acc[1][0] = MFMA32(fb1, fa0, acc[1][0]); acc[1][1] = MFMA32(fb1, fa1, acc[1][1]);
        }
        if (kt + 2 < nk) WAIT_V(6); else WAIT_V(0);
        RAW_BARRIER();
        cur = cur == 2 ? 0 : cur + 1;
    }
#if PROBE_GEMM2X == 1
    {
        f32x16 d[2][2];
        for (int a = 0; a < 2; ++a) for (int b = 0; b < 2; ++b) for (int i = 0; i < 16; ++i) d[a][b][i] = 0.f;
        RAW_BARRIER(); GEMM_DMA(0, 0); GEMM_DMA(1, 1); WAIT_V(6); RAW_BARRIER();
        int cur2 = 0;
#pragma unroll 1
        for (int kt = 0; kt < nk; ++kt) {
            const int nxt = cur2 == 0 ? 2 : cur2 - 1;
            if (kt + 2 < nk) GEMM_DMA(nxt, kt + 2);
            const uchar* s = lds + cur2 * GEMM_STAGE;
#pragma unroll
            for (int ks = 0; ks < 4; ++ks) {
                const bf16x8 fa0 = *(const bf16x8*)(s + aro + xo[ks]), fa1 = *(const bf16x8*)(s + aro + 4096 + xo[ks]);
                const bf16x8 fb0 = *(const bf16x8*)(s + bro + xo[ks]), fb1 = *(const bf16x8*)(s + bro + 4096 + xo[ks]);
                d[0][0] = MFMA32(fb0, fa0, d[0][0]); d[0][1] = MFMA32(fb0, fa1, d[0][1]);
                d[1][0] = MFMA32(fb1, fa0, d[1][0]); d[1][1] = MFMA32(fb1, fa1, d[1][1]);
            }
            if (kt + 2 < nk) WAIT_V(6); else WAIT_V(0);
            RAW_BARRIER();
            cur2 = cur2 == 2 ? 0 : cur2 + 1;
        }
        asm volatile("" :: "v"(d[0][0]), "v"(d[0][1]), "v"(d[1][0]), "v"(d[1][1]));
    }
#elif PROBE_GEMM2X == 2
    {
        f32x4 d[4][4];
        for (int a = 0; a < 4; ++a) for (int b = 0; b < 4; ++b) d[a][b] = (f32x4){0.f, 0.f, 0.f, 0.f};
        RAW_BARRIER(); GEMM_DMA(0, 0); GEMM_DMA(1, 1); WAIT_V(6); RAW_BARRIER();
        int cur2 = 0;
#pragma unroll 1
        for (int kt = 0; kt < nk; ++kt) {
            const int nxt = cur2 == 0 ? 2 : cur2 - 1;
            if (kt + 2 < nk) GEMM_DMA(nxt, kt + 2);
            const uchar* s = lds + cur2 * GEMM_STAGE;
#pragma unroll
            for (int kp = 0; kp < 2; ++kp) {
                bf16x8 fa[4], fb[4];
                fa[0] = *(const bf16x8*)(s + aro + xo[2 * kp]); fa[1] = *(const bf16x8*)(s + aro + 4096 + xo[2 * kp]); fa[2] = *(const bf16x8*)(s + aro + xo[2 * kp + 1]); fa[3] = *(const bf16x8*)(s + aro + 4096 + xo[2 * kp + 1]);
                fb[0] = *(const bf16x8*)(s + bro + xo[2 * kp]); fb[1] = *(const bf16x8*)(s + bro + 4096 + xo[2 * kp]); fb[2] = *(const bf16x8*)(s + bro + xo[2 * kp + 1]); fb[3] = *(const bf16x8*)(s + bro + 4096 + xo[2 * kp + 1]);
#pragma unroll
                for (int a = 0; a < 4; ++a)
#pragma unroll
                    for (int b = 0; b < 4; ++b) d[a][b] = __builtin_amdgcn_mfma_f32_16x16x32_bf16(fb[b], fa[a], d[a][b], 0, 0, 0);
            }
            if (kt + 2 < nk) WAIT_V(6); else WAIT_V(0);
            RAW_BARRIER();
            cur2 = cur2 == 2 ? 0 : cur2 + 1;
        }
        asm volatile("" :: "v"(d[0][0]), "v"(d[0][1]), "v"(d[0][2]), "v"(d[0][3]), "v"(d[1][0]), "v"(d[1][1]), "v"(d[1][2]), "v"(d[1][3]));
        asm volatile("" :: "v"(d[2][0]), "v"(d[2][1]), "v"(d[2][2]), "v"(d[2][3]), "v"(d[3][0]), "v"(d[3][1]), "v"(d[3][2]), "v"(d[3][3]));
    }
#endif
    epi(acc, wr * 64, wc, lane, lds + wid * EPI_WAVE);
}

constexpr int G1_A = 128 * 128, G1_STAGE = 2 * G1_A;
template <class Epi>
DI void gemm_tile128(uchar* lds, const u16* a0, const u16* a1, const u16* b0, const u16* b1, int nk, int ksplit, long bjump, Epi&& epi) {
    const int tid = tid_opaque(), lane = tid & 63, wid = tid >> 6, kh = wid >> 2, wr = (wid >> 1) & 1, wc = wid & 1, l31 = lane & 31, hh = lane >> 5;
    const int lch = (lane & 7) ^ ((((wid & 1) << 3) + (lane >> 3)) >> 1);
    a0 += lch * 8; a1 += lch * 8; b0 += lch * 8; b1 += lch * 8;
    const unsigned pw = (unsigned)__builtin_amdgcn_readfirstlane(wid) * 1024u;
    const int sw = (l31 >> 1) & 7;
    unsigned xo[2];
#pragma unroll
    for (int ks = 0; ks < 2; ++ks) xo[ks] = (unsigned)((((kh * 2 + ks) * 2 + hh) ^ sw) << 4);
    const unsigned aro = (unsigned)((wr * 64 + l31) * 128), bro = (unsigned)(G1_A + (wc * 64 + l31) * 128);
    f32x16 acc[2][2];
#pragma unroll
    for (int a = 0; a < 2; ++a)
#pragma unroll
        for (int b = 0; b < 2; ++b)
#pragma unroll
            for (int i = 0; i < 16; ++i) acc[a][b][i] = 0.f;
#define G1_DMA(st_, kt_) do { const int kq_ = (kt_); const long bo_ = (long)kq_ * 64 + (kq_ >= ksplit ? bjump : 0); uchar* s_ = lds + (st_) * G1_STAGE + pw; \
        __builtin_amdgcn_global_load_lds((const unsigned*)(a0 + kq_ * 64), (LAS unsigned*)(s_), 16, 0, 0); \
        __builtin_amdgcn_global_load_lds((const unsigned*)(a1 + kq_ * 64), (LAS unsigned*)(s_ + 8192), 16, 0, 0); \
        __builtin_amdgcn_global_load_lds((const unsigned*)(b0 + bo_), (LAS unsigned*)(s_ + G1_A), 16, 0, 0); \
        __builtin_amdgcn_global_load_lds((const unsigned*)(b1 + bo_), (LAS unsigned*)(s_ + G1_A + 8192), 16, 0, 0); } while (0)
    RAW_BARRIER();
    G1_DMA(0, 0); G1_DMA(1, 1);
    WAIT_V(4);
    RAW_BARRIER();
    int cur = 0;
#pragma unroll 1
    for (int kt = 0; kt < nk; ++kt) {
        const int nxt = cur == 0 ? 2 : cur - 1;
        if (kt + 2 < nk) G1_DMA(nxt, kt + 2);
        const uchar* s = lds + cur * G1_STAGE;
#pragma unroll
        for (int ks = 0; ks < 2; ++ks) {
            const bf16x8 fa0 = *(const bf16x8*)(s + aro + xo[ks]), fa1 = *(const bf16x8*)(s + aro + 4096 + xo[ks]);
            const bf16x8 fb0 = *(const bf16x8*)(s + bro + xo[ks]), fb1 = *(const bf16x8*)(s + bro + 4096 + xo[ks]);
            acc[0][0] = MFMA32(fb0, fa0, acc[0][0]); acc[0][1] = MFMA32(fb0, fa1, acc[0][1]);
            acc[1][0] = MFMA32(fb1, fa0, acc[1][0]); acc[1][1] = MFMA32(fb1, fa1, acc[1][1]);
        }
        if (kt + 2 < nk) WAIT_V(4); else WAIT_V(0);
        RAW_BARRIER();
        cur = cur == 2 ? 0 : cur + 1;
    }
    uchar* xb = lds + (wid & 3) * 16384 + lane * 16;
    if (kh == 1) {
#pragma unroll
        for (int a = 0; a < 2; ++a)
#pragma unroll
            for (int b = 0; b < 2; ++b)
#pragma unroll
                for (int g = 0; g < 4; ++g) *(f32x4*)(xb + ((a * 2 + b) * 4 + g) * 1024) = (f32x4){acc[a][b][4 * g], acc[a][b][4 * g + 1], acc[a][b][4 * g + 2], acc[a][b][4 * g + 3]};
    }
    RAW_BARRIER();
    if (kh == 0) {
#pragma unroll
        for (int a = 0; a < 2; ++a)
#pragma unroll
            for (int b = 0; b < 2; ++b)
#pragma unroll
                for (int g = 0; g < 4; ++g) { const f32x4 v = *(const f32x4*)(xb + ((a * 2 + b) * 4 + g) * 1024); acc[a][b][4 * g] += v[0]; acc[a][b][4 * g + 1] += v[1]; acc[a][b][4 * g + 2] += v[2]; acc[a][b][4 * g + 3] += v[3]; }
        epi(acc, wr * 64, wc, lane, lds + 65536 + (wid & 3) * EPI_WAVE);
    }
}

constexpr int G2_A = 256 * 64, G2_STAGE = 2 * G2_A;
template <class Epi>
DI void gemm_tile256(uchar* lds, const u16* a0, const u16* a1, const u16* b0, const u16* b1, int nk, int ksplit, long bjump, Epi&& epi) {
    const int tid = tid_opaque(), lane = tid & 63, wid = tid >> 6, wr = wid >> 2, wc = wid & 3, l31 = lane & 31, hh = lane >> 5;
    const int lch = (lane & 3) ^ ((lane >> 4) & 3);
    a0 += lch * 8; a1 += lch * 8; b0 += lch * 8; b1 += lch * 8;
    const unsigned pw = (unsigned)__builtin_amdgcn_readfirstlane(wid) * 1024u;
    const int sw = (l31 >> 2) & 3;
    const unsigned xo0 = (unsigned)(((0 + hh) ^ sw) << 4), xo1 = (unsigned)(((2 + hh) ^ sw) << 4);
    const unsigned aro = (unsigned)((wr * 128 + l31) * 64), bro = (unsigned)(G2_A + (wc * 64 + l31) * 64);
    f32x16 acc[2][4];
#pragma unroll
    for (int a = 0; a < 2; ++a)
#pragma unroll
        for (int b = 0; b < 4; ++b)
#pragma unroll
            for (int i = 0; i < 16; ++i) acc[a][b][i] = 0.f;
#define G2_DMA(st_, kt_) do { const int kq_ = (kt_); const long bo_ = (long)kq_ * 32 + (kq_ >= ksplit ? bjump : 0); uchar* s_ = lds + (st_) * G2_STAGE + pw; \
        __builtin_amdgcn_global_load_lds((const unsigned*)(a0 + kq_ * 32), (LAS unsigned*)(s_), 16, 0, 0); \
        __builtin_amdgcn_global_load_lds((const unsigned*)(a1 + kq_ * 32), (LAS unsigned*)(s_ + 8192), 16, 0, 0); \
        __builtin_amdgcn_global_load_lds((const unsigned*)(b0 + bo_), (LAS unsigned*)(s_ + G2_A), 16, 0, 0); \
        __builtin_amdgcn_global_load_lds((const unsigned*)(b1 + bo_), (LAS unsigned*)(s_ + G2_A + 8192), 16, 0, 0); } while (0)
    RAW_BARRIER();
    G2_DMA(0, 0); G2_DMA(1, 1); G2_DMA(2, 2);
    WAIT_V(8);
    RAW_BARRIER();
#pragma unroll 1
    for (int kt = 0; kt < nk; ++kt) {
        if (kt + 3 < nk) G2_DMA((kt + 3) & 3, kt + 3);
        const uchar* s = lds + (kt & 3) * G2_STAGE;
#pragma unroll
        for (int ks = 0; ks < 2; ++ks) {
            const unsigned xo = ks ? xo1 : xo0;
            bf16x8 fa[4], fb[2];
#pragma unroll
            for (int mb = 0; mb < 4; ++mb) fa[mb] = *(const bf16x8*)(s + aro + mb * 2048 + xo);
#pragma unroll
            for (int nb = 0; nb < 2; ++nb) fb[nb] = *(const bf16x8*)(s + bro + nb * 2048 + xo);
#pragma unroll
            for (int nb = 0; nb < 2; ++nb)
#pragma unroll
                for (int mb = 0; mb < 4; ++mb) acc[nb][mb] = MFMA32(fb[nb], fa[mb], acc[nb][mb]);
        }
        if (kt + 3 < nk) WAIT_V(8); else if (kt + 2 < nk) WAIT_V(4); else WAIT_V(0);
        RAW_BARRIER();
    }
#pragma unroll
    for (int half = 0; half < 2; ++half) {
        f32x16 t[2][2];
#pragma unroll
        for (int nb = 0; nb < 2; ++nb)
#pragma unroll
            for (int mb = 0; mb < 2; ++mb) t[nb][mb] = acc[nb][2 * half + mb];
        epi(t, wr * 128 + half * 64, wc, lane, lds + wid * EPI_WAVE);
    }
}

DI void epi_put4(uchar* w, int row, int col, float a, float b, float c, float d) { *(f32x4*)(w + row * EPI_PITCH + col * 4) = (f32x4){a, b, c, d}; }
DI void epi_stage(uchar* w, const f32x16 (&acc)[2][2], int l31, int hh) {
#pragma unroll
    for (int mb = 0; mb < 2; ++mb)
#pragma unroll
        for (int nb = 0; nb < 2; ++nb)
#pragma unroll
            for (int g = 0; g < 4; ++g) epi_put4(w, mb * 32 + l31, nb * 32 + 8 * g + 4 * hh, acc[nb][mb][4 * g], acc[nb][mb][4 * g + 1], acc[nb][mb][4 * g + 2], acc[nb][mb][4 * g + 3]);
}
template <class F> DI void epi_rows4(const uchar* w, int lane, F&& f) {
#pragma unroll
    for (int it = 0; it < 16; ++it) { const int row = it * 4 + (lane >> 4), col = (lane & 15) * 4; f(row, col, *(const f32x4*)(w + row * EPI_PITCH + col * 4)); }
}
template <int NC, class F> DI void epi_rows8(const uchar* w, int lane, F&& f) {
    constexpr int LPR = NC / 8, RPI = 64 / LPR;
#pragma unroll
    for (int it = 0; it < 64 / RPI; ++it) { const int row = it * RPI + lane / LPR, col = (lane % LPR) * 8; f(row, col, *(const f32x4*)(w + row * EPI_PITCH + col * 4), *(const f32x4*)(w + row * EPI_PITCH + col * 4 + 16)); }
}
DI u32x4 pack8(const f32x4& a, const f32x4& b) { u32x4 r; r.x = pk2(a[0], a[1]); r.y = pk2(a[2], a[3]); r.z = pk2(b[0], b[1]); r.w = pk2(b[2], b[3]); return r; }

#define MFMA16(a, b, c) __builtin_amdgcn_mfma_f32_16x16x32_bf16((a), (b), (c), 0, 0, 0)
constexpr int P8_HT = 16384;
DI void p8_rc(int tid, int& r0, int& c) { const int wid = tid >> 6, lane = tid & 63; r0 = (wid >> 1) * 16 + (lane >> 2); c = (wid & 1) * 32 + (((lane & 3) ^ ((lane >> 5) << 1)) << 3); }
DI void glds16(const uchar* g, uchar* s) { __builtin_amdgcn_global_load_lds((const unsigned*)g, (LAS unsigned*)s, 16, 0, 0); }
template <class Epi>
DI void gemm_tile8p(uchar* lds, const uchar* abase, unsigned a0_0, unsigned a1_0, unsigned a0_1, unsigned a1_1, int ac1_0, int ac0_1, int ac1_1,
                    const uchar* bbase, unsigned bo, int bc1_0, int bc0_1, int bc1_1, int nk, int ksplit, long bjump, Epi&& epi) {
    constexpr int ac0_0 = 0, bc0_0 = 0;
    const int tid = tid_opaque(), lane = tid & 63, wid = tid >> 6, wr = wid >> 2, wc = wid & 3, fr = lane & 15, fq = lane >> 4;
    const unsigned pw = (unsigned)__builtin_amdgcn_readfirstlane(wid) * 1024u;
    const unsigned lp = (unsigned)((fr * 64 + fq * 16) ^ ((fr >> 3) << 5));
    const unsigned la = (unsigned)wr * 8192u + lp, lb = (unsigned)wc * 4096u + lp;
    f32x4 acc[2][2][4][2];
#pragma unroll
    for (int a = 0; a < 2; ++a)
#pragma unroll
        for (int b = 0; b < 2; ++b)
#pragma unroll
            for (int m = 0; m < 4; ++m)
#pragma unroll
                for (int n = 0; n < 2; ++n) acc[a][b][m][n] = (f32x4){0.f, 0.f, 0.f, 0.f};
    bf16x8 At[4][2], B0[2][2], B1[2][2];
#define P8_SA(b, h) (((b) * 2 + (h)) * P8_HT)
#define P8_SB(b, h) ((4 + (b) * 2 + (h)) * P8_HT)
#define P8_STAGE_A(b, h, kt) do { const uchar* g_ = abase + (size_t)(kt) * 128; uchar* s_ = lds + P8_SA(b, h) + pw; glds16(g_ + ac0_##h + a0_##h, s_); glds16(g_ + ac1_##h + a1_##h, s_ + 8192); } while (0)
#define P8_STAGE_B(b, h, kt) do { const int kq_ = (kt); const uchar* g_ = bbase + (size_t)kq_ * 128 + (kq_ >= ksplit ? bjump : 0); uchar* s_ = lds + P8_SB(b, h) + pw; glds16(g_ + bc0_##h + bo, s_); glds16(g_ + bc1_##h + bo, s_ + 8192); } while (0)
#define P8_LDA(dst, b, h) do { _Pragma("unroll") for (int m = 0; m < 4; ++m) { _Pragma("unroll") for (int k = 0; k < 2; ++k) dst[m][k] = *(const bf16x8*)(lds + P8_SA(b, h) + la + (m * 2 + k) * 1024); } } while (0)
#define P8_LDB(dst, b, h) do { _Pragma("unroll") for (int n = 0; n < 2; ++n) { _Pragma("unroll") for (int k = 0; k < 2; ++k) dst[n][k] = *(const bf16x8*)(lds + P8_SB(b, h) + lb + (n * 2 + k) * 1024); } } while (0)
#define P8_MMA(ai, bj, Bx) do { __builtin_amdgcn_s_setprio(1); \
        _Pragma("unroll") for (int m = 0; m < 4; ++m) { _Pragma("unroll") for (int n = 0; n < 2; ++n) { _Pragma("unroll") for (int k = 0; k < 2; ++k) acc[ai][bj][m][n] = MFMA16(Bx[n][k], At[m][k], acc[ai][bj][m][n]); } } \
        __builtin_amdgcn_s_setprio(0); } while (0)
#define P8_BAR() __builtin_amdgcn_s_barrier()
#define P8_SCHED() __builtin_amdgcn_sched_barrier(0)
    RAW_BARRIER();
    P8_STAGE_B(0, 0, 0); P8_STAGE_A(0, 0, 0); P8_STAGE_B(0, 1, 0); P8_STAGE_A(0, 1, 0);
    if (wr == 1) P8_BAR();
    WAIT_V(4); P8_BAR();
    P8_STAGE_B(1, 0, 1); P8_STAGE_A(1, 0, 1); P8_STAGE_B(1, 1, 1);
    WAIT_V(6); P8_BAR();
#pragma unroll 1
    for (int t = 0; t < nk - 2; t += 2) {
        P8_LDB(B0, 0, 0); P8_SCHED(); P8_LDA(At, 0, 0); P8_STAGE_A(1, 1, t + 1);
        WAIT_L(8); P8_BAR(); WAIT_L(0); P8_MMA(0, 0, B0); P8_BAR(); P8_SCHED();
        P8_LDB(B1, 0, 1); P8_STAGE_B(0, 0, t + 2);
        P8_BAR(); WAIT_L(0); P8_MMA(0, 1, B1); P8_BAR();
        P8_LDA(At, 0, 1); P8_STAGE_A(0, 0, t + 2);
        P8_BAR(); WAIT_L(0); P8_MMA(1, 0, B0); P8_BAR(); P8_SCHED();
        P8_STAGE_B(0, 1, t + 2);
        WAIT_V(6); P8_BAR(); P8_MMA(1, 1, B1); P8_BAR();
        P8_LDB(B0, 1, 0); P8_SCHED(); P8_LDA(At, 1, 0); P8_STAGE_A(0, 1, t + 2);
        WAIT_L(8); P8_BAR(); WAIT_L(0); P8_MMA(0, 0, B0); P8_BAR(); P8_SCHED();
        P8_LDB(B1, 1, 1); P8_STAGE_B(1, 0, t + 3);
        P8_BAR(); WAIT_L(0); P8_MMA(0, 1, B1); P8_BAR();
        P8_LDA(At, 1, 1); P8_STAGE_A(1, 0, t + 3);
        P8_BAR(); WAIT_L(0); P8_MMA(1, 0, B0); P8_BAR(); P8_SCHED();
        P8_STAGE_B(1, 1, t + 3);
        WAIT_V(6); P8_BAR(); P8_MMA(1, 1, B1); P8_BAR();
    }
    {
        P8_LDB(B0, 0, 0); P8_LDA(At, 0, 0); P8_STAGE_A(1, 1, nk - 1);
        P8_BAR(); WAIT_L(0); P8_MMA(0, 0, B0); P8_BAR();
        P8_LDB(B1, 0, 1); P8_BAR(); WAIT_L(0); P8_MMA(0, 1, B1); P8_BAR();
        P8_LDA(At, 0, 1); WAIT_V(4); P8_BAR(); WAIT_L(0); P8_MMA(1, 0, B0); P8_MMA(1, 1, B1); P8_BAR();
    }
    {
        P8_LDB(B0, 1, 0); P8_LDA(At, 1, 0); WAIT_V(2); P8_BAR(); WAIT_L(0); P8_MMA(0, 0, B0); P8_BAR();
        P8_LDB(B1, 1, 1); WAIT_V(0); P8_BAR(); WAIT_L(0); P8_MMA(0, 1, B1); P8_BAR();
        P8_LDA(At, 1, 1); P8_BAR(); WAIT_L(0); P8_MMA(1, 0, B0); P8_MMA(1, 1, B1); P8_BAR();
    }
    if (wr == 0) P8_BAR();
    RAW_BARRIER();
    uchar* w = lds + wid * EPI_WAVE;
#pragma unroll
    for (int ai = 0; ai < 2; ++ai) {
#pragma unroll
        for (int bj = 0; bj < 2; ++bj)
#pragma unroll
            for (int m = 0; m < 4; ++m)
#pragma unroll
                for (int n = 0; n < 2; ++n) *(f32x4*)(w + (m * 16 + fr) * EPI_PITCH + (bj * 32 + n * 16 + fq * 4) * 4) = acc[ai][bj][m][n];
        epi(wr * 128 + ai * 64, wc, lane, w);
    }
}
DI void epi_unstage(const uchar* w, f32x16 (&t)[2][2], int l31, int hh) {
#pragma unroll
    for (int mb = 0; mb < 2; ++mb)
#pragma unroll
        for (int nb = 0; nb < 2; ++nb)
#pragma unroll
            for (int g = 0; g < 4; ++g) { const f32x4 v = *(const f32x4*)(w + (mb * 32 + l31) * EPI_PITCH + (nb * 32 + 8 * g + 4 * hh) * 4); t[nb][mb][4 * g] = v[0]; t[nb][mb][4 * g + 1] = v[1]; t[nb][mb][4 * g + 2] = v[2]; t[nb][mb][4 * g + 3] = v[3]; }
}

DI void rect_unit(int v, int MT, int NT, int& mt, int& nt) {
    if (gridDim.x != 256) { mt = v / NT; nt = v % NT; return; }
    const int r = v >> 8, b = v & 255, x = b & 7, y = b >> 3;
    const int q = r * 8 + x, nqn = NT >> 2, qm = q / nqn, qn = q - qm * nqn;
    mt = qm * 8 + (y & 7); nt = qn * 4 + (y >> 3);
}
DI void phase_inproj0(const Params& P, const Ctx& p, uchar* lds) {
    const int tid = tid_opaque();
    const u16* hb = (const u16*)(p.ws + WS_HB);
    const u16* w = (const u16*)(p.ws + WS_WIN0);
    u16* zc = (u16*)(p.ws + WS_REGA + RA_ZC);
    u16* qa = (u16*)(p.ws + WS_REGA + RA_Q);
    u16* ka = (u16*)(p.ws + WS_REGA + RA_K);
    u16* vt = (u16*)(p.ws + WS_REGA + RA_VT);
    const f32x2* rope = (const f32x2*)(p.ws + WS_ROPE);
    const int rs = tid >> 3;
    for (int u = blockIdx.x; u < 768 + 48; u += gridDim.x) {
        const bool big = u < 768;
        int mt, nt; if (big) rect_unit(u, 64, 12, mt, nt); else { mt = (u - 768) / 12; nt = (u - 768) % 12; }
        const int m0 = big ? mt * 256 : NL + mt * 128, n0 = nt * 256;
        auto epi =
            [&](f32x16 (&acc)[2][2], int roff, int wc, int lane, uchar* w) {
                const int l31 = lane & 31, hh = lane >> 5, nw = n0 + wc * 64;
                const int row0 = m0 + roff;
                int b, spos0; if (row0 < NL) { b = row0 >> 13; spos0 = row0 & 8191; } else { b = (row0 - NL) >> 8; spos0 = SEQ + ((row0 - NL) & 255); }
                if (nw < 1536) {
                    epi_stage(w, acc, l31, hh);
                    epi_rows8<64>(w, lane, [&](int row, int col, const f32x4& v0, const f32x4& v1) { *(u32x4*)(zc + (size_t)(row0 + row) * 1536 + nw + col) = pack8(v0, v1); });
                } else if (nw < 2560) {
                    const bool isq = nw < 2048;
                    const int cg = (nw - (isq ? 1536 : 2048)) >> 6, head = cg >> 1, map = cg & 1;
                    const float* gain = isq ? inp(p, I_QN) : inp(p, I_KN);
                    const float osc = isq ? QSCALE : 1.0f;
#pragma unroll
                    for (int mb = 0; mb < 2; ++mb) {
                        float ss = 0.f;
#pragma unroll
                        for (int nb = 0; nb < 2; ++nb)
#pragma unroll
                            for (int i = 0; i < 16; ++i) ss += acc[nb][mb][i] * acc[nb][mb][i];
                        ss = xor32_sum(ss);
                        const float rstd = rsqrtf(ss * (1.0f / 64.0f) + EPS);
                        const int spos = spos0 + mb * 32 + l31;
#pragma unroll
                        for (int g = 0; g < 4; ++g) {
                            const int d0 = 8 * g + 4 * hh;
                            const f32x4 g1v = *(const f32x4*)(gain + d0), g2v = *(const f32x4*)(gain + 32 + d0);
                            f32x4 csa = (f32x4){1.f, 0.f, 1.f, 0.f}, csb = csa;
                            if (row0 < NL) { csa = *(const f32x4*)((const float*)(rope + spos * 32 + d0)); csb = *(const f32x4*)((const float*)(rope + spos * 32 + d0 + 2)); }
                            float o1[4], o2[4];
#pragma unroll
                            for (int e = 0; e < 4; ++e) {
                                const float v1 = acc[0][mb][4 * g + e] * rstd * g1v[e], v2 = acc[1][mb][4 * g + e] * rstd * g2v[e];
                                const float cs = e < 2 ? csa[2 * e] : csb[2 * (e - 2)], sn = e < 2 ? csa[2 * e + 1] : csb[2 * (e - 2) + 1];
                                o1[e] = (v1 * cs - v2 * sn) * osc; o2[e] = (v2 * cs + v1 * sn) * osc;
                            }
                            epi_put4(w, mb * 32 + l31, d0, o1[0], o1[1], o1[2], o1[3]);
                            epi_put4(w, mb * 32 + l31, 32 + d0, o2[0], o2[1], o2[2], o2[3]);
                        }
                    }
                    u16* dst = (isq ? qa : ka) + ((size_t)(((b * 4 + head) * 2 + map)) * SK + spos0) * 64;
                    epi_rows8<64>(w, lane, [&](int row, int col, const f32x4& v0, const f32x4& v1) { *(u32x4*)(dst + (size_t)row * 64 + col) = pack8(v0, v1); });
                } else {
                    const int head = (nw - 2560) >> 7, vb0 = (nw - 2560) & 127;
#pragma unroll
                    for (int mb = 0; mb < 2; ++mb) {
                        const int tok = mb * 32 + l31, tp = (tok & ~12) | (((tok >> 3) & 1) << 2) | (((tok >> 2) & 1) << 3);
#pragma unroll
                        for (int nb = 0; nb < 2; ++nb)
#pragma unroll
                            for (int i = 0; i < 16; ++i) *(u16*)(w + (nb * 32 + crow(i, hh)) * 144 + tp * 2) = f2b(acc[nb][mb][i]);
                    }
                    u16* dst = vt + ((size_t)(b * 4 + head) * 128 + vb0) * SK + spos0;
#pragma unroll
                    for (int it = 0; it < 8; ++it) { const int v = it * 8 + (lane >> 3), c8 = lane & 7; *(u32x4*)(dst + (size_t)v * SK + c8 * 8) = *(const u32x4*)(w + v * 144 + c8 * 16); }
                }
            };
        if (big) {
            int r0, c; p8_rc(tid, r0, c);
            const unsigned ao = (unsigned)(r0 * 2048 + c * 2), bo = (unsigned)((((r0 >> 5) * 64 + (r0 & 31)) * 2048) + c * 2);
            gemm_tile8p(lds, (const uchar*)(hb + (size_t)m0 * 1024), ao, ao, ao, ao, 128 * 2048, 64 * 2048, 192 * 2048,
                        (const uchar*)(w + (size_t)n0 * 1024), bo, 128 * 2048, 32 * 2048, 160 * 2048, 16, 1 << 30, 0,
                        [&](int roff, int wc, int lane, uchar* w) {
                            const int nw = n0 + wc * 64;
                            if (nw < 1536) { const int row0 = m0 + roff; epi_rows8<64>(w, lane, [&](int row, int col, const f32x4& v0, const f32x4& v1) { *(u32x4*)(zc + (size_t)(row0 + row) * 1536 + nw + col) = pack8(v0, v1); }); }
                            else { f32x16 t[2][2]; epi_unstage(w, t, lane & 31, lane >> 5); epi(t, roff, wc, lane, w); } });
        } else {
            const u16* ab = hb + (size_t)(m0 + rs) * 1024;
            const u16* bb = w + (size_t)(n0 + rs) * 1024;
            gemm_tile(lds, ab, ab + 64 * 1024, bb, bb + 64 * 1024, bb + 128 * 1024, bb + 192 * 1024, 16, 1 << 30, 0, epi);
        }
    }
    tail_cvt_moe(P, lds, 768 + 48, 0, 0, MOE_CVT_TILES / 2);
    tail_cvt_dense(P, lds, 768 + 48, P.jobs[1].tile0, P.jobs[2].tile0);
}

constexpr int ATT_K = 64 * 128, ATT_V = 128 * 128;
constexpr int ATT_STAGE = 2 * ATT_K + ATT_V;
DI void attn_unit(const Ctx& p, uchar* lds, int bh, int q0, int key0, int ntile, int out_row0) {
    const int tid = tid_opaque();
    const int lane = tid & 63, wid = tid >> 6, l31 = lane & 31, hh = lane >> 5, m = wid >> 2, g = wid & 3;
    const u16* qa = (const u16*)(p.ws + WS_REGA + RA_Q);
    const u16* ka = (const u16*)(p.ws + WS_REGA + RA_K);
    const u16* vt = (const u16*)(p.ws + WS_REGA + RA_VT);
    uchar* qs = lds + 2 * ATT_STAGE + wid * 8192 + lane * 16;
    RAW_BARRIER();
    {
        const u16* qp = qa + ((size_t)(bh * 2 + m) * SK + q0 + g * 64 + l31) * 64 + hh * 8;
#pragma unroll
        for (int rg = 0; rg < 2; ++rg)
#pragma unroll
            for (int ks = 0; ks < 4; ++ks) *(bf16x8*)(qs + (rg * 4 + ks) * 1024) = *(const bf16x8*)(qp + rg * 32 * 64 + ks * 16);
    }
    const int lch = (lane & 7) ^ ((((wid & 1) << 3) + (lane >> 3)) >> 1);
    const u16* kp = ka + ((size_t)(bh * 2) * SK + key0 + wid * 8 + (lane >> 3)) * 64 + lch * 8;
    const u16* vp = vt + ((size_t)bh * 128 + wid * 8 + (lane >> 3)) * SK + key0 + lch * 8;
    const unsigned pw = (unsigned)__builtin_amdgcn_readfirstlane(wid) * 1024u;
    const int sw = (l31 >> 1) & 7;
    unsigned xo[4];
#pragma unroll
    for (int ks = 0; ks < 4; ++ks) xo[ks] = (unsigned)(((ks * 2 + hh) ^ sw) << 4);
    const unsigned kro = (unsigned)(m * ATT_K + l31 * 128), vro = (unsigned)(2 * ATT_K + l31 * 128);
    f32x16 O[2][4];
#pragma unroll
    for (int rg = 0; rg < 2; ++rg)
#pragma unroll
        for (int vb = 0; vb < 4; ++vb)
#pragma unroll
            for (int i = 0; i < 16; ++i) O[rg][vb][i] = 0.f;
    float lsum0 = 0.f, lsum1 = 0.f;
#define ATT_DMA(st_, t_) do { const int tq_ = (t_); uchar* s_ = lds + (st_) * ATT_STAGE + pw; \
        __builtin_amdgcn_global_load_lds((const unsigned*)(kp + (size_t)tq_ * 4096), (LAS unsigned*)(s_), 16, 0, 0); \
        __builtin_amdgcn_global_load_lds((const unsigned*)(kp + (size_t)SK * 64 + (size_t)tq_ * 4096), (LAS unsigned*)(s_ + ATT_K), 16, 0, 0); \
        __builtin_amdgcn_global_load_lds((const unsigned*)(vp + tq_ * 64), (LAS unsigned*)(s_ + 2 * ATT_K), 16, 0, 0); \
        __builtin_amdgcn_global_load_lds((const unsigned*)(vp + (size_t)64 * SK + tq_ * 64), (LAS unsigned*)(s_ + 2 * ATT_K + 8192), 16, 0, 0); } while (0)
    ATT_DMA(0, 0);
    WAIT_V(0);
    RAW_BARRIER();
    float one; asm volatile("s_mov_b32 %0, 1.0" : "=s"(one));
#pragma unroll 1
    for (int t = 0; t < ntile; ++t) {
        if (t + 1 < ntile) ATT_DMA((t + 1) & 1, t + 1);
        const uchar* s = lds + (t & 1) * ATT_STAGE;
        bf16x8 qf[2][4];
#pragma unroll
        for (int rg = 0; rg < 2; ++rg)
#pragma unroll
            for (int ks = 0; ks < 4; ++ks) qf[rg][ks] = *(const bf16x8*)(qs + (rg * 4 + ks) * 1024);
        int kb = 0;
#pragma unroll 1
        do {
            bf16x8 P[2][2];
#pragma unroll
            for (int rg = 0; rg < 2; ++rg) {
                f32x16 S;
#pragma unroll
                for (int i = 0; i < 16; ++i) S[i] = 0.f;
#pragma unroll
                for (int ks = 0; ks < 4; ++ks) { const bf16x8 kf = *(const bf16x8*)(s + kro + kb * 4096 + xo[ks]); S = MFMA32(kf, qf[rg][ks], S); }
                float ls = rg ? lsum1 : lsum0;
#pragma unroll
                for (int i = 0; i < 16; ++i) { S[i] = __builtin_amdgcn_exp2f(S[i]); ls = rg ? __builtin_fmaf(S[i], one, ls) : ls + S[i]; }
                if (rg == 0) lsum0 = ls; else lsum1 = ls;
#pragma unroll
                for (int s2 = 0; s2 < 2; ++s2) {
                    u32x4 pw4; pw4.x = pk2(S[8 * s2], S[8 * s2 + 1]); pw4.y = pk2(S[8 * s2 + 2], S[8 * s2 + 3]); pw4.z = pk2(S[8 * s2 + 4], S[8 * s2 + 5]); pw4.w = pk2(S[8 * s2 + 6], S[8 * s2 + 7]);
                    P[rg][s2] = __builtin_bit_cast(bf16x8, pw4);
                }
            }
#pragma unroll
            for (int s2 = 0; s2 < 2; ++s2)
#pragma unroll
                for (int vb = 0; vb < 4; ++vb) {
                    const bf16x8 vf = *(const bf16x8*)(s + vro + vb * 4096 + (unsigned)(((4 * kb + 2 * s2 + hh) ^ sw) << 4));
                    O[0][vb] = MFMA32(vf, P[0][s2], O[0][vb]); O[1][vb] = MFMA32(vf, P[1][s2], O[1][vb]);
                }
            asm volatile("s_add_u32 %0, %0, 1" : "+s"(kb) : : "scc");
        } while (kb < 2);
        WAIT_V(0);
        RAW_BARRIER();
    }
    lsum0 = xor32_sum(lsum0); lsum1 = xor32_sum(lsum1);
    const int tid2 = tid_opaque(), lane2 = tid2 & 63, wid2 = tid2 >> 6, e_l31 = lane2 & 31, e_hh = lane2 >> 5, e_m = wid2 >> 2, e_g = wid2 & 3;
    float lam;
    { float d1 = inp(p, I_LQ1)[lane2] * inp(p, I_LK1)[lane2], d2 = inp(p, I_LQ2)[lane2] * inp(p, I_LK2)[lane2]; d1 = wave_sum(d1); d2 = wave_sum(d2); lam = fexp(d1) - fexp(d2) + LAM_INIT0; }
    float* comb = (float*)lds + (size_t)e_g * 8192 + lane2;
    if (e_m == 1) {
#pragma unroll
        for (int rg = 0; rg < 2; ++rg) {
            const float sc = lam / (rg ? lsum1 : lsum0);
#pragma unroll
            for (int vb = 0; vb < 4; ++vb) {
#pragma unroll
                for (int i = 0; i < 16; ++i) comb[((rg * 4 + vb) * 16 + i) * 64] = O[rg][vb][i] * sc;
                __builtin_amdgcn_sched_barrier(0);
            }
        }
    }
    RAW_BARRIER();
    if (e_m == 0) {
        const float* snl = (const float*)(lds + 131072);
        const int h = bh & 3;
        uchar* strip = lds + (size_t)e_g * 32768;
#pragma unroll
        for (int rg = 0; rg < 2; ++rg) {
            const float i0 = 1.0f / (rg ? lsum1 : lsum0);
            float ss = 0.f;
#pragma unroll
            for (int vb = 0; vb < 4; ++vb) {
#pragma unroll
                for (int i = 0; i < 16; ++i) { const float o = O[rg][vb][i] * i0 - comb[((rg * 4 + vb) * 16 + i) * 64]; O[rg][vb][i] = o; ss += o * o; }
                __builtin_amdgcn_sched_barrier(0);
            }
            ss = xor32_sum(ss);
            const float rstd = rsqrtf(ss * (1.0f / 128.0f) + EPS) * (1.0f - LAM_INIT0);
#pragma unroll
            for (int vb = 0; vb < 4; ++vb)
#pragma unroll
                for (int gq = 0; gq < 4; ++gq) {
                    const int v0 = vb * 32 + 8 * gq + 4 * e_hh;
                    const f32x4 gn = *(const f32x4*)(snl + v0);
                    u32x2 w; w.x = pk2(O[rg][vb][4 * gq] * rstd * gn[0], O[rg][vb][4 * gq + 1] * rstd * gn[1]); w.y = pk2(O[rg][vb][4 * gq + 2] * rstd * gn[2], O[rg][vb][4 * gq + 3] * rstd * gn[3]);
                    *(u32x2*)(strip + (rg * 32 + e_l31) * 272 + v0 * 2) = w;
                }
            __builtin_amdgcn_sched_barrier(0);
        }
        u16* dst = (u16*)(p.ws + WS_HB) + (size_t)(out_row0 + e_g * 64) * 1024 + 512 + h * 128;
#pragma unroll
        for (int it = 0; it < 16; ++it) {
            const int row = it * 4 + (lane2 >> 4), c16 = lane2 & 15;
            *(u32x4*)(dst + (size_t)row * 1024 + c16 * 8) = *(const u32x4*)(strip + row * 272 + c16 * 16);
        }
    }
}
DI void phase_attn(const Ctx& p, uchar* lds) {
    const int tid = tid_opaque();
    if (tid < 128) ((float*)(lds + 131072))[tid] = inp(p, I_SUBN)[tid];
    for (int u = blockIdx.x; u < (gridDim.x == 256 ? 256 : 264); u += gridDim.x) {
        const bool lat = u < 256;
        const int bh = u & 7, qb = u >> 3;
        attn_unit(p, lds, bh, lat ? qb * 256 : SEQ, lat ? 0 : SEQ, lat ? 132 : 4, lat ? (bh >> 2) * SEQ + qb * 256 : NL + (bh >> 2) * CTXL);
    }
    {
        const u16* zc = (const u16*)(p.ws + WS_REGA + RA_ZC);
        u16* hb = (u16*)(p.ws + WS_HB);
        const int tid2 = tid_opaque(), lane = tid2 & 63, wid = tid2 >> 6, c8 = lane * 8;
        float w0[8], w1[8], w2[8], bias[8];
        {
            const float* cw = inp(p, I_EVCW) + c8; const float* cb = inp(p, I_EVCB) + c8;
#pragma unroll
            for (int h = 0; h < 2; ++h) {
                const f32x4 a = *(const f32x4*)(cw + 4 * h), b = *(const f32x4*)(cw + 512 + 4 * h), c = *(const f32x4*)(cw + 1024 + 4 * h), d = *(const f32x4*)(cb + 4 * h);
#pragma unroll
                for (int e = 0; e < 4; ++e) { w0[4 * h + e] = a[e]; w1[4 * h + e] = b[e]; w2[4 * h + e] = c[e]; bias[4 * h + e] = d[e]; }
            }
        }
        auto unpack8 = [](const u32x4& v, float (&f)[8]) { f[0] = blo(v.x); f[1] = bhi(v.x); f[2] = blo(v.y); f[3] = bhi(v.y); f[4] = blo(v.z); f[5] = bhi(v.z); f[6] = blo(v.w); f[7] = bhi(v.w); };
        for (int u = blockIdx.x; u < 256; u += gridDim.x) {
            const int rb = u * 66 + wid * 9, nr = wid < 7 ? 9 : 3;
            u32x4 cc[11], cx[11], cg[9];
#pragma unroll
            for (int j = 0; j < 11; ++j) {
                int row = rb - 1 + j; row = row < 0 ? 0 : (row >= R ? R - 1 : row);
                cc[j] = *(const u32x4*)(zc + (size_t)row * 1536 + 512 + c8); cx[j] = *(const u32x4*)(zc + (size_t)row * 1536 + 1024 + c8);
            }
#pragma unroll
            for (int i = 0; i < 9; ++i) { const int row = rb + i < R ? rb + i : R - 1; cg[i] = *(const u32x4*)(zc + (size_t)row * 1536 + c8); }
            float pm[8], pc[8], pn[8];
            { float a[8], b[8]; unpack8(cc[0], a); unpack8(cx[0], b);
#pragma unroll
              for (int e = 0; e < 8; ++e) pm[e] = a[e] * b[e];
              unpack8(cc[1], a); unpack8(cx[1], b);
#pragma unroll
              for (int e = 0; e < 8; ++e) pc[e] = a[e] * b[e]; }
#pragma unroll
            for (int i = 0; i < 9; ++i) {
                { float a[8], b[8]; unpack8(cc[i + 2], a); unpack8(cx[i + 2], b);
#pragma unroll
                  for (int e = 0; e < 8; ++e) pn[e] = a[e] * b[e]; }
                const int r = rb + i;
                const bool first = r < NL ? (r & 8191) == 0 : ((r - NL) & 255) == 0, last = r < NL ? (r & 8191) == 8191 : ((r - NL) & 255) == 255;
                if (i < nr) {
                    float g[8], o[8]; unpack8(cg[i], g);
#pragma unroll
                    for (int e = 0; e < 8; ++e) o[e] = g[e] * (bias[e] + w0[e] * (first ? 0.f : pm[e]) + w1[e] * pc[e] + w2[e] * (last ? 0.f : pn[e]));
                    u32x4 wv; wv.x = pk2(o[0], o[1]); wv.y = pk2(o[2], o[3]); wv.z = pk2(o[4], o[5]); wv.w = pk2(o[6], o[7]);
                    *(u32x4*)(hb + (size_t)r * 1024 + c8) = wv;
                }
#pragma unroll
                for (int e = 0; e < 8; ++e) { pm[e] = pc[e]; pc[e] = pn[e]; }
            }
        }
    }
}

DI void phase_outproj(const Params& P, const Ctx& p, uchar* lds, int layer) {
    const int tid = tid_opaque();
    const u16* hb = (const u16*)(p.ws + WS_HB);
    const u16* w = (const u16*)(p.ws + (layer == 0 ? WS_WOUT0 : WS_WOUT1));
    float* xs = (float*)(p.ws + WS_XS);
    const float* mod = (const float*)(p.ws + WS_MOD);
    const int nbig = 256, nunits = nbig + (layer == 0 ? 32 : 0);
    const bool ctx_split = layer == 0 && gridDim.x == 256;
    unsigned* ctxf = (unsigned*)(p.ws + WS_CTL + CTL_CTXF);
    if (ctx_split && blockIdx.x >= 248) {
        if (tid < 128) ((float*)(lds + 131072))[tid] = inp(p, I_SUBN)[tid];
        const int bh = blockIdx.x - 248;
        attn_unit(p, lds, bh, SEQ, SEQ, 4, NL + (bh >> 2) * CTXL);
        asm volatile("s_waitcnt vmcnt(0)" ::: "memory");
        __syncthreads();
        if (tid_opaque() == 0) { __builtin_amdgcn_fence(__ATOMIC_RELEASE, "agent"); asm volatile("s_waitcnt vmcnt(0)" ::: "memory"); (void)xb_add(ctxf, 1u); }
    }
    bool ctx_ready = !ctx_split;
    for (int u = blockIdx.x; u < nunits; u += gridDim.x) {
        const bool big = u < nbig;
        if (!big && !ctx_ready) {
            if (tid_opaque() == 0) { unsigned sp = 0; while (xb_ld(ctxf) < 8u && ++sp < (1u << 22)) __builtin_amdgcn_s_sleep(2); __builtin_amdgcn_fence(__ATOMIC_ACQUIRE, "agent"); asm volatile("s_waitcnt vmcnt(0)" ::: "memory"); }
            __syncthreads();
            ctx_ready = true;
        }
        int mt, nt; if (big) rect_unit(u, 64, 4, mt, nt); else { mt = (u - nbig) >> 3; nt = (u - nbig) & 7; }
        const int m0 = big ? mt * 256 : NL + mt * 128, n0 = big ? nt * 256 : nt * 128;
        auto epi_body =
            [&](int roff, int wc, int lane, uchar* w) {
                const int row0 = m0 + roff, nw = n0 + wc * 64;
                const float* g1 = mod + (layer * 3 + mod_row(row0)) * 6144 + 2048 + nw;
                const float* src = row_src(p, layer, row0) + nw;
                f32x4 xi[16], gg = *(const f32x4*)(g1 + (lane & 15) * 4);
#pragma unroll
                for (int it = 0; it < 16; ++it) xi[it] = *(const f32x4*)(src + (size_t)(it * 4 + (lane >> 4)) * 1024 + (lane & 15) * 4);
#pragma unroll
                for (int it = 0; it < 16; ++it) {
                    const int row = it * 4 + (lane >> 4), col = (lane & 15) * 4;
                    const f32x4 v = *(const f32x4*)(w + row * EPI_PITCH + col * 4);
                    f32x4 o;
#pragma unroll
                    for (int e = 0; e < 4; ++e) o[e] = xi[it][e] + gg[e] * v[e];
                    *(f32x4*)(xs + (size_t)(row0 + row) * 1024 + nw + col) = o;
                }
            };
        auto epi = [&](f32x16 (&acc)[2][2], int roff, int wc, int lane, uchar* w) { epi_stage(w, acc, lane & 31, lane >> 5); epi_body(roff, wc, lane, w); };
        if (big) {
            int r0, c; p8_rc(tid, r0, c);
            const unsigned ao = (unsigned)(r0 * 2048 + c * 2), bo = (unsigned)((((r0 >> 5) * 64 + (r0 & 31)) * 2048) + c * 2);
            gemm_tile8p(lds, (const uchar*)(hb + (size_t)m0 * 1024), ao, ao, ao, ao, 128 * 2048, 64 * 2048, 192 * 2048,
                        (const uchar*)(w + (size_t)n0 * 1024), bo, 128 * 2048, 32 * 2048, 160 * 2048, 16, 1 << 30, 0, epi_body);
        } else {
            const int rs = tid >> 3;
            const u16* ab = hb + (size_t)(m0 + rs) * 1024;
            const u16* bb = w + (size_t)(n0 + rs) * 1024;
            gemm_tile128(lds, ab, ab + 64 * 1024, bb, bb + 64 * 1024, 16, 1 << 30, 0, epi);
        }
    }
    if (layer == 0) {
        if (ctx_split) { if (blockIdx.x >= 32 && blockIdx.x < 248) cvt_list(P, lds, MOE_CVT_TILES / 2 + ((int)blockIdx.x - 32), 216, MOE_CVT_TILES, [&](int idx, int& j, int& t) { j = 6 + (idx >> 11); t = (idx & 2047); }); }
        else tail_cvt_moe(P, lds, nunits, 0, MOE_CVT_TILES / 2, MOE_CVT_TILES);
    }
}

struct TileInfo { int bucket, mt, cnt, ntiles; };
DI int moe_ntiles(const int* cnt) { int s = 0; for (int b = 0; b < 24; ++b) s += (cnt[b * 32] + 127) >> 7; return s; }
DI TileInfo moe_tile(const int* cnt, int t) {
    TileInfo ti; ti.bucket = 0; ti.mt = 0; ti.cnt = 0; ti.ntiles = 0;
    int base = 0;
    for (int b = 0; b < 24; ++b) { const int c = cnt[b * 32], n = (c + 127) >> 7; if (t >= base && t < base + n) { ti.bucket = b; ti.mt = t - base; ti.cnt = c; } base += n; }
    ti.ntiles = base; return ti;
}
DI void bucket_experts(int bucket, int& ea, int& eb) {
    const int g = bucket / 6, pi = bucket - g * 6;
    const int lo = pi < 3 ? 0 : (pi < 5 ? 1 : 2), hi = pi < 3 ? pi + 1 : (pi < 5 ? pi - 1 : 3);
    ea = g * 4 + lo; eb = g * 4 + hi;
}
struct MoeUnit { int bucket, t, mt, cnt, big, nt; };
typedef const volatile LAS int* lcnt_t;
DI int moe_units(lcnt_t cnt, int NT, int G, int& B, int& NBIG) {
    int b2 = 0, s1 = 0;
    for (int b = 0; b < 24; ++b) { const int n = (cnt[b] + 127) >> 7; b2 += n >> 1; s1 += n & 1; }
    B = b2;
    const int cand = b2 * NT;
    int best = 1 << 30; NBIG = 0;
    for (int k = 0; k <= (cand + G - 1) / G; ++k) {
        const int nb = k * G < cand ? k * G : cand, U = 2 * cand + s1 * NT - nb;
        const int rb = (nb + G - 1) / G, ru = (U + G - 1) / G, cost = rb * 7 + (ru - rb) * 5;
        if (cost < best) { best = cost; NBIG = nb; }
    }
    return 2 * cand + s1 * NT - NBIG;
}
DI MoeUnit moe_unit(lcnt_t cnt, int u, int NT, int B, int NBIG) {
    const int sh = NT == 8 ? 3 : 2;
    int kind, idx, half = 0, nt;
    if (u < NBIG) {
        kind = 0; idx = u >> sh; nt = u & (NT - 1);
        if (gridDim.x == 256 && u < (NBIG & ~255)) { const int r = u >> 8, b = u & 255, x = b & 7, y = b >> 3; idx = (r << (8 - sh)) + x * (32 >> sh) + (y >> sh); nt = y & (NT - 1); }
    }
    else {
        int v = u - NBIG; const int npl = B - (NBIG >> sh);
        if (v < npl * 2 * NT) { kind = 1; idx = (NBIG >> sh) + (v >> (sh + 1)); half = (v >> sh) & 1; nt = v & (NT - 1); }
        else { v -= npl * 2 * NT; kind = 2; idx = v >> sh; nt = v & (NT - 1); }
    }
    MoeUnit r; r.bucket = 0; r.t = 0; r.mt = 0; r.cnt = 0; r.big = kind == 0; r.nt = nt;
    int pb = 0, ps = 0, pt = 0;
    for (int b = 0; b < 24; ++b) {
        const int c = cnt[b], n = (c + 127) >> 7, np = n >> 1, sg = n & 1;
        if (kind != 2) { if (idx >= pb && idx < pb + np) { r.bucket = b; r.mt = 2 * (idx - pb) + half; r.t = pt + r.mt; r.cnt = c; } }
        else if (sg && idx == ps) { r.bucket = b; r.mt = n - 1; r.t = pt + n - 1; r.cnt = c; }
        pb += np; ps += sg; pt += n;
    }
    return r;
}
constexpr int MOE_TOK = 3 * GEMM_STAGE;
DI void phase_moe_up(const Params& P, const Ctx& p, uchar* lds, int layer) {
    const int tid = tid_opaque();
    const int* cnt = (const int*)(p.ws + WS_CTL + CTL_CNT) + layer * 1024;
    const int* list = (const int*)(p.ws + WS_LIST);
    const f32x2* route = (const f32x2*)(p.ws + WS_ROUTE);
    const u16* hb = (const u16*)(p.ws + WS_HB);
    const u16* wgu = (const u16*)(p.ws + WS_WGU) + (size_t)layer * 16 * 1024 * 1024;
    u16* act = (u16*)(p.ws + WS_REGA + RA_ACT);
    int* tok = (int*)(lds + MOE_TOK);
    const int rs = tid >> 3;
    lcnt_t lc = (lcnt_t)(smem + 640);
    __syncthreads();
    if (tid < 24) ((volatile LAS int*)(smem + 640))[tid] = cnt[tid * 32];
    __syncthreads();
    int B, NBIG;
    const int U = moe_units(lc, 8, gridDim.x, B, NBIG);
    for (int u = blockIdx.x; u < U; u += gridDim.x) {
        const MoeUnit mu = moe_unit(lc, u, 8, B, NBIG);
        const int nt = mu.nt;
        int ea, eb; bucket_experts(mu.bucket, ea, eb);
        __syncthreads();
        if (tid < (mu.big ? 256 : 128)) { const int pos = mu.mt * 128 + tid; tok[tid] = list[(size_t)mu.bucket * R + (pos < mu.cnt ? pos : 0)]; }
        __syncthreads();
        const int e = nt < 4 ? ea : eb;
        auto epi_body =
            [&](int roff, int wc, int lane, uchar* w) {
                u16* dst = act + ((size_t)mu.t * 128 + roff) * 1024 + (nt >= 4 ? 512 : 0) + (nt & 3) * 128 + wc * 32;
                const int col = (lane & 3) * 8;
                f32x2 rw[4];
#pragma unroll
                for (int it = 0; it < 4; ++it) rw[it] = route[tok[roff + it * 16 + (lane >> 2)]];
#pragma unroll
                for (int it = 0; it < 4; ++it) {
                    const int row = it * 16 + (lane >> 2);
                    const float wgt = nt < 4 ? rw[it].x : rw[it].y;
                    const uchar* wp = w + row * EPI_PITCH + col * 4;
                    const f32x4 g0 = *(const f32x4*)wp, g1 = *(const f32x4*)(wp + 16), u0 = *(const f32x4*)(wp + 128), u1 = *(const f32x4*)(wp + 144);
                    f32x4 o0, o1;
#pragma unroll
                    for (int e2 = 0; e2 < 4; ++e2) { o0[e2] = g0[e2] * sigmoidf_(g0[e2]) * u0[e2] * wgt; o1[e2] = g1[e2] * sigmoidf_(g1[e2]) * u1[e2] * wgt; }
                    *(u32x4*)(dst + (size_t)row * 1024 + col) = pack8(o0, o1);
                }
            };
        if (mu.big) {
            int r0, c; p8_rc(tid, r0, c);
            const unsigned bo = (unsigned)((((r0 >> 5) * 64 + (r0 & 31)) * 2048) + c * 2);
            const unsigned a00 = (unsigned)tok[r0] * 2048u + c * 2, a10 = (unsigned)tok[128 + r0] * 2048u + c * 2, a01 = (unsigned)tok[64 + r0] * 2048u + c * 2, a11 = (unsigned)tok[192 + r0] * 2048u + c * 2;
            gemm_tile8p(lds, (const uchar*)hb, a00, a10, a01, a11, 0, 0, 0,
                        (const uchar*)(wgu + ((size_t)e * 1024 + (nt & 3) * 256) * 1024), bo, 128 * 2048, 32 * 2048, 160 * 2048, 16, 1 << 30, 0, epi_body);
        } else {
            const u16* a0 = hb + (size_t)tok[rs] * 1024;
            const u16* a1 = hb + (size_t)tok[rs + 64] * 1024;
            const u16* bb = wgu + ((size_t)e * 1024 + (nt & 3) * 256 + rs) * 1024;
            gemm_tile(lds, a0, a1, bb, bb + 64 * 1024, bb + 128 * 1024, bb + 192 * 1024, 16, 1 << 30, 0,
                [&](f32x16 (&acc)[2][2], int roff, int wc, int lane, uchar* w) { epi_stage(w, acc, lane & 31, lane >> 5); epi_body(roff, wc, lane, w); });
        }
    }
    if (layer == 0) tail_cvt_dense(P, lds, U, P.jobs[2].tile0, P.jobs[6].tile0);
}
DI void phase_moe_down(const Params& P, const Ctx& p, uchar* lds, int layer) {
    const int tid = tid_opaque();
    const int* cnt = (const int*)(p.ws + WS_CTL + CTL_CNT) + layer * 1024;
    const int* list = (const int*)(p.ws + WS_LIST);
    const u16* wd = (const u16*)(p.ws + WS_WD) + (size_t)layer * 16 * 1024 * 512;
    const u16* act = (const u16*)(p.ws + WS_REGA + RA_ACT);
    float* xs = (float*)(p.ws + WS_XS);
    float* dsto = layer == 0 ? xs : p.out;
    const float* mod = (const float*)(p.ws + WS_MOD);
    int* tok = (int*)(lds + MOE_TOK);
    const int rs = tid >> 3;
    lcnt_t lc = (lcnt_t)(smem + 640);
    __syncthreads();
    if (tid < 24) ((volatile LAS int*)(smem + 640))[tid] = cnt[tid * 32];
    __syncthreads();
    int B, NBIG;
    const int U = moe_units(lc, 4, gridDim.x, B, NBIG);
    for (int u = blockIdx.x; u < U; u += gridDim.x) {
        const MoeUnit mu = moe_unit(lc, u, 4, B, NBIG);
        const int nt = mu.nt, n0 = nt * 256;
        int ea, eb; bucket_experts(mu.bucket, ea, eb);
        __syncthreads();
        if (tid < (mu.big ? 256 : 128)) { const int pos = mu.mt * 128 + tid; tok[tid] = pos < mu.cnt ? list[(size_t)mu.bucket * R + pos] : -1; }
        __syncthreads();
        const long bjump = (long)(eb - ea) * 1024 * 512 - 512;
        auto epi_body =
            [&](int roff, int wc, int lane, uchar* w) {
                const int nw = n0 + wc * 64 + (lane & 15) * 4;
                int tk[16]; f32x4 xi[16], g3[3];
#pragma unroll
                for (int q = 0; q < 3; ++q) g3[q] = *(const f32x4*)(mod + (layer * 3 + q) * 6144 + 5 * 1024 + nw);
#pragma unroll
                for (int it = 0; it < 16; ++it) {
                    tk[it] = tok[roff + it * 4 + (lane >> 4)];
                    xi[it] = (f32x4){0.f, 0.f, 0.f, 0.f};
                    if (tk[it] >= 0) xi[it] = *(const f32x4*)(xs + (size_t)tk[it] * 1024 + nw);
                }
#pragma unroll
                for (int it = 0; it < 16; ++it) {
                    const int row = it * 4 + (lane >> 4);
                    if (tk[it] >= 0) {
                        const int mr = mod_row(tk[it]);
                        const f32x4 gg = mr == 0 ? g3[0] : (mr == 1 ? g3[1] : g3[2]);
                        const f32x4 v = *(const f32x4*)(w + row * EPI_PITCH + (lane & 15) * 16);
                        f32x4 o;
#pragma unroll
                        for (int e = 0; e < 4; ++e) o[e] = xi[it][e] + gg[e] * v[e];
                        *(f32x4*)(dsto + (size_t)tk[it] * 1024 + nw) = o;
                    }
                }
            };
        if (mu.big) {
            int r0, c; p8_rc(tid, r0, c);
            const unsigned ao = (unsigned)(r0 * 2048 + c * 2), bo = (unsigned)((((r0 >> 5) * 64 + (r0 & 31)) * 1024) + c * 2);
            gemm_tile8p(lds, (const uchar*)(act + (size_t)mu.t * 128 * 1024), ao, ao, ao, ao, 128 * 2048, 64 * 2048, 192 * 2048,
                        (const uchar*)(wd + ((size_t)ea * 1024 + n0) * 512), bo, 128 * 1024, 32 * 1024, 160 * 1024, 16, 8, bjump * 2, epi_body);
        } else {
            const u16* ab = act + ((size_t)mu.t * 128 + rs) * 1024;
            const u16* bb = wd + ((size_t)ea * 1024 + n0 + rs) * 512;
            gemm_tile(lds, ab, ab + 64 * 1024, bb, bb + 64 * 512, bb + 128 * 512, bb + 192 * 512, 16, 8, bjump,
                [&](f32x16 (&acc)[2][2], int roff, int wc, int lane, uchar* w) { epi_stage(w, acc, lane & 31, lane >> 5); epi_body(roff, wc, lane, w); });
        }
    }
    if (layer == 0) tail_cvt_moe(P, lds, U, 1, 0, MOE_CVT_TILES / 2);
}

DI void phase_inproj1(const Params& P, const Ctx& p, uchar* lds) {
    const int tid = tid_opaque();
    const u16* hb = (const u16*)(p.ws + WS_HB);
    const u16* w = (const u16*)(p.ws + WS_WIN1);
    u16* yb = (u16*)(p.ws + WS_REGA + RA_Y);
    u16* ub = (u16*)(p.ws + WS_REGA + RA_U);
    const int rs = tid >> 3;
    for (int u = blockIdx.x; u < 512 + 32; u += gridDim.x) {
        const bool big = u < 512;
        int mt, nt, nh = 0; if (big) rect_unit(u, 64, 8, mt, nt); else { mt = (u - 512) >> 3; nt = 4 + (((u - 512) >> 1) & 3); nh = (u - 512) & 1; }
        const int m0 = big ? mt * 256 : NL + mt * 128, n0 = nt * 256 + nh * 128;
        auto epi_body =
            [&](int roff, int wc, int lane, uchar* w) {
                const int row0 = m0 + roff, nw = n0 + wc * 64;
                if (nt < 4) {
                    epi_rows8<64>(w, lane, [&](int row, int col, const f32x4& v0, const f32x4& v1) {
                        f32x4 a, b2;
#pragma unroll
                        for (int e = 0; e < 4; ++e) { const float x = v0[e], y = v1[e]; a[e] = x * sigmoidf_(1.5957691216057308f * (x + 0.044715f * x * x * x)); b2[e] = y * sigmoidf_(1.5957691216057308f * (y + 0.044715f * y * y * y)); }
                        *(u32x4*)(yb + (size_t)(row0 + row) * 1024 + nw + col) = pack8(a, b2); });
                } else {
                    epi_rows8<64>(w, lane, [&](int row, int col, const f32x4& v0, const f32x4& v1) { *(u32x4*)(ub + (size_t)(row0 + row) * 1024 + nw - 1024 + col) = pack8(v0, v1); });
                }
            };
        if (big) {
            int r0, c; p8_rc(tid, r0, c);
            const unsigned ao = (unsigned)(r0 * 2048 + c * 2), bo = (unsigned)((((r0 >> 5) * 64 + (r0 & 31)) * 2048) + c * 2);
            gemm_tile8p(lds, (const uchar*)(hb + (size_t)m0 * 1024), ao, ao, ao, ao, 128 * 2048, 64 * 2048, 192 * 2048,
                        (const uchar*)(w + (size_t)n0 * 1024), bo, 128 * 2048, 32 * 2048, 160 * 2048, 16, 1 << 30, 0, epi_body);
        } else {
            const u16* ab = hb + (size_t)(m0 + rs) * 1024;
            const u16* bb = w + (size_t)(n0 + rs) * 1024;
            gemm_tile128(lds, ab, ab + 64 * 1024, bb, bb + 64 * 1024, 16, 1 << 30, 0,
                [&](f32x16 (&acc)[2][2], int roff, int wc, int lane, uchar* w) { epi_stage(w, acc, lane & 31, lane >> 5); epi_body(roff, wc, lane, w); });
        }
    }
    tail_cvt_moe(P, lds, 512 + 32, 1, MOE_CVT_TILES / 2, MOE_CVT_TILES);
}

constexpr int LRU_GK = 142336;
constexpr int LRU_U = 0, LRU_UC = 36864, UROW = 272, UC_BLK = 64 * UROW  , UC_DIR = 2 * UC_BLK;
DI int lru_perm(int r) { return ((r >> 2) & 1) * 16 + (r >> 3) * 4 + (r & 3); }
DI unsigned* lru_bsave(const Ctx& p, int dir, int c, int cblk, int wid) {
    unsigned* base = (unsigned*)(p.ws + (dir == 0 ? WS_REGA + RA_BS0 : WS_WGU));
    return base + ((size_t)(c * 4 + cblk) * 8 + wid) * 1024;
}
DI u32x4* lru_osave(const Ctx& p, int dir, int c, int cblk, int wid, int q, int lane) {
    if (dir == 0) return (u32x4*)(p.ws + WS_HB + ((size_t)(c * 64 + (wid * 4 + q) * 2 + (lane >> 5)) * 2048 + cblk * 512 + (lane & 31) * 16));
    uchar* base = p.ws + (c < 128 ? WS_WD : WS_OM1B);
    return (u32x4*)(base + ((size_t)((c & 127) * 4 + cblk) * 32768 + ((wid * 4 + q) * 64 + lane) * 16));
}
struct LruW { bf16x8 fa[8], fx[8]; };
DI void lru_wload(const Ctx& p, int dir, int cblk, int wid, int lane, LruW& w, int which = 3) {
    const int l31 = lane & 31, hh = lane >> 5, bl = wid >> 2, jq = wid & 3, blkg = cblk * 2 + bl;
    const u16* wa = (const u16*)(p.ws + WS_WA) + ((size_t)(dir * 8 + blkg) * 128 + jq * 32 + l31) * 128 + hh * 8;
    const u16* wx = (const u16*)(p.ws + WS_WX) + ((size_t)(dir * 8 + blkg) * 128 + jq * 32 + l31) * 128 + hh * 8;
    if (which & 1) {
#pragma unroll
        for (int ks = 0; ks < 8; ++ks) w.fa[ks] = *(const bf16x8*)(wa + ks * 16);
    }
    if (which & 2) {
#pragma unroll
        for (int ks = 0; ks < 8; ++ks) w.fx[ks] = *(const bf16x8*)(wx + ks * 16);
    }
    __builtin_amdgcn_sched_barrier(0);
}
template <class Hook, class Hook2>
DI void lru_gates(const Ctx& p, const uchar* lds, int dir, int cblk, int wid, int lane, const LruW& w, float (&a)[2][16], float (&b)[2][16], unsigned* bsave, Hook&& hook, Hook2&& hook2, bool cached = false) {
    const int l31 = lane & 31, hh = lane >> 5, bl = wid >> 2, jq = wid & 3;
    const int chl = bl * 128 + jq * 32 + l31;
    const int ch = cblk * 256 + chl;
    const uchar* uc = lds + LRU_UC + dir * UC_DIR + bl * UC_BLK;
    f32x16 dr[2], di[2];
#pragma unroll
    for (int rb = 0; rb < 2; ++rb)
#pragma unroll
        for (int i = 0; i < 16; ++i) { dr[rb][i] = 0.f; di[rb][i] = 0.f; }
    const int tk = lru_perm(l31);
#pragma unroll
    for (int ks = 0; ks < 8; ++ks) {
#pragma unroll
        for (int rb = 0; rb < 2; ++rb) dr[rb] = MFMA32(*(const bf16x8*)(uc + (rb * 32 + tk) * UROW + ks * 32 + hh * 16), w.fa[ks], dr[rb]);
    }
#pragma unroll
    for (int ks = 0; ks < 8; ++ks) {
#pragma unroll
        for (int rb = 0; rb < 2; ++rb) di[rb] = MFMA32(*(const bf16x8*)(uc + (rb * 32 + tk) * UROW + ks * 32 + hh * 16), w.fx[ks], di[rb]);
    }
    __builtin_amdgcn_sched_barrier(0);
    hook();
    const float nl2 = -1.4426950408889634f;
    float kba, kbx, c1;
    if (cached) {
        const float* gk = (const float*)(lds + LRU_GK) + dir * 256 + chl;
        kba = gk[0]; kbx = gk[512]; c1 = gk[1024];
    } else {
        kba = inp(p, I_ODBA)[dir * 1024 + ch] * nl2; kbx = inp(p, I_ODBX)[dir * 1024 + ch] * nl2;
        c1 = 8.0f * log1pf(__expf(-inp(p, I_ODLAM)[dir * 1024 + ch])) * nl2;
    }
    const int cofs = (jq * 32 + l31) * 2;
#pragma unroll
    for (int rb = 0; rb < 2; ++rb)
#pragma unroll
        for (int i = 0; i < 16; ++i) {
            const int token = rb * 32 + hh * 16 + i;
            const float r = frcp(1.0f + __builtin_amdgcn_exp2f(__builtin_fmaf(dr[rb][i], nl2, kba)));
            const float av = __builtin_amdgcn_exp2f(c1 * r);
            a[rb][i] = av;
            const float om = __builtin_fmaf(-av, av, 1.0f);
            const float ucv = b2f(*(const u16*)(uc + token * UROW + cofs));
            const float ig = frcp(1.0f + __builtin_amdgcn_exp2f(__builtin_fmaf(di[rb][i], nl2, kbx)));
            b[rb][i] = __builtin_amdgcn_sqrtf(om) * (ig * ucv);
        }
    __builtin_amdgcn_sched_barrier(0);
    hook2();
    if (bsave) {
#pragma unroll
        for (int q = 0; q < 4; ++q) {
            u32x4 v;
#pragma unroll
            for (int e = 0; e < 4; ++e) { const int j = q * 4 + e, rb = j >> 3, i = (j & 7) * 2; v[e] = pk2(b[rb][i], b[rb][i + 1]); }
            ((u32x4*)bsave)[q * 64 + lane] = v;
        }
    }
}
constexpr int LRU_U2 = 106496;
DI void lru_seq(int c, int& s0, int& s1) { if (c < 256) { s0 = (c >> 7) * SEQ; s1 = s0 + SEQ; } else { s0 = NL + ((c - 256) >> 2) * CTXL; s1 = s0 + CTXL; } }
DI void lru_dma(const Ctx& p, uchar* lds, int c, int cblk, int buf) {
    const int tid = tid_opaque(), lane = tid & 63, wid = tid >> 6;
    const u16* ub = (const u16*)(p.ws + WS_REGA + RA_U);
    int s0, s1; lru_seq(c, s0, s1);
    const int w0 = __builtin_amdgcn_readfirstlane(wid);
    uchar* dst = lds + (buf ? LRU_U2 : LRU_U);
#pragma unroll
    for (int k = 0; k < 5; ++k) {
        const int i = w0 + 8 * k;
        if (i < 35) {
            int row = c * 64 - 3 + 2 * i + (lane >> 5);
            row = row < s0 ? s0 : (row >= s1 ? s1 - 1 : row);
            __builtin_amdgcn_global_load_lds((const unsigned*)(ub + (size_t)row * 1024 + cblk * 256 + (lane & 31) * 8), (LAS unsigned*)(dst + i * 1024), 16, 0, 0);
        }
    }
}
DI void lru_conv(const Ctx& p, uchar* lds, int c, int cblk, int buf, bool counted = false) {
    const int tid = tid_opaque();
    const int row0 = c * 64;
    int s0, s1; lru_seq(c, s0, s1);
    const uchar* ut = lds + (buf ? LRU_U2 : LRU_U);
    if (counted) WAIT_V(8); else WAIT_V(0);
    __syncthreads();
    const int c8 = tid & 31, tq = tid >> 5, t0 = tq * 4;
    float uv[10][8];
#pragma unroll
    for (int rr = 0; rr < 10; ++rr) {
        u32x4 v = *(const u32x4*)(ut + (t0 + rr) * 512 + c8 * 16);
        const int row = row0 - 3 + t0 + rr;
        if (row < s0 || row >= s1) v = (u32x4){0u, 0u, 0u, 0u};
        uv[rr][0] = blo(v.x); uv[rr][1] = bhi(v.x); uv[rr][2] = blo(v.y); uv[rr][3] = bhi(v.y); uv[rr][4] = blo(v.z); uv[rr][5] = bhi(v.z); uv[rr][6] = blo(v.w); uv[rr][7] = bhi(v.w);
    }
#pragma unroll
    for (int dir = 0; dir < 2; ++dir) {
        const float* cw = inp(p, I_ODCW) + dir * 4096 + cblk * 256 + c8 * 8;
        const float* cb = inp(p, I_ODCB) + dir * 1024 + cblk * 256 + c8 * 8;
        float w[4][8], bs[8];
#pragma unroll
        for (int k = 0; k < 4; ++k) { const f32x4 x0 = *(const f32x4*)(cw + k * 1024), x1 = *(const f32x4*)(cw + k * 1024 + 4); w[k][0] = x0[0]; w[k][1] = x0[1]; w[k][2] = x0[2]; w[k][3] = x0[3]; w[k][4] = x1[0]; w[k][5] = x1[1]; w[k][6] = x1[2]; w[k][7] = x1[3]; }
        { const f32x4 x0 = *(const f32x4*)cb, x1 = *(const f32x4*)(cb + 4); bs[0] = x0[0]; bs[1] = x0[1]; bs[2] = x0[2]; bs[3] = x0[3]; bs[4] = x1[0]; bs[5] = x1[1]; bs[6] = x1[2]; bs[7] = x1[3]; }
#pragma unroll
        for (int tt = 0; tt < 4; ++tt) {
            float o[8];
#pragma unroll
            for (int e = 0; e < 8; ++e) {
                float s = bs[e];
#pragma unroll
                for (int k = 0; k < 4; ++k) s += w[k][e] * uv[tt + k + (dir ? 3 : 0)][e];
                o[e] = s;
            }
            const int t = t0 + tt;
            u32x4 wv; wv.x = pk2(o[0], o[1]); wv.y = pk2(o[2], o[3]); wv.z = pk2(o[4], o[5]); wv.w = pk2(o[6], o[7]);
            *(u32x4*)(lds + LRU_UC + dir * UC_DIR + (c8 >> 4) * UC_BLK + t * UROW + (c8 & 15) * 16) = wv;
        }
    }
    __syncthreads();
}
DI void lru_seg(const float (&a)[2][16], const float (&b)[2][16], int dir, int hh, float (&SA)[4], float (&SB)[4]) {
    float oa[2], ob[2];
#pragma unroll
    for (int rb = 0; rb < 2; ++rb) {
        float A = 1.f, B = 0.f;
#pragma unroll
        for (int ii = 0; ii < 16; ++ii) { const int i = dir ? 15 - ii : ii; B = a[rb][i] * B + b[rb][i]; A *= a[rb][i]; }
        oa[rb] = A; ob[rb] = B;
    }
    float pa[2], pb[2];
#pragma unroll
    for (int rb = 0; rb < 2; ++rb) { pa[rb] = __shfl_xor(oa[rb], 32); pb[rb] = __shfl_xor(ob[rb], 32); }
#pragma unroll
    for (int rb = 0; rb < 2; ++rb)
#pragma unroll
        for (int h = 0; h < 2; ++h) {
            const float A = (h == hh) ? oa[rb] : pa[rb], B = (h == hh) ? ob[rb] : pb[rb];
            const int s = dir ? 3 - (rb * 2 + h) : rb * 2 + h;
            SA[s] = A; SB[s] = B;
        }
}
DI void st_summ(f32x2* q, f32x2 v) { __hip_atomic_store((unsigned long long*)q, __builtin_bit_cast(unsigned long long, v), __ATOMIC_RELAXED, __HIP_MEMORY_SCOPE_AGENT); }
DI f32x2 ld_summ(const f32x2* q) { return __builtin_bit_cast(f32x2, __hip_atomic_load((unsigned long long*)q, __ATOMIC_RELAXED, __HIP_MEMORY_SCOPE_AGENT)); }
DI void lru_summ_item(int j, int& c, int& cblk, int& role) {
    if (j < 1024) { c = j >> 2; cblk = j & 3; role = -1; } else { const int mini = j - 1024, cu = mini >> 3; c = 256 + (cu >> 2); cblk = cu & 3; role = mini & 7; }
}
template <class F>
DI void lru_summ_wave(const Ctx& p, uchar* lds, int c, int cblk, int role, LruW& w, F&& next_dma, bool cached = false) {
    const int tid = tid_opaque(), lane = tid & 63, wid = role < 0 ? (tid >> 6) : role, hh = lane >> 5;
    f32x2* summ = (f32x2*)(p.ws + WS_SUMM);
    const int ch = cblk * 256 + (wid >> 2) * 128 + (wid & 3) * 32 + (lane & 31);
#pragma unroll
    for (int dir = 0; dir < 2; ++dir) {
        float a[2][16], b[2][16];
        unsigned* bs = c < 256 ? lru_bsave(p, dir, c, cblk, wid) : (unsigned*)nullptr;
        if (dir == 0) lru_gates(p, lds, 0, cblk, wid, lane, w, a, b, bs, [&]() { lru_wload(p, 1, cblk, wid, lane, w, 1); }, [&]() { lru_wload(p, 1, cblk, wid, lane, w, 2); }, cached);
        else          lru_gates(p, lds, 1, cblk, wid, lane, w, a, b, bs, [&]() { next_dma(); lru_wload(p, 0, cblk, wid, lane, w, 1); }, [&]() { lru_wload(p, 0, cblk, wid, lane, w, 2); }, cached);
        if (c < 256) {
#pragma unroll
            for (int q = 0; q < 4; ++q) {
                u32x4 v;
#pragma unroll
                for (int e = 0; e < 4; ++e) { const int j = q * 4 + e, rb = j >> 3, i = (j & 7) * 2; v[e] = pk2(1.0f - a[rb][i], 1.0f - a[rb][i + 1]); }
                *lru_osave(p, dir, c, cblk, wid, q, lane) = v;
            }
        }
        float SA[4], SB[4];
        lru_seg(a, b, dir, hh, SA, SB);
        float A = 1.f, B = 0.f;
#pragma unroll
        for (int s = 0; s < 4; ++s) { B = SA[s] * B + SB[s]; A *= SA[s]; }
        if (hh == 0) st_summ(summ + ((size_t)dir * 264 + c) * 1024 + ch, (f32x2){A, B});
    }
}
DI void phase_lru_carry(const Ctx& p);
DI void phase_lru_summ_body(const Ctx& p, uchar* lds) {
    const int tid = tid_opaque(), lane = tid & 63, wid = tid >> 6;
    constexpr int NITEM = 1024 + 32 * 8;
    int c, cblk, role;
    if ((int)blockIdx.x >= NITEM) return;
    lru_summ_item(blockIdx.x, c, cblk, role); lru_dma(p, lds, c, cblk, 0);
    const int cblk_own = cblk;
    {
        const int dir = tid >> 8, chl = tid & 255, ch = cblk_own * 256 + chl;
        const float nl2 = -1.4426950408889634f;
        float* gk = (float*)(lds + LRU_GK) + dir * 256 + chl;
        gk[0] = inp(p, I_ODBA)[dir * 1024 + ch] * nl2; gk[512] = inp(p, I_ODBX)[dir * 1024 + ch] * nl2;
        gk[1024] = 8.0f * log1pf(__expf(-inp(p, I_ODLAM)[dir * 1024 + ch])) * nl2;
    }
    LruW w;
    lru_wload(p, 0, cblk, role < 0 ? wid : role, lane, w);
    int buf = 0;
    bool counted = false;
    for (int j = blockIdx.x; j < NITEM; j += gridDim.x, buf ^= 1) {
        lru_summ_item(j, c, cblk, role);
        lru_conv(p, lds, c, cblk, buf, counted);
        counted = role < 0;
        int c2 = 0, cblk2 = 0, role2 = -1;
        const bool more = j + (int)gridDim.x < NITEM;
        if (more) lru_summ_item(j + gridDim.x, c2, cblk2, role2);
        auto next_dma = [&]() { if (more) lru_dma(p, lds, c2, cblk2, buf ^ 1); };
        if (role < 0) {
            lru_summ_wave(p, lds, c, cblk, -1, w, next_dma, cblk == cblk_own);
            if (more && role2 >= 0) lru_wload(p, 0, cblk2, role2, lane, w);
        } else {
            if (wid == 0) lru_summ_wave(p, lds, c, cblk, role, w, next_dma); else next_dma();
            if (more && (cblk2 != cblk || role2 != role)) lru_wload(p, 0, cblk2, role2, lane, w);
        }
    }
    WAIT_V(0);
}
DI void phase_lru_summ(const Ctx& p, uchar* lds, bool fused) {
    phase_lru_summ_body(p, lds);
    if (!fused) return;
    unsigned* sumf = (unsigned*)(p.ws + WS_CTL + 32768 + 512);
    asm volatile("s_waitcnt vmcnt(0)" ::: "memory");
    __syncthreads();
    if (tid_opaque() == 0) (void)xb_add(sumf, 1u);
    if (blockIdx.x * 512 < 4096) {
        if (tid_opaque() == 0) { unsigned sp = 0; while (xb_ld(sumf) < gridDim.x && ++sp < (1u << 22)) __builtin_amdgcn_s_sleep(2); }
        __syncthreads();
        phase_lru_carry(p);
    }
}
DI void phase_lru_carry(const Ctx& p) {
    const int tid = tid_opaque();
    const f32x2* summ = (const f32x2*)(p.ws + WS_SUMM);
    float* carry = (float*)(p.ws + WS_CARRY);
    for (int g = blockIdx.x * 512 + tid; g < 4096; g += gridDim.x * 512) {
        const int ch = g & 1023, bt = (g >> 10) & 1, dir = g >> 11;
        const f32x2* sd = summ + (size_t)dir * 264 * 1024 + ch;
        float h = 0.f;
        f32x2 s[4];
#pragma unroll
        for (int q = 0; q < 4; ++q) s[q] = ld_summ((f32x2*)sd + (size_t)(256 + bt * 4 + (dir ? 3 - q : q)) * 1024);
#pragma unroll
        for (int q = 0; q < 4; ++q) h = s[q].x * h + s[q].y;
        f32x2 ta[16], tb[16];
#pragma unroll
        for (int q = 0; q < 16; ++q) { const int ci = dir ? 127 - q : q; ta[q] = ld_summ((f32x2*)sd + (size_t)(bt * 128 + ci) * 1024); }
#pragma unroll 1
        for (int q0 = 0; q0 < 128; q0 += 32) {
#pragma unroll
            for (int q = 0; q < 16; ++q) { const int ci = dir ? 127 - (q0 + 16 + q) : q0 + 16 + q; tb[q] = ld_summ((f32x2*)sd + (size_t)(bt * 128 + ci) * 1024); }
#pragma unroll
            for (int q = 0; q < 16; ++q) { const int ci = dir ? 127 - (q0 + q) : q0 + q; carry[((size_t)dir * 256 + bt * 128 + ci) * 1024 + ch] = h; h = ta[q].x * h + ta[q].y; }
            if (q0 + 32 < 128) {
#pragma unroll
                for (int q = 0; q < 16; ++q) { const int ci = dir ? 127 - (q0 + 32 + q) : q0 + 32 + q; ta[q] = ld_summ((f32x2*)sd + (size_t)(bt * 128 + ci) * 1024); }
            }
#pragma unroll
            for (int q = 0; q < 16; ++q) { const int ci = dir ? 127 - (q0 + 16 + q) : q0 + 16 + q; carry[((size_t)dir * 256 + bt * 128 + ci) * 1024 + ch] = h; h = tb[q].x * h + tb[q].y; }
        }
    }
}
DI void phase_lru_scan(const Ctx& p, uchar* lds) {
    const int tid = tid_opaque(), lane = tid & 63, wid = tid >> 6, hh = lane >> 5;
    const u16* yb = (const u16*)(p.ws + WS_REGA + RA_Y);
    u16* hb = (u16*)(p.ws + WS_HB);
    for (int u = blockIdx.x; u < 256 * 4; u += gridDim.x) {
        const int c = u >> 2, cblk = u & 3;
        const int ch = cblk * 256 + (wid >> 2) * 128 + (wid & 3) * 32 + (lane & 31);
        float hsum[2][16];
        __syncthreads();
#pragma unroll
        for (int dir = 0; dir < 2; ++dir) {
            const float h0 = ((const float*)(p.ws + WS_CARRY))[((size_t)dir * 256 + c) * 1024 + ch];
            float a[2][16], b[2][16];
            {
                const unsigned* bs = lru_bsave(p, dir, c, cblk, wid);
                unsigned bw[16], ow[16];
#pragma unroll
                for (int q = 0; q < 4; ++q) {
                    const u32x4 vb = ((const u32x4*)bs)[q * 64 + lane], vo = *lru_osave(p, dir, c, cblk, wid, q, lane);
#pragma unroll
                    for (int e = 0; e < 4; ++e) { bw[q * 4 + e] = vb[e]; ow[q * 4 + e] = vo[e]; }
                }
#pragma unroll
                for (int rb = 0; rb < 2; ++rb)
#pragma unroll
                    for (int i = 0; i < 16; ++i) {
                        const unsigned wb = bw[rb * 8 + (i >> 1)], wo = ow[rb * 8 + (i >> 1)];
                        b[rb][i] = (i & 1) ? bhi(wb) : blo(wb);
                        a[rb][i] = 1.0f - ((i & 1) ? bhi(wo) : blo(wo));
                    }
            }
            float SA[4], SB[4];
            lru_seg(a, b, dir, hh, SA, SB);
            float st[4]; st[0] = h0;
#pragma unroll
            for (int s = 1; s < 4; ++s) st[s] = SA[s - 1] * st[s - 1] + SB[s - 1];
#pragma unroll
            for (int rb = 0; rb < 2; ++rb) {
                const int sidx = dir ? 3 - (rb * 2 + hh) : rb * 2 + hh;
                float h = sidx == 0 ? st[0] : (sidx == 1 ? st[1] : (sidx == 2 ? st[2] : st[3]));
#pragma unroll
                for (int ii = 0; ii < 16; ++ii) { const int i = dir ? 15 - ii : ii; h = a[rb][i] * h + b[rb][i]; if (dir == 0) hsum[rb][i] = h; else hsum[rb][i] += h; }
            }
        }
        __syncthreads();
        {
            const int chl = (wid >> 2) * 128 + (wid & 3) * 32 + (lane & 31);
#pragma unroll
            for (int rb = 0; rb < 2; ++rb)
#pragma unroll
                for (int i = 0; i < 16; ++i) *(float*)(lds + (rb * 32 + hh * 16 + i) * 1040 + chl * 4) = hsum[rb][i];
        }
        __syncthreads();
        u32x4 yv[4];
#pragma unroll
        for (int j = 0; j < 4; ++j) { const int pi = j * 512 + tid, tk = pi >> 5, c8 = pi & 31; yv[j] = *(const u32x4*)(yb + (size_t)(c * 64 + tk) * 1024 + cblk * 256 + c8 * 8); }
#pragma unroll
        for (int j = 0; j < 4; ++j) {
            const int pi = j * 512 + tid, tk = pi >> 5, c8 = pi & 31;
            const f32x4 h0 = *(const f32x4*)(lds + tk * 1040 + c8 * 32), h1 = *(const f32x4*)(lds + tk * 1040 + c8 * 32 + 16);
            const size_t o = (size_t)(c * 64 + tk) * 1024 + cblk * 256 + c8 * 8;
            u32x4 w;
            w.x = pk2(blo(yv[j].x) * h0[0], bhi(yv[j].x) * h0[1]); w.y = pk2(blo(yv[j].y) * h0[2], bhi(yv[j].y) * h0[3]);
            w.z = pk2(blo(yv[j].z) * h1[0], bhi(yv[j].z) * h1[1]); w.w = pk2(blo(yv[j].w) * h1[2], bhi(yv[j].w) * h1[3]);
            *(u32x4*)(hb + o) = w;
        }
    }
}

__global__ void __launch_bounds__(512) fwd_mega(const Params P) {
    uchar* lds = smem + LDS_USER;
    LAS unsigned long long* tab = (LAS unsigned long long*)(smem + 64);
    if (threadIdx.x < N_IN) tab[threadIdx.x] = (unsigned long long)P.in[threadIdx.x];
    if ((threadIdx.x & 63) == 0) ((volatile LAS int*)smem)[96 + hw_slot()] = threadIdx.x >> 6;
    const bool multi = (P.ph_hi - P.ph_lo) > 1;
    if (threadIdx.x == 0) { ((volatile LAS unsigned*)smem)[0] = 0u; ((volatile LAS unsigned*)smem)[1] = 0u; ((volatile LAS unsigned*)smem)[2] = 0u; ((volatile LAS unsigned*)smem)[3] = 0u; }
    __syncthreads();
    if (multi) (void)xcd_barrier_post((unsigned*)(P.ws + WS_CTL), (volatile LAS unsigned*)smem);
#define RUN_PHASE(k, call) if (P.ph_lo <= (k) && (k) < P.ph_hi) { { Ctx p; { unsigned long long wsi = (unsigned long long)P.ws; asm volatile("" : "+s"(wsi)); p.ws = (uchar*)(__attribute__((address_space(1))) uchar*)wsi; } p.out = P.out; p.tab = tab; call; } if ((PROBE_REPS >> (k)) & 1) { { XcdBarrier xb_; xb_.bar = (unsigned*)(P.ws + WS_CTL); xb_.x = xb_xcc_id(); xb_.st = (volatile LAS unsigned*)smem; xcd_barrier(xb_); } Ctx p; { unsigned long long wsi = (unsigned long long)P.ws; asm volatile("" : "+s"(wsi)); p.ws = (uchar*)(__attribute__((address_space(1))) uchar*)wsi; } p.out = P.out; p.tab = tab; call; } if (multi && (k) + 1 < P.ph_hi) { XcdBarrier xb_; xb_.bar = (unsigned*)(P.ws + WS_CTL); xb_.x = xb_xcc_id(); xb_.st = (volatile LAS unsigned*)smem; xcd_barrier(xb_); } }
    RUN_PHASE(0, phase_prep(P, p, lds))
    RUN_PHASE(1, phase_norm(p, 0))
    RUN_PHASE(2, phase_inproj0(P, p, lds))
    RUN_PHASE(3, phase_attn(p, lds))
    RUN_PHASE(4, phase_outproj(P, p, lds, 0))
    RUN_PHASE(5, phase_router(p, lds, 0))
#if PROBE_ROUTER2X
    if (P.ph_lo <= 5 && 5 < P.ph_hi) { Ctx p; { unsigned long long wsi = (unsigned long long)P.ws; asm volatile("" : "+s"(wsi)); p.ws = (uchar*)(__attribute__((address_space(1))) uchar*)wsi; } p.out = P.out; p.tab = tab; phase_router(p, lds, 0, 2); { XcdBarrier xb_; xb_.bar = (unsigned*)(P.ws + WS_CTL); xb_.x = xb_xcc_id(); xb_.st = (volatile LAS unsigned*)smem; xcd_barrier(xb_); } }
#endif
    RUN_PHASE(6, phase_moe_up(P, p, lds, 0))
    RUN_PHASE(7, phase_moe_down(P, p, lds, 0))
    RUN_PHASE(8, phase_norm(p, 1))
    RUN_PHASE(9, phase_inproj1(P, p, lds))
    const bool fused1011 = P.ph_lo <= 10 && P.ph_hi > 11;
    if (fused1011) { RUN_PHASE(11, phase_lru_summ(p, lds, true)) }
    else { RUN_PHASE(10, phase_lru_summ(p, lds, false)) RUN_PHASE(11, phase_lru_carry(p)) }
    RUN_PHASE(12, phase_lru_scan(p, lds))
    RUN_PHASE(13, phase_outproj(P, p, lds, 1))
    RUN_PHASE(14, phase_router(p, lds, 1))
    RUN_PHASE(15, phase_moe_up(P, p, lds, 1))
    RUN_PHASE(16, phase_moe_down(P, p, lds, 1))
}

extern "C" void kernel_launch(void* const* d_in, const int* in_sizes, int n_in, void* d_out, int out_size, void* d_ws, size_t ws_size, hipStream_t stream) {
    static int grid = 0;
    if (grid == 0) {
        if (n_in != N_IN || out_size != NL * D || ws_size < WS_END) { fprintf(stderr, "kernel_launch: unexpected shapes (n_in %d, out %d, ws %zu, need %zu)\n", n_in, out_size, ws_size, (size_t)WS_END); grid = -1; return; }
        int dev = 0, cus = 0, per_cu = 0;
        if (hipGetDevice(&dev) != hipSuccess || hipDeviceGetAttribute(&cus, hipDeviceAttributeMultiprocessorCount, dev) != hipSuccess) { grid = -1; return; }
        if (hipFuncSetAttribute((const void*)fwd_mega, hipFuncAttributeMaxDynamicSharedMemorySize, LDS_BYTES) != hipSuccess) { fprintf(stderr, "kernel_launch: hipFuncSetAttribute failed\n"); grid = -1; return; }
        if (hipOccupancyMaxActiveBlocksPerMultiprocessor(&per_cu, (const void*)fwd_mega, 512, LDS_BYTES) != hipSuccess || per_cu < 1) { fprintf(stderr, "kernel_launch: occupancy query says %d\n", per_cu); (void)hipGetLastError(); grid = -1; return; }
        grid = cus;
    }
    if (grid < 0) return;
    if (hipMemsetAsync((char*)d_ws + WS_CTL, 0, CTL_BYTES, stream) != hipSuccess) return;
    Params p{};
    for (int i = 0; i < N_IN; ++i) p.in[i] = (const float*)d_in[i];
    p.out = (float*)d_out; p.ws = (uchar*)d_ws;
    uchar* ws = (uchar*)d_ws;
    int t0 = 0;
    auto job = [&](int j, const float* src, size_t dst_off, int nmat, int K, int N, int sstride, int dstride, int lddst, int mode, int half) {
        CvtJob& J = p.jobs[j]; J.src = src; J.dst = (u16*)(ws + dst_off); J.nmat = nmat; J.K = K; J.N = N; J.sstride = sstride; J.dstride = dstride; J.lddst = lddst; J.mode = mode; J.half = half; J.tile0 = t0; J.pad = 0;
        t0 += nmat * (K / 64) * (N / 64);
    };
    job(0, p.in[I_EVWIN], WS_WIN0, 1, 1024, 3072, 0, 0, 1024, 0, 0);
    job(1, p.in[I_EVWOUT], WS_WOUT0, 1, 1024, 1024, 0, 0, 1024, 0, 0);
    job(2, p.in[I_ODWIN], WS_WIN1, 1, 1024, 2048, 0, 0, 1024, 0, 0);
    job(3, p.in[I_ODWOUT], WS_WOUT1, 1, 1024, 1024, 0, 0, 1024, 0, 0);
    job(4, p.in[I_ODWA], WS_WA, 16, 128, 128, 16384, 16384, 128, 0, 0);
    job(5, p.in[I_ODWX], WS_WX, 16, 128, 128, 16384, 16384, 128, 0, 0);
    job(6, p.in[I_MGATE], WS_WGU, 32, 1024, 512, 524288, 1048576, 1024, 1, 0);
    job(7, p.in[I_MUP], WS_WGU, 32, 1024, 512, 524288, 1048576, 1024, 1, 1);
    job(8, p.in[I_MDOWN], WS_WD, 32, 512, 1024, 524288, 524288, 512, 0, 0);
    p.ncvt = t0;
    const int nl = N_LAUNCHES;
    for (int li = 0; li < nl; ++li) {
        p.ph_lo = li * NPH / nl; p.ph_hi = (li + 1) * NPH / nl;
        hipLaunchKernelGGL(fwd_mega, dim3(grid), dim3(512), LDS_BYTES, stream, p);
    }
}
```
